# Optimizing an MI355X kernel written in HIP

```python
import jax, jax.numpy as jnp
from jax import lax
import numpy as np

D_MODEL = 1024
BATCH = 1
SEQ = 16384
DEPTH = 1

PLE_DIM = 256
GLA_HEADS = 4
GLA_DK = 64
GLA_DV = 128
GLA_LOWRANK = 16
GLA_TAU = 16.0
GLA_CHUNK = 64
MOBA_HEADS = 4
MOBA_HD = 128
MOBA_BLOCK = 256
MOBA_TOPK = 3
MOBA_QBLOCK = 128
ROPE_THETA = 10000.0
D_FF = 4 * D_MODEL
EPS = 1e-6

GLA_QK_W = GLA_HEADS * GLA_DK
GLA_V_W = GLA_HEADS * GLA_DV
MOBA_W = MOBA_HEADS * MOBA_HD
MIX_W = GLA_V_W + MOBA_W
SPLIT_SIZES = (GLA_QK_W, GLA_QK_W, GLA_V_W, GLA_V_W, GLA_LOWRANK, MOBA_W, MOBA_W, MOBA_W)
IN_W = 2 * GLA_QK_W + 2 * GLA_V_W + GLA_LOWRANK + 3 * MOBA_W

kernel_name = "hymba_gla_moba_sqrelu_ple"


def rms_norm(x, g):
    xf = x.astype(jnp.float32)
    y = xf * lax.rsqrt(jnp.mean(xf * xf, axis=-1, keepdims=True) + EPS)
    return (y * g.astype(jnp.float32)).astype(x.dtype)


def rope(x, positions):
    hd = x.shape[-1]
    half = hd // 2
    inv = 1.0 / (ROPE_THETA ** (jnp.arange(half, dtype=jnp.float32) / half))
    ang = positions.astype(jnp.float32)[:, None, :, None] * inv
    cos, sin = jnp.cos(ang), jnp.sin(ang)
    xf = x.astype(jnp.float32)
    x1, x2 = xf[..., :half], xf[..., half:]
    out = jnp.concatenate([x1 * cos - x2 * sin, x2 * cos + x1 * sin], axis=-1)
    return out.astype(x.dtype)


def gla_chunked(q, k, v, log_a):
    B, H, S, dk = q.shape
    dv = v.shape[-1]
    C = GLA_CHUNK
    nc = S // C
    q = q.reshape(B, H, nc, C, dk)
    k = k.reshape(B, H, nc, C, dk)
    v = v.reshape(B, H, nc, C, dv)
    g = log_a.reshape(B, H, nc, C, dk)
    b = jnp.cumsum(g, axis=3)
    b_last = b[:, :, :, -1:, :]
    q_dec = q * jnp.exp(b) * (dk ** -0.5)
    k_inv = k * jnp.exp(-b)
    causal = jnp.tril(jnp.ones((C, C), dtype=bool))
    A = jnp.einsum('bhncd,bhnjd->bhncj', q_dec, k_inv)
    A = jnp.where(causal, A, 0.0)
    o_intra = jnp.einsum('bhncj,bhnje->bhnce', A, v)
    k_to_end = k * jnp.exp(b_last - b)
    dS = jnp.einsum('bhncd,bhnce->bhnde', k_to_end, v)
    decay = jnp.exp(b_last[:, :, :, 0, :])

    def step(state, inp):
        ds_n, dec_n = inp
        return dec_n[..., None] * state + ds_n, state

    _, s_prev = lax.scan(step, jnp.zeros((B, H, dk, dv), jnp.float32),
                         (jnp.moveaxis(dS, 2, 0), jnp.moveaxis(decay, 2, 0)))
    s_prev = jnp.moveaxis(s_prev, 0, 2)
    o_inter = jnp.einsum('bhncd,bhnde->bhnce', q_dec, s_prev)
    return (o_intra + o_inter).reshape(B, H, S, dv)


def moba_attention(q, k, v):
    B, H, S, hd = q.shape
    BLK = MOBA_BLOCK
    QB = MOBA_QBLOCK
    nb = -(-S // BLK)
    pad = nb * BLK - S
    k_p = jnp.pad(k, ((0, 0), (0, 0), (0, pad), (0, 0)))
    v_p = jnp.pad(v, ((0, 0), (0, 0), (0, pad), (0, 0)))
    k_blocks = k_p.reshape(B, H, nb, BLK, hd)
    v_blocks = v_p.reshape(B, H, nb, BLK, hd)
    k_mean = jnp.mean(k_blocks.astype(jnp.float32), axis=3)
    n_sel = min(MOBA_TOPK, nb)
    nqb = S // QB
    q_blocks = q.reshape(B, H, nqb, QB, hd).transpose(2, 0, 1, 3, 4)
    scale = hd ** -0.5
    bi = jnp.arange(B)[:, None, None, None]
    hi = jnp.arange(H)[None, :, None, None]
    blk_ids = jnp.arange(nb)

    def one_block(args):
        qb, i = args
        q_start = i * QB
        kb = q_start // BLK
        qf = qb.astype(jnp.float32)
        gate = jnp.einsum('bhqd,bhnd->bhqn', qf, k_mean)
        gate = jnp.where(blk_ids < kb, gate, -jnp.inf)
        _, idx = lax.top_k(gate, n_sel)
        sel_valid = idx < kb
        k_sel = k_blocks[bi, hi, idx].astype(jnp.float32)
        v_sel = v_blocks[bi, hi, idx].astype(jnp.float32)
        s_sel = jnp.einsum('bhqd,bhqnkd->bhqnk', qf, k_sel) * scale
        s_sel = jnp.where(sel_valid[..., None], s_sel, -jnp.inf).reshape(B, H, QB, n_sel * BLK)
        k_own = lax.dynamic_index_in_dim(k_blocks, kb, axis=2, keepdims=False).astype(jnp.float32)
        v_own = lax.dynamic_index_in_dim(v_blocks, kb, axis=2, keepdims=False).astype(jnp.float32)
        s_own = jnp.einsum('bhqd,bhkd->bhqk', qf, k_own) * scale
        q_pos = q_start + jnp.arange(QB)
        k_pos = kb * BLK + jnp.arange(BLK)
        s_own = jnp.where(k_pos[None, :] <= q_pos[:, None], s_own, -jnp.inf)
        probs = jax.nn.softmax(jnp.concatenate([s_sel, s_own], axis=-1), axis=-1)
        p_sel = probs[..., :n_sel * BLK].reshape(B, H, QB, n_sel, BLK)
        p_own = probs[..., n_sel * BLK:]
        o = (jnp.einsum('bhqnk,bhqnkd->bhqd', p_sel, v_sel)
             + jnp.einsum('bhqk,bhkd->bhqd', p_own, v_own))
        return o.astype(q.dtype)

    out = lax.map(one_block, (q_blocks, jnp.arange(nqb)))
    return out.transpose(1, 2, 0, 3, 4).reshape(B, H, S, hd)


def setup_inputs(seed: int = 0) -> dict:
    key = jax.random.key(seed)
    ks = jax.random.split(key, 20)
    f32 = jnp.float32

    def nrm(k, shape, scale):
        return jax.random.normal(k, shape, f32) * scale

    def gain(k, shape):
        return 1.0 + 0.02 * jax.random.normal(k, shape, f32)

    L = DEPTH
    return {
        "x": nrm(ks[0], (BATCH, SEQ, D_MODEL), 1.0),
        "p": nrm(ks[1], (DEPTH, BATCH, SEQ, PLE_DIM), 1.0),
        "positions": jnp.broadcast_to(jnp.arange(SEQ, dtype=jnp.int32), (BATCH, SEQ)),
        "g_mix": gain(ks[2], (L, D_MODEL)),
        "w_in": nrm(ks[3], (L, D_MODEL, IN_W), D_MODEL ** -0.5),
        "w_gla_a2": nrm(ks[4], (L, GLA_LOWRANK, GLA_QK_W), GLA_LOWRANK ** -0.5),
        "b_gla_a": nrm(ks[5], (L, GLA_QK_W), 0.1),
        "g_gla_out": gain(ks[6], (L, GLA_DV)),
        "g_moba_q": gain(ks[7], (L, MOBA_HD)),
        "g_moba_k": gain(ks[8], (L, MOBA_HD)),
        "w_out": nrm(ks[9], (L, MIX_W, D_MODEL), MIX_W ** -0.5),
        "g_ffn": gain(ks[10], (L, D_MODEL)),
        "w_up": nrm(ks[11], (L, D_MODEL, D_FF), D_MODEL ** -0.5),
        "w_down": nrm(ks[12], (L, D_FF, D_MODEL), D_FF ** -0.5),
        "g_ple_gate": gain(ks[13], (L, D_MODEL)),
        "w_ple_gate": nrm(ks[14], (L, D_MODEL, D_MODEL), D_MODEL ** -0.5),
        "w_ple_proj": nrm(ks[15], (L, PLE_DIM, D_MODEL), PLE_DIM ** -0.5),
        "g_ple_emb": gain(ks[16], (L, D_MODEL)),
    }


def reference(x, p, positions, g_mix, w_in, w_gla_a2, b_gla_a, g_gla_out, g_moba_q, g_moba_k,
              w_out, g_ffn, w_up, w_down, g_ple_gate, w_ple_gate, w_ple_proj, g_ple_emb):
    B, S, _ = x.shape
    split_points = np.cumsum(SPLIT_SIZES)[:-1].tolist()

    def heads(t, n):
        return t.reshape(B, S, n, -1).transpose(0, 2, 1, 3)

    h = x
    for i in range(DEPTH):
        u = rms_norm(h, g_mix[i])
        z = u @ w_in[i]
        gq, gk, gv, gg, ga, mq, mk, mv = jnp.split(z, split_points, axis=-1)

        a_pre = (ga @ w_gla_a2[i] + b_gla_a[i]).astype(jnp.float32)
        log_a = jax.nn.log_sigmoid(a_pre) / GLA_TAU
        o_gla = gla_chunked(heads(gq, GLA_HEADS).astype(jnp.float32),
                            heads(gk, GLA_HEADS).astype(jnp.float32),
                            heads(gv, GLA_HEADS).astype(jnp.float32),
                            heads(log_a, GLA_HEADS))
        o_gla = rms_norm(o_gla, g_gla_out[i]).transpose(0, 2, 1, 3).reshape(B, S, GLA_V_W)
        o_gla = o_gla.astype(x.dtype) * jax.nn.silu(gg)

        q = rope(rms_norm(heads(mq, MOBA_HEADS), g_moba_q[i]), positions)
        k = rope(rms_norm(heads(mk, MOBA_HEADS), g_moba_k[i]), positions)
        v = heads(mv, MOBA_HEADS)
        o_moba = moba_attention(q, k, v).transpose(0, 2, 1, 3).reshape(B, S, MOBA_W)

        h = h + jnp.concatenate([o_gla, o_moba.astype(x.dtype)], axis=-1) @ w_out[i]

        f = rms_norm(h, g_ffn[i]) @ w_up[i]
        h = h + jnp.square(jax.nn.relu(f)) @ w_down[i]

        gate = jax.nn.sigmoid(rms_norm(h, g_ple_gate[i]) @ w_ple_gate[i])
        e = rms_norm(p[i] @ w_ple_proj[i], g_ple_emb[i])
        h = h + gate * e
    return h
```

```cpp
#include <hip/hip_runtime.h>
#include <math.h>
#include <stdint.h>

namespace nv {
constexpr int S = 16384, D = 1024, PLE = 256, INW = 3088, FF = 4096;
constexpr int C_GQ = 0, C_GK = 256, C_GV = 512, C_GG = 1024, C_GA = 1536, C_MQ = 1552, C_MK = 2064, C_MV = 2576;
constexpr float EPS = 1e-6f;

__device__ __forceinline__ float wave_sum(float v) {
#pragma unroll
    for (int o = 1; o < 64; o <<= 1) v += __shfl_xor(v, o);
    return v;
}
__device__ __forceinline__ float wave_max(float v) {
#pragma unroll
    for (int o = 1; o < 64; o <<= 1) v = fmaxf(v, __shfl_xor(v, o));
    return v;
}

__global__ void k_rmsnorm(const float* __restrict__ x, const float* __restrict__ g, float* __restrict__ out, int rows, int cols) {
    const int wave = (blockIdx.x * blockDim.x + threadIdx.x) >> 6, lane = threadIdx.x & 63;
    if (wave >= rows) return;
    const float* xr = x + (size_t)wave * cols;
    float ss = 0.f;
    for (int c = lane; c < cols; c += 64) { const float v = xr[c]; ss += v * v; }
    ss = wave_sum(ss);
    const float r = 1.0f / sqrtf(ss / (float)cols + EPS);
    for (int c = lane; c < cols; c += 64) out[(size_t)wave * cols + c] = xr[c] * r * g[c];
}

template <int ACT>
__global__ void __launch_bounds__(256) k_gemm(const float* __restrict__ A, int lda, const float* __restrict__ B, int ldb, float* __restrict__ C, int ldc,
                                               const float* __restrict__ R, int M, int N, int K) {
    __shared__ float As[16][65];
    __shared__ float Bs[16][65];
    const int tid = threadIdx.x, tx = tid & 15, ty = tid >> 4;
    const int row0 = blockIdx.y * 64, col0 = blockIdx.x * 64;
    float acc[4][4];
#pragma unroll
    for (int i = 0; i < 4; ++i)
#pragma unroll
        for (int j = 0; j < 4; ++j) acc[i][j] = 0.f;
    for (int k0 = 0; k0 < K; k0 += 16) {
#pragma unroll
        for (int i = 0; i < 4; ++i) {
            const int idx = tid + 256 * i;
            const int r = idx >> 4, kk = idx & 15;
            As[kk][r] = A[(size_t)(row0 + r) * lda + k0 + kk];
            const int kb = idx >> 6, c = idx & 63;
            Bs[kb][c] = (col0 + c < N) ? B[(size_t)(k0 + kb) * ldb + col0 + c] : 0.f;
        }
        __syncthreads();
#pragma unroll
        for (int kk = 0; kk < 16; ++kk) {
            float a[4], b[4];
#pragma unroll
            for (int i = 0; i < 4; ++i) { a[i] = As[kk][ty * 4 + i]; b[i] = Bs[kk][tx * 4 + i]; }
#pragma unroll
            for (int i = 0; i < 4; ++i)
#pragma unroll
                for (int j = 0; j < 4; ++j) acc[i][j] += a[i] * b[j];
        }
        __syncthreads();
    }
#pragma unroll
    for (int i = 0; i < 4; ++i)
#pragma unroll
        for (int j = 0; j < 4; ++j) {
            const int r = row0 + ty * 4 + i, c = col0 + tx * 4 + j;
            if (c < N) {
                float v = acc[i][j];
                if (ACT == 1) { v = fmaxf(v, 0.f); v = v * v; }
                if (ACT == 2) v += R[(size_t)r * ldc + c];
                C[(size_t)r * ldc + c] = v;
            }
        }
}

__global__ void k_gla_prep(const float* __restrict__ z, const float* __restrict__ w_a2, const float* __restrict__ b_a, float* __restrict__ a_out) {
    const int idx = blockIdx.x * blockDim.x + threadIdx.x;
    if (idx >= S * 256) return;
    const int t = idx >> 8, c = idx & 255;
    float s = b_a[c];
#pragma unroll
    for (int r = 0; r < 16; ++r) s += z[(size_t)t * INW + C_GA + r] * w_a2[r * 256 + c];
    const float ls = fminf(s, 0.f) - log1pf(expf(-fabsf(s)));
    a_out[idx] = expf(ls * (1.0f / 16.0f));
}

__global__ void __launch_bounds__(64) k_gla_rec(const float* __restrict__ z, const float* __restrict__ a, float* __restrict__ o_raw) {
    const int h = blockIdx.x >> 1, e = (blockIdx.x & 1) * 64 + threadIdx.x;
    float St[64];
#pragma unroll
    for (int d = 0; d < 64; ++d) St[d] = 0.f;
    for (int t = 0; t < S; ++t) {
        const float* zr = z + (size_t)t * INW;
        const float v = zr[C_GV + h * 128 + e];
        const float* qr = zr + C_GQ + h * 64;
        const float* kr = zr + C_GK + h * 64;
        const float* ar = a + (size_t)t * 256 + h * 64;
        float o = 0.f;
#pragma unroll
        for (int d = 0; d < 64; ++d) {
            St[d] = ar[d] * St[d] + kr[d] * v;
            o += qr[d] * St[d];
        }
        o_raw[(size_t)t * 512 + h * 128 + e] = o * 0.125f;
    }
}

__global__ void k_gla_post(const float* __restrict__ o_raw, const float* __restrict__ z, const float* __restrict__ g_out, float* __restrict__ mix) {
    const int wave = (blockIdx.x * blockDim.x + threadIdx.x) >> 6, lane = threadIdx.x & 63;
    if (wave >= S * 4) return;
    const int t = wave >> 2, h = wave & 3;
    const float o0 = o_raw[(size_t)t * 512 + h * 128 + lane], o1 = o_raw[(size_t)t * 512 + h * 128 + 64 + lane];
    const float ss = wave_sum(o0 * o0 + o1 * o1);
    const float r = 1.0f / sqrtf(ss * (1.0f / 128.0f) + EPS);
    const float g0 = z[(size_t)t * INW + C_GG + h * 128 + lane], g1 = z[(size_t)t * INW + C_GG + h * 128 + 64 + lane];
    mix[(size_t)t * D + h * 128 + lane] = o0 * r * g_out[lane] * (g0 / (1.0f + expf(-g0)));
    mix[(size_t)t * D + h * 128 + 64 + lane] = o1 * r * g_out[64 + lane] * (g1 / (1.0f + expf(-g1)));
}

__device__ __forceinline__ void sincos_acc(float angf, float& s, float& c) {
    double r = (double)angf * 0.15915494309189533577;
    r -= floor(r);
    const double q = floor(4.0 * r + 0.5);
    const float phi = (float)((r - 0.25 * q) * 6.283185307179586477);
    const float p2 = phi * phi;
    const float sn = phi * (1.0f + p2 * (-1.0f / 6.0f + p2 * (1.0f / 120.0f + p2 * (-1.0f / 5040.0f + p2 * (1.0f / 362880.0f)))));
    const float cs = 1.0f + p2 * (-0.5f + p2 * (1.0f / 24.0f + p2 * (-1.0f / 720.0f + p2 * (1.0f / 40320.0f + p2 * (-1.0f / 3628800.0f)))));
    const int qi = ((int)q) & 3;
    s = (qi == 0) ? sn : (qi == 1) ? cs : (qi == 2) ? -sn : -cs;
    c = (qi == 0) ? cs : (qi == 1) ? -sn : (qi == 2) ? -cs : sn;
}

__global__ void k_moba_qk(float* __restrict__ z, const int* __restrict__ pos, const float* __restrict__ gq, const float* __restrict__ gk) {
    const int wave = (blockIdx.x * blockDim.x + threadIdx.x) >> 6, lane = threadIdx.x & 63;
    if (wave >= S * 8) return;
    const int t = wave >> 3, h = (wave >> 1) & 3, which = wave & 1;
    float* p = z + (size_t)t * INW + (which ? C_MK : C_MQ) + h * 128;
    const float* g = which ? gk : gq;
    const float x1 = p[lane], x2 = p[lane + 64];
    const float ss = wave_sum(x1 * x1 + x2 * x2);
    const float r = 1.0f / sqrtf(ss * (1.0f / 128.0f) + EPS);
    const float y1 = x1 * r * g[lane], y2 = x2 * r * g[lane + 64];
    const float inv = 1.0f / powf(10000.0f, (float)lane / 64.0f);
    const float ang = (float)pos[t] * inv;
    float sn, cs; sincos_acc(ang, sn, cs);
    p[lane] = y1 * cs - y2 * sn;
    p[lane + 64] = y2 * cs + y1 * sn;
}

__global__ void k_moba_kmean(const float* __restrict__ z, float* __restrict__ kmean) {
    const int h = blockIdx.x >> 6, blk = blockIdx.x & 63, d = threadIdx.x;
    float s = 0.f;
    for (int i = 0; i < 256; ++i) s += z[(size_t)(blk * 256 + i) * INW + C_MK + h * 128 + d];
    kmean[(size_t)(h * 64 + blk) * 128 + d] = s * (1.0f / 256.0f);
}

__global__ void __launch_bounds__(256) k_moba_attn(const float* __restrict__ z, const float* __restrict__ kmean, float* __restrict__ mix) {
    __shared__ float pl[4][1024];
    const int w = threadIdx.x >> 6, lane = threadIdx.x & 63;
    const int wave = blockIdx.x * 4 + w;
    const int q = wave >> 2, h = wave & 3;
    const int kb = q >> 8;
    const float* qrow = z + (size_t)q * INW + C_MQ + h * 128;
    const float scale = 0.08838834764831845f;
    float g = -INFINITY;
    if (lane < kb) {
        const float* km = kmean + (size_t)(h * 64 + lane) * 128;
        float s = 0.f;
        for (int d = 0; d < 128; ++d) s += qrow[d] * km[d];
        g = s;
    }
    int sel[3];
#pragma unroll
    for (int r = 0; r < 3; ++r) {
        const float m = wave_max(g);
        const unsigned long long bal = __ballot(g == m);
        const int idx = __ffsll((long long)bal) - 1;
        sel[r] = (m > -INFINITY) ? idx : -1;
        if (lane == idx) g = -INFINITY;
    }
    float sc[16];
#pragma unroll
    for (int seg = 0; seg < 4; ++seg) {
        const int blk = (seg < 3) ? sel[seg] : kb;
#pragma unroll
        for (int r = 0; r < 4; ++r) {
            float s = -INFINITY;
            if (blk >= 0) {
                const int key = blk * 256 + r * 64 + lane;
                if (seg < 3 || key <= q) {
                    const float* kr = z + (size_t)key * INW + C_MK + h * 128;
                    float a = 0.f;
                    for (int d = 0; d < 128; ++d) a += qrow[d] * kr[d];
                    s = a * scale;
                }
            }
            sc[seg * 4 + r] = s;
        }
    }
    float m = sc[0];
#pragma unroll
    for (int i = 1; i < 16; ++i) m = fmaxf(m, sc[i]);
    m = wave_max(m);
    float sum = 0.f;
#pragma unroll
    for (int i = 0; i < 16; ++i) { const float p = (sc[i] > -INFINITY) ? expf(sc[i] - m) : 0.f; sum += p; pl[w][i * 64 + lane] = p; }
    sum = wave_sum(sum);
    __syncthreads();
    float a0 = 0.f, a1 = 0.f;
#pragma unroll
    for (int seg = 0; seg < 4; ++seg) {
        const int blk = (seg < 3) ? sel[seg] : kb;
        if (blk < 0) continue;
        const int nk = (seg < 3) ? 256 : ((q & 255) + 1);
        for (int i = 0; i < nk; ++i) {
            const float p = pl[w][seg * 256 + i];
            const float* vr = z + (size_t)(blk * 256 + i) * INW + C_MV + h * 128;
            a0 += p * vr[lane]; a1 += p * vr[lane + 64];
        }
    }
    const float inv = 1.0f / sum;
    mix[(size_t)q * D + 512 + h * 128 + lane] = a0 * inv;
    mix[(size_t)q * D + 512 + h * 128 + 64 + lane] = a1 * inv;
}

__global__ void k_final(float* __restrict__ out, const float* __restrict__ gp, const float* __restrict__ e, const float* __restrict__ g) {
    const int wave = (blockIdx.x * blockDim.x + threadIdx.x) >> 6, lane = threadIdx.x & 63;
    if (wave >= S) return;
    const float* er = e + (size_t)wave * D;
    float ss = 0.f;
    for (int c = lane; c < D; c += 64) ss += er[c] * er[c];
    ss = wave_sum(ss);
    const float r = 1.0f / sqrtf(ss * (1.0f / D) + EPS);
    for (int c = lane; c < D; c += 64) {
        const float gv = gp[(size_t)wave * D + c];
        out[(size_t)wave * D + c] += (1.0f / (1.0f + expf(-gv))) * (er[c] * r * g[c]);
    }
}
}

extern "C" void kernel_launch(void* const* d_in, const int* in_sizes, int n_in, void* d_out, int out_size, void* d_ws, size_t ws_size, hipStream_t stream) {
    using namespace nv;
    const float* x = (const float*)d_in[0];
    const float* p = (const float*)d_in[1];
    const int* pos = (const int*)d_in[2];
    const float* g_mix = (const float*)d_in[3];
    const float* w_in = (const float*)d_in[4];
    const float* w_a2 = (const float*)d_in[5];
    const float* b_a = (const float*)d_in[6];
    const float* g_gla = (const float*)d_in[7];
    const float* g_mq = (const float*)d_in[8];
    const float* g_mk = (const float*)d_in[9];
    const float* w_out = (const float*)d_in[10];
    const float* g_ffn = (const float*)d_in[11];
    const float* w_up = (const float*)d_in[12];
    const float* w_down = (const float*)d_in[13];
    const float* g_pg = (const float*)d_in[14];
    const float* w_pg = (const float*)d_in[15];
    const float* w_pp = (const float*)d_in[16];
    const float* g_pe = (const float*)d_in[17];
    float* out = (float*)d_out;
    char* ws = (char*)d_ws;
    const size_t MiB = 1u << 20;
    float* zb = (float*)ws;
    float* ab = (float*)(ws + 194 * MiB);
    float* orawb = (float*)(ws + 210 * MiB);
    float* kmean = (float*)(ws + 242 * MiB);
    float* h1 = (float*)ws;
    float* hn = (float*)(ws + 64 * MiB);
    float* fb = (float*)(ws + 128 * MiB);
    float* eb = (float*)(ws + 192 * MiB);
    k_rmsnorm<<<S / 4, 256, 0, stream>>>(x, g_mix, out, S, D);
    k_gemm<0><<<dim3((INW + 63) / 64, S / 64), 256, 0, stream>>>(out, D, w_in, INW, zb, INW, nullptr, S, INW, D);
    k_gla_prep<<<S * 256 / 256, 256, 0, stream>>>(zb, w_a2, b_a, ab);
    k_gla_rec<<<8, 64, 0, stream>>>(zb, ab, orawb);
    k_gla_post<<<S * 4 / 4, 256, 0, stream>>>(orawb, zb, g_gla, out);
    k_moba_qk<<<S * 8 / 4, 256, 0, stream>>>(zb, pos, g_mq, g_mk);
    k_moba_kmean<<<256, 128, 0, stream>>>(zb, kmean);
    k_moba_attn<<<S * 4 / 4, 256, 0, stream>>>(zb, kmean, out);
    k_gemm<2><<<dim3(D / 64, S / 64), 256, 0, stream>>>(out, D, w_out, D, h1, D, x, S, D, D);
    k_rmsnorm<<<S / 4, 256, 0, stream>>>(h1, g_ffn, hn, S, D);
    for (int c = 0; c < 4; ++c) {
        const size_t ro = (size_t)c * 4096;
        k_gemm<1><<<dim3(FF / 64, 4096 / 64), 256, 0, stream>>>(hn + ro * D, D, w_up, FF, fb, FF, nullptr, 4096, FF, D);
        k_gemm<2><<<dim3(D / 64, 4096 / 64), 256, 0, stream>>>(fb, FF, w_down, D, out + ro * D, D, h1 + ro * D, 4096, D, FF);
    }
    k_rmsnorm<<<S / 4, 256, 0, stream>>>(out, g_pg, hn, S, D);
    k_gemm<0><<<dim3(D / 64, S / 64), 256, 0, stream>>>(hn, D, w_pg, D, fb, D, nullptr, S, D, D);
    k_gemm<0><<<dim3(D / 64, S / 64), 256, 0, stream>>>(p, PLE, w_pp, D, eb, D, nullptr, S, D, PLE);
    k_final<<<S / 4, 256, 0, stream>>>(out, fb, eb, g_pe);
}
```

```cpp
#include <hip/hip_runtime.h>
#include <cstdio>
#include <cstdint>
#include <math.h>
namespace pg8 {
#define PG8_LAS __attribute__((address_space(3)))
typedef unsigned short bf16_t;
typedef short bf16x8 __attribute__((ext_vector_type(8)));
typedef float f32x4 __attribute__((ext_vector_type(4)));
typedef unsigned u32x4 __attribute__((ext_vector_type(4)));
constexpr int BM = 256, BK = 64, HALF = 128, HTB = HALF * BK * 2  , STAGE_BYTES = 8 * HTB, NXCD = 8, WGM = 8;

__host__ __device__ __forceinline__ int lds_byte(int r, int c) { const int st = (r >> 4) * 2 + (c >> 5), rr = r & 15, cc = c & 31, ob = rr * 64 + cc * 2; return st * 1024 + (ob ^ (((ob >> 9) & 1) << 5)); }
__host__ __device__ __forceinline__ void stage_rc(int b, int& R, int& C) { const int st = b / 1024, sb = b % 1024, swz = sb ^ (((sb >> 9) & 1) << 5); R = (st >> 1) * 16 + swz / 64; C = (st & 1) * 32 + (swz % 64) / 2; }
__host__ __device__ __forceinline__ int perm32(int rho) { const int n = rho >> 4, i = rho & 15; return 8 * (i >> 2) + 4 * n + (i & 3); }

struct Unit { int pm, pn; };
struct Gemm { const bf16_t* A; const bf16_t* Bt; int M, N, K; };

struct StaticOrder {
    int nM, nN, nwg, G, c;
    __host__ __device__ void init(int M, int N, int G_, int c_) { nM = M / BM; nN = N / BM; nwg = nM * nN; G = G_; c = c_; }
    __host__ __device__ bool next(int i, Unit& u) const {
        const long L = (long)i * G + c; if (L >= nwg) return false;
        int wgid = (int)L; { const int q = nwg / NXCD, r = nwg % NXCD, xcd = wgid % NXCD, off = wgid / NXCD; wgid = (xcd < r ? xcd * (q + 1) : r * (q + 1) + (xcd - r) * q) + off; }
        const int nig = WGM * nN, gid = wgid / nig, fm = gid * WGM, gsz = (nM - fm) < WGM ? (nM - fm) : WGM;
        u.pm = fm + ((wgid % nig) % gsz); u.pn = (wgid % nig) / gsz; return true;
    }
    __device__ __forceinline__ void a_ready(const Unit&) const {}
    __device__ __forceinline__ void done(const Unit&) const {}
};

__device__ __forceinline__ unsigned cvt_pk_bf16(float lo, float hi) { unsigned r; asm volatile("v_cvt_pk_bf16_f32 %0, %1, %2" : "=v"(r) : "v"(lo), "v"(hi)); return r; }
typedef float f32x2 __attribute__((ext_vector_type(2)));

__device__ __forceinline__ float rstd_from_part(const float* part, int row, float inv_n, float eps) {
    const f32x4 p = *(const f32x4*)(part + (size_t)row * 4);
    return 1.0f / sqrtf(((p[0] + p[1]) + (p[2] + p[3])) * inv_n + eps);
}
template <int ACT, int RS> struct EpiScale {
    static constexpr bool PERM = true, AFTER_DRAIN = false;
    bf16_t* O; int ldc; const float* rsv; float eps;
    __device__ __forceinline__ void operator()(const f32x4 (&acc)[2][2][4][2], const Unit& u, int wr, int wc, int fr, int fq) const {
        const int row0 = u.pm * BM + wr * 64 + fr, col0 = u.pn * BM + wc * 32 + 8 * fq;
#pragma unroll
        for (int ai = 0; ai < 2; ++ai)
#pragma unroll
            for (int m = 0; m < 4; ++m) {
                const int row = row0 + ai * HALF + m * 16;
                float s = 1.f;
                if (RS == 1) s = rsv[row];
                if (RS == 2) s = rstd_from_part(rsv, row, 1.0f / 1024.0f, eps);
                bf16_t* rowp = O + (size_t)row * ldc + col0;
#pragma unroll
                for (int bj = 0; bj < 2; ++bj) {
                    f32x4 v0 = acc[ai][bj][m][0] * s, v1 = acc[ai][bj][m][1] * s;
                    if (ACT == 1) {
#pragma unroll
                        for (int e = 0; e < 4; ++e) { const float a = fmaxf(v0[e], 0.f), b = fmaxf(v1[e], 0.f); v0[e] = a * a; v1[e] = b * b; }
                    }
                    u32x4 w; w.x = cvt_pk_bf16(v0[0], v0[1]); w.y = cvt_pk_bf16(v0[2], v0[3]); w.z = cvt_pk_bf16(v1[0], v1[1]); w.w = cvt_pk_bf16(v1[2], v1[3]);
                    *(u32x4*)(rowp + bj * HALF) = w;
                }
            }
    }
};
template <bool RES> struct EpiRes {
    static constexpr bool PERM = true, AFTER_DRAIN = true;
    const float* base; float* out; bf16_t* hb; float* part; int ldc;
    __device__ __forceinline__ void fused(f32x4 (&acc)[2][2][4][2], const Unit& u, int wr, int wc, int fr, int fq, PG8_LAS unsigned char* lds, int wid, int lane) const {
        PG8_LAS float* P = (PG8_LAS float*)lds;
        const int row0 = u.pm * BM + wr * 64 + fr, col0 = u.pn * BM + wc * 32 + 8 * fq;
#pragma unroll
        for (int ai = 0; ai < 2; ++ai)
#pragma unroll
            for (int m = 0; m < 4; ++m) {
                const int row = row0 + ai * HALF + m * 16;
                const size_t off = (size_t)row * ldc + col0;
                float q = 0.f;
#pragma unroll
                for (int bj = 0; bj < 2; ++bj) {
                    f32x4 v0 = acc[ai][bj][m][0], v1 = acc[ai][bj][m][1];
                    if (RES) {
                        const f32x4 b0 = *(const f32x4*)(base + off + bj * HALF), b1 = *(const f32x4*)(base + off + bj * HALF + 4);
                        v0 = v0 + b0; v1 = v1 + b1;
                        *(f32x4*)(out + off + bj * HALF) = v0; *(f32x4*)(out + off + bj * HALF + 4) = v1;
                    }
                    u32x4 w; w.x = cvt_pk_bf16(v0[0], v0[1]); w.y = cvt_pk_bf16(v0[2], v0[3]); w.z = cvt_pk_bf16(v1[0], v1[1]); w.w = cvt_pk_bf16(v1[2], v1[3]);
                    *(u32x4*)(hb + off + bj * HALF) = w;
                    q += (v0[0] * v0[0] + v0[1] * v0[1]) + (v0[2] * v0[2] + v0[3] * v0[3]) + (v1[0] * v1[0] + v1[1] * v1[1]) + (v1[2] * v1[2] + v1[3] * v1[3]);
                }
                q += __shfl_xor(q, 16); q += __shfl_xor(q, 32);
                if (fq == 0) P[(ai * HALF + wr * 64 + m * 16 + fr) * 4 + wc] = q;
            }
        asm volatile("s_waitcnt lgkmcnt(0)" ::: "memory"); __builtin_amdgcn_s_barrier(); asm volatile("" ::: "memory");
        const int tid = wid * 64 + lane;
        if (tid < 256) { const f32x4 p = ((const PG8_LAS f32x4*)lds)[tid]; part[(size_t)(u.pm * BM + tid) * 4 + u.pn] = (p[0] + p[1]) + (p[2] + p[3]); }
        asm volatile("s_waitcnt lgkmcnt(0)" ::: "memory"); __builtin_amdgcn_s_barrier(); asm volatile("" ::: "memory");
    }
};
struct EpiGate {
    static constexpr bool PERM = true, AFTER_DRAIN = false;
    float* out; const bf16_t* eraw; const float* part_h; const float* part_e; const float* g_emb; int ldc; float eps;
    __device__ __forceinline__ void operator()(const f32x4 (&acc)[2][2][4][2], const Unit& u, int wr, int wc, int fr, int fq) const {
        const int row0 = u.pm * BM + wr * 64 + fr, col0 = u.pn * BM + wc * 32 + 8 * fq;
        f32x4 gv[2][2];
#pragma unroll
        for (int bj = 0; bj < 2; ++bj) { gv[bj][0] = *(const f32x4*)(g_emb + col0 + bj * HALF); gv[bj][1] = *(const f32x4*)(g_emb + col0 + bj * HALF + 4); }
#pragma unroll
        for (int ai = 0; ai < 2; ++ai)
#pragma unroll
            for (int m = 0; m < 4; ++m) {
                const int row = row0 + ai * HALF + m * 16;
                const size_t off = (size_t)row * ldc + col0;
                const float sh = rstd_from_part(part_h, row, 1.0f / 1024.0f, eps), se = rstd_from_part(part_e, row, 1.0f / 1024.0f, eps);
#pragma unroll
                for (int bj = 0; bj < 2; ++bj) {
                    const u32x4 ew = *(const u32x4*)(eraw + off + bj * HALF);
                    f32x4 e0, e1;
                    e0[0] = __uint_as_float(ew.x << 16); e0[1] = __uint_as_float(ew.x & 0xffff0000u); e0[2] = __uint_as_float(ew.y << 16); e0[3] = __uint_as_float(ew.y & 0xffff0000u);
                    e1[0] = __uint_as_float(ew.z << 16); e1[1] = __uint_as_float(ew.z & 0xffff0000u); e1[2] = __uint_as_float(ew.w << 16); e1[3] = __uint_as_float(ew.w & 0xffff0000u);
                    f32x4 h0 = *(const f32x4*)(out + off + bj * HALF), h1 = *(const f32x4*)(out + off + bj * HALF + 4);
                    const f32x4 a0 = acc[ai][bj][m][0] * sh, a1 = acc[ai][bj][m][1] * sh;
#pragma unroll
                    for (int e = 0; e < 4; ++e) {
                        const float g0 = 1.0f / (1.0f + __expf(-a0[e])), g1 = 1.0f / (1.0f + __expf(-a1[e]));
                        h0[e] += g0 * (e0[e] * se * gv[bj][0][e]); h1[e] += g1 * (e1[e] * se * gv[bj][1][e]);
                    }
                    *(f32x4*)(out + off + bj * HALF) = h0; *(f32x4*)(out + off + bj * HALF + 4) = h1;
                }
            }
    }
};
template <class Epi, class Sched, bool ALIGN_EPI = false, bool SP2 = false>
__device__ __forceinline__ void gemm_phase(PG8_LAS unsigned char* lds, const Gemm g, const Sched& S, const Epi& E) {
    const int tid = threadIdx.x, wid = __builtin_amdgcn_readfirstlane(tid >> 6), lane = tid & 63, wr = wid >> 2, wc = wid & 3, fr = lane & 15, fq = lane >> 4;
    const int K = g.K, nt = K / BK;
    unsigned voffA[2], voffB[2];
#pragma unroll
    for (int i = 0; i < 2; ++i) { int R, C; stage_rc(tid * 16 + i * 8192, R, C); const int Rb = Epi::PERM ? ((R & ~31) + perm32(R & 31)) : R;
        voffA[i] = (unsigned)(R * K + C) * 2u; voffB[i] = (unsigned)(Rb * K + C) * 2u; }
    const size_t kstep = (size_t)(BK * 2);
    const size_t hstep = (size_t)HALF * K * 2;
    const size_t tstep = 2 * hstep;
    const unsigned ldsw = (unsigned)wid * 1024u;
    const int aoff = lds_byte(wr * 64 + fr, fq * 8), boff = lds_byte(wc * 32 + fr, fq * 8);
#define PG8_SA(b, h) (((b) * 2 + (h)) * HTB)
#define PG8_SB(b, h) ((4 + (b) * 2 + (h)) * HTB)
#define PG8_STAGE(bufoff, gbase, voff) do { _Pragma("unroll") for (int _i = 0; _i < 2; ++_i) \
        __builtin_amdgcn_global_load_lds((const unsigned*)((const char*)(gbase) + (voff)[_i]), (PG8_LAS unsigned*)(lds + (bufoff) + ldsw + _i * 8192), 16, 0, 0); } while (0)
#define PG8_LDA(dst, b, h) do { _Pragma("unroll") for (int m = 0; m < 4; ++m) _Pragma("unroll") for (int k = 0; k < 2; ++k) dst[m][k] = *(const PG8_LAS bf16x8*)(lds + PG8_SA(b, h) + aoff + m * 2048 + k * 1024); } while (0)
#define PG8_LDB(dst, b, h) do { _Pragma("unroll") for (int n = 0; n < 2; ++n) _Pragma("unroll") for (int k = 0; k < 2; ++k) dst[n][k] = *(const PG8_LAS bf16x8*)(lds + PG8_SB(b, h) + boff + n * 2048 + k * 1024); } while (0)
#define PG8_MMA(ai, bj, At, Bt) do { __builtin_amdgcn_s_setprio(1); _Pragma("unroll") for (int m = 0; m < 4; ++m) _Pragma("unroll") for (int n = 0; n < 2; ++n) _Pragma("unroll") for (int k = 0; k < 2; ++k) \
        acc[ai][bj][m][n] = __builtin_amdgcn_mfma_f32_16x16x32_bf16(Bt[n][k], At[m][k], acc[ai][bj][m][n], 0, 0, 0); __builtin_amdgcn_s_setprio(0); } while (0)
#define PG8_WAIT_V(n) asm volatile("s_waitcnt vmcnt(" #n ")" ::: "memory")
#define PG8_WAIT_L(n) asm volatile("s_waitcnt lgkmcnt(" #n ")" ::: "memory")
#define PG8_BAR __builtin_amdgcn_s_barrier()
#define PG8_SCHED __builtin_amdgcn_sched_barrier(0)
    Unit cur, nxt; int ui = 0;
    if (!S.next(0, cur)) return;
    f32x4 acc[2][2][4][2];
#pragma unroll
    for (int a = 0; a < 2; ++a)
#pragma unroll
        for (int b = 0; b < 2; ++b)
#pragma unroll
            for (int m = 0; m < 4; ++m)
#pragma unroll
                for (int n = 0; n < 2; ++n) acc[a][b][m][n] = (f32x4){0.f, 0.f, 0.f, 0.f};
    bf16x8 At[4][2], B0[2][2], B1[2][2];
    const char* cA = (const char*)g.A + (size_t)cur.pm * tstep; const char* cB = (const char*)g.Bt + (size_t)cur.pn * tstep;
    S.a_ready(cur);
    if constexpr (SP2) {
        PG8_STAGE(PG8_SB(0, 0), cB, voffB); PG8_STAGE(PG8_SB(0, 1), cB + hstep, voffB); PG8_STAGE(PG8_SA(0, 0), cA, voffA); PG8_STAGE(PG8_SA(0, 1), cA + hstep, voffA);
        if (wr == 1) PG8_BAR;
        PG8_WAIT_V(2); PG8_BAR;
        PG8_STAGE(PG8_SB(1, 0), cB + kstep, voffB); PG8_STAGE(PG8_SA(1, 0), cA + kstep, voffA); PG8_STAGE(PG8_SB(1, 1), cB + hstep + kstep, voffB);
        PG8_WAIT_V(6); PG8_BAR;
    } else {
        PG8_STAGE(PG8_SB(0, 0), cB, voffB); PG8_STAGE(PG8_SA(0, 0), cA, voffA); PG8_STAGE(PG8_SB(0, 1), cB + hstep, voffB); PG8_STAGE(PG8_SA(0, 1), cA + hstep, voffA);
        if (wr == 1) PG8_BAR;
        PG8_WAIT_V(4); PG8_BAR;
        PG8_STAGE(PG8_SB(1, 0), cB + kstep, voffB); PG8_STAGE(PG8_SA(1, 0), cA + kstep, voffA); PG8_STAGE(PG8_SB(1, 1), cB + hstep + kstep, voffB);
        PG8_WAIT_V(6); PG8_BAR;
    }
    for (;;) {
        const bool has_next = S.next(ui + 1, nxt);
        const char* nA = has_next ? (const char*)g.A + (size_t)nxt.pm * tstep : cA; const char* nB = has_next ? (const char*)g.Bt + (size_t)nxt.pn * tstep : cB;
        for (int t = 0; t < nt; t += 2) {
            const bool last = (t == nt - 2);
            const char* a1 = cA + (size_t)(t + 1) * kstep;
            const char* a2 = last ? nA : cA + (size_t)(t + 2) * kstep; const char* b2 = last ? nB : cB + (size_t)(t + 2) * kstep;
            const char* a3 = a2 + kstep; const char* b3 = b2 + kstep;
            if (last && has_next) S.a_ready(nxt);
            if constexpr (SP2) {
            PG8_LDB(B0, 0, 0); PG8_LDB(B1, 0, 1); PG8_SCHED; PG8_LDA(At, 0, 0); PG8_STAGE(PG8_SA(1, 1), a1 + hstep, voffA);
            PG8_WAIT_V(8); PG8_WAIT_L(0); PG8_BAR; PG8_MMA(0, 0, At, B0); PG8_MMA(0, 1, At, B1); PG8_BAR; PG8_SCHED;
            PG8_LDA(At, 0, 1); PG8_STAGE(PG8_SB(0, 0), b2, voffB); PG8_STAGE(PG8_SB(0, 1), b2 + hstep, voffB); PG8_STAGE(PG8_SA(0, 0), a2, voffA);
            PG8_WAIT_V(8); PG8_WAIT_L(0); PG8_BAR; PG8_MMA(1, 0, At, B0); PG8_MMA(1, 1, At, B1); PG8_BAR; PG8_SCHED;
            PG8_LDB(B0, 1, 0); PG8_LDB(B1, 1, 1); PG8_SCHED; PG8_LDA(At, 1, 0); PG8_STAGE(PG8_SA(0, 1), a2 + hstep, voffA);
            PG8_WAIT_V(8); PG8_WAIT_L(0); PG8_BAR; PG8_MMA(0, 0, At, B0); PG8_MMA(0, 1, At, B1); PG8_BAR; PG8_SCHED;
            PG8_LDA(At, 1, 1); PG8_STAGE(PG8_SB(1, 0), b3, voffB); PG8_STAGE(PG8_SB(1, 1), b3 + hstep, voffB); PG8_STAGE(PG8_SA(1, 0), a3, voffA);
            PG8_WAIT_V(8); PG8_WAIT_L(0); PG8_BAR; PG8_MMA(1, 0, At, B0); PG8_MMA(1, 1, At, B1); PG8_BAR; PG8_SCHED;
            } else {
            PG8_LDB(B0, 0, 0); PG8_SCHED; PG8_LDA(At, 0, 0); PG8_STAGE(PG8_SA(1, 1), a1 + hstep, voffA);
            PG8_WAIT_L(8); PG8_BAR; PG8_WAIT_L(0); PG8_MMA(0, 0, At, B0); PG8_BAR; PG8_SCHED;
            PG8_LDB(B1, 0, 1); PG8_STAGE(PG8_SB(0, 0), b2, voffB);
            PG8_BAR; PG8_WAIT_L(0); PG8_MMA(0, 1, At, B1); PG8_BAR;
            PG8_LDA(At, 0, 1); PG8_STAGE(PG8_SA(0, 0), a2, voffA);
            PG8_BAR; PG8_WAIT_L(0); PG8_MMA(1, 0, At, B0); PG8_BAR; PG8_SCHED;
            PG8_STAGE(PG8_SB(0, 1), b2 + hstep, voffB);
            PG8_WAIT_V(6); PG8_BAR; PG8_MMA(1, 1, At, B1); PG8_BAR;
            PG8_LDB(B0, 1, 0); PG8_SCHED; PG8_LDA(At, 1, 0); PG8_STAGE(PG8_SA(0, 1), a2 + hstep, voffA);
            PG8_WAIT_L(8); PG8_BAR; PG8_WAIT_L(0); PG8_MMA(0, 0, At, B0); PG8_BAR; PG8_SCHED;
            PG8_LDB(B1, 1, 1); PG8_STAGE(PG8_SB(1, 0), b3, voffB);
            PG8_BAR; PG8_WAIT_L(0); PG8_MMA(0, 1, At, B1); PG8_BAR;
            PG8_LDA(At, 1, 1); PG8_STAGE(PG8_SA(1, 0), a3, voffA);
            PG8_BAR; PG8_WAIT_L(0); PG8_MMA(1, 0, At, B0); PG8_BAR; PG8_SCHED;
            PG8_STAGE(PG8_SB(1, 1), b3 + hstep, voffB);
            PG8_WAIT_V(6); PG8_BAR; PG8_MMA(1, 1, At, B1); PG8_BAR;
            }
        }
        if constexpr (ALIGN_EPI) { if (wr == 0) PG8_BAR; }
        if constexpr (!Epi::AFTER_DRAIN) { E(acc, cur, wr, wc, fr, fq); S.done(cur); }
        if (!has_next) break;
#pragma unroll
        for (int a = 0; a < 2; ++a)
#pragma unroll
            for (int b = 0; b < 2; ++b)
#pragma unroll
                for (int m = 0; m < 4; ++m)
#pragma unroll
                    for (int n = 0; n < 2; ++n) acc[a][b][m][n] = (f32x4){0.f, 0.f, 0.f, 0.f};
        cur = nxt; cA = nA; cB = nB; ++ui;
        if constexpr (ALIGN_EPI) { if (wr == 1) PG8_BAR; }
    }
    PG8_WAIT_V(0);
    if constexpr (!ALIGN_EPI) { if (wr == 0) PG8_BAR; }
    PG8_BAR;
    if constexpr (Epi::AFTER_DRAIN) { E.fused(acc, cur, wr, wc, fr, fq, lds, wid, lane); S.done(cur); }
#undef PG8_SA
#undef PG8_SB
#undef PG8_STAGE
#undef PG8_LDA
#undef PG8_LDB
#undef PG8_MMA
#undef PG8_WAIT_V
#undef PG8_WAIT_L
#undef PG8_BAR
#undef PG8_SCHED
}
}
#ifndef PG8_SP2
#define PG8_SP2 true
#endif
#ifndef PG8_ALIGN
#define PG8_ALIGN true
#endif

constexpr int NWAVES = 8;
constexpr int S_ = 16384, D_ = 1024, FF_ = 4096, PLE_ = 256, INW_ = 3088, ZW = 3072;
constexpr int Z_GQ = 0, Z_GK = 256, Z_GV = 512, Z_GG = 1024, Z_MQ = 1536, Z_MK = 2048, Z_MV = 2560;
constexpr float EPS_ = 1e-6f;

constexpr size_t MiB = 1u << 20, KiB = 1u << 10;
constexpr size_t WS_CTL = 0, CTL_ZERO_BYTES = 1 * MiB;
constexpr size_t WS_WIN = 1 * MiB, WS_WOUT = 7 * MiB, WS_WUP = 9 * MiB, WS_WDOWN = 17 * MiB, WS_WPG = 25 * MiB, WS_WPP = 27 * MiB, WS_WGA = 27 * MiB + 512 * KiB;
constexpr size_t WS_SMALL = 28 * MiB;
constexpr size_t WS_RSTDX = WS_SMALL, WS_GA = WS_SMALL + 64 * KiB, WS_DECAY = WS_SMALL + 1088 * KiB, WS_KMEAN = WS_SMALL + 1344 * KiB,
                 WS_SSQH1 = WS_SMALL + 1472 * KiB, WS_SSQH2 = WS_SMALL + 1728 * KiB, WS_SSQE = WS_SMALL + 1984 * KiB, WS_LPART = WS_SMALL + 2240 * KiB;
constexpr size_t WS_ERAW = 32 * MiB, WS_AB = 64 * MiB, WS_Z = 96 * MiB, WS_MIX = 192 * MiB, WS_PB = 224 * MiB, WS_ACT = 96 * MiB, WS_END = 256 * MiB;
constexpr size_t WS_DS = 224 * MiB, WS_SPREV = 64 * MiB, WS_LIST = 80 * MiB;
constexpr size_t OUT_PART = 0, OUT_VT = 48 * MiB;
constexpr int CW_TMO = 0, CW_CNT = 1024  , CW_BAR = 4096;

constexpr int RING_OFF = 0, RING_BYTES = 131072;
constexpr int LDS_BYTES = 160 * 1024;
constexpr int MISC_OFF = LDS_BYTES - 128;

#define GAS __attribute__((address_space(1)))
#define LAS __attribute__((address_space(3)))
typedef unsigned short bf16;
typedef unsigned v4u __attribute__((ext_vector_type(4)));
typedef float f32x4 __attribute__((ext_vector_type(4)));
typedef short bf16x8 __attribute__((ext_vector_type(8)));
typedef GAS unsigned gu32;
typedef GAS unsigned long long gu64;
#define RLX_AGENT __ATOMIC_RELAXED, __HIP_MEMORY_SCOPE_AGENT
#define LDS_WAIT() asm volatile("s_waitcnt lgkmcnt(0)" ::: "memory")
#define VM_WAIT() asm volatile("s_waitcnt vmcnt(0)" ::: "memory")
__device__ __forceinline__ unsigned long long rt() { return __builtin_amdgcn_s_memrealtime(); }
__device__ __forceinline__ unsigned f2bf(float f) { unsigned u = __builtin_bit_cast(unsigned, f); return (u + 0x7fffu + ((u >> 16) & 1u)) >> 16; }
__device__ __forceinline__ unsigned pk2(float lo, float hi) { return f2bf(lo) | (f2bf(hi) << 16); }

#define XB_TMO      128
#define XB_XCNT(j)  (256  + 64 * (j))
#define XB_XSUB(j)  (1280 + 64 * (j))
#define XB_XGEN(j)  (2304 + 64 * (j))
#define XB_TOP      3328
#define XB_TOPGEN   3392
#define XCD_BAR_WORDS 3456
#define XB_SPIN_CAP (1u << 18)

__device__ __forceinline__ unsigned xb_ld(unsigned* p)              { return __hip_atomic_load(p, __ATOMIC_RELAXED, __HIP_MEMORY_SCOPE_AGENT); }
__device__ __forceinline__ unsigned xb_add(unsigned* p, unsigned v) { return __hip_atomic_fetch_add(p, v, __ATOMIC_RELAXED, __HIP_MEMORY_SCOPE_AGENT); }
__device__ __forceinline__ unsigned xb_xcc_id() { return (unsigned)__builtin_amdgcn_s_getreg((3 << 11) | 20) & 0xFu; }
#define XB_SPIN(cond, bar) do { unsigned _sp = 0; while (cond) { __builtin_amdgcn_s_sleep(1); \
    if ((++_sp & 255u) == 0u) { if (xb_ld(&(bar)[XB_TMO])) break; if (_sp > XB_SPIN_CAP) { atomicAdd(&(bar)[XB_TMO], 1u); break; } } } } while (0)

struct XcdBarrier {
    unsigned* bar; unsigned x;
    volatile LAS unsigned* st;
};

__device__ __forceinline__ XcdBarrier xcd_barrier_post(unsigned* bar, volatile LAS unsigned* st) {
    XcdBarrier b; b.bar = bar; b.x = xb_xcc_id(); b.st = st;
    if (threadIdx.x == 0) (void)xb_add(&bar[XB_XCNT(b.x)], 1u);
    return b;
}
__device__ __forceinline__ void xcd_barrier_complete(unsigned* bar, unsigned x, unsigned& nloc, unsigned& nx) {
    const unsigned G = gridDim.x * gridDim.y * gridDim.z;
    unsigned sum, cnt, mine, sp = 0u;
    for (;;) {
        sum = 0u; cnt = 0u; mine = 0u;
#pragma unroll
        for (unsigned j = 0; j < 16; ++j) { const unsigned c = xb_ld(&bar[XB_XCNT(j)]); sum += c; cnt += (c > 0u) ? 1u : 0u; mine = (j == x) ? c : mine; }
        if (sum == G) break;
        __builtin_amdgcn_s_sleep(1);
        if ((++sp & 255u) == 0u) { if (xb_ld(&bar[XB_TMO])) break; if (sp > XB_SPIN_CAP) { atomicAdd(&bar[XB_TMO], 1u); break; } }
    }
    nloc = mine > 0u ? mine : 1u; nx = cnt > 0u ? cnt : 1u;
}

__device__ __forceinline__ void xcd_barrier(const XcdBarrier& b) {
    asm volatile("s_waitcnt vmcnt(0)" ::: "memory");
    __syncthreads();
    if (threadIdx.x == 0) {
        unsigned* bar = b.bar;
        __builtin_amdgcn_s_waitcnt(0);
        unsigned nloc = b.st[0], nx = b.st[1];
        if (nloc == 0u) { xcd_barrier_complete(bar, b.x, nloc, nx); b.st[0] = nloc; b.st[1] = nx; }
        const unsigned old = xb_add(&bar[XB_XSUB(b.x)], 1u);
        const unsigned gen = old / nloc;
        if (old + 1u == (gen + 1u) * nloc) {
            __builtin_amdgcn_fence(__ATOMIC_RELEASE, "agent");
            asm volatile("s_waitcnt vmcnt(0)" ::: "memory");
            const unsigned og = xb_add(&bar[XB_TOP], 1u);
            const unsigned tg = og / nx;
            if (og + 1u == (tg + 1u) * nx) xb_add(&bar[XB_TOPGEN], 1u);
            else XB_SPIN(xb_ld(&bar[XB_TOPGEN]) == tg, bar);
            __builtin_amdgcn_fence(__ATOMIC_ACQUIRE, "agent");
            xb_add(&bar[XB_XGEN(b.x)], 1u);
            asm volatile("s_waitcnt vmcnt(0)" ::: "memory");
        } else {
            XB_SPIN(xb_ld(&bar[XB_XGEN(b.x)]) == gen, bar);
            __builtin_amdgcn_fence(__ATOMIC_ACQUIRE, "agent");
            asm volatile("s_waitcnt vmcnt(0)" ::: "memory");
        }
    }
    __syncthreads();
}

struct Frame {
    LAS unsigned char* lds;
    volatile LAS unsigned* MISC;
    gu32* ctl;
    int tid, lane, wave, vcu, G;
    unsigned char* ws; float* out;
    const float *x, *p; const int* pos;
    const float *g_mix, *w_in, *w_a2, *b_a, *g_gla, *g_mq, *g_mk, *w_out, *g_ffn, *w_up, *w_down, *g_pg, *w_pg, *w_pp, *g_pe;
};
__device__ __forceinline__ float wave_sum(float v) {
#pragma unroll
    for (int o = 1; o < 64; o <<= 1) v += __shfl_xor(v, o);
    return v;
}
__device__ __forceinline__ float bf2f(unsigned v16) { return __uint_as_float(v16 << 16); }

__device__ __forceinline__ void p0_transpose_item(const float* W, int ldn, int src_col, const float* gain, int K, bf16* WT, int n_dst, int k0, LAS float* scr, int lane) {
#pragma unroll 8
    for (int i = 0; i < 32; ++i) { const int kk = 2 * i + (lane >> 5); float w = W[(size_t)(k0 + kk) * ldn + src_col + (lane & 31)]; if (gain) w *= gain[k0 + kk]; scr[kk * 33 + (lane & 31)] = w; }
    LDS_WAIT(); asm volatile("" ::: "memory");
    const int c = lane & 7;
#pragma unroll
    for (int j = 0; j < 4; ++j) { const int n = (lane >> 3) + 8 * j; const LAS float* s = scr + (8 * c) * 33 + n;
        v4u o; o.x = pk2(s[0 * 33], s[1 * 33]); o.y = pk2(s[2 * 33], s[3 * 33]); o.z = pk2(s[4 * 33], s[5 * 33]); o.w = pk2(s[6 * 33], s[7 * 33]);
        *(GAS v4u*)(WT + (size_t)(n_dst + n) * K + k0 + 8 * c) = o; }
    LDS_WAIT(); asm volatile("" ::: "memory");
}
__device__ __forceinline__ void p0_prologue(Frame& F) {
    LAS float* scr = (LAS float*)(F.lds + RING_OFF + F.wave * 16384);
    const int gw = F.vcu * NWAVES + F.wave, NGW = F.G * NWAVES;
    bf16* Win_t = (bf16*)(F.ws + WS_WIN); bf16* Wout_t = (bf16*)(F.ws + WS_WOUT); bf16* Wup_t = (bf16*)(F.ws + WS_WUP); bf16* Wdown_t = (bf16*)(F.ws + WS_WDOWN);
    bf16* Wpg_t = (bf16*)(F.ws + WS_WPG); bf16* Wpp_t = (bf16*)(F.ws + WS_WPP); bf16* Wga_t = (bf16*)(F.ws + WS_WGA);
    constexpr int I_IN = (D_ / 64) * (ZW / 32), I_OUT = (D_ / 64) * (D_ / 32), I_UP = (D_ / 64) * (FF_ / 32), I_DN = (FF_ / 64) * (D_ / 32), I_PG = I_OUT, I_PP = (PLE_ / 64) * (D_ / 32);
    constexpr int NITEMS = I_IN + I_OUT + I_UP + I_DN + I_PG + I_PP;
    for (int it = gw; it < NITEMS; it += NGW) {
        int r = it;
        if (r < I_IN) { const int nb = r % (ZW / 32), kb = r / (ZW / 32), n0 = 32 * nb; p0_transpose_item(F.w_in, INW_, n0 < 1536 ? n0 : n0 + 16, F.g_mix, D_, Win_t, n0, 64 * kb, scr, F.lane); continue; } r -= I_IN;
        if (r < I_OUT) { const int nb = r % (D_ / 32), kb = r / (D_ / 32); p0_transpose_item(F.w_out, D_, 32 * nb, nullptr, D_, Wout_t, 32 * nb, 64 * kb, scr, F.lane); continue; } r -= I_OUT;
        if (r < I_UP) { const int nb = r % (FF_ / 32), kb = r / (FF_ / 32); p0_transpose_item(F.w_up, FF_, 32 * nb, F.g_ffn, D_, Wup_t, 32 * nb, 64 * kb, scr, F.lane); continue; } r -= I_UP;
        if (r < I_DN) { const int nb = r % (D_ / 32), kb = r / (D_ / 32); p0_transpose_item(F.w_down, D_, 32 * nb, nullptr, FF_, Wdown_t, 32 * nb, 64 * kb, scr, F.lane); continue; } r -= I_DN;
        if (r < I_PG) { const int nb = r % (D_ / 32), kb = r / (D_ / 32); p0_transpose_item(F.w_pg, D_, 32 * nb, F.g_pg, D_, Wpg_t, 32 * nb, 64 * kb, scr, F.lane); continue; } r -= I_PG;
        { const int nb = r % (D_ / 32), kb = r / (D_ / 32); p0_transpose_item(F.w_pp, D_, 32 * nb, nullptr, PLE_, Wpp_t, 32 * nb, 64 * kb, scr, F.lane); }
    }
    for (int i = (F.vcu * NWAVES + F.wave) * 64 + F.lane; i < 16 * D_; i += NGW * 64) { const int r = i >> 10, k = i & 1023; Wga_t[i] = (bf16)f2bf(F.w_in[(size_t)k * INW_ + 1536 + r] * F.g_mix[k]); }
    bf16* xb = (bf16*)(F.ws + WS_AB); bf16* pb = (bf16*)(F.ws + WS_PB); float* rstdx = (float*)(F.ws + WS_RSTDX);
    for (int m = gw; m < S_; m += NGW) {
        const GAS f32x4* xr = (const GAS f32x4*)(F.x + (size_t)m * D_) + F.lane;
        f32x4 v[4]; float s = 0.f;
#pragma unroll
        for (int j = 0; j < 4; ++j) { v[j] = xr[64 * j]; s += (v[j].x * v[j].x + v[j].y * v[j].y) + (v[j].z * v[j].z + v[j].w * v[j].w); }
        s = wave_sum(s);
        GAS unsigned long long* o8 = (GAS unsigned long long*)(xb + (size_t)m * D_) + F.lane;
#pragma unroll
        for (int j = 0; j < 4; ++j) o8[64 * j] = (unsigned long long)pk2(v[j].x, v[j].y) | ((unsigned long long)pk2(v[j].z, v[j].w) << 32);
        if (F.lane == 0) rstdx[m] = 1.0f / sqrtf(s * (1.0f / D_) + EPS_);
        const f32x4 pv = *((const GAS f32x4*)(F.p + (size_t)m * PLE_) + F.lane);
        *((GAS unsigned long long*)(pb + (size_t)m * PLE_) + F.lane) = (unsigned long long)pk2(pv.x, pv.y) | ((unsigned long long)pk2(pv.z, pv.w) << 32);
    }
}

struct Args { const void* in[18]; float* out; unsigned char* ws; int ph_lo, ph_hi, li, pad; };
constexpr int N_PHASES = 10;
__global__ void __launch_bounds__(NWAVES * 64, 2) mk_fwd(Args args) {
    extern __shared__ __attribute__((aligned(16))) unsigned char lds[];
    Frame F;
    F.lds = (LAS unsigned char*)lds;
    F.MISC = (volatile LAS unsigned*)(F.lds + MISC_OFF);
    F.tid = threadIdx.x; F.lane = F.tid & 63; F.wave = __builtin_amdgcn_readfirstlane(F.tid >> 6);
    F.G = gridDim.x; { const int bx = blockIdx.x; F.vcu = (F.G % 8 == 0) ? (bx % 8) * (F.G / 8) + bx / 8 : bx; }
    F.ws = args.ws; F.out = args.out; F.ctl = (gu32*)(args.ws + WS_CTL);
    F.x = (const float*)args.in[0]; F.p = (const float*)args.in[1]; F.pos = (const int*)args.in[2]; F.g_mix = (const float*)args.in[3]; F.w_in = (const float*)args.in[4];
    F.w_a2 = (const float*)args.in[5]; F.b_a = (const float*)args.in[6]; F.g_gla = (const float*)args.in[7]; F.g_mq = (const float*)args.in[8]; F.g_mk = (const float*)args.in[9];
    F.w_out = (const float*)args.in[10]; F.g_ffn = (const float*)args.in[11]; F.w_up = (const float*)args.in[12]; F.w_down = (const float*)args.in[13];
    F.g_pg = (const float*)args.in[14]; F.w_pg = (const float*)args.in[15]; F.w_pp = (const float*)args.in[16]; F.g_pe = (const float*)args.in[17];
    if (F.tid < 32) F.MISC[F.tid] = 0u;
    __syncthreads();
    XcdBarrier bar = xcd_barrier_post((unsigned*)(F.ctl + CW_BAR) + args.li * XCD_BAR_WORDS, F.MISC + 8);
    const int lo = args.ph_lo, hi = args.ph_hi;
#define IN(k) (lo <= (k) && (k) < hi)
#define SEAM(k) do { if (IN(k) && IN((k) + 1)) xcd_barrier(bar); } while (0)
    bf16* xb = (bf16*)(F.ws + WS_AB); bf16* zb = (bf16*)(F.ws + WS_Z); bf16* mixb = (bf16*)(F.ws + WS_MIX); bf16* actb = (bf16*)(F.ws + WS_ACT); bf16* erawb = (bf16*)(F.ws + WS_ERAW);

    if (IN(0)) { p0_prologue(F); } SEAM(0);
    if (IN(1)) {
        { pg8::Gemm g{xb, (const bf16*)(F.ws + WS_WIN), S_, ZW, D_}; pg8::StaticOrder S; S.init(S_, ZW, F.G, (int)blockIdx.x);
          pg8::EpiScale<0, 1> E{zb, ZW, (const float*)(F.ws + WS_RSTDX), EPS_};
          pg8::gemm_phase<pg8::EpiScale<0, 1>, pg8::StaticOrder, PG8_ALIGN, PG8_SP2>(F.lds + RING_OFF, g, S, E); }
        { pg8::Gemm g{(const bf16*)(F.ws + WS_PB), (const bf16*)(F.ws + WS_WPP), S_, D_, PLE_}; pg8::StaticOrder S; S.init(S_, D_, F.G, (int)blockIdx.x);
          pg8::EpiRes<false> E{nullptr, nullptr, erawb, (float*)(F.ws + WS_SSQE), D_};
          pg8::gemm_phase<pg8::EpiRes<false>, pg8::StaticOrder, false, PG8_SP2>(F.lds + RING_OFF, g, S, E); }
    } SEAM(1);
    if (IN(6)) {
        pg8::Gemm g{mixb, (const bf16*)(F.ws + WS_WOUT), S_, D_, D_}; pg8::StaticOrder S; S.init(S_, D_, F.G, (int)blockIdx.x);
        pg8::EpiRes<true> E{F.x, F.out, xb, (float*)(F.ws + WS_SSQH1), D_};
        pg8::gemm_phase<pg8::EpiRes<true>, pg8::StaticOrder, false, PG8_SP2>(F.lds + RING_OFF, g, S, E);
    } SEAM(6);
    if (IN(7)) {
        pg8::Gemm g{xb, (const bf16*)(F.ws + WS_WUP), S_, FF_, D_}; pg8::StaticOrder S; S.init(S_, FF_, F.G, (int)blockIdx.x);
        pg8::EpiScale<1, 2> E{actb, FF_, (const float*)(F.ws + WS_SSQH1), EPS_};
        pg8::gemm_phase<pg8::EpiScale<1, 2>, pg8::StaticOrder, PG8_ALIGN, PG8_SP2>(F.lds + RING_OFF, g, S, E);
    } SEAM(7);
    if (IN(8)) {
        pg8::Gemm g{actb, (const bf16*)(F.ws + WS_WDOWN), S_, D_, FF_}; pg8::StaticOrder S; S.init(S_, D_, F.G, (int)blockIdx.x);
        pg8::EpiRes<true> E{F.out, F.out, xb, (float*)(F.ws + WS_SSQH2), D_};
        pg8::gemm_phase<pg8::EpiRes<true>, pg8::StaticOrder, false, PG8_SP2>(F.lds + RING_OFF, g, S, E);
    } SEAM(8);
    if (IN(9)) {
        pg8::Gemm g{xb, (const bf16*)(F.ws + WS_WPG), S_, D_, D_}; pg8::StaticOrder S; S.init(S_, D_, F.G, (int)blockIdx.x);
        pg8::EpiGate E{F.out, erawb, (const float*)(F.ws + WS_SSQH2), (const float*)(F.ws + WS_SSQE), F.g_pe, D_, EPS_};
        pg8::gemm_phase<pg8::EpiGate, pg8::StaticOrder, false, PG8_SP2>(F.lds + RING_OFF, g, S, E);
    }
#undef IN
#undef SEAM
}

namespace nv {
__device__ __forceinline__ float ldz(const bf16* z, int t, int col) { return bf2f(z[(size_t)t * ZW + col]); }
__device__ __forceinline__ float wave_max(float v) {
#pragma unroll
    for (int o = 1; o < 64; o <<= 1) v = fmaxf(v, __shfl_xor(v, o));
    return v;
}
__global__ void k_ga(const bf16* __restrict__ xb, const bf16* __restrict__ wga_t, const float* __restrict__ rstdx, float* __restrict__ ga) {
    const int idx = blockIdx.x * blockDim.x + threadIdx.x; if (idx >= S_ * 16) return;
    const int t = idx >> 4, r = idx & 15; float s = 0.f;
    for (int k = 0; k < D_; ++k) s += bf2f(xb[(size_t)t * D_ + k]) * bf2f(wga_t[r * D_ + k]);
    ga[idx] = s * rstdx[t];
}
__global__ void k_gla_prep(const float* __restrict__ ga, const float* __restrict__ w_a2, const float* __restrict__ b_a, float* __restrict__ a_out) {
    const int idx = blockIdx.x * blockDim.x + threadIdx.x; if (idx >= S_ * 256) return;
    const int t = idx >> 8, c = idx & 255; float s = b_a[c];
#pragma unroll
    for (int r = 0; r < 16; ++r) s += ga[t * 16 + r] * w_a2[r * 256 + c];
    const float ls = fminf(s, 0.f) - log1pf(expf(-fabsf(s)));
    a_out[idx] = expf(ls * (1.0f / 16.0f));
}
__global__ void __launch_bounds__(64) k_gla_rec(const bf16* __restrict__ z, const float* __restrict__ a, float* __restrict__ o_raw) {
    const int h = blockIdx.x >> 1, e = (blockIdx.x & 1) * 64 + threadIdx.x;
    float St[64];
#pragma unroll
    for (int d = 0; d < 64; ++d) St[d] = 0.f;
    for (int t = 0; t < S_; ++t) {
        const bf16* zr = z + (size_t)t * ZW;
        const float v = bf2f(zr[Z_GV + h * 128 + e]);
        const bf16* qr = zr + Z_GQ + h * 64; const bf16* kr = zr + Z_GK + h * 64; const float* ar = a + (size_t)t * 256 + h * 64;
        float o = 0.f;
#pragma unroll
        for (int d = 0; d < 64; ++d) { St[d] = ar[d] * St[d] + bf2f(kr[d]) * v; o += bf2f(qr[d]) * St[d]; }
        o_raw[(size_t)t * 512 + h * 128 + e] = o * 0.125f;
    }
}
__global__ void k_gla_post(const float* __restrict__ o_raw, const bf16* __restrict__ z, const float* __restrict__ g_out, bf16* __restrict__ mix) {
    const int wave = (blockIdx.x * blockDim.x + threadIdx.x) >> 6, lane = threadIdx.x & 63; if (wave >= S_ * 4) return;
    const int t = wave >> 2, h = wave & 3;
    const float o0 = o_raw[(size_t)t * 512 + h * 128 + lane], o1 = o_raw[(size_t)t * 512 + h * 128 + 64 + lane];
    const float ss = wave_sum(o0 * o0 + o1 * o1); const float r = 1.0f / sqrtf(ss * (1.0f / 128.0f) + EPS_);
    const float g0 = ldz(z, t, Z_GG + h * 128 + lane), g1 = ldz(z, t, Z_GG + h * 128 + 64 + lane);
    mix[(size_t)t * D_ + h * 128 + lane] = (bf16)f2bf(o0 * r * g_out[lane] * (g0 / (1.0f + expf(-g0))));
    mix[(size_t)t * D_ + h * 128 + 64 + lane] = (bf16)f2bf(o1 * r * g_out[64 + lane] * (g1 / (1.0f + expf(-g1))));
}
__device__ __forceinline__ void sincos_acc(float angf, float& s, float& c) {
    double r = (double)angf * 0.15915494309189533577; r -= floor(r);
    const double q = floor(4.0 * r + 0.5);
    const float phi = (float)((r - 0.25 * q) * 6.283185307179586477);
    const float p2 = phi * phi;
    const float sn = phi * (1.0f + p2 * (-1.0f / 6.0f + p2 * (1.0f / 120.0f + p2 * (-1.0f / 5040.0f + p2 * (1.0f / 362880.0f)))));
    const float cs = 1.0f + p2 * (-0.5f + p2 * (1.0f / 24.0f + p2 * (-1.0f / 720.0f + p2 * (1.0f / 40320.0f + p2 * (-1.0f / 3628800.0f)))));
    const int qi = ((int)q) & 3;
    s = (qi == 0) ? sn : (qi == 1) ? cs : (qi == 2) ? -sn : -cs;
    c = (qi == 0) ? cs : (qi == 1) ? -sn : (qi == 2) ? -cs : sn;
}
__global__ void k_moba_qk(bf16* __restrict__ z, const int* __restrict__ pos, const float* __restrict__ gq, const float* __restrict__ gk) {
    const int wave = (blockIdx.x * blockDim.x + threadIdx.x) >> 6, lane = threadIdx.x & 63; if (wave >= S_ * 8) return;
    const int t = wave >> 3, h = (wave >> 1) & 3, which = wave & 1;
    bf16* p = z + (size_t)t * ZW + (which ? Z_MK : Z_MQ) + h * 128; const float* g = which ? gk : gq;
    const float x1 = bf2f(p[lane]), x2 = bf2f(p[lane + 64]);
    const float ss = wave_sum(x1 * x1 + x2 * x2); const float r = 1.0f / sqrtf(ss * (1.0f / 128.0f) + EPS_);
    const float y1 = x1 * r * g[lane], y2 = x2 * r * g[lane + 64];
    const float inv = 1.0f / powf(10000.0f, (float)lane / 64.0f); const float ang = (float)pos[t] * inv;
    float sn, cs; sincos_acc(ang, sn, cs);
    p[lane] = (bf16)f2bf(y1 * cs - y2 * sn); p[lane + 64] = (bf16)f2bf(y2 * cs + y1 * sn);
}
__global__ void k_moba_kmean(const bf16* __restrict__ z, float* __restrict__ kmean) {
    const int h = blockIdx.x >> 6, blk = blockIdx.x & 63, d = threadIdx.x; float s = 0.f;
    for (int i = 0; i < 256; ++i) s += ldz(z, blk * 256 + i, Z_MK + h * 128 + d);
    kmean[(size_t)(h * 64 + blk) * 128 + d] = s * (1.0f / 256.0f);
}
__global__ void __launch_bounds__(256) k_moba_attn(const bf16* __restrict__ z, const float* __restrict__ kmean, bf16* __restrict__ mix) {
    __shared__ float pl[4][1024];
    const int w = threadIdx.x >> 6, lane = threadIdx.x & 63; const int wave = blockIdx.x * 4 + w; const int q = wave >> 2, h = wave & 3; const int kb = q >> 8;
    const bf16* qrow = z + (size_t)q * ZW + Z_MQ + h * 128; const float scale = 0.08838834764831845f;
    float g = -INFINITY;
    if (lane < kb) { const float* km = kmean + (size_t)(h * 64 + lane) * 128; float s = 0.f; for (int d = 0; d < 128; ++d) s += bf2f(qrow[d]) * km[d]; g = s; }
    int sel[3];
#pragma unroll
    for (int r = 0; r < 3; ++r) { const float m = wave_max(g); const unsigned long long bal = __ballot(g == m); const int idx = __ffsll((long long)bal) - 1; sel[r] = (m > -INFINITY) ? idx : -1; if (lane == idx) g = -INFINITY; }
    float sc[16];
#pragma unroll
    for (int seg = 0; seg < 4; ++seg) { const int blk = (seg < 3) ? sel[seg] : kb;
#pragma unroll
        for (int r = 0; r < 4; ++r) { float s = -INFINITY;
            if (blk >= 0) { const int key = blk * 256 + r * 64 + lane;
                if (seg < 3 || key <= q) { const bf16* kr = z + (size_t)key * ZW + Z_MK + h * 128; float a = 0.f; for (int d = 0; d < 128; ++d) a += bf2f(qrow[d]) * bf2f(kr[d]); s = a * scale; } }
            sc[seg * 4 + r] = s; } }
    float m = sc[0];
#pragma unroll
    for (int i = 1; i < 16; ++i) m = fmaxf(m, sc[i]);
    m = wave_max(m); float sum = 0.f;
#pragma unroll
    for (int i = 0; i < 16; ++i) { const float p = (sc[i] > -INFINITY) ? expf(sc[i] - m) : 0.f; sum += p; pl[w][i * 64 + lane] = p; }
    sum = wave_sum(sum); __syncthreads();
    float a0 = 0.f, a1 = 0.f;
#pragma unroll
    for (int seg = 0; seg < 4; ++seg) { const int blk = (seg < 3) ? sel[seg] : kb; if (blk < 0) continue; const int nk = (seg < 3) ? 256 : ((q & 255) + 1);
        for (int i = 0; i < nk; ++i) { const float p = pl[w][seg * 256 + i]; const bf16* vr = z + (size_t)(blk * 256 + i) * ZW + Z_MV + h * 128; a0 += p * bf2f(vr[lane]); a1 += p * bf2f(vr[lane + 64]); } }
    const float inv = 1.0f / sum;
    mix[(size_t)q * D_ + 512 + h * 128 + lane] = (bf16)f2bf(a0 * inv); mix[(size_t)q * D_ + 512 + h * 128 + 64 + lane] = (bf16)f2bf(a1 * inv);
}
}

static void launch_range(const Args& a0, int lo, int hi, int li, int grid, hipStream_t stream) {
    Args a = a0; a.ph_lo = lo; a.ph_hi = hi; a.li = li;
    hipLaunchKernelGGL(mk_fwd, dim3(grid), dim3(NWAVES * 64), LDS_BYTES, stream, a);
    const hipError_t le = hipPeekAtLastError();
    if (le != hipSuccess) fprintf(stderr, "kernel_launch: launch [%d,%d) failed: %s\n", lo, hi, hipGetErrorName(le));
}
extern "C" void kernel_launch(void* const* d_in, const int* in_sizes, int n_in, void* d_out, int out_size, void* d_ws, size_t ws_size, hipStream_t stream) {
    static int grid = 0;
    if (grid == 0) {
        if (n_in != 18 || out_size != S_ * D_ || ws_size < WS_END) { fprintf(stderr, "kernel_launch: unexpected shapes (n_in %d out %d ws %zu)\n", n_in, out_size, ws_size); grid = -1; return; }
        int dev = 0, cus = 0, per_cu = 0;
        if (hipGetDevice(&dev) != hipSuccess || hipDeviceGetAttribute(&cus, hipDeviceAttributeMultiprocessorCount, dev) != hipSuccess) { grid = -1; return; }
        if (hipFuncSetAttribute((const void*)mk_fwd, hipFuncAttributeMaxDynamicSharedMemorySize, LDS_BYTES) != hipSuccess) { fprintf(stderr, "kernel_launch: hipFuncSetAttribute failed\n"); grid = -1; return; }
        if (hipOccupancyMaxActiveBlocksPerMultiprocessor(&per_cu, (const void*)mk_fwd, NWAVES * 64, LDS_BYTES) != hipSuccess || per_cu < 1) { fprintf(stderr, "kernel_launch: occupancy query says %d\n", per_cu); per_cu = 1; }
        (void)hipGetLastError();
        grid = cus;
        if (grid != 256) fprintf(stderr, "kernel_launch: note: %d CUs\n", grid);
    }
    if (grid < 0) return;
    (void)hipMemsetAsync((char*)d_ws + WS_CTL, 0, CTL_ZERO_BYTES, stream);
    Args a{};
    for (int i = 0; i < 18; ++i) a.in[i] = d_in[i];
    a.out = (float*)d_out; a.ws = (unsigned char*)d_ws;
    launch_range(a, 0, 2, 0, grid, stream);
    {
        unsigned char* ws = (unsigned char*)d_ws;
        bf16* zb = (bf16*)(ws + WS_Z); bf16* mixb = (bf16*)(ws + WS_MIX);
        float* ga = (float*)(ws + WS_GA); float* abuf = (float*)(ws + WS_DS); float* oraw = (float*)d_out; float* kmean = (float*)(ws + WS_KMEAN);
        nv::k_ga<<<S_ * 16 / 256, 256, 0, stream>>>((const bf16*)(ws + WS_AB), (const bf16*)(ws + WS_WGA), (const float*)(ws + WS_RSTDX), ga);
        nv::k_gla_prep<<<S_, 256, 0, stream>>>(ga, (const float*)d_in[5], (const float*)d_in[6], abuf);
        nv::k_gla_rec<<<8, 64, 0, stream>>>(zb, abuf, oraw);
        nv::k_gla_post<<<S_, 256, 0, stream>>>(oraw, zb, (const float*)d_in[7], mixb);
        nv::k_moba_qk<<<S_ * 2, 256, 0, stream>>>(zb, (const int*)d_in[2], (const float*)d_in[8], (const float*)d_in[9]);
        nv::k_moba_kmean<<<256, 128, 0, stream>>>(zb, kmean);
        nv::k_moba_attn<<<S_, 256, 0, stream>>>(zb, kmean, mixb);
    }
    launch_range(a, 6, 10, 1, grid, stream);
}
```

```cpp
#include <hip/hip_runtime.h>
#include <cstdio>
#include <cstdint>
#include <math.h>
namespace pg8 {
#define PG8_LAS __attribute__((address_space(3)))
typedef unsigned short bf16_t;
typedef short bf16x8 __attribute__((ext_vector_type(8)));
typedef float f32x4 __attribute__((ext_vector_type(4)));
typedef unsigned u32x4 __attribute__((ext_vector_type(4)));
constexpr int BM = 256, BK = 64, HALF = 128, HTB = HALF * BK * 2  , STAGE_BYTES = 8 * HTB, NXCD = 8, WGM = 8;

__host__ __device__ __forceinline__ int lds_byte(int r, int c) { const int st = (r >> 4) * 2 + (c >> 5), rr = r & 15, cc = c & 31, ob = rr * 64 + cc * 2; return st * 1024 + (ob ^ (((ob >> 9) & 1) << 5)); }
__host__ __device__ __forceinline__ void stage_rc(int b, int& R, int& C) { const int st = b / 1024, sb = b % 1024, swz = sb ^ (((sb >> 9) & 1) << 5); R = (st >> 1) * 16 + swz / 64; C = (st & 1) * 32 + (swz % 64) / 2; }
__host__ __device__ __forceinline__ int perm32(int rho) { const int n = rho >> 4, i = rho & 15; return 8 * (i >> 2) + 4 * n + (i & 3); }

struct Unit { int pm, pn; };
struct Gemm { const bf16_t* A; const bf16_t* Bt; int M, N, K; };

struct StaticOrder {
    int nM, nN, nwg, G, c;
    __host__ __device__ void init(int M, int N, int G_, int c_) { nM = M / BM; nN = N / BM; nwg = nM * nN; G = G_; c = c_; }
    __host__ __device__ bool next(int i, Unit& u) const {
        const long L = (long)i * G + c; if (L >= nwg) return false;
        int wgid = (int)L; { const int q = nwg / NXCD, r = nwg % NXCD, xcd = wgid % NXCD, off = wgid / NXCD; wgid = (xcd < r ? xcd * (q + 1) : r * (q + 1) + (xcd - r) * q) + off; }
        const int nig = WGM * nN, gid = wgid / nig, fm = gid * WGM, gsz = (nM - fm) < WGM ? (nM - fm) : WGM;
        u.pm = fm + ((wgid % nig) % gsz); u.pn = (wgid % nig) / gsz; return true;
    }
    __device__ __forceinline__ void a_ready(const Unit&) const {}
    __device__ __forceinline__ void done(const Unit&) const {}
};

__device__ __forceinline__ unsigned cvt_pk_bf16(float lo, float hi) { unsigned r; asm volatile("v_cvt_pk_bf16_f32 %0, %1, %2" : "=v"(r) : "v"(lo), "v"(hi)); return r; }
typedef float f32x2 __attribute__((ext_vector_type(2)));

__device__ __forceinline__ float rstd_from_part(const float* part, int row, float inv_n, float eps) {
    const f32x4 p = *(const f32x4*)(part + (size_t)row * 4);
    return 1.0f / sqrtf(((p[0] + p[1]) + (p[2] + p[3])) * inv_n + eps);
}
template <int ACT, int RS> struct EpiScale {
    static constexpr bool PERM = true, AFTER_DRAIN = false;
    bf16_t* O; int ldc; const float* rsv; float eps;
    __device__ __forceinline__ void operator()(const f32x4 (&acc)[2][2][4][2], const Unit& u, int wr, int wc, int fr, int fq) const {
        const int row0 = u.pm * BM + wr * 64 + fr, col0 = u.pn * BM + wc * 32 + 8 * fq;
#pragma unroll
        for (int ai = 0; ai < 2; ++ai)
#pragma unroll
            for (int m = 0; m < 4; ++m) {
                const int row = row0 + ai * HALF + m * 16;
                float s = 1.f;
                if (RS == 1) s = rsv[row];
                if (RS == 2) s = rstd_from_part(rsv, row, 1.0f / 1024.0f, eps);
                bf16_t* rowp = O + (size_t)row * ldc + col0;
#pragma unroll
                for (int bj = 0; bj < 2; ++bj) {
                    f32x4 v0 = acc[ai][bj][m][0] * s, v1 = acc[ai][bj][m][1] * s;
                    if (ACT == 1) {
#pragma unroll
                        for (int e = 0; e < 4; ++e) { const float a = fmaxf(v0[e], 0.f), b = fmaxf(v1[e], 0.f); v0[e] = a * a; v1[e] = b * b; }
                    }
                    u32x4 w; w.x = cvt_pk_bf16(v0[0], v0[1]); w.y = cvt_pk_bf16(v0[2], v0[3]); w.z = cvt_pk_bf16(v1[0], v1[1]); w.w = cvt_pk_bf16(v1[2], v1[3]);
                    *(u32x4*)(rowp + bj * HALF) = w;
                }
            }
    }
};
template <bool RES> struct EpiRes {
    static constexpr bool PERM = true, AFTER_DRAIN = true;
    const float* base; float* out; bf16_t* hb; float* part; int ldc;
    __device__ __forceinline__ void fused(f32x4 (&acc)[2][2][4][2], const Unit& u, int wr, int wc, int fr, int fq, PG8_LAS unsigned char* lds, int wid, int lane) const {
        PG8_LAS float* P = (PG8_LAS float*)lds;
        const int row0 = u.pm * BM + wr * 64 + fr, col0 = u.pn * BM + wc * 32 + 8 * fq;
#pragma unroll
        for (int ai = 0; ai < 2; ++ai)
#pragma unroll
            for (int m = 0; m < 4; ++m) {
                const int row = row0 + ai * HALF + m * 16;
                const size_t off = (size_t)row * ldc + col0;
                float q = 0.f;
#pragma unroll
                for (int bj = 0; bj < 2; ++bj) {
                    f32x4 v0 = acc[ai][bj][m][0], v1 = acc[ai][bj][m][1];
                    if (RES) {
                        const f32x4 b0 = *(const f32x4*)(base + off + bj * HALF), b1 = *(const f32x4*)(base + off + bj * HALF + 4);
                        v0 = v0 + b0; v1 = v1 + b1;
                        *(f32x4*)(out + off + bj * HALF) = v0; *(f32x4*)(out + off + bj * HALF + 4) = v1;
                    }
                    u32x4 w; w.x = cvt_pk_bf16(v0[0], v0[1]); w.y = cvt_pk_bf16(v0[2], v0[3]); w.z = cvt_pk_bf16(v1[0], v1[1]); w.w = cvt_pk_bf16(v1[2], v1[3]);
                    *(u32x4*)(hb + off + bj * HALF) = w;
                    q += (v0[0] * v0[0] + v0[1] * v0[1]) + (v0[2] * v0[2] + v0[3] * v0[3]) + (v1[0] * v1[0] + v1[1] * v1[1]) + (v1[2] * v1[2] + v1[3] * v1[3]);
                }
                q += __shfl_xor(q, 16); q += __shfl_xor(q, 32);
                if (fq == 0) P[(ai * HALF + wr * 64 + m * 16 + fr) * 4 + wc] = q;
            }
        asm volatile("s_waitcnt lgkmcnt(0)" ::: "memory"); __builtin_amdgcn_s_barrier(); asm volatile("" ::: "memory");
        const int tid = wid * 64 + lane;
        if (tid < 256) { const f32x4 p = ((const PG8_LAS f32x4*)lds)[tid]; part[(size_t)(u.pm * BM + tid) * 4 + u.pn] = (p[0] + p[1]) + (p[2] + p[3]); }
        asm volatile("s_waitcnt lgkmcnt(0)" ::: "memory"); __builtin_amdgcn_s_barrier(); asm volatile("" ::: "memory");
    }
};
struct EpiGate {
    static constexpr bool PERM = true, AFTER_DRAIN = false;
    float* out; const bf16_t* eraw; const float* part_h; const float* part_e; const float* g_emb; int ldc; float eps;
    __device__ __forceinline__ void operator()(const f32x4 (&acc)[2][2][4][2], const Unit& u, int wr, int wc, int fr, int fq) const {
        const int row0 = u.pm * BM + wr * 64 + fr, col0 = u.pn * BM + wc * 32 + 8 * fq;
        f32x4 gv[2][2];
#pragma unroll
        for (int bj = 0; bj < 2; ++bj) { gv[bj][0] = *(const f32x4*)(g_emb + col0 + bj * HALF); gv[bj][1] = *(const f32x4*)(g_emb + col0 + bj * HALF + 4); }
#pragma unroll
        for (int ai = 0; ai < 2; ++ai)
#pragma unroll
            for (int m = 0; m < 4; ++m) {
                const int row = row0 + ai * HALF + m * 16;
                const size_t off = (size_t)row * ldc + col0;
                const float sh = rstd_from_part(part_h, row, 1.0f / 1024.0f, eps), se = rstd_from_part(part_e, row, 1.0f / 1024.0f, eps);
#pragma unroll
                for (int bj = 0; bj < 2; ++bj) {
                    const u32x4 ew = *(const u32x4*)(eraw + off + bj * HALF);
                    f32x4 e0, e1;
                    e0[0] = __uint_as_float(ew.x << 16); e0[1] = __uint_as_float(ew.x & 0xffff0000u); e0[2] = __uint_as_float(ew.y << 16); e0[3] = __uint_as_float(ew.y & 0xffff0000u);
                    e1[0] = __uint_as_float(ew.z << 16); e1[1] = __uint_as_float(ew.z & 0xffff0000u); e1[2] = __uint_as_float(ew.w << 16); e1[3] = __uint_as_float(ew.w & 0xffff0000u);
                    f32x4 h0 = *(const f32x4*)(out + off + bj * HALF), h1 = *(const f32x4*)(out + off + bj * HALF + 4);
                    const f32x4 a0 = acc[ai][bj][m][0] * sh, a1 = acc[ai][bj][m][1] * sh;
#pragma unroll
                    for (int e = 0; e < 4; ++e) {
                        const float g0 = 1.0f / (1.0f + __expf(-a0[e])), g1 = 1.0f / (1.0f + __expf(-a1[e]));
                        h0[e] += g0 * (e0[e] * se * gv[bj][0][e]); h1[e] += g1 * (e1[e] * se * gv[bj][1][e]);
                    }
                    *(f32x4*)(out + off + bj * HALF) = h0; *(f32x4*)(out + off + bj * HALF + 4) = h1;
                }
            }
    }
};
template <class Epi, class Sched, bool ALIGN_EPI = false, bool SP2 = false>
__device__ __forceinline__ void gemm_phase(PG8_LAS unsigned char* lds, const Gemm g, const Sched& S, const Epi& E) {
    const int tid = threadIdx.x, wid = __builtin_amdgcn_readfirstlane(tid >> 6), lane = tid & 63, wr = wid >> 2, wc = wid & 3, fr = lane & 15, fq = lane >> 4;
    const int K = g.K, nt = K / BK;
    unsigned voffA[2], voffB[2];
#pragma unroll
    for (int i = 0; i < 2; ++i) { int R, C; stage_rc(tid * 16 + i * 8192, R, C); const int Rb = Epi::PERM ? ((R & ~31) + perm32(R & 31)) : R;
        voffA[i] = (unsigned)(R * K + C) * 2u; voffB[i] = (unsigned)(Rb * K + C) * 2u; }
    const size_t kstep = (size_t)(BK * 2);
    const size_t hstep = (size_t)HALF * K * 2;
    const size_t tstep = 2 * hstep;
    const unsigned ldsw = (unsigned)wid * 1024u;
    const int aoff = lds_byte(wr * 64 + fr, fq * 8), boff = lds_byte(wc * 32 + fr, fq * 8);
#define PG8_SA(b, h) (((b) * 2 + (h)) * HTB)
#define PG8_SB(b, h) ((4 + (b) * 2 + (h)) * HTB)
#define PG8_STAGE(bufoff, gbase, voff) do { _Pragma("unroll") for (int _i = 0; _i < 2; ++_i) \
        __builtin_amdgcn_global_load_lds((const unsigned*)((const char*)(gbase) + (voff)[_i]), (PG8_LAS unsigned*)(lds + (bufoff) + ldsw + _i * 8192), 16, 0, 0); } while (0)
#define PG8_LDA(dst, b, h) do { _Pragma("unroll") for (int m = 0; m < 4; ++m) _Pragma("unroll") for (int k = 0; k < 2; ++k) dst[m][k] = *(const PG8_LAS bf16x8*)(lds + PG8_SA(b, h) + aoff + m * 2048 + k * 1024); } while (0)
#define PG8_LDB(dst, b, h) do { _Pragma("unroll") for (int n = 0; n < 2; ++n) _Pragma("unroll") for (int k = 0; k < 2; ++k) dst[n][k] = *(const PG8_LAS bf16x8*)(lds + PG8_SB(b, h) + boff + n * 2048 + k * 1024); } while (0)
#define PG8_MMA(ai, bj, At, Bt) do { __builtin_amdgcn_s_setprio(1); _Pragma("unroll") for (int m = 0; m < 4; ++m) _Pragma("unroll") for (int n = 0; n < 2; ++n) _Pragma("unroll") for (int k = 0; k < 2; ++k) \
        acc[ai][bj][m][n] = __builtin_amdgcn_mfma_f32_16x16x32_bf16(Bt[n][k], At[m][k], acc[ai][bj][m][n], 0, 0, 0); __builtin_amdgcn_s_setprio(0); } while (0)
#define PG8_WAIT_V(n) asm volatile("s_waitcnt vmcnt(" #n ")" ::: "memory")
#define PG8_WAIT_L(n) asm volatile("s_waitcnt lgkmcnt(" #n ")" ::: "memory")
#define PG8_BAR __builtin_amdgcn_s_barrier()
#define PG8_SCHED __builtin_amdgcn_sched_barrier(0)
    Unit cur, nxt; int ui = 0;
    if (!S.next(0, cur)) return;
    f32x4 acc[2][2][4][2];
#pragma unroll
    for (int a = 0; a < 2; ++a)
#pragma unroll
        for (int b = 0; b < 2; ++b)
#pragma unroll
            for (int m = 0; m < 4; ++m)
#pragma unroll
                for (int n = 0; n < 2; ++n) acc[a][b][m][n] = (f32x4){0.f, 0.f, 0.f, 0.f};
    bf16x8 At[4][2], B0[2][2], B1[2][2];
    const char* cA = (const char*)g.A + (size_t)cur.pm * tstep; const char* cB = (const char*)g.Bt + (size_t)cur.pn * tstep;
    S.a_ready(cur);
    if constexpr (SP2) {
        PG8_STAGE(PG8_SB(0, 0), cB, voffB); PG8_STAGE(PG8_SB(0, 1), cB + hstep, voffB); PG8_STAGE(PG8_SA(0, 0), cA, voffA); PG8_STAGE(PG8_SA(0, 1), cA + hstep, voffA);
        if (wr == 1) PG8_BAR;
        PG8_WAIT_V(2); PG8_BAR;
        PG8_STAGE(PG8_SB(1, 0), cB + kstep, voffB); PG8_STAGE(PG8_SA(1, 0), cA + kstep, voffA); PG8_STAGE(PG8_SB(1, 1), cB + hstep + kstep, voffB);
        PG8_WAIT_V(6); PG8_BAR;
    } else {
        PG8_STAGE(PG8_SB(0, 0), cB, voffB); PG8_STAGE(PG8_SA(0, 0), cA, voffA); PG8_STAGE(PG8_SB(0, 1), cB + hstep, voffB); PG8_STAGE(PG8_SA(0, 1), cA + hstep, voffA);
        if (wr == 1) PG8_BAR;
        PG8_WAIT_V(4); PG8_BAR;
        PG8_STAGE(PG8_SB(1, 0), cB + kstep, voffB); PG8_STAGE(PG8_SA(1, 0), cA + kstep, voffA); PG8_STAGE(PG8_SB(1, 1), cB + hstep + kstep, voffB);
        PG8_WAIT_V(6); PG8_BAR;
    }
    for (;;) {
        const bool has_next = S.next(ui + 1, nxt);
        const char* nA = has_next ? (const char*)g.A + (size_t)nxt.pm * tstep : cA; const char* nB = has_next ? (const char*)g.Bt + (size_t)nxt.pn * tstep : cB;
        for (int t = 0; t < nt; t += 2) {
            const bool last = (t == nt - 2);
            const char* a1 = cA + (size_t)(t + 1) * kstep;
            const char* a2 = last ? nA : cA + (size_t)(t + 2) * kstep; const char* b2 = last ? nB : cB + (size_t)(t + 2) * kstep;
            const char* a3 = a2 + kstep; const char* b3 = b2 + kstep;
            if (last && has_next) S.a_ready(nxt);
            if constexpr (SP2) {
            PG8_LDB(B0, 0, 0); PG8_LDB(B1, 0, 1); PG8_SCHED; PG8_LDA(At, 0, 0); PG8_STAGE(PG8_SA(1, 1), a1 + hstep, voffA);
            PG8_WAIT_V(8); PG8_WAIT_L(0); PG8_BAR; PG8_MMA(0, 0, At, B0); PG8_MMA(0, 1, At, B1); PG8_BAR; PG8_SCHED;
            PG8_LDA(At, 0, 1); PG8_STAGE(PG8_SB(0, 0), b2, voffB); PG8_STAGE(PG8_SB(0, 1), b2 + hstep, voffB); PG8_STAGE(PG8_SA(0, 0), a2, voffA);
            PG8_WAIT_V(8); PG8_WAIT_L(0); PG8_BAR; PG8_MMA(1, 0, At, B0); PG8_MMA(1, 1, At, B1); PG8_BAR; PG8_SCHED;
            PG8_LDB(B0, 1, 0); PG8_LDB(B1, 1, 1); PG8_SCHED; PG8_LDA(At, 1, 0); PG8_STAGE(PG8_SA(0, 1), a2 + hstep, voffA);
            PG8_WAIT_V(8); PG8_WAIT_L(0); PG8_BAR; PG8_MMA(0, 0, At, B0); PG8_MMA(0, 1, At, B1); PG8_BAR; PG8_SCHED;
            PG8_LDA(At, 1, 1); PG8_STAGE(PG8_SB(1, 0), b3, voffB); PG8_STAGE(PG8_SB(1, 1), b3 + hstep, voffB); PG8_STAGE(PG8_SA(1, 0), a3, voffA);
            PG8_WAIT_V(8); PG8_WAIT_L(0); PG8_BAR; PG8_MMA(1, 0, At, B0); PG8_MMA(1, 1, At, B1); PG8_BAR; PG8_SCHED;
            } else {
            PG8_LDB(B0, 0, 0); PG8_SCHED; PG8_LDA(At, 0, 0); PG8_STAGE(PG8_SA(1, 1), a1 + hstep, voffA);
            PG8_WAIT_L(8); PG8_BAR; PG8_WAIT_L(0); PG8_MMA(0, 0, At, B0); PG8_BAR; PG8_SCHED;
            PG8_LDB(B1, 0, 1); PG8_STAGE(PG8_SB(0, 0), b2, voffB);
            PG8_BAR; PG8_WAIT_L(0); PG8_MMA(0, 1, At, B1); PG8_BAR;
            PG8_LDA(At, 0, 1); PG8_STAGE(PG8_SA(0, 0), a2, voffA);
            PG8_BAR; PG8_WAIT_L(0); PG8_MMA(1, 0, At, B0); PG8_BAR; PG8_SCHED;
            PG8_STAGE(PG8_SB(0, 1), b2 + hstep, voffB);
            PG8_WAIT_V(6); PG8_BAR; PG8_MMA(1, 1, At, B1); PG8_BAR;
            PG8_LDB(B0, 1, 0); PG8_SCHED; PG8_LDA(At, 1, 0); PG8_STAGE(PG8_SA(0, 1), a2 + hstep, voffA);
            PG8_WAIT_L(8); PG8_BAR; PG8_WAIT_L(0); PG8_MMA(0, 0, At, B0); PG8_BAR; PG8_SCHED;
            PG8_LDB(B1, 1, 1); PG8_STAGE(PG8_SB(1, 0), b3, voffB);
            PG8_BAR; PG8_WAIT_L(0); PG8_MMA(0, 1, At, B1); PG8_BAR;
            PG8_LDA(At, 1, 1); PG8_STAGE(PG8_SA(1, 0), a3, voffA);
            PG8_BAR; PG8_WAIT_L(0); PG8_MMA(1, 0, At, B0); PG8_BAR; PG8_SCHED;
            PG8_STAGE(PG8_SB(1, 1), b3 + hstep, voffB);
            PG8_WAIT_V(6); PG8_BAR; PG8_MMA(1, 1, At, B1); PG8_BAR;
            }
        }
        if constexpr (ALIGN_EPI) { if (wr == 0) PG8_BAR; }
        if constexpr (!Epi::AFTER_DRAIN) { E(acc, cur, wr, wc, fr, fq); S.done(cur); }
        if (!has_next) break;
#pragma unroll
        for (int a = 0; a < 2; ++a)
#pragma unroll
            for (int b = 0; b < 2; ++b)
#pragma unroll
                for (int m = 0; m < 4; ++m)
#pragma unroll
                    for (int n = 0; n < 2; ++n) acc[a][b][m][n] = (f32x4){0.f, 0.f, 0.f, 0.f};
        cur = nxt; cA = nA; cB = nB; ++ui;
        if constexpr (ALIGN_EPI) { if (wr == 1) PG8_BAR; }
    }
    PG8_WAIT_V(0);
    if constexpr (!ALIGN_EPI) { if (wr == 0) PG8_BAR; }
    PG8_BAR;
    if constexpr (Epi::AFTER_DRAIN) { E.fused(acc, cur, wr, wc, fr, fq, lds, wid, lane); S.done(cur); }
#undef PG8_SA
#undef PG8_SB
#undef PG8_STAGE
#undef PG8_LDA
#undef PG8_LDB
#undef PG8_MMA
#undef PG8_WAIT_V
#undef PG8_WAIT_L
#undef PG8_BAR
#undef PG8_SCHED
}
}
#ifndef PG8_SP2
#define PG8_SP2 true
#endif
#ifndef PG8_ALIGN
#define PG8_ALIGN true
#endif

constexpr int NWAVES = 8;
constexpr int S_ = 16384, D_ = 1024, FF_ = 4096, PLE_ = 256, INW_ = 3088, ZW = 3072;
constexpr int Z_GQ = 0, Z_GK = 256, Z_GV = 512, Z_GG = 1024, Z_MQ = 1536, Z_MK = 2048, Z_MV = 2560;
constexpr float EPS_ = 1e-6f;

constexpr size_t MiB = 1u << 20, KiB = 1u << 10;
constexpr size_t WS_CTL = 0, CTL_ZERO_BYTES = 1 * MiB;
constexpr size_t WS_WIN = 1 * MiB, WS_WOUT = 7 * MiB, WS_WUP = 9 * MiB, WS_WDOWN = 17 * MiB, WS_WPG = 25 * MiB, WS_WPP = 27 * MiB, WS_WGA = 27 * MiB + 512 * KiB;
constexpr size_t WS_SMALL = 28 * MiB;
constexpr size_t WS_RSTDX = WS_SMALL, WS_GA = WS_SMALL + 64 * KiB, WS_DECAY = WS_SMALL + 1088 * KiB, WS_KMEAN = WS_SMALL + 1344 * KiB,
                 WS_SSQH1 = WS_SMALL + 1472 * KiB, WS_SSQH2 = WS_SMALL + 1728 * KiB, WS_SSQE = WS_SMALL + 1984 * KiB, WS_LPART = WS_SMALL + 2240 * KiB;
constexpr size_t WS_ERAW = 32 * MiB, WS_AB = 64 * MiB, WS_Z = 96 * MiB, WS_MIX = 192 * MiB, WS_PB = 224 * MiB, WS_ACT = 96 * MiB, WS_END = 256 * MiB;
constexpr size_t WS_DS = 224 * MiB, WS_SPREV = 64 * MiB, WS_LIST = 80 * MiB;
constexpr size_t OUT_PART = 0, OUT_VT = 48 * MiB;
constexpr int CW_TMO = 0, CW_CNT = 1024  , CW_BAR = 4096;

constexpr int RING_OFF = 0, RING_BYTES = 131072;
constexpr int LDS_BYTES = 160 * 1024;
constexpr int MISC_OFF = LDS_BYTES - 128;

#define GAS __attribute__((address_space(1)))
#define LAS __attribute__((address_space(3)))
typedef unsigned short bf16;
typedef unsigned v4u __attribute__((ext_vector_type(4)));
typedef float f32x4 __attribute__((ext_vector_type(4)));
typedef short bf16x8 __attribute__((ext_vector_type(8)));
typedef GAS unsigned gu32;
typedef GAS unsigned long long gu64;
#define RLX_AGENT __ATOMIC_RELAXED, __HIP_MEMORY_SCOPE_AGENT
#define LDS_WAIT() asm volatile("s_waitcnt lgkmcnt(0)" ::: "memory")
#define VM_WAIT() asm volatile("s_waitcnt vmcnt(0)" ::: "memory")
__device__ __forceinline__ unsigned long long rt() { return __builtin_amdgcn_s_memrealtime(); }
__device__ __forceinline__ unsigned f2bf(float f) { unsigned u = __builtin_bit_cast(unsigned, f); return (u + 0x7fffu + ((u >> 16) & 1u)) >> 16; }
__device__ __forceinline__ unsigned pk2(float lo, float hi) { return f2bf(lo) | (f2bf(hi) << 16); }

#define XB_TMO      128
#define XB_XCNT(j)  (256  + 64 * (j))
#define XB_XSUB(j)  (1280 + 64 * (j))
#define XB_XGEN(j)  (2304 + 64 * (j))
#define XB_TOP      3328
#define XB_TOPGEN   3392
#define XCD_BAR_WORDS 3456
#define XB_SPIN_CAP (1u << 18)

__device__ __forceinline__ unsigned xb_ld(unsigned* p)              { return __hip_atomic_load(p, __ATOMIC_RELAXED, __HIP_MEMORY_SCOPE_AGENT); }
__device__ __forceinline__ unsigned xb_add(unsigned* p, unsigned v) { return __hip_atomic_fetch_add(p, v, __ATOMIC_RELAXED, __HIP_MEMORY_SCOPE_AGENT); }
__device__ __forceinline__ unsigned xb_xcc_id() { return (unsigned)__builtin_amdgcn_s_getreg((3 << 11) | 20) & 0xFu; }
#define XB_SPIN(cond, bar) do { unsigned _sp = 0; while (cond) { __builtin_amdgcn_s_sleep(1); \
    if ((++_sp & 255u) == 0u) { if (xb_ld(&(bar)[XB_TMO])) break; if (_sp > XB_SPIN_CAP) { atomicAdd(&(bar)[XB_TMO], 1u); break; } } } } while (0)

struct XcdBarrier {
    unsigned* bar; unsigned x;
    volatile LAS unsigned* st;
};

__device__ __forceinline__ XcdBarrier xcd_barrier_post(unsigned* bar, volatile LAS unsigned* st) {
    XcdBarrier b; b.bar = bar; b.x = xb_xcc_id(); b.st = st;
    if (threadIdx.x == 0) (void)xb_add(&bar[XB_XCNT(b.x)], 1u);
    return b;
}
__device__ __forceinline__ void xcd_barrier_complete(unsigned* bar, unsigned x, unsigned& nloc, unsigned& nx) {
    const unsigned G = gridDim.x * gridDim.y * gridDim.z;
    unsigned sum, cnt, mine, sp = 0u;
    for (;;) {
        sum = 0u; cnt = 0u; mine = 0u;
#pragma unroll
        for (unsigned j = 0; j < 16; ++j) { const unsigned c = xb_ld(&bar[XB_XCNT(j)]); sum += c; cnt += (c > 0u) ? 1u : 0u; mine = (j == x) ? c : mine; }
        if (sum == G) break;
        __builtin_amdgcn_s_sleep(1);
        if ((++sp & 255u) == 0u) { if (xb_ld(&bar[XB_TMO])) break; if (sp > XB_SPIN_CAP) { atomicAdd(&bar[XB_TMO], 1u); break; } }
    }
    nloc = mine > 0u ? mine : 1u; nx = cnt > 0u ? cnt : 1u;
}

__device__ __forceinline__ void xcd_barrier(const XcdBarrier& b) {
    asm volatile("s_waitcnt vmcnt(0)" ::: "memory");
    __syncthreads();
    if (threadIdx.x == 0) {
        unsigned* bar = b.bar;
        __builtin_amdgcn_s_waitcnt(0);
        unsigned nloc = b.st[0], nx = b.st[1];
        if (nloc == 0u) { xcd_barrier_complete(bar, b.x, nloc, nx); b.st[0] = nloc; b.st[1] = nx; }
        const unsigned old = xb_add(&bar[XB_XSUB(b.x)], 1u);
        const unsigned gen = old / nloc;
        if (old + 1u == (gen + 1u) * nloc) {
            __builtin_amdgcn_fence(__ATOMIC_RELEASE, "agent");
            asm volatile("s_waitcnt vmcnt(0)" ::: "memory");
            const unsigned og = xb_add(&bar[XB_TOP], 1u);
            const unsigned tg = og / nx;
            if (og + 1u == (tg + 1u) * nx) xb_add(&bar[XB_TOPGEN], 1u);
            else XB_SPIN(xb_ld(&bar[XB_TOPGEN]) == tg, bar);
            __builtin_amdgcn_fence(__ATOMIC_ACQUIRE, "agent");
            xb_add(&bar[XB_XGEN(b.x)], 1u);
            asm volatile("s_waitcnt vmcnt(0)" ::: "memory");
        } else {
            XB_SPIN(xb_ld(&bar[XB_XGEN(b.x)]) == gen, bar);
            __builtin_amdgcn_fence(__ATOMIC_ACQUIRE, "agent");
            asm volatile("s_waitcnt vmcnt(0)" ::: "memory");
        }
    }
    __syncthreads();
}

struct Frame {
    LAS unsigned char* lds;
    volatile LAS unsigned* MISC;
    gu32* ctl;
    int tid, lane, wave, vcu, G;
    unsigned char* ws; float* out;
    const float *x, *p; const int* pos;
    const float *g_mix, *w_in, *w_a2, *b_a, *g_gla, *g_mq, *g_mk, *w_out, *g_ffn, *w_up, *w_down, *g_pg, *w_pg, *w_pp, *g_pe;
};
__device__ __forceinline__ float wave_sum(float v) {
#pragma unroll
    for (int o = 1; o < 64; o <<= 1) v += __shfl_xor(v, o);
    return v;
}
__device__ __forceinline__ float bf2f(unsigned v16) { return __uint_as_float(v16 << 16); }

__device__ __forceinline__ void p0_transpose_item(const float* W, int ldn, int src_col, const float* gain, int K, bf16* WT, int n_dst, int k0, LAS float* scr, int lane) {
#pragma unroll 8
    for (int i = 0; i < 32; ++i) { const int kk = 2 * i + (lane >> 5); float w = W[(size_t)(k0 + kk) * ldn + src_col + (lane & 31)]; if (gain) w *= gain[k0 + kk]; scr[kk * 33 + (lane & 31)] = w; }
    LDS_WAIT(); asm volatile("" ::: "memory");
    const int c = lane & 7;
#pragma unroll
    for (int j = 0; j < 4; ++j) { const int n = (lane >> 3) + 8 * j; const LAS float* s = scr + (8 * c) * 33 + n;
        v4u o; o.x = pk2(s[0 * 33], s[1 * 33]); o.y = pk2(s[2 * 33], s[3 * 33]); o.z = pk2(s[4 * 33], s[5 * 33]); o.w = pk2(s[6 * 33], s[7 * 33]);
        *(GAS v4u*)(WT + (size_t)(n_dst + n) * K + k0 + 8 * c) = o; }
    LDS_WAIT(); asm volatile("" ::: "memory");
}
__device__ __forceinline__ void p0_prologue(Frame& F) {
    LAS float* scr = (LAS float*)(F.lds + RING_OFF + F.wave * 16384);
    const int gw = F.vcu * NWAVES + F.wave, NGW = F.G * NWAVES;
    bf16* Win_t = (bf16*)(F.ws + WS_WIN); bf16* Wout_t = (bf16*)(F.ws + WS_WOUT); bf16* Wup_t = (bf16*)(F.ws + WS_WUP); bf16* Wdown_t = (bf16*)(F.ws + WS_WDOWN);
    bf16* Wpg_t = (bf16*)(F.ws + WS_WPG); bf16* Wpp_t = (bf16*)(F.ws + WS_WPP); bf16* Wga_t = (bf16*)(F.ws + WS_WGA);
    constexpr int I_IN = (D_ / 64) * (ZW / 32), I_OUT = (D_ / 64) * (D_ / 32), I_UP = (D_ / 64) * (FF_ / 32), I_DN = (FF_ / 64) * (D_ / 32), I_PG = I_OUT, I_PP = (PLE_ / 64) * (D_ / 32);
    constexpr int NITEMS = I_IN + I_OUT + I_UP + I_DN + I_PG + I_PP;
    for (int it = gw; it < NITEMS; it += NGW) {
        int r = it;
        if (r < I_IN) { const int nb = r % (ZW / 32), kb = r / (ZW / 32), n0 = 32 * nb; p0_transpose_item(F.w_in, INW_, n0 < 1536 ? n0 : n0 + 16, F.g_mix, D_, Win_t, n0, 64 * kb, scr, F.lane); continue; } r -= I_IN;
        if (r < I_OUT) { const int nb = r % (D_ / 32), kb = r / (D_ / 32); p0_transpose_item(F.w_out, D_, 32 * nb, nullptr, D_, Wout_t, 32 * nb, 64 * kb, scr, F.lane); continue; } r -= I_OUT;
        if (r < I_UP) { const int nb = r % (FF_ / 32), kb = r / (FF_ / 32); p0_transpose_item(F.w_up, FF_, 32 * nb, F.g_ffn, D_, Wup_t, 32 * nb, 64 * kb, scr, F.lane); continue; } r -= I_UP;
        if (r < I_DN) { const int nb = r % (D_ / 32), kb = r / (D_ / 32); p0_transpose_item(F.w_down, D_, 32 * nb, nullptr, FF_, Wdown_t, 32 * nb, 64 * kb, scr, F.lane); continue; } r -= I_DN;
        if (r < I_PG) { const int nb = r % (D_ / 32), kb = r / (D_ / 32); p0_transpose_item(F.w_pg, D_, 32 * nb, F.g_pg, D_, Wpg_t, 32 * nb, 64 * kb, scr, F.lane); continue; } r -= I_PG;
        { const int nb = r % (D_ / 32), kb = r / (D_ / 32); p0_transpose_item(F.w_pp, D_, 32 * nb, nullptr, PLE_, Wpp_t, 32 * nb, 64 * kb, scr, F.lane); }
    }
    for (int i = (F.vcu * NWAVES + F.wave) * 64 + F.lane; i < 16 * D_; i += NGW * 64) { const int r = i >> 10, k = i & 1023; Wga_t[i] = (bf16)f2bf(F.w_in[(size_t)k * INW_ + 1536 + r] * F.g_mix[k]); }
    bf16* xb = (bf16*)(F.ws + WS_AB); bf16* pb = (bf16*)(F.ws + WS_PB); float* rstdx = (float*)(F.ws + WS_RSTDX);
    for (int m = gw; m < S_; m += NGW) {
        const GAS f32x4* xr = (const GAS f32x4*)(F.x + (size_t)m * D_) + F.lane;
        f32x4 v[4]; float s = 0.f;
#pragma unroll
        for (int j = 0; j < 4; ++j) { v[j] = xr[64 * j]; s += (v[j].x * v[j].x + v[j].y * v[j].y) + (v[j].z * v[j].z + v[j].w * v[j].w); }
        s = wave_sum(s);
        GAS unsigned long long* o8 = (GAS unsigned long long*)(xb + (size_t)m * D_) + F.lane;
#pragma unroll
        for (int j = 0; j < 4; ++j) o8[64 * j] = (unsigned long long)pk2(v[j].x, v[j].y) | ((unsigned long long)pk2(v[j].z, v[j].w) << 32);
        if (F.lane == 0) rstdx[m] = 1.0f / sqrtf(s * (1.0f / D_) + EPS_);
        const f32x4 pv = *((const GAS f32x4*)(F.p + (size_t)m * PLE_) + F.lane);
        *((GAS unsigned long long*)(pb + (size_t)m * PLE_) + F.lane) = (unsigned long long)pk2(pv.x, pv.y) | ((unsigned long long)pk2(pv.z, pv.w) << 32);
    }
}

typedef float f32x16 __attribute__((ext_vector_type(16)));
typedef __bf16 bf2_t __attribute__((ext_vector_type(2)));
typedef float f2_t __attribute__((ext_vector_type(2)));
__device__ __forceinline__ unsigned pkbf(float lo, float hi) { f2_t v = {lo, hi}; bf2_t b = __builtin_convertvector(v, bf2_t); return __builtin_bit_cast(unsigned, b); }
#define MFMA32(a, b, c) __builtin_amdgcn_mfma_f32_32x32x16_bf16((a), (b), (c), 0, 0, 0)
#define WG_SYNC() do { asm volatile("s_waitcnt vmcnt(0) lgkmcnt(0)" ::: "memory"); __builtin_amdgcn_s_barrier(); asm volatile("" ::: "memory"); } while (0)
__device__ __forceinline__ bf16x8 pack8(const f32x16& x, int s) {
    v4u p; p.x = pkbf(x[8 * s], x[8 * s + 1]); p.y = pkbf(x[8 * s + 2], x[8 * s + 3]); p.z = pkbf(x[8 * s + 4], x[8 * s + 5]); p.w = pkbf(x[8 * s + 6], x[8 * s + 7]);
    return __builtin_bit_cast(bf16x8, p);
}
__device__ __forceinline__ float log_sigmoid(float s) { return fminf(s, 0.f) - log1pf(__expf(-fabsf(s))); }
constexpr int GROW = 72;
__device__ __forceinline__ int tperm(int tt) { return (tt & ~15) + 8 * ((tt >> 2) & 1) + 4 * ((tt >> 3) & 1) + (tt & 3); }

__device__ __forceinline__ void gla_cumsum(Frame& F, const LAS float* GAS_, LAS float* TOT, float (&bl)[32], float& blast, float& boff) {
    const int c = F.tid & 255, half = F.tid >> 8;
    float w2[16];
#pragma unroll
    for (int r = 0; r < 16; ++r) w2[r] = F.w_a2[r * 256 + c];
    const float bias = F.b_a[c];
    float run = 0.f;
#pragma unroll
    for (int i = 0; i < 32; ++i) {
        const LAS f32x4* g4 = (const LAS f32x4*)(GAS_ + (32 * half + i) * 16);
        const f32x4 g0 = g4[0], g1 = g4[1], g2 = g4[2], g3 = g4[3];
        float a = bias;
        a += g0[0] * w2[0]; a += g0[1] * w2[1]; a += g0[2] * w2[2]; a += g0[3] * w2[3];
        a += g1[0] * w2[4]; a += g1[1] * w2[5]; a += g1[2] * w2[6]; a += g1[3] * w2[7];
        a += g2[0] * w2[8]; a += g2[1] * w2[9]; a += g2[2] * w2[10]; a += g2[3] * w2[11];
        a += g3[0] * w2[12]; a += g3[1] * w2[13]; a += g3[2] * w2[14]; a += g3[3] * w2[15];
        run += log_sigmoid(a) * (1.0f / 16.0f);
        bl[i] = run;
    }
    TOT[half * 256 + c] = run;
    WG_SYNC();
    const float t0 = TOT[c], t1 = TOT[256 + c];
    blast = t0 + t1; boff = half ? t0 : 0.f;
}
__device__ __forceinline__ void gla_fill_vt(Frame& F, const bf16* zb, int t0, LAS bf16* VT) {
    const int tt = F.tid & 63, grp = F.tid >> 6, h = grp >> 1, e0 = (grp & 1) * 64, pt = tperm(tt);
    const bf16* src = zb + (size_t)(t0 + tt) * ZW + Z_GV + 64 * grp;
#pragma unroll
    for (int i = 0; i < 8; ++i) {
        const v4u w = *(const v4u*)(src + 8 * i);
        LAS bf16* dst = VT + (size_t)(h * 128 + e0 + 8 * i) * GROW + pt;
        dst[0 * GROW] = (bf16)(w.x & 0xffffu); dst[1 * GROW] = (bf16)(w.x >> 16); dst[2 * GROW] = (bf16)(w.y & 0xffffu); dst[3 * GROW] = (bf16)(w.y >> 16);
        dst[4 * GROW] = (bf16)(w.z & 0xffffu); dst[5 * GROW] = (bf16)(w.z >> 16); dst[6 * GROW] = (bf16)(w.w & 0xffffu); dst[7 * GROW] = (bf16)(w.w >> 16);
    }
}

__device__ __forceinline__ void gla_a_chunk(Frame& F, int ch) {
    LAS float* GA_S = (LAS float*)(F.lds);
    LAS float* TOT = (LAS float*)(F.lds + 8192);
    LAS bf16* KTE = (LAS bf16*)(F.lds + 10240);
    LAS bf16* VT = (LAS bf16*)(F.lds + 10240 + 4 * 64 * GROW * 2);
    const bf16* xb = (const bf16*)(F.ws + WS_AB); const bf16* zb = (const bf16*)(F.ws + WS_Z); const bf16* wga = (const bf16*)(F.ws + WS_WGA);
    const float* rstdx = (const float*)(F.ws + WS_RSTDX); float* ga_g = (float*)(F.ws + WS_GA); float* decay_g = (float*)(F.ws + WS_DECAY); float* dS_g = (float*)(F.ws + WS_DS);
    const int t0 = ch * 64;
    {
        const int rg = F.wave & 3, kh = F.wave >> 2, r = F.lane & 15, q = F.lane >> 4;
        const bf16* arow = xb + (size_t)(t0 + 16 * rg + r) * D_ + 8 * q; const bf16* brow = wga + (size_t)r * D_ + 8 * q;
        pg8::f32x4 acc = {0.f, 0.f, 0.f, 0.f};
#pragma unroll 4
        for (int s = 16 * kh; s < 16 * kh + 16; ++s) { const bf16x8 a = *(const bf16x8*)(arow + 32 * s), b = *(const bf16x8*)(brow + 32 * s); acc = __builtin_amdgcn_mfma_f32_16x16x32_bf16(a, b, acc, 0, 0, 0); }
#pragma unroll
        for (int g = 0; g < 4; ++g) GA_S[kh * 1024 + (16 * rg + 4 * q + g) * 16 + r] = acc[g];
    }
    WG_SYNC();
    for (int idx = F.tid; idx < 1024; idx += 512) { const float v = (GA_S[idx] + GA_S[1024 + idx]) * rstdx[t0 + (idx >> 4)]; GA_S[idx] = v; ga_g[(size_t)t0 * 16 + idx] = v; }
    WG_SYNC();
    float bl[32], blast, boff;
    gla_cumsum(F, GA_S, TOT, bl, blast, boff);
    {
        const int c = F.tid & 255, half = F.tid >> 8, h = c >> 6, d = c & 63;
        if (half == 0) decay_g[ch * 256 + c] = __expf(blast);
        const bf16* kcol = zb + (size_t)(t0 + 32 * half) * ZW + Z_GK + c;
#pragma unroll
        for (int g8 = 0; g8 < 4; ++g8) {
            float v[8];
#pragma unroll
            for (int j = 0; j < 8; ++j) v[j] = bf2f(kcol[(size_t)(8 * g8 + j) * ZW]) * __expf(blast - (boff + bl[8 * g8 + j]));
            const int tt = 32 * half + 8 * g8, hi = (tt >> 3) & 1;
            LAS bf16* row = KTE + (size_t)(h * 64 + d) * GROW + (tt & ~15) + 4 * hi;
            typedef unsigned u2 __attribute__((ext_vector_type(2)));
            u2 lo, hi2; lo.x = pkbf(v[0], v[1]); lo.y = pkbf(v[2], v[3]); hi2.x = pkbf(v[4], v[5]); hi2.y = pkbf(v[6], v[7]);
            *(LAS u2*)(row) = lo; *(LAS u2*)(row + 8) = hi2;
        }
    }
    gla_fill_vt(F, zb, t0, VT);
    WG_SYNC();
    {
        const int h = F.wave >> 1, dt = F.wave & 1, i = F.lane & 31, hh = F.lane >> 5;
        f32x16 acc[4];
#pragma unroll
        for (int et = 0; et < 4; ++et)
#pragma unroll
            for (int r = 0; r < 16; ++r) acc[et][r] = 0.f;
#pragma unroll
        for (int s = 0; s < 4; ++s) {
            const bf16x8 a = *(const LAS bf16x8*)(KTE + (size_t)(h * 64 + 32 * dt + i) * GROW + 16 * s + 8 * hh);
#pragma unroll
            for (int et = 0; et < 4; ++et) { const bf16x8 b = *(const LAS bf16x8*)(VT + (size_t)(h * 128 + 32 * et + i) * GROW + 16 * s + 8 * hh); acc[et] = MFMA32(a, b, acc[et]); }
        }
#pragma unroll
        for (int et = 0; et < 4; ++et) {
            float* dst = dS_g + ((size_t)(ch * 4 + h) * 128 + 32 * et + i) * 64 + 32 * dt + 4 * hh;
#pragma unroll
            for (int g = 0; g < 4; ++g) *(pg8::f32x4*)(dst + 8 * g) = (pg8::f32x4){acc[et][4 * g], acc[et][4 * g + 1], acc[et][4 * g + 2], acc[et][4 * g + 3]};
        }
    }
    WG_SYNC();
}

__device__ __forceinline__ void gla_b_pair(Frame& F, int pair) {
    LAS float* DSL = (LAS float*)(F.lds);
    LAS float* DEC = (LAS float*)(F.lds + 65536);
    LAS float* SEGE = (LAS float*)(F.lds + 131072);
    LAS float* SEGP = (LAS float*)(F.lds + 131072 + 2048);
    const float* decay_g = (const float*)(F.ws + WS_DECAY); const float* dS_g = (const float*)(F.ws + WS_DS); bf16* sp_g = (bf16*)(F.ws + WS_SPREV);
    const int h = pair >> 6, seg = F.tid >> 6, d = F.tid & 63;
#pragma unroll
    for (int i = 0; i < 8; ++i) { const int idx = F.tid + 512 * i, n = idx >> 4, d4 = idx & 15; *(LAS pg8::f32x4*)(DEC + n * 64 + 4 * d4) = *(const pg8::f32x4*)(decay_g + (size_t)n * 256 + h * 64 + 4 * d4); }
    float Pp[32];
    for (int sub = 0; sub < 2; ++sub) {
        const int e = (pair & 63) * 2 + sub;
#pragma unroll
        for (int i = 0; i < 8; ++i) { const int idx = F.tid + 512 * i, n = idx >> 4, d4 = idx & 15; *(LAS pg8::f32x4*)(DSL + n * 64 + 4 * d4) = *(const pg8::f32x4*)(dS_g + ((size_t)(n * 4 + h) * 128 + e) * 64 + 4 * d4); }
        WG_SYNC();
        float Sv = 0.f, P = 1.f;
#pragma unroll
        for (int i = 0; i < 32; ++i) { const int n = seg * 32 + i; const float x = DSL[n * 64 + d], a = DEC[n * 64 + d]; DSL[n * 64 + d] = Sv; Pp[i] = P; Sv = a * Sv + x; P *= a; }
        SEGE[seg * 64 + d] = Sv; SEGP[seg * 64 + d] = P;
        WG_SYNC();
        float st = 0.f;
        for (int k = 0; k < seg; ++k) st = SEGP[k * 64 + d] * st + SEGE[k * 64 + d];
#pragma unroll
        for (int i = 0; i < 32; ++i) { const int n = seg * 32 + i; const float v = DSL[n * 64 + d] + Pp[i] * st; sp_g[((size_t)(n * 4 + h) * 128 + e) * 64 + d] = (bf16)f2bf(v); }
        WG_SYNC();
    }
}

__device__ __forceinline__ void gla_c_chunk(Frame& F, int ch) {
    LAS float* GA2 = (LAS float*)(F.lds);
    LAS float* TOT = (LAS float*)(F.lds + 4096);
    LAS bf16* QD = (LAS bf16*)(F.lds + 6144);
    LAS bf16* KI = (LAS bf16*)(F.lds + 6144 + 36864);
    LAS bf16* VT = (LAS bf16*)(F.lds + 6144 + 2 * 36864);
    const bf16* zb = (const bf16*)(F.ws + WS_Z); const float* ga_g = (const float*)(F.ws + WS_GA); const bf16* sp_g = (const bf16*)(F.ws + WS_SPREV); bf16* mixb = (bf16*)(F.ws + WS_MIX);
    const int t0 = ch * 64;
    for (int idx = F.tid; idx < 1024; idx += 512) GA2[idx] = ga_g[(size_t)t0 * 16 + idx];
    WG_SYNC();
    float bl[32], blast, boff;
    gla_cumsum(F, GA2, TOT, bl, blast, boff);
    {
        const int c = F.tid & 255, half = F.tid >> 8, h = c >> 6, d = c & 63;
        const bf16* qcol = zb + (size_t)(t0 + 32 * half) * ZW + Z_GQ + c; const bf16* kcol = zb + (size_t)(t0 + 32 * half) * ZW + Z_GK + c;
#pragma unroll
        for (int i = 0; i < 32; ++i) {
            const float b = boff + bl[i];
            const float qd = bf2f(qcol[(size_t)i * ZW]) * __expf(b) * 0.125f, ki = bf2f(kcol[(size_t)i * ZW]) * __expf(-b);
            QD[(size_t)(h * 64 + 32 * half + i) * GROW + d] = (bf16)f2bf(qd); KI[(size_t)(h * 64 + 32 * half + i) * GROW + d] = (bf16)f2bf(ki);
        }
    }
    gla_fill_vt(F, zb, t0, VT);
    WG_SYNC();
    {
        const int h = F.wave >> 1, ct = F.wave & 1, i = F.lane & 31, hh = F.lane >> 5;
        bf16x8 qf[4];
#pragma unroll
        for (int s = 0; s < 4; ++s) qf[s] = *(const LAS bf16x8*)(QD + (size_t)(h * 64 + 32 * ct + i) * GROW + 16 * s + 8 * hh);
        f32x16 acc[4];
#pragma unroll
        for (int et = 0; et < 4; ++et)
#pragma unroll
            for (int r = 0; r < 16; ++r) acc[et][r] = 0.f;
#pragma unroll
        for (int et = 0; et < 4; ++et) {
            const bf16* srow = sp_g + ((size_t)(ch * 4 + h) * 128 + 32 * et + i) * 64 + 8 * hh;
#pragma unroll
            for (int s = 0; s < 4; ++s) { const bf16x8 sf = *(const bf16x8*)(srow + 16 * s); acc[et] = MFMA32(sf, qf[s], acc[et]); }
        }
        for (int jt = 0; jt <= ct; ++jt) {
            f32x16 X;
#pragma unroll
            for (int r = 0; r < 16; ++r) X[r] = 0.f;
#pragma unroll
            for (int s = 0; s < 4; ++s) { const bf16x8 kf = *(const LAS bf16x8*)(KI + (size_t)(h * 64 + 32 * jt + i) * GROW + 16 * s + 8 * hh); X = MFMA32(kf, qf[s], X); }
            if (jt == ct) {
#pragma unroll
                for (int r = 0; r < 16; ++r) { const int j = (r & 3) + 8 * (r >> 2) + 4 * hh; if (j > i) X[r] = 0.f; }
            }
#pragma unroll
            for (int s2 = 0; s2 < 2; ++s2) {
                const bf16x8 xs = pack8(X, s2);
#pragma unroll
                for (int et = 0; et < 4; ++et) { const bf16x8 vf = *(const LAS bf16x8*)(VT + (size_t)(h * 128 + 32 * et + i) * GROW + 32 * jt + 16 * s2 + 8 * hh); acc[et] = MFMA32(vf, xs, acc[et]); }
            }
        }
        float ss = 0.f;
#pragma unroll
        for (int et = 0; et < 4; ++et)
#pragma unroll
            for (int r = 0; r < 16; ++r) ss += acc[et][r] * acc[et][r];
        ss += __shfl_xor(ss, 32);
        const float rn = 1.0f / sqrtf(ss * (1.0f / 128.0f) + EPS_);
        const int t = t0 + 32 * ct + i;
        const bf16* ggrow = zb + (size_t)t * ZW + Z_GG + h * 128; bf16* orow = mixb + (size_t)t * D_ + h * 128;
#pragma unroll
        for (int et = 0; et < 4; ++et)
#pragma unroll
            for (int g = 0; g < 4; ++g) {
                const int e0 = 32 * et + 8 * g + 4 * hh;
                typedef unsigned u2 __attribute__((ext_vector_type(2)));
                const u2 gw = *(const u2*)(ggrow + e0);
                const pg8::f32x4 gl = *(const pg8::f32x4*)(F.g_gla + e0);
                float gv[4] = {bf2f(gw.x & 0xffffu), bf2f(gw.x >> 16), bf2f(gw.y & 0xffffu), bf2f(gw.y >> 16)};
                float o[4];
#pragma unroll
                for (int j = 0; j < 4; ++j) o[j] = acc[et][4 * g + j] * rn * gl[j] * (gv[j] / (1.0f + __expf(-gv[j])));
                u2 w; w.x = pkbf(o[0], o[1]); w.y = pkbf(o[2], o[3]);
                *(u2*)(orow + e0) = w;
            }
    }
    WG_SYNC();
}

struct Args { const void* in[18]; float* out; unsigned char* ws; int ph_lo, ph_hi, li, pad; };
constexpr int N_PHASES = 10;
__global__ void __launch_bounds__(NWAVES * 64, 2) mk_fwd(Args args) {
    extern __shared__ __attribute__((aligned(16))) unsigned char lds[];
    Frame F;
    F.lds = (LAS unsigned char*)lds;
    F.MISC = (volatile LAS unsigned*)(F.lds + MISC_OFF);
    F.tid = threadIdx.x; F.lane = F.tid & 63; F.wave = __builtin_amdgcn_readfirstlane(F.tid >> 6);
    F.G = gridDim.x; { const int bx = blockIdx.x; F.vcu = (F.G % 8 == 0) ? (bx % 8) * (F.G / 8) + bx / 8 : bx; }
    F.ws = args.ws; F.out = args.out; F.ctl = (gu32*)(args.ws + WS_CTL);
    F.x = (const float*)args.in[0]; F.p = (const float*)args.in[1]; F.pos = (const int*)args.in[2]; F.g_mix = (const float*)args.in[3]; F.w_in = (const float*)args.in[4];
    F.w_a2 = (const float*)args.in[5]; F.b_a = (const float*)args.in[6]; F.g_gla = (const float*)args.in[7]; F.g_mq = (const float*)args.in[8]; F.g_mk = (const float*)args.in[9];
    F.w_out = (const float*)args.in[10]; F.g_ffn = (const float*)args.in[11]; F.w_up = (const float*)args.in[12]; F.w_down = (const float*)args.in[13];
    F.g_pg = (const float*)args.in[14]; F.w_pg = (const float*)args.in[15]; F.w_pp = (const float*)args.in[16]; F.g_pe = (const float*)args.in[17];
    if (F.tid < 32) F.MISC[F.tid] = 0u;
    __syncthreads();
    XcdBarrier bar = xcd_barrier_post((unsigned*)(F.ctl + CW_BAR) + args.li * XCD_BAR_WORDS, F.MISC + 8);
    const int lo = args.ph_lo, hi = args.ph_hi;
#define IN(k) (lo <= (k) && (k) < hi)
#define SEAM(k) do { if (IN(k) && IN((k) + 1)) xcd_barrier(bar); } while (0)
    bf16* xb = (bf16*)(F.ws + WS_AB); bf16* zb = (bf16*)(F.ws + WS_Z); bf16* mixb = (bf16*)(F.ws + WS_MIX); bf16* actb = (bf16*)(F.ws + WS_ACT); bf16* erawb = (bf16*)(F.ws + WS_ERAW);

    if (IN(0)) { p0_prologue(F); } SEAM(0);
    if (IN(1)) {
        { pg8::Gemm g{xb, (const bf16*)(F.ws + WS_WIN), S_, ZW, D_}; pg8::StaticOrder S; S.init(S_, ZW, F.G, (int)blockIdx.x);
          pg8::EpiScale<0, 1> E{zb, ZW, (const float*)(F.ws + WS_RSTDX), EPS_};
          pg8::gemm_phase<pg8::EpiScale<0, 1>, pg8::StaticOrder, PG8_ALIGN, PG8_SP2>(F.lds + RING_OFF, g, S, E); }
        { pg8::Gemm g{(const bf16*)(F.ws + WS_PB), (const bf16*)(F.ws + WS_WPP), S_, D_, PLE_}; pg8::StaticOrder S; S.init(S_, D_, F.G, (int)blockIdx.x);
          pg8::EpiRes<false> E{nullptr, nullptr, erawb, (float*)(F.ws + WS_SSQE), D_};
          pg8::gemm_phase<pg8::EpiRes<false>, pg8::StaticOrder, false, PG8_SP2>(F.lds + RING_OFF, g, S, E); }
    } SEAM(1);
    if (IN(2)) { for (int ch = F.vcu; ch < 256; ch += F.G) gla_a_chunk(F, ch); } SEAM(2);
    if (IN(3)) { for (int pr = F.vcu; pr < 256; pr += F.G) gla_b_pair(F, pr); } SEAM(3);
    if (IN(4)) { for (int ch = F.vcu; ch < 256; ch += F.G) gla_c_chunk(F, ch); } SEAM(4);
    SEAM(5);
    if (IN(6)) {
        pg8::Gemm g{mixb, (const bf16*)(F.ws + WS_WOUT), S_, D_, D_}; pg8::StaticOrder S; S.init(S_, D_, F.G, (int)blockIdx.x);
        pg8::EpiRes<true> E{F.x, F.out, xb, (float*)(F.ws + WS_SSQH1), D_};
        pg8::gemm_phase<pg8::EpiRes<true>, pg8::StaticOrder, false, PG8_SP2>(F.lds + RING_OFF, g, S, E);
    } SEAM(6);
    if (IN(7)) {
        pg8::Gemm g{xb, (const bf16*)(F.ws + WS_WUP), S_, FF_, D_}; pg8::StaticOrder S; S.init(S_, FF_, F.G, (int)blockIdx.x);
        pg8::EpiScale<1, 2> E{actb, FF_, (const float*)(F.ws + WS_SSQH1), EPS_};
        pg8::gemm_phase<pg8::EpiScale<1, 2>, pg8::StaticOrder, PG8_ALIGN, PG8_SP2>(F.lds + RING_OFF, g, S, E);
    } SEAM(7);
    if (IN(8)) {
        pg8::Gemm g{actb, (const bf16*)(F.ws + WS_WDOWN), S_, D_, FF_}; pg8::StaticOrder S; S.init(S_, D_, F.G, (int)blockIdx.x);
        pg8::EpiRes<true> E{F.out, F.out, xb, (float*)(F.ws + WS_SSQH2), D_};
        pg8::gemm_phase<pg8::EpiRes<true>, pg8::StaticOrder, false, PG8_SP2>(F.lds + RING_OFF, g, S, E);
    } SEAM(8);
    if (IN(9)) {
        pg8::Gemm g{xb, (const bf16*)(F.ws + WS_WPG), S_, D_, D_}; pg8::StaticOrder S; S.init(S_, D_, F.G, (int)blockIdx.x);
        pg8::EpiGate E{F.out, erawb, (const float*)(F.ws + WS_SSQH2), (const float*)(F.ws + WS_SSQE), F.g_pe, D_, EPS_};
        pg8::gemm_phase<pg8::EpiGate, pg8::StaticOrder, false, PG8_SP2>(F.lds + RING_OFF, g, S, E);
    }
#undef IN
#undef SEAM
}

namespace nv {
__device__ __forceinline__ float ldz(const bf16* z, int t, int col) { return bf2f(z[(size_t)t * ZW + col]); }
__device__ __forceinline__ float wave_max(float v) {
#pragma unroll
    for (int o = 1; o < 64; o <<= 1) v = fmaxf(v, __shfl_xor(v, o));
    return v;
}
__global__ void k_ga(const bf16* __restrict__ xb, const bf16* __restrict__ wga_t, const float* __restrict__ rstdx, float* __restrict__ ga) {
    const int idx = blockIdx.x * blockDim.x + threadIdx.x; if (idx >= S_ * 16) return;
    const int t = idx >> 4, r = idx & 15; float s = 0.f;
    for (int k = 0; k < D_; ++k) s += bf2f(xb[(size_t)t * D_ + k]) * bf2f(wga_t[r * D_ + k]);
    ga[idx] = s * rstdx[t];
}
__global__ void k_gla_prep(const float* __restrict__ ga, const float* __restrict__ w_a2, const float* __restrict__ b_a, float* __restrict__ a_out) {
    const int idx = blockIdx.x * blockDim.x + threadIdx.x; if (idx >= S_ * 256) return;
    const int t = idx >> 8, c = idx & 255; float s = b_a[c];
#pragma unroll
    for (int r = 0; r < 16; ++r) s += ga[t * 16 + r] * w_a2[r * 256 + c];
    const float ls = fminf(s, 0.f) - log1pf(expf(-fabsf(s)));
    a_out[idx] = expf(ls * (1.0f / 16.0f));
}
__global__ void __launch_bounds__(64) k_gla_rec(const bf16* __restrict__ z, const float* __restrict__ a, float* __restrict__ o_raw) {
    const int h = blockIdx.x >> 1, e = (blockIdx.x & 1) * 64 + threadIdx.x;
    float St[64];
#pragma unroll
    for (int d = 0; d < 64; ++d) St[d] = 0.f;
    for (int t = 0; t < S_; ++t) {
        const bf16* zr = z + (size_t)t * ZW;
        const float v = bf2f(zr[Z_GV + h * 128 + e]);
        const bf16* qr = zr + Z_GQ + h * 64; const bf16* kr = zr + Z_GK + h * 64; const float* ar = a + (size_t)t * 256 + h * 64;
        float o = 0.f;
#pragma unroll
        for (int d = 0; d < 64; ++d) { St[d] = ar[d] * St[d] + bf2f(kr[d]) * v; o += bf2f(qr[d]) * St[d]; }
        o_raw[(size_t)t * 512 + h * 128 + e] = o * 0.125f;
    }
}
__global__ void k_gla_post(const float* __restrict__ o_raw, const bf16* __restrict__ z, const float* __restrict__ g_out, bf16* __restrict__ mix) {
    const int wave = (blockIdx.x * blockDim.x + threadIdx.x) >> 6, lane = threadIdx.x & 63; if (wave >= S_ * 4) return;
    const int t = wave >> 2, h = wave & 3;
    const float o0 = o_raw[(size_t)t * 512 + h * 128 + lane], o1 = o_raw[(size_t)t * 512 + h * 128 + 64 + lane];
    const float ss = wave_sum(o0 * o0 + o1 * o1); const float r = 1.0f / sqrtf(ss * (1.0f / 128.0f) + EPS_);
    const float g0 = ldz(z, t, Z_GG + h * 128 + lane), g1 = ldz(z, t, Z_GG + h * 128 + 64 + lane);
    mix[(size_t)t * D_ + h * 128 + lane] = (bf16)f2bf(o0 * r * g_out[lane] * (g0 / (1.0f + expf(-g0))));
    mix[(size_t)t * D_ + h * 128 + 64 + lane] = (bf16)f2bf(o1 * r * g_out[64 + lane] * (g1 / (1.0f + expf(-g1))));
}
__device__ __forceinline__ void sincos_acc(float angf, float& s, float& c) {
    double r = (double)angf * 0.15915494309189533577; r -= floor(r);
    const double q = floor(4.0 * r + 0.5);
    const float phi = (float)((r - 0.25 * q) * 6.283185307179586477);
    const float p2 = phi * phi;
    const float sn = phi * (1.0f + p2 * (-1.0f / 6.0f + p2 * (1.0f / 120.0f + p2 * (-1.0f / 5040.0f + p2 * (1.0f / 362880.0f)))));
    const float cs = 1.0f + p2 * (-0.5f + p2 * (1.0f / 24.0f + p2 * (-1.0f / 720.0f + p2 * (1.0f / 40320.0f + p2 * (-1.0f / 3628800.0f)))));
    const int qi = ((int)q) & 3;
    s = (qi == 0) ? sn : (qi == 1) ? cs : (qi == 2) ? -sn : -cs;
    c = (qi == 0) ? cs : (qi == 1) ? -sn : (qi == 2) ? -cs : sn;
}
__global__ void k_moba_qk(bf16* __restrict__ z, const int* __restrict__ pos, const float* __restrict__ gq, const float* __restrict__ gk) {
    const int wave = (blockIdx.x * blockDim.x + threadIdx.x) >> 6, lane = threadIdx.x & 63; if (wave >= S_ * 8) return;
    const int t = wave >> 3, h = (wave >> 1) & 3, which = wave & 1;
    bf16* p = z + (size_t)t * ZW + (which ? Z_MK : Z_MQ) + h * 128; const float* g = which ? gk : gq;
    const float x1 = bf2f(p[lane]), x2 = bf2f(p[lane + 64]);
    const float ss = wave_sum(x1 * x1 + x2 * x2); const float r = 1.0f / sqrtf(ss * (1.0f / 128.0f) + EPS_);
    const float y1 = x1 * r * g[lane], y2 = x2 * r * g[lane + 64];
    const float inv = 1.0f / powf(10000.0f, (float)lane / 64.0f); const float ang = (float)pos[t] * inv;
    float sn, cs; sincos_acc(ang, sn, cs);
    p[lane] = (bf16)f2bf(y1 * cs - y2 * sn); p[lane + 64] = (bf16)f2bf(y2 * cs + y1 * sn);
}
__global__ void k_moba_kmean(const bf16* __restrict__ z, float* __restrict__ kmean) {
    const int h = blockIdx.x >> 6, blk = blockIdx.x & 63, d = threadIdx.x; float s = 0.f;
    for (int i = 0; i < 256; ++i) s += ldz(z, blk * 256 + i, Z_MK + h * 128 + d);
    kmean[(size_t)(h * 64 + blk) * 128 + d] = s * (1.0f / 256.0f);
}
__global__ void __launch_bounds__(256) k_moba_attn(const bf16* __restrict__ z, const float* __restrict__ kmean, bf16* __restrict__ mix) {
    __shared__ float pl[4][1024];
    const int w = threadIdx.x >> 6, lane = threadIdx.x & 63; const int wave = blockIdx.x * 4 + w; const int q = wave >> 2, h = wave & 3; const int kb = q >> 8;
    const bf16* qrow = z + (size_t)q * ZW + Z_MQ + h * 128; const float scale = 0.08838834764831845f;
    float g = -INFINITY;
    if (lane < kb) { const float* km = kmean + (size_t)(h * 64 + lane) * 128; float s = 0.f; for (int d = 0; d < 128; ++d) s += bf2f(qrow[d]) * km[d]; g = s; }
    int sel[3];
#pragma unroll
    for (int r = 0; r < 3; ++r) { const float m = wave_max(g); const unsigned long long bal = __ballot(g == m); const int idx = __ffsll((long long)bal) - 1; sel[r] = (m > -INFINITY) ? idx : -1; if (lane == idx) g = -INFINITY; }
    float sc[16];
#pragma unroll
    for (int seg = 0; seg < 4; ++seg) { const int blk = (seg < 3) ? sel[seg] : kb;
#pragma unroll
        for (int r = 0; r < 4; ++r) { float s = -INFINITY;
            if (blk >= 0) { const int key = blk * 256 + r * 64 + lane;
                if (seg < 3 || key <= q) { const bf16* kr = z + (size_t)key * ZW + Z_MK + h * 128; float a = 0.f; for (int d = 0; d < 128; ++d) a += bf2f(qrow[d]) * bf2f(kr[d]); s = a * scale; } }
            sc[seg * 4 + r] = s; } }
    float m = sc[0];
#pragma unroll
    for (int i = 1; i < 16; ++i) m = fmaxf(m, sc[i]);
    m = wave_max(m); float sum = 0.f;
#pragma unroll
    for (int i = 0; i < 16; ++i) { const float p = (sc[i] > -INFINITY) ? expf(sc[i] - m) : 0.f; sum += p; pl[w][i * 64 + lane] = p; }
    sum = wave_sum(sum); __syncthreads();
    float a0 = 0.f, a1 = 0.f;
#pragma unroll
    for (int seg = 0; seg < 4; ++seg) { const int blk = (seg < 3) ? sel[seg] : kb; if (blk < 0) continue; const int nk = (seg < 3) ? 256 : ((q & 255) + 1);
        for (int i = 0; i < nk; ++i) { const float p = pl[w][seg * 256 + i]; const bf16* vr = z + (size_t)(blk * 256 + i) * ZW + Z_MV + h * 128; a0 += p * bf2f(vr[lane]); a1 += p * bf2f(vr[lane + 64]); } }
    const float inv = 1.0f / sum;
    mix[(size_t)q * D_ + 512 + h * 128 + lane] = (bf16)f2bf(a0 * inv); mix[(size_t)q * D_ + 512 + h * 128 + 64 + lane] = (bf16)f2bf(a1 * inv);
}
}

static void launch_range(const Args& a0, int lo, int hi, int li, int grid, hipStream_t stream) {
    Args a = a0; a.ph_lo = lo; a.ph_hi = hi; a.li = li;
    hipLaunchKernelGGL(mk_fwd, dim3(grid), dim3(NWAVES * 64), LDS_BYTES, stream, a);
    const hipError_t le = hipPeekAtLastError();
    if (le != hipSuccess) fprintf(stderr, "kernel_launch: launch [%d,%d) failed: %s\n", lo, hi, hipGetErrorName(le));
}
extern "C" void kernel_launch(void* const* d_in, const int* in_sizes, int n_in, void* d_out, int out_size, void* d_ws, size_t ws_size, hipStream_t stream) {
    static int grid = 0;
    if (grid == 0) {
        if (n_in != 18 || out_size != S_ * D_ || ws_size < WS_END) { fprintf(stderr, "kernel_launch: unexpected shapes (n_in %d out %d ws %zu)\n", n_in, out_size, ws_size); grid = -1; return; }
        int dev = 0, cus = 0, per_cu = 0;
        if (hipGetDevice(&dev) != hipSuccess || hipDeviceGetAttribute(&cus, hipDeviceAttributeMultiprocessorCount, dev) != hipSuccess) { grid = -1; return; }
        if (hipFuncSetAttribute((const void*)mk_fwd, hipFuncAttributeMaxDynamicSharedMemorySize, LDS_BYTES) != hipSuccess) { fprintf(stderr, "kernel_launch: hipFuncSetAttribute failed\n"); grid = -1; return; }
        if (hipOccupancyMaxActiveBlocksPerMultiprocessor(&per_cu, (const void*)mk_fwd, NWAVES * 64, LDS_BYTES) != hipSuccess || per_cu < 1) { fprintf(stderr, "kernel_launch: occupancy query says %d\n", per_cu); per_cu = 1; }
        (void)hipGetLastError();
        grid = cus;
        if (grid != 256) fprintf(stderr, "kernel_launch: note: %d CUs\n", grid);
    }
    if (grid < 0) return;
    (void)hipMemsetAsync((char*)d_ws + WS_CTL, 0, CTL_ZERO_BYTES, stream);
    Args a{};
    for (int i = 0; i < 18; ++i) a.in[i] = d_in[i];
    a.out = (float*)d_out; a.ws = (unsigned char*)d_ws;
    launch_range(a, 0, 2, 0, grid, stream);
    launch_range(a, 2, 5, 1, grid, stream);
    {
        unsigned char* ws = (unsigned char*)d_ws;
        bf16* zb = (bf16*)(ws + WS_Z); bf16* mixb = (bf16*)(ws + WS_MIX); float* kmean = (float*)(ws + WS_KMEAN);
        nv::k_moba_qk<<<S_ * 2, 256, 0, stream>>>(zb, (const int*)d_in[2], (const float*)d_in[8], (const float*)d_in[9]);
        nv::k_moba_kmean<<<256, 128, 0, stream>>>(zb, kmean);
        nv::k_moba_attn<<<S_, 256, 0, stream>>>(zb, kmean, mixb);
    }
    launch_range(a, 6, 10, 2, grid, stream);
}
```

```cpp
#include <hip/hip_runtime.h>
#include <cstdio>
#include <cstdint>
#include <math.h>
namespace pg8 {
#define PG8_LAS __attribute__((address_space(3)))
typedef unsigned short bf16_t;
typedef short bf16x8 __attribute__((ext_vector_type(8)));
typedef float f32x4 __attribute__((ext_vector_type(4)));
typedef unsigned u32x4 __attribute__((ext_vector_type(4)));
constexpr int BM = 256, BK = 64, HALF = 128, HTB = HALF * BK * 2  , STAGE_BYTES = 8 * HTB, NXCD = 8, WGM = 8;

__host__ __device__ __forceinline__ int lds_byte(int r, int c) { const int st = (r >> 4) * 2 + (c >> 5), rr = r & 15, cc = c & 31, ob = rr * 64 + cc * 2; return st * 1024 + (ob ^ (((ob >> 9) & 1) << 5)); }
__host__ __device__ __forceinline__ void stage_rc(int b, int& R, int& C) { const int st = b / 1024, sb = b % 1024, swz = sb ^ (((sb >> 9) & 1) << 5); R = (st >> 1) * 16 + swz / 64; C = (st & 1) * 32 + (swz % 64) / 2; }
__host__ __device__ __forceinline__ int perm32(int rho) { const int n = rho >> 4, i = rho & 15; return 8 * (i >> 2) + 4 * n + (i & 3); }

struct Unit { int pm, pn; };
struct Gemm { const bf16_t* A; const bf16_t* Bt; int M, N, K; };

struct StaticOrder {
    int nM, nN, nwg, G, c;
    __host__ __device__ void init(int M, int N, int G_, int c_) { nM = M / BM; nN = N / BM; nwg = nM * nN; G = G_; c = c_; }
    __host__ __device__ bool next(int i, Unit& u) const {
        const long L = (long)i * G + c; if (L >= nwg) return false;
        int wgid = (int)L; { const int q = nwg / NXCD, r = nwg % NXCD, xcd = wgid % NXCD, off = wgid / NXCD; wgid = (xcd < r ? xcd * (q + 1) : r * (q + 1) + (xcd - r) * q) + off; }
        const int nig = WGM * nN, gid = wgid / nig, fm = gid * WGM, gsz = (nM - fm) < WGM ? (nM - fm) : WGM;
        u.pm = fm + ((wgid % nig) % gsz); u.pn = (wgid % nig) / gsz; return true;
    }
    __device__ __forceinline__ void a_ready(const Unit&) const {}
    __device__ __forceinline__ void done(const Unit&) const {}
};

__device__ __forceinline__ unsigned cvt_pk_bf16(float lo, float hi) { unsigned r; asm volatile("v_cvt_pk_bf16_f32 %0, %1, %2" : "=v"(r) : "v"(lo), "v"(hi)); return r; }
typedef float f32x2 __attribute__((ext_vector_type(2)));

__device__ __forceinline__ float rstd_from_part(const float* part, int row, float inv_n, float eps) {
    const f32x4 p = *(const f32x4*)(part + (size_t)row * 4);
    return 1.0f / sqrtf(((p[0] + p[1]) + (p[2] + p[3])) * inv_n + eps);
}
template <int ACT, int RS> struct EpiScale {
    static constexpr bool PERM = true, AFTER_DRAIN = false;
    bf16_t* O; int ldc; const float* rsv; float eps;
    __device__ __forceinline__ void operator()(const f32x4 (&acc)[2][2][4][2], const Unit& u, int wr, int wc, int fr, int fq) const {
        const int row0 = u.pm * BM + wr * 64 + fr, col0 = u.pn * BM + wc * 32 + 8 * fq;
#pragma unroll
        for (int ai = 0; ai < 2; ++ai)
#pragma unroll
            for (int m = 0; m < 4; ++m) {
                const int row = row0 + ai * HALF + m * 16;
                float s = 1.f;
                if (RS == 1) s = rsv[row];
                if (RS == 2) s = rstd_from_part(rsv, row, 1.0f / 1024.0f, eps);
                bf16_t* rowp = O + (size_t)row * ldc + col0;
#pragma unroll
                for (int bj = 0; bj < 2; ++bj) {
                    f32x4 v0 = acc[ai][bj][m][0] * s, v1 = acc[ai][bj][m][1] * s;
                    if (ACT == 1) {
#pragma unroll
                        for (int e = 0; e < 4; ++e) { const float a = fmaxf(v0[e], 0.f), b = fmaxf(v1[e], 0.f); v0[e] = a * a; v1[e] = b * b; }
                    }
                    u32x4 w; w.x = cvt_pk_bf16(v0[0], v0[1]); w.y = cvt_pk_bf16(v0[2], v0[3]); w.z = cvt_pk_bf16(v1[0], v1[1]); w.w = cvt_pk_bf16(v1[2], v1[3]);
                    *(u32x4*)(rowp + bj * HALF) = w;
                }
            }
    }
};
template <bool RES> struct EpiRes {
    static constexpr bool PERM = true, AFTER_DRAIN = true;
    const float* base; float* out; bf16_t* hb; float* part; int ldc;
    __device__ __forceinline__ void fused(f32x4 (&acc)[2][2][4][2], const Unit& u, int wr, int wc, int fr, int fq, PG8_LAS unsigned char* lds, int wid, int lane) const {
        PG8_LAS float* P = (PG8_LAS float*)lds;
        const int row0 = u.pm * BM + wr * 64 + fr, col0 = u.pn * BM + wc * 32 + 8 * fq;
#pragma unroll
        for (int ai = 0; ai < 2; ++ai)
#pragma unroll
            for (int m = 0; m < 4; ++m) {
                const int row = row0 + ai * HALF + m * 16;
                const size_t off = (size_t)row * ldc + col0;
                float q = 0.f;
#pragma unroll
                for (int bj = 0; bj < 2; ++bj) {
                    f32x4 v0 = acc[ai][bj][m][0], v1 = acc[ai][bj][m][1];
                    if (RES) {
                        const f32x4 b0 = *(const f32x4*)(base + off + bj * HALF), b1 = *(const f32x4*)(base + off + bj * HALF + 4);
                        v0 = v0 + b0; v1 = v1 + b1;
                        *(f32x4*)(out + off + bj * HALF) = v0; *(f32x4*)(out + off + bj * HALF + 4) = v1;
                    }
                    u32x4 w; w.x = cvt_pk_bf16(v0[0], v0[1]); w.y = cvt_pk_bf16(v0[2], v0[3]); w.z = cvt_pk_bf16(v1[0], v1[1]); w.w = cvt_pk_bf16(v1[2], v1[3]);
                    *(u32x4*)(hb + off + bj * HALF) = w;
                    q += (v0[0] * v0[0] + v0[1] * v0[1]) + (v0[2] * v0[2] + v0[3] * v0[3]) + (v1[0] * v1[0] + v1[1] * v1[1]) + (v1[2] * v1[2] + v1[3] * v1[3]);
                }
                q += __shfl_xor(q, 16); q += __shfl_xor(q, 32);
                if (fq == 0) P[(ai * HALF + wr * 64 + m * 16 + fr) * 4 + wc] = q;
            }
        asm volatile("s_waitcnt lgkmcnt(0)" ::: "memory"); __builtin_amdgcn_s_barrier(); asm volatile("" ::: "memory");
        const int tid = wid * 64 + lane;
        if (tid < 256) { const f32x4 p = ((const PG8_LAS f32x4*)lds)[tid]; part[(size_t)(u.pm * BM + tid) * 4 + u.pn] = (p[0] + p[1]) + (p[2] + p[3]); }
        asm volatile("s_waitcnt lgkmcnt(0)" ::: "memory"); __builtin_amdgcn_s_barrier(); asm volatile("" ::: "memory");
    }
};
struct EpiGate {
    static constexpr bool PERM = true, AFTER_DRAIN = false;
    float* out; const bf16_t* eraw; const float* part_h; const float* part_e; const float* g_emb; int ldc; float eps;
    __device__ __forceinline__ void operator()(const f32x4 (&acc)[2][2][4][2], const Unit& u, int wr, int wc, int fr, int fq) const {
        const int row0 = u.pm * BM + wr * 64 + fr, col0 = u.pn * BM + wc * 32 + 8 * fq;
        f32x4 gv[2][2];
#pragma unroll
        for (int bj = 0; bj < 2; ++bj) { gv[bj][0] = *(const f32x4*)(g_emb + col0 + bj * HALF); gv[bj][1] = *(const f32x4*)(g_emb + col0 + bj * HALF + 4); }
#pragma unroll
        for (int ai = 0; ai < 2; ++ai)
#pragma unroll
            for (int m = 0; m < 4; ++m) {
                const int row = row0 + ai * HALF + m * 16;
                const size_t off = (size_t)row * ldc + col0;
                const float sh = rstd_from_part(part_h, row, 1.0f / 1024.0f, eps), se = rstd_from_part(part_e, row, 1.0f / 1024.0f, eps);
#pragma unroll
                for (int bj = 0; bj < 2; ++bj) {
                    const u32x4 ew = *(const u32x4*)(eraw + off + bj * HALF);
                    f32x4 e0, e1;
                    e0[0] = __uint_as_float(ew.x << 16); e0[1] = __uint_as_float(ew.x & 0xffff0000u); e0[2] = __uint_as_float(ew.y << 16); e0[3] = __uint_as_float(ew.y & 0xffff0000u);
                    e1[0] = __uint_as_float(ew.z << 16); e1[1] = __uint_as_float(ew.z & 0xffff0000u); e1[2] = __uint_as_float(ew.w << 16); e1[3] = __uint_as_float(ew.w & 0xffff0000u);
                    f32x4 h0 = *(const f32x4*)(out + off + bj * HALF), h1 = *(const f32x4*)(out + off + bj * HALF + 4);
                    const f32x4 a0 = acc[ai][bj][m][0] * sh, a1 = acc[ai][bj][m][1] * sh;
#pragma unroll
                    for (int e = 0; e < 4; ++e) {
                        const float g0 = 1.0f / (1.0f + __expf(-a0[e])), g1 = 1.0f / (1.0f + __expf(-a1[e]));
                        h0[e] += g0 * (e0[e] * se * gv[bj][0][e]); h1[e] += g1 * (e1[e] * se * gv[bj][1][e]);
                    }
                    *(f32x4*)(out + off + bj * HALF) = h0; *(f32x4*)(out + off + bj * HALF + 4) = h1;
                }
            }
    }
};
template <class Epi, class Sched, bool ALIGN_EPI = false, bool SP2 = false>
__device__ __forceinline__ void gemm_phase(PG8_LAS unsigned char* lds, const Gemm g, const Sched& S, const Epi& E) {
    const int tid = threadIdx.x, wid = __builtin_amdgcn_readfirstlane(tid >> 6), lane = tid & 63, wr = wid >> 2, wc = wid & 3, fr = lane & 15, fq = lane >> 4;
    const int K = g.K, nt = K / BK;
    unsigned voffA[2], voffB[2];
#pragma unroll
    for (int i = 0; i < 2; ++i) { int R, C; stage_rc(tid * 16 + i * 8192, R, C); const int Rb = Epi::PERM ? ((R & ~31) + perm32(R & 31)) : R;
        voffA[i] = (unsigned)(R * K + C) * 2u; voffB[i] = (unsigned)(Rb * K + C) * 2u; }
    const size_t kstep = (size_t)(BK * 2);
    const size_t hstep = (size_t)HALF * K * 2;
    const size_t tstep = 2 * hstep;
    const unsigned ldsw = (unsigned)wid * 1024u;
    const int aoff = lds_byte(wr * 64 + fr, fq * 8), boff = lds_byte(wc * 32 + fr, fq * 8);
#define PG8_SA(b, h) (((b) * 2 + (h)) * HTB)
#define PG8_SB(b, h) ((4 + (b) * 2 + (h)) * HTB)
#define PG8_STAGE(bufoff, gbase, voff) do { _Pragma("unroll") for (int _i = 0; _i < 2; ++_i) \
        __builtin_amdgcn_global_load_lds((const unsigned*)((const char*)(gbase) + (voff)[_i]), (PG8_LAS unsigned*)(lds + (bufoff) + ldsw + _i * 8192), 16, 0, 0); } while (0)
#define PG8_LDA(dst, b, h) do { _Pragma("unroll") for (int m = 0; m < 4; ++m) _Pragma("unroll") for (int k = 0; k < 2; ++k) dst[m][k] = *(const PG8_LAS bf16x8*)(lds + PG8_SA(b, h) + aoff + m * 2048 + k * 1024); } while (0)
#define PG8_LDB(dst, b, h) do { _Pragma("unroll") for (int n = 0; n < 2; ++n) _Pragma("unroll") for (int k = 0; k < 2; ++k) dst[n][k] = *(const PG8_LAS bf16x8*)(lds + PG8_SB(b, h) + boff + n * 2048 + k * 1024); } while (0)
#define PG8_MMA(ai, bj, At, Bt) do { __builtin_amdgcn_s_setprio(1); _Pragma("unroll") for (int m = 0; m < 4; ++m) _Pragma("unroll") for (int n = 0; n < 2; ++n) _Pragma("unroll") for (int k = 0; k < 2; ++k) \
        acc[ai][bj][m][n] = __builtin_amdgcn_mfma_f32_16x16x32_bf16(Bt[n][k], At[m][k], acc[ai][bj][m][n], 0, 0, 0); __builtin_amdgcn_s_setprio(0); } while (0)
#define PG8_WAIT_V(n) asm volatile("s_waitcnt vmcnt(" #n ")" ::: "memory")
#define PG8_WAIT_L(n) asm volatile("s_waitcnt lgkmcnt(" #n ")" ::: "memory")
#define PG8_BAR __builtin_amdgcn_s_barrier()
#define PG8_SCHED __builtin_amdgcn_sched_barrier(0)
    Unit cur, nxt; int ui = 0;
    if (!S.next(0, cur)) return;
    f32x4 acc[2][2][4][2];
#pragma unroll
    for (int a = 0; a < 2; ++a)
#pragma unroll
        for (int b = 0; b < 2; ++b)
#pragma unroll
            for (int m = 0; m < 4; ++m)
#pragma unroll
                for (int n = 0; n < 2; ++n) acc[a][b][m][n] = (f32x4){0.f, 0.f, 0.f, 0.f};
    bf16x8 At[4][2], B0[2][2], B1[2][2];
    const char* cA = (const char*)g.A + (size_t)cur.pm * tstep; const char* cB = (const char*)g.Bt + (size_t)cur.pn * tstep;
    S.a_ready(cur);
    if constexpr (SP2) {
        PG8_STAGE(PG8_SB(0, 0), cB, voffB); PG8_STAGE(PG8_SB(0, 1), cB + hstep, voffB); PG8_STAGE(PG8_SA(0, 0), cA, voffA); PG8_STAGE(PG8_SA(0, 1), cA + hstep, voffA);
        if (wr == 1) PG8_BAR;
        PG8_WAIT_V(2); PG8_BAR;
        PG8_STAGE(PG8_SB(1, 0), cB + kstep, voffB); PG8_STAGE(PG8_SA(1, 0), cA + kstep, voffA); PG8_STAGE(PG8_SB(1, 1), cB + hstep + kstep, voffB);
        PG8_WAIT_V(6); PG8_BAR;
    } else {
        PG8_STAGE(PG8_SB(0, 0), cB, voffB); PG8_STAGE(PG8_SA(0, 0), cA, voffA); PG8_STAGE(PG8_SB(0, 1), cB + hstep, voffB); PG8_STAGE(PG8_SA(0, 1), cA + hstep, voffA);
        if (wr == 1) PG8_BAR;
        PG8_WAIT_V(4); PG8_BAR;
        PG8_STAGE(PG8_SB(1, 0), cB + kstep, voffB); PG8_STAGE(PG8_SA(1, 0), cA + kstep, voffA); PG8_STAGE(PG8_SB(1, 1), cB + hstep + kstep, voffB);
        PG8_WAIT_V(6); PG8_BAR;
    }
    for (;;) {
        const bool has_next = S.next(ui + 1, nxt);
        const char* nA = has_next ? (const char*)g.A + (size_t)nxt.pm * tstep : cA; const char* nB = has_next ? (const char*)g.Bt + (size_t)nxt.pn * tstep : cB;
        for (int t = 0; t < nt; t += 2) {
            const bool last = (t == nt - 2);
            const char* a1 = cA + (size_t)(t + 1) * kstep;
            const char* a2 = last ? nA : cA + (size_t)(t + 2) * kstep; const char* b2 = last ? nB : cB + (size_t)(t + 2) * kstep;
            const char* a3 = a2 + kstep; const char* b3 = b2 + kstep;
            if (last && has_next) S.a_ready(nxt);
            if constexpr (SP2) {
            PG8_LDB(B0, 0, 0); PG8_LDB(B1, 0, 1); PG8_SCHED; PG8_LDA(At, 0, 0); PG8_STAGE(PG8_SA(1, 1), a1 + hstep, voffA);
            PG8_WAIT_V(8); PG8_WAIT_L(0); PG8_BAR; PG8_MMA(0, 0, At, B0); PG8_MMA(0, 1, At, B1); PG8_BAR; PG8_SCHED;
            PG8_LDA(At, 0, 1); PG8_STAGE(PG8_SB(0, 0), b2, voffB); PG8_STAGE(PG8_SB(0, 1), b2 + hstep, voffB); PG8_STAGE(PG8_SA(0, 0), a2, voffA);
            PG8_WAIT_V(8); PG8_WAIT_L(0); PG8_BAR; PG8_MMA(1, 0, At, B0); PG8_MMA(1, 1, At, B1); PG8_BAR; PG8_SCHED;
            PG8_LDB(B0, 1, 0); PG8_LDB(B1, 1, 1); PG8_SCHED; PG8_LDA(At, 1, 0); PG8_STAGE(PG8_SA(0, 1), a2 + hstep, voffA);
            PG8_WAIT_V(8); PG8_WAIT_L(0); PG8_BAR; PG8_MMA(0, 0, At, B0); PG8_MMA(0, 1, At, B1); PG8_BAR; PG8_SCHED;
            PG8_LDA(At, 1, 1); PG8_STAGE(PG8_SB(1, 0), b3, voffB); PG8_STAGE(PG8_SB(1, 1), b3 + hstep, voffB); PG8_STAGE(PG8_SA(1, 0), a3, voffA);
            PG8_WAIT_V(8); PG8_WAIT_L(0); PG8_BAR; PG8_MMA(1, 0, At, B0); PG8_MMA(1, 1, At, B1); PG8_BAR; PG8_SCHED;
            } else {
            PG8_LDB(B0, 0, 0); PG8_SCHED; PG8_LDA(At, 0, 0); PG8_STAGE(PG8_SA(1, 1), a1 + hstep, voffA);
            PG8_WAIT_L(8); PG8_BAR; PG8_WAIT_L(0); PG8_MMA(0, 0, At, B0); PG8_BAR; PG8_SCHED;
            PG8_LDB(B1, 0, 1); PG8_STAGE(PG8_SB(0, 0), b2, voffB);
            PG8_BAR; PG8_WAIT_L(0); PG8_MMA(0, 1, At, B1); PG8_BAR;
            PG8_LDA(At, 0, 1); PG8_STAGE(PG8_SA(0, 0), a2, voffA);
            PG8_BAR; PG8_WAIT_L(0); PG8_MMA(1, 0, At, B0); PG8_BAR; PG8_SCHED;
            PG8_STAGE(PG8_SB(0, 1), b2 + hstep, voffB);
            PG8_WAIT_V(6); PG8_BAR; PG8_MMA(1, 1, At, B1); PG8_BAR;
            PG8_LDB(B0, 1, 0); PG8_SCHED; PG8_LDA(At, 1, 0); PG8_STAGE(PG8_SA(0, 1), a2 + hstep, voffA);
            PG8_WAIT_L(8); PG8_BAR; PG8_WAIT_L(0); PG8_MMA(0, 0, At, B0); PG8_BAR; PG8_SCHED;
            PG8_LDB(B1, 1, 1); PG8_STAGE(PG8_SB(1, 0), b3, voffB);
            PG8_BAR; PG8_WAIT_L(0); PG8_MMA(0, 1, At, B1); PG8_BAR;
            PG8_LDA(At, 1, 1); PG8_STAGE(PG8_SA(1, 0), a3, voffA);
            PG8_BAR; PG8_WAIT_L(0); PG8_MMA(1, 0, At, B0); PG8_BAR; PG8_SCHED;
            PG8_STAGE(PG8_SB(1, 1), b3 + hstep, voffB);
            PG8_WAIT_V(6); PG8_BAR; PG8_MMA(1, 1, At, B1); PG8_BAR;
            }
        }
        if constexpr (ALIGN_EPI) { if (wr == 0) PG8_BAR; }
        if constexpr (!Epi::AFTER_DRAIN) { E(acc, cur, wr, wc, fr, fq); S.done(cur); }
        if (!has_next) break;
#pragma unroll
        for (int a = 0; a < 2; ++a)
#pragma unroll
            for (int b = 0; b < 2; ++b)
#pragma unroll
                for (int m = 0; m < 4; ++m)
#pragma unroll
                    for (int n = 0; n < 2; ++n) acc[a][b][m][n] = (f32x4){0.f, 0.f, 0.f, 0.f};
        cur = nxt; cA = nA; cB = nB; ++ui;
        if constexpr (ALIGN_EPI) { if (wr == 1) PG8_BAR; }
    }
    PG8_WAIT_V(0);
    if constexpr (!ALIGN_EPI) { if (wr == 0) PG8_BAR; }
    PG8_BAR;
    if constexpr (Epi::AFTER_DRAIN) { E.fused(acc, cur, wr, wc, fr, fq, lds, wid, lane); S.done(cur); }
#undef PG8_SA
#undef PG8_SB
#undef PG8_STAGE
#undef PG8_LDA
#undef PG8_LDB
#undef PG8_MMA
#undef PG8_WAIT_V
#undef PG8_WAIT_L
#undef PG8_BAR
#undef PG8_SCHED
}
}
#ifndef PG8_SP2
#define PG8_SP2 true
#endif
#ifndef PG8_ALIGN
#define PG8_ALIGN true
#endif

constexpr int NWAVES = 8;
constexpr int S_ = 16384, D_ = 1024, FF_ = 4096, PLE_ = 256, INW_ = 3088, ZW = 3072;
constexpr int Z_GQ = 0, Z_GK = 256, Z_GV = 512, Z_GG = 1024, Z_MQ = 1536, Z_MK = 2048, Z_MV = 2560;
constexpr float EPS_ = 1e-6f;

constexpr size_t MiB = 1u << 20, KiB = 1u << 10;
constexpr size_t WS_CTL = 0, CTL_ZERO_BYTES = 1 * MiB;
constexpr size_t WS_WIN = 1 * MiB, WS_WOUT = 7 * MiB, WS_WUP = 9 * MiB, WS_WDOWN = 17 * MiB, WS_WPG = 25 * MiB, WS_WPP = 27 * MiB, WS_WGA = 27 * MiB + 512 * KiB;
constexpr size_t WS_SMALL = 28 * MiB;
constexpr size_t WS_RSTDX = WS_SMALL, WS_GA = WS_SMALL + 64 * KiB, WS_DECAY = WS_SMALL + 1088 * KiB, WS_KMEAN = WS_SMALL + 1344 * KiB,
                 WS_SSQH1 = WS_SMALL + 1472 * KiB, WS_SSQH2 = WS_SMALL + 1728 * KiB, WS_SSQE = WS_SMALL + 1984 * KiB, WS_LPART = WS_SMALL + 2240 * KiB;
constexpr size_t WS_ERAW = 32 * MiB, WS_AB = 64 * MiB, WS_Z = 96 * MiB, WS_MIX = 192 * MiB, WS_PB = 224 * MiB, WS_ACT = 96 * MiB, WS_END = 256 * MiB;
constexpr size_t WS_DS = 224 * MiB, WS_SPREV = 64 * MiB, WS_LIST = 80 * MiB;
constexpr size_t OUT_PART = 0, OUT_VT = 48 * MiB;
constexpr int CW_TMO = 0, CW_CNT = 1024  , CW_BAR = 4096;

constexpr int RING_OFF = 0, RING_BYTES = 131072;
constexpr int LDS_BYTES = 160 * 1024;
constexpr int MISC_OFF = LDS_BYTES - 512;

#define GAS __attribute__((address_space(1)))
#define LAS __attribute__((address_space(3)))
typedef unsigned short bf16;
typedef unsigned v4u __attribute__((ext_vector_type(4)));
typedef float f32x4 __attribute__((ext_vector_type(4)));
typedef short bf16x8 __attribute__((ext_vector_type(8)));
typedef GAS unsigned gu32;
typedef GAS unsigned long long gu64;
#define RLX_AGENT __ATOMIC_RELAXED, __HIP_MEMORY_SCOPE_AGENT
#define LDS_WAIT() asm volatile("s_waitcnt lgkmcnt(0)" ::: "memory")
#define VM_WAIT() asm volatile("s_waitcnt vmcnt(0)" ::: "memory")
__device__ __forceinline__ unsigned long long rt() { return __builtin_amdgcn_s_memrealtime(); }
__device__ __forceinline__ unsigned f2bf(float f) { unsigned u = __builtin_bit_cast(unsigned, f); return (u + 0x7fffu + ((u >> 16) & 1u)) >> 16; }
__device__ __forceinline__ unsigned pk2(float lo, float hi) { return f2bf(lo) | (f2bf(hi) << 16); }

#define XB_TMO      128
#define XB_XCNT(j)  (256  + 64 * (j))
#define XB_XSUB(j)  (1280 + 64 * (j))
#define XB_XGEN(j)  (2304 + 64 * (j))
#define XB_TOP      3328
#define XB_TOPGEN   3392
#define XCD_BAR_WORDS 3456
#define XB_SPIN_CAP (1u << 18)

__device__ __forceinline__ unsigned xb_ld(unsigned* p)              { return __hip_atomic_load(p, __ATOMIC_RELAXED, __HIP_MEMORY_SCOPE_AGENT); }
__device__ __forceinline__ unsigned xb_add(unsigned* p, unsigned v) { return __hip_atomic_fetch_add(p, v, __ATOMIC_RELAXED, __HIP_MEMORY_SCOPE_AGENT); }
__device__ __forceinline__ unsigned xb_xcc_id() { return (unsigned)__builtin_amdgcn_s_getreg((3 << 11) | 20) & 0xFu; }
#define XB_SPIN(cond, bar) do { unsigned _sp = 0; while (cond) { __builtin_amdgcn_s_sleep(1); \
    if ((++_sp & 255u) == 0u) { if (xb_ld(&(bar)[XB_TMO])) break; if (_sp > XB_SPIN_CAP) { atomicAdd(&(bar)[XB_TMO], 1u); break; } } } } while (0)

struct XcdBarrier {
    unsigned* bar; unsigned x;
    volatile LAS unsigned* st;
};

__device__ __forceinline__ XcdBarrier xcd_barrier_post(unsigned* bar, volatile LAS unsigned* st) {
    XcdBarrier b; b.bar = bar; b.x = xb_xcc_id(); b.st = st;
    if (threadIdx.x == 0) (void)xb_add(&bar[XB_XCNT(b.x)], 1u);
    return b;
}
__device__ __forceinline__ void xcd_barrier_complete(unsigned* bar, unsigned x, unsigned& nloc, unsigned& nx) {
    const unsigned G = gridDim.x * gridDim.y * gridDim.z;
    unsigned sum, cnt, mine, sp = 0u;
    for (;;) {
        sum = 0u; cnt = 0u; mine = 0u;
#pragma unroll
        for (unsigned j = 0; j < 16; ++j) { const unsigned c = xb_ld(&bar[XB_XCNT(j)]); sum += c; cnt += (c > 0u) ? 1u : 0u; mine = (j == x) ? c : mine; }
        if (sum == G) break;
        __builtin_amdgcn_s_sleep(1);
        if ((++sp & 255u) == 0u) { if (xb_ld(&bar[XB_TMO])) break; if (sp > XB_SPIN_CAP) { atomicAdd(&bar[XB_TMO], 1u); break; } }
    }
    nloc = mine > 0u ? mine : 1u; nx = cnt > 0u ? cnt : 1u;
}

__device__ __forceinline__ void xcd_barrier(const XcdBarrier& b) {
    asm volatile("s_waitcnt vmcnt(0)" ::: "memory");
    __syncthreads();
    if (threadIdx.x == 0) {
        unsigned* bar = b.bar;
        __builtin_amdgcn_s_waitcnt(0);
        unsigned nloc = b.st[0], nx = b.st[1];
        if (nloc == 0u) { xcd_barrier_complete(bar, b.x, nloc, nx); b.st[0] = nloc; b.st[1] = nx; }
        const unsigned old = xb_add(&bar[XB_XSUB(b.x)], 1u);
        const unsigned gen = old / nloc;
        if (old + 1u == (gen + 1u) * nloc) {
            __builtin_amdgcn_fence(__ATOMIC_RELEASE, "agent");
            asm volatile("s_waitcnt vmcnt(0)" ::: "memory");
            const unsigned og = xb_add(&bar[XB_TOP], 1u);
            const unsigned tg = og / nx;
            if (og + 1u == (tg + 1u) * nx) xb_add(&bar[XB_TOPGEN], 1u);
            else XB_SPIN(xb_ld(&bar[XB_TOPGEN]) == tg, bar);
            __builtin_amdgcn_fence(__ATOMIC_ACQUIRE, "agent");
            xb_add(&bar[XB_XGEN(b.x)], 1u);
            asm volatile("s_waitcnt vmcnt(0)" ::: "memory");
        } else {
            XB_SPIN(xb_ld(&bar[XB_XGEN(b.x)]) == gen, bar);
            __builtin_amdgcn_fence(__ATOMIC_ACQUIRE, "agent");
            asm volatile("s_waitcnt vmcnt(0)" ::: "memory");
        }
    }
    __syncthreads();
}

struct Frame {
    LAS unsigned char* lds;
    volatile LAS unsigned* MISC;
    gu32* ctl;
    int tid, lane, wave, vcu, G;
    unsigned char* ws; float* out;
};
__device__ __forceinline__ const void* in_ptr(const Frame& F, int k) {
    const unsigned lo = __builtin_amdgcn_readfirstlane(F.MISC[32 + 2 * k]), hi = __builtin_amdgcn_readfirstlane(F.MISC[33 + 2 * k]);
    return (const void*)(((unsigned long long)hi << 32) | lo);
}
#define IN_x ((const float*)in_ptr(F, 0))
#define IN_p ((const float*)in_ptr(F, 1))
#define IN_pos ((const int*)in_ptr(F, 2))
#define IN_g_mix ((const float*)in_ptr(F, 3))
#define IN_w_in ((const float*)in_ptr(F, 4))
#define IN_w_a2 ((const float*)in_ptr(F, 5))
#define IN_b_a ((const float*)in_ptr(F, 6))
#define IN_g_gla ((const float*)in_ptr(F, 7))
#define IN_g_mq ((const float*)in_ptr(F, 8))
#define IN_g_mk ((const float*)in_ptr(F, 9))
#define IN_w_out ((const float*)in_ptr(F, 10))
#define IN_g_ffn ((const float*)in_ptr(F, 11))
#define IN_w_up ((const float*)in_ptr(F, 12))
#define IN_w_down ((const float*)in_ptr(F, 13))
#define IN_g_pg ((const float*)in_ptr(F, 14))
#define IN_w_pg ((const float*)in_ptr(F, 15))
#define IN_w_pp ((const float*)in_ptr(F, 16))
#define IN_g_pe ((const float*)in_ptr(F, 17))
__device__ __forceinline__ float wave_sum(float v) {
#pragma unroll
    for (int o = 1; o < 64; o <<= 1) v += __shfl_xor(v, o);
    return v;
}
__device__ __forceinline__ float bf2f(unsigned v16) { return __uint_as_float(v16 << 16); }

__device__ __forceinline__ void p0_transpose_item(const float* W, int ldn, int src_col, const float* gain, int K, bf16* WT, int n_dst, int k0, LAS float* scr, int lane) {
#pragma unroll 8
    for (int i = 0; i < 32; ++i) { const int kk = 2 * i + (lane >> 5); float w = W[(size_t)(k0 + kk) * ldn + src_col + (lane & 31)]; if (gain) w *= gain[k0 + kk]; scr[kk * 33 + (lane & 31)] = w; }
    LDS_WAIT(); asm volatile("" ::: "memory");
    const int c = lane & 7;
#pragma unroll
    for (int j = 0; j < 4; ++j) { const int n = (lane >> 3) + 8 * j; const LAS float* s = scr + (8 * c) * 33 + n;
        v4u o; o.x = pk2(s[0 * 33], s[1 * 33]); o.y = pk2(s[2 * 33], s[3 * 33]); o.z = pk2(s[4 * 33], s[5 * 33]); o.w = pk2(s[6 * 33], s[7 * 33]);
        *(GAS v4u*)(WT + (size_t)(n_dst + n) * K + k0 + 8 * c) = o; }
    LDS_WAIT(); asm volatile("" ::: "memory");
}
__device__ __forceinline__ void p0_prologue(Frame& F) {
    LAS float* scr = (LAS float*)(F.lds + RING_OFF + F.wave * 16384);
    const int gw = F.vcu * NWAVES + F.wave, NGW = F.G * NWAVES;
    bf16* Win_t = (bf16*)(F.ws + WS_WIN); bf16* Wout_t = (bf16*)(F.ws + WS_WOUT); bf16* Wup_t = (bf16*)(F.ws + WS_WUP); bf16* Wdown_t = (bf16*)(F.ws + WS_WDOWN);
    bf16* Wpg_t = (bf16*)(F.ws + WS_WPG); bf16* Wpp_t = (bf16*)(F.ws + WS_WPP); bf16* Wga_t = (bf16*)(F.ws + WS_WGA);
    constexpr int I_IN = (D_ / 64) * (ZW / 32), I_OUT = (D_ / 64) * (D_ / 32), I_UP = (D_ / 64) * (FF_ / 32), I_DN = (FF_ / 64) * (D_ / 32), I_PG = I_OUT, I_PP = (PLE_ / 64) * (D_ / 32);
    constexpr int NITEMS = I_IN + I_OUT + I_UP + I_DN + I_PG + I_PP;
    for (int it = gw; it < NITEMS; it += NGW) {
        int r = it;
        if (r < I_IN) { const int nb = r % (ZW / 32), kb = r / (ZW / 32), n0 = 32 * nb; p0_transpose_item(IN_w_in, INW_, n0 < 1536 ? n0 : n0 + 16, IN_g_mix, D_, Win_t, n0, 64 * kb, scr, F.lane); continue; } r -= I_IN;
        if (r < I_OUT) { const int nb = r % (D_ / 32), kb = r / (D_ / 32); p0_transpose_item(IN_w_out, D_, 32 * nb, nullptr, D_, Wout_t, 32 * nb, 64 * kb, scr, F.lane); continue; } r -= I_OUT;
        if (r < I_UP) { const int nb = r % (FF_ / 32), kb = r / (FF_ / 32); p0_transpose_item(IN_w_up, FF_, 32 * nb, IN_g_ffn, D_, Wup_t, 32 * nb, 64 * kb, scr, F.lane); continue; } r -= I_UP;
        if (r < I_DN) { const int nb = r % (D_ / 32), kb = r / (D_ / 32); p0_transpose_item(IN_w_down, D_, 32 * nb, nullptr, FF_, Wdown_t, 32 * nb, 64 * kb, scr, F.lane); continue; } r -= I_DN;
        if (r < I_PG) { const int nb = r % (D_ / 32), kb = r / (D_ / 32); p0_transpose_item(IN_w_pg, D_, 32 * nb, IN_g_pg, D_, Wpg_t, 32 * nb, 64 * kb, scr, F.lane); continue; } r -= I_PG;
        { const int nb = r % (D_ / 32), kb = r / (D_ / 32); p0_transpose_item(IN_w_pp, D_, 32 * nb, nullptr, PLE_, Wpp_t, 32 * nb, 64 * kb, scr, F.lane); }
    }
    { const float* wi_ = IN_w_in; const float* gm_ = IN_g_mix;
      for (int i = (F.vcu * NWAVES + F.wave) * 64 + F.lane; i < 16 * D_; i += NGW * 64) { const int r = i >> 10, k = i & 1023; Wga_t[i] = (bf16)f2bf(wi_[(size_t)k * INW_ + 1536 + r] * gm_[k]); } }
    bf16* xb = (bf16*)(F.ws + WS_AB); bf16* pb = (bf16*)(F.ws + WS_PB); float* rstdx = (float*)(F.ws + WS_RSTDX);
    const float* x_ = IN_x; const float* p_ = IN_p;
    for (int m = gw; m < S_; m += NGW) {
        const GAS f32x4* xr = (const GAS f32x4*)(x_ + (size_t)m * D_) + F.lane;
        f32x4 v[4]; float s = 0.f;
#pragma unroll
        for (int j = 0; j < 4; ++j) { v[j] = xr[64 * j]; s += (v[j].x * v[j].x + v[j].y * v[j].y) + (v[j].z * v[j].z + v[j].w * v[j].w); }
        s = wave_sum(s);
        GAS unsigned long long* o8 = (GAS unsigned long long*)(xb + (size_t)m * D_) + F.lane;
#pragma unroll
        for (int j = 0; j < 4; ++j) o8[64 * j] = (unsigned long long)pk2(v[j].x, v[j].y) | ((unsigned long long)pk2(v[j].z, v[j].w) << 32);
        if (F.lane == 0) rstdx[m] = 1.0f / sqrtf(s * (1.0f / D_) + EPS_);
        const f32x4 pv = *((const GAS f32x4*)(p_ + (size_t)m * PLE_) + F.lane);
        *((GAS unsigned long long*)(pb + (size_t)m * PLE_) + F.lane) = (unsigned long long)pk2(pv.x, pv.y) | ((unsigned long long)pk2(pv.z, pv.w) << 32);
    }
}

typedef float f32x16 __attribute__((ext_vector_type(16)));
typedef __bf16 bf2_t __attribute__((ext_vector_type(2)));
typedef float f2_t __attribute__((ext_vector_type(2)));
__device__ __forceinline__ unsigned pkbf(float lo, float hi) { f2_t v = {lo, hi}; bf2_t b = __builtin_convertvector(v, bf2_t); return __builtin_bit_cast(unsigned, b); }
#define MFMA32(a, b, c) __builtin_amdgcn_mfma_f32_32x32x16_bf16((a), (b), (c), 0, 0, 0)
#define WG_SYNC() do { asm volatile("s_waitcnt vmcnt(0) lgkmcnt(0)" ::: "memory"); __builtin_amdgcn_s_barrier(); asm volatile("" ::: "memory"); } while (0)
__device__ __forceinline__ bf16x8 pack8(const f32x16& x, int s) {
    v4u p; p.x = pkbf(x[8 * s], x[8 * s + 1]); p.y = pkbf(x[8 * s + 2], x[8 * s + 3]); p.z = pkbf(x[8 * s + 4], x[8 * s + 5]); p.w = pkbf(x[8 * s + 6], x[8 * s + 7]);
    return __builtin_bit_cast(bf16x8, p);
}
__device__ __forceinline__ float log_sigmoid(float s) { return fminf(s, 0.f) - log1pf(__expf(-fabsf(s))); }
constexpr int GROW = 72;
__device__ __forceinline__ int tperm(int tt) { return (tt & ~15) + 8 * ((tt >> 2) & 1) + 4 * ((tt >> 3) & 1) + (tt & 3); }

__device__ __forceinline__ void gla_cumsum(Frame& F, const LAS float* GAS_, LAS float* TOT, float (&bl)[32], float& blast, float& boff) {
    const int c = F.tid & 255, half = F.tid >> 8;
    float w2[16];
    const float* wa2_ = IN_w_a2;
#pragma unroll
    for (int r = 0; r < 16; ++r) w2[r] = wa2_[r * 256 + c];
    const float bias = IN_b_a[c];
    float run = 0.f;
#pragma unroll
    for (int i = 0; i < 32; ++i) {
        const LAS f32x4* g4 = (const LAS f32x4*)(GAS_ + (32 * half + i) * 16);
        const f32x4 g0 = g4[0], g1 = g4[1], g2 = g4[2], g3 = g4[3];
        float a = bias;
        a += g0[0] * w2[0]; a += g0[1] * w2[1]; a += g0[2] * w2[2]; a += g0[3] * w2[3];
        a += g1[0] * w2[4]; a += g1[1] * w2[5]; a += g1[2] * w2[6]; a += g1[3] * w2[7];
        a += g2[0] * w2[8]; a += g2[1] * w2[9]; a += g2[2] * w2[10]; a += g2[3] * w2[11];
        a += g3[0] * w2[12]; a += g3[1] * w2[13]; a += g3[2] * w2[14]; a += g3[3] * w2[15];
        run += log_sigmoid(a) * (1.0f / 16.0f);
        bl[i] = run;
    }
    TOT[half * 256 + c] = run;
    WG_SYNC();
    const float t0 = TOT[c], t1 = TOT[256 + c];
    blast = t0 + t1; boff = half ? t0 : 0.f;
}
__device__ __forceinline__ void gla_fill_vt(Frame& F, const bf16* zb, int t0, LAS bf16* VT) {
    const int tt = F.tid & 63, grp = F.tid >> 6, h = grp >> 1, e0 = (grp & 1) * 64, pt = tperm(tt);
    const bf16* src = zb + (size_t)(t0 + tt) * ZW + Z_GV + 64 * grp;
#pragma unroll
    for (int i = 0; i < 8; ++i) {
        const v4u w = *(const v4u*)(src + 8 * i);
        LAS bf16* dst = VT + (size_t)(h * 128 + e0 + 8 * i) * GROW + pt;
        dst[0 * GROW] = (bf16)(w.x & 0xffffu); dst[1 * GROW] = (bf16)(w.x >> 16); dst[2 * GROW] = (bf16)(w.y & 0xffffu); dst[3 * GROW] = (bf16)(w.y >> 16);
        dst[4 * GROW] = (bf16)(w.z & 0xffffu); dst[5 * GROW] = (bf16)(w.z >> 16); dst[6 * GROW] = (bf16)(w.w & 0xffffu); dst[7 * GROW] = (bf16)(w.w >> 16);
    }
}

__device__ __forceinline__ void gla_a_chunk(Frame& F, int ch) {
    LAS float* GA_S = (LAS float*)(F.lds);
    LAS float* TOT = (LAS float*)(F.lds + 8192);
    LAS bf16* KTE = (LAS bf16*)(F.lds + 10240);
    LAS bf16* VT = (LAS bf16*)(F.lds + 10240 + 4 * 64 * GROW * 2);
    const bf16* xb = (const bf16*)(F.ws + WS_AB); const bf16* zb = (const bf16*)(F.ws + WS_Z); const bf16* wga = (const bf16*)(F.ws + WS_WGA);
    const float* rstdx = (const float*)(F.ws + WS_RSTDX); float* ga_g = (float*)(F.ws + WS_GA); float* decay_g = (float*)(F.ws + WS_DECAY); float* dS_g = (float*)(F.ws + WS_DS);
    const int t0 = ch * 64;
    {
        const int rg = F.wave & 3, kh = F.wave >> 2, r = F.lane & 15, q = F.lane >> 4;
        const bf16* arow = xb + (size_t)(t0 + 16 * rg + r) * D_ + 8 * q; const bf16* brow = wga + (size_t)r * D_ + 8 * q;
        pg8::f32x4 acc = {0.f, 0.f, 0.f, 0.f};
#pragma unroll 4
        for (int s = 16 * kh; s < 16 * kh + 16; ++s) { const bf16x8 a = *(const bf16x8*)(arow + 32 * s), b = *(const bf16x8*)(brow + 32 * s); acc = __builtin_amdgcn_mfma_f32_16x16x32_bf16(a, b, acc, 0, 0, 0); }
#pragma unroll
        for (int g = 0; g < 4; ++g) GA_S[kh * 1024 + (16 * rg + 4 * q + g) * 16 + r] = acc[g];
    }
    WG_SYNC();
    for (int idx = F.tid; idx < 1024; idx += 512) { const float v = (GA_S[idx] + GA_S[1024 + idx]) * rstdx[t0 + (idx >> 4)]; GA_S[idx] = v; ga_g[(size_t)t0 * 16 + idx] = v; }
    WG_SYNC();
    float bl[32], blast, boff;
    gla_cumsum(F, GA_S, TOT, bl, blast, boff);
    {
        const int c = F.tid & 255, half = F.tid >> 8, h = c >> 6, d = c & 63;
        if (half == 0) decay_g[ch * 256 + c] = __expf(blast);
        const bf16* kcol = zb + (size_t)(t0 + 32 * half) * ZW + Z_GK + c;
#pragma unroll
        for (int g8 = 0; g8 < 4; ++g8) {
            float v[8];
#pragma unroll
            for (int j = 0; j < 8; ++j) v[j] = bf2f(kcol[(size_t)(8 * g8 + j) * ZW]) * __expf(blast - (boff + bl[8 * g8 + j]));
            const int tt = 32 * half + 8 * g8, hi = (tt >> 3) & 1;
            LAS bf16* row = KTE + (size_t)(h * 64 + d) * GROW + (tt & ~15) + 4 * hi;
            typedef unsigned u2 __attribute__((ext_vector_type(2)));
            u2 lo, hi2; lo.x = pkbf(v[0], v[1]); lo.y = pkbf(v[2], v[3]); hi2.x = pkbf(v[4], v[5]); hi2.y = pkbf(v[6], v[7]);
            *(LAS u2*)(row) = lo; *(LAS u2*)(row + 8) = hi2;
        }
    }
    gla_fill_vt(F, zb, t0, VT);
    WG_SYNC();
    {
        const int h = F.wave >> 1, dt = F.wave & 1, i = F.lane & 31, hh = F.lane >> 5;
        f32x16 acc[4];
#pragma unroll
        for (int et = 0; et < 4; ++et)
#pragma unroll
            for (int r = 0; r < 16; ++r) acc[et][r] = 0.f;
#pragma unroll
        for (int s = 0; s < 4; ++s) {
            const bf16x8 a = *(const LAS bf16x8*)(KTE + (size_t)(h * 64 + 32 * dt + i) * GROW + 16 * s + 8 * hh);
#pragma unroll
            for (int et = 0; et < 4; ++et) { const bf16x8 b = *(const LAS bf16x8*)(VT + (size_t)(h * 128 + 32 * et + i) * GROW + 16 * s + 8 * hh); acc[et] = MFMA32(a, b, acc[et]); }
        }
#pragma unroll
        for (int et = 0; et < 4; ++et) {
            float* dst = dS_g + ((size_t)(ch * 4 + h) * 128 + 32 * et + i) * 64 + 32 * dt + 4 * hh;
#pragma unroll
            for (int g = 0; g < 4; ++g) *(pg8::f32x4*)(dst + 8 * g) = (pg8::f32x4){acc[et][4 * g], acc[et][4 * g + 1], acc[et][4 * g + 2], acc[et][4 * g + 3]};
        }
    }
    WG_SYNC();
}

__device__ __forceinline__ void gla_b_pair(Frame& F, int pair) {
    LAS float* DSL = (LAS float*)(F.lds);
    LAS float* DEC = (LAS float*)(F.lds + 65536);
    LAS float* SEGE = (LAS float*)(F.lds + 131072);
    LAS float* SEGP = (LAS float*)(F.lds + 131072 + 2048);
    const float* decay_g = (const float*)(F.ws + WS_DECAY); const float* dS_g = (const float*)(F.ws + WS_DS); bf16* sp_g = (bf16*)(F.ws + WS_SPREV);
    const int h = pair >> 6, seg = F.tid >> 6, d = F.tid & 63;
#pragma unroll
    for (int i = 0; i < 8; ++i) { const int idx = F.tid + 512 * i, n = idx >> 4, d4 = idx & 15; *(LAS pg8::f32x4*)(DEC + n * 64 + 4 * d4) = *(const pg8::f32x4*)(decay_g + (size_t)n * 256 + h * 64 + 4 * d4); }
    float Pp[32];
    for (int sub = 0; sub < 2; ++sub) {
        const int e = (pair & 63) * 2 + sub;
#pragma unroll
        for (int i = 0; i < 8; ++i) { const int idx = F.tid + 512 * i, n = idx >> 4, d4 = idx & 15; *(LAS pg8::f32x4*)(DSL + n * 64 + 4 * d4) = *(const pg8::f32x4*)(dS_g + ((size_t)(n * 4 + h) * 128 + e) * 64 + 4 * d4); }
        WG_SYNC();
        float Sv = 0.f, P = 1.f;
#pragma unroll
        for (int i = 0; i < 32; ++i) { const int n = seg * 32 + i; const float x = DSL[n * 64 + d], a = DEC[n * 64 + d]; DSL[n * 64 + d] = Sv; Pp[i] = P; Sv = a * Sv + x; P *= a; }
        SEGE[seg * 64 + d] = Sv; SEGP[seg * 64 + d] = P;
        WG_SYNC();
        float st = 0.f;
        for (int k = 0; k < seg; ++k) st = SEGP[k * 64 + d] * st + SEGE[k * 64 + d];
#pragma unroll
        for (int i = 0; i < 32; ++i) { const int n = seg * 32 + i; const float v = DSL[n * 64 + d] + Pp[i] * st; sp_g[((size_t)(n * 4 + h) * 128 + e) * 64 + d] = (bf16)f2bf(v); }
        WG_SYNC();
    }
}

__device__ __forceinline__ void gla_c_chunk(Frame& F, int ch) {
    LAS float* GA2 = (LAS float*)(F.lds);
    LAS float* TOT = (LAS float*)(F.lds + 4096);
    LAS bf16* QD = (LAS bf16*)(F.lds + 6144);
    LAS bf16* KI = (LAS bf16*)(F.lds + 6144 + 36864);
    LAS bf16* VT = (LAS bf16*)(F.lds + 6144 + 2 * 36864);
    const bf16* zb = (const bf16*)(F.ws + WS_Z); const float* ga_g = (const float*)(F.ws + WS_GA); const bf16* sp_g = (const bf16*)(F.ws + WS_SPREV); bf16* mixb = (bf16*)(F.ws + WS_MIX);
    const int t0 = ch * 64;
    for (int idx = F.tid; idx < 1024; idx += 512) GA2[idx] = ga_g[(size_t)t0 * 16 + idx];
    WG_SYNC();
    float bl[32], blast, boff;
    gla_cumsum(F, GA2, TOT, bl, blast, boff);
    {
        const int c = F.tid & 255, half = F.tid >> 8, h = c >> 6, d = c & 63;
        const bf16* qcol = zb + (size_t)(t0 + 32 * half) * ZW + Z_GQ + c; const bf16* kcol = zb + (size_t)(t0 + 32 * half) * ZW + Z_GK + c;
#pragma unroll
        for (int i = 0; i < 32; ++i) {
            const float b = boff + bl[i];
            const float qd = bf2f(qcol[(size_t)i * ZW]) * __expf(b) * 0.125f, ki = bf2f(kcol[(size_t)i * ZW]) * __expf(-b);
            QD[(size_t)(h * 64 + 32 * half + i) * GROW + d] = (bf16)f2bf(qd); KI[(size_t)(h * 64 + 32 * half + i) * GROW + d] = (bf16)f2bf(ki);
        }
    }
    gla_fill_vt(F, zb, t0, VT);
    WG_SYNC();
    {
        const int h = F.wave >> 1, ct = F.wave & 1, i = F.lane & 31, hh = F.lane >> 5;
        bf16x8 qf[4];
#pragma unroll
        for (int s = 0; s < 4; ++s) qf[s] = *(const LAS bf16x8*)(QD + (size_t)(h * 64 + 32 * ct + i) * GROW + 16 * s + 8 * hh);
        f32x16 acc[4];
#pragma unroll
        for (int et = 0; et < 4; ++et)
#pragma unroll
            for (int r = 0; r < 16; ++r) acc[et][r] = 0.f;
#pragma unroll
        for (int et = 0; et < 4; ++et) {
            const bf16* srow = sp_g + ((size_t)(ch * 4 + h) * 128 + 32 * et + i) * 64 + 8 * hh;
#pragma unroll
            for (int s = 0; s < 4; ++s) { const bf16x8 sf = *(const bf16x8*)(srow + 16 * s); acc[et] = MFMA32(sf, qf[s], acc[et]); }
        }
        for (int jt = 0; jt <= ct; ++jt) {
            f32x16 X;
#pragma unroll
            for (int r = 0; r < 16; ++r) X[r] = 0.f;
#pragma unroll
            for (int s = 0; s < 4; ++s) { const bf16x8 kf = *(const LAS bf16x8*)(KI + (size_t)(h * 64 + 32 * jt + i) * GROW + 16 * s + 8 * hh); X = MFMA32(kf, qf[s], X); }
            if (jt == ct) {
#pragma unroll
                for (int r = 0; r < 16; ++r) { const int j = (r & 3) + 8 * (r >> 2) + 4 * hh; if (j > i) X[r] = 0.f; }
            }
#pragma unroll
            for (int s2 = 0; s2 < 2; ++s2) {
                const bf16x8 xs = pack8(X, s2);
#pragma unroll
                for (int et = 0; et < 4; ++et) { const bf16x8 vf = *(const LAS bf16x8*)(VT + (size_t)(h * 128 + 32 * et + i) * GROW + 32 * jt + 16 * s2 + 8 * hh); acc[et] = MFMA32(vf, xs, acc[et]); }
            }
        }
        float ss = 0.f;
#pragma unroll
        for (int et = 0; et < 4; ++et)
#pragma unroll
            for (int r = 0; r < 16; ++r) ss += acc[et][r] * acc[et][r];
        ss += __shfl_xor(ss, 32);
        const float rn = 1.0f / sqrtf(ss * (1.0f / 128.0f) + EPS_);
        const int t = t0 + 32 * ct + i;
        const bf16* ggrow = zb + (size_t)t * ZW + Z_GG + h * 128; bf16* orow = mixb + (size_t)t * D_ + h * 128;
        const float* ggl_ = IN_g_gla;
#pragma unroll
        for (int et = 0; et < 4; ++et)
#pragma unroll
            for (int g = 0; g < 4; ++g) {
                const int e0 = 32 * et + 8 * g + 4 * hh;
                typedef unsigned u2 __attribute__((ext_vector_type(2)));
                const u2 gw = *(const u2*)(ggrow + e0);
                const pg8::f32x4 gl = *(const pg8::f32x4*)(ggl_ + e0);
                float gv[4] = {bf2f(gw.x & 0xffffu), bf2f(gw.x >> 16), bf2f(gw.y & 0xffffu), bf2f(gw.y >> 16)};
                float o[4];
#pragma unroll
                for (int j = 0; j < 4; ++j) o[j] = acc[et][4 * g + j] * rn * gl[j] * (gv[j] / (1.0f + __expf(-gv[j])));
                u2 w; w.x = pkbf(o[0], o[1]); w.y = pkbf(o[2], o[3]);
                *(u2*)(orow + e0) = w;
            }
    }
    WG_SYNC();
}

constexpr int KROW = 136;
constexpr int VROW = 264;
constexpr int LIST_PER_HEAD = 256 * 2016;
__device__ __forceinline__ int list_off(int h, int j) { return h * LIST_PER_HEAD + 256 * (63 * j - (j * (j - 1)) / 2); }
typedef unsigned u2_t __attribute__((ext_vector_type(2)));

__device__ __forceinline__ void sincos_acc(float angf, float& s, float& c) {
    double r = (double)angf * 0.15915494309189533577; r -= floor(r);
    const double q = floor(4.0 * r + 0.5);
    const float phi = (float)((r - 0.25 * q) * 6.283185307179586477);
    const float p2 = phi * phi;
    const float sn = phi * (1.0f + p2 * (-1.0f / 6.0f + p2 * (1.0f / 120.0f + p2 * (-1.0f / 5040.0f + p2 * (1.0f / 362880.0f)))));
    const float cs = 1.0f + p2 * (-0.5f + p2 * (1.0f / 24.0f + p2 * (-1.0f / 720.0f + p2 * (1.0f / 40320.0f + p2 * (-1.0f / 3628800.0f)))));
    const int qi = ((int)q) & 3;
    s = (qi == 0) ? sn : (qi == 1) ? cs : (qi == 2) ? -sn : -cs;
    c = (qi == 0) ? cs : (qi == 1) ? -sn : (qi == 2) ? -cs : sn;
}

__device__ __forceinline__ void moba_a_item(Frame& F, int item) {
    const int blk = item >> 2, h = item & 3;
    LAS bf16* VTL = (LAS bf16*)(F.lds);
    LAS float* KM = (LAS float*)(F.lds + 128 * VROW * 2);
    bf16* zb = (bf16*)(F.ws + WS_Z); float* kmean_g = (float*)(F.ws + WS_KMEAN); bf16* vT_g = (bf16*)((unsigned char*)F.out + OUT_VT);
    {
        const int i = F.lane;
        const float inv = 1.0f / powf(10000.0f, (float)i / 64.0f);
        const float* gmq_ = IN_g_mq; const float* gmk_ = IN_g_mk; const int* pos_ = IN_pos;
        const float gq1 = gmq_[i], gq2 = gmq_[i + 64], gk1 = gmk_[i], gk2 = gmk_[i + 64];
        float km1 = 0.f, km2 = 0.f;
        for (int it = 0; it < 32; ++it) {
            const int t = blk * 256 + F.wave * 32 + it;
            const float ang = (float)pos_[t] * inv;
            float sn, cs; sincos_acc(ang, sn, cs);
            bf16* pq = zb + (size_t)t * ZW + Z_MQ + h * 128; bf16* pk = zb + (size_t)t * ZW + Z_MK + h * 128;
            const float q1 = bf2f(pq[i]), q2 = bf2f(pq[i + 64]), k1 = bf2f(pk[i]), k2 = bf2f(pk[i + 64]);
            const float sq = wave_sum(q1 * q1 + q2 * q2), sk = wave_sum(k1 * k1 + k2 * k2);
            const float rq = 1.0f / sqrtf(sq * (1.0f / 128.0f) + EPS_), rk = 1.0f / sqrtf(sk * (1.0f / 128.0f) + EPS_);
            const float yq1 = q1 * rq * gq1, yq2 = q2 * rq * gq2, yk1 = k1 * rk * gk1, yk2 = k2 * rk * gk2;
            const float oq1 = yq1 * cs - yq2 * sn, oq2 = yq2 * cs + yq1 * sn, ok1 = yk1 * cs - yk2 * sn, ok2 = yk2 * cs + yk1 * sn;
            pq[i] = (bf16)f2bf(oq1); pq[i + 64] = (bf16)f2bf(oq2); pk[i] = (bf16)f2bf(ok1); pk[i + 64] = (bf16)f2bf(ok2);
            km1 += ok1; km2 += ok2;
        }
        KM[F.wave * 128 + i] = km1; KM[F.wave * 128 + 64 + i] = km2;
    }
    {
        const int tt = F.tid & 255, half = F.tid >> 8, pt = tperm(tt);
        const bf16* src = zb + (size_t)(blk * 256 + tt) * ZW + Z_MV + h * 128 + 64 * half;
#pragma unroll
        for (int i = 0; i < 8; ++i) {
            const v4u w = *(const v4u*)(src + 8 * i);
            LAS bf16* dst = VTL + (size_t)(64 * half + 8 * i) * VROW + pt;
            dst[0 * VROW] = (bf16)(w.x & 0xffffu); dst[1 * VROW] = (bf16)(w.x >> 16); dst[2 * VROW] = (bf16)(w.y & 0xffffu); dst[3 * VROW] = (bf16)(w.y >> 16);
            dst[4 * VROW] = (bf16)(w.z & 0xffffu); dst[5 * VROW] = (bf16)(w.z >> 16); dst[6 * VROW] = (bf16)(w.w & 0xffffu); dst[7 * VROW] = (bf16)(w.w >> 16);
        }
    }
    WG_SYNC();
    if (F.tid < 128) { float s = 0.f;
#pragma unroll
        for (int w = 0; w < 8; ++w) s += KM[w * 128 + F.tid];
        kmean_g[(size_t)(h * 64 + blk) * 128 + F.tid] = s * (1.0f / 256.0f); }
#pragma unroll
    for (int i = 0; i < 8; ++i) { const int idx = F.tid + 512 * i, e = idx >> 5, c16 = idx & 31;
        *(v4u*)(vT_g + ((size_t)(h * 64 + blk) * 128 + e) * 256 + 8 * c16) = *(const LAS v4u*)(VTL + (size_t)e * VROW + 8 * c16); }
    WG_SYNC();
}

__device__ __forceinline__ void top3_insert(float v, int j, float& v0, float& v1, float& v2, int& i0, int& i1, int& i2) {
    const bool b0 = (v > v0) || (v == v0 && j < i0), b1 = (v > v1) || (v == v1 && j < i1), b2 = (v > v2) || (v == v2 && j < i2);
    const float n2 = b1 ? v1 : (b2 ? v : v2); const int m2 = b1 ? i1 : (b2 ? j : i2);
    const float n1 = b0 ? v0 : (b1 ? v : v1); const int m1 = b0 ? i0 : (b1 ? j : i1);
    const float n0 = b0 ? v : v0; const int m0 = b0 ? j : i0;
    v0 = n0; v1 = n1; v2 = n2; i0 = m0; i1 = m1; i2 = m2;
}
__device__ __forceinline__ void moba_b_item(Frame& F, int item) {
    const int kb = item >> 2, h = item & 3;
    if (kb == 0) return;
    LAS float* KMF = (LAS float*)(F.lds);
    LAS unsigned* HIST = (LAS unsigned*)(F.lds + 64 * 129 * 4);
    LAS unsigned* BASE = HIST + 64;
    const bf16* zb = (const bf16*)(F.ws + WS_Z); const float* kmean_g = (const float*)(F.ws + WS_KMEAN); unsigned* list_g = (unsigned*)(F.ws + WS_LIST);
    for (int idx = F.tid; idx < 64 * 128; idx += 512) { const int j = idx >> 7, d = idx & 127; KMF[j * 129 + d] = (j < kb) ? kmean_g[(size_t)(h * 64 + j) * 128 + d] : 0.f; }
    if (F.tid < 64) HIST[F.tid] = 0u;
    WG_SYNC();
    const int i = F.lane & 31, kk = F.lane >> 5;
    const int t = kb * 256 + F.wave * 32 + i;
    float v0 = -INFINITY, v1 = -INFINITY, v2 = -INFINITY; int i0 = 1 << 20, i1 = 1 << 20, i2 = 1 << 20;
    const bool two = kb > 32;
    {
        f32x16 acc0, acc1;
#pragma unroll
        for (int r = 0; r < 16; ++r) { acc0[r] = 0.f; acc1[r] = 0.f; }
        const v4u* qrow = (const v4u*)(zb + (size_t)t * ZW + Z_MQ + h * 128);
        const LAS float* arow0 = KMF + i * 129 + kk; const LAS float* arow1 = KMF + (32 + i) * 129 + kk;
#pragma unroll 2
        for (int m = 0; m < 16; ++m) {
            const v4u qw = qrow[m];
#pragma unroll
            for (int c = 0; c < 4; ++c) {
                const unsigned w = qw[c];
                const float b = __uint_as_float(kk ? (w & 0xffff0000u) : (w << 16));
                acc0 = __builtin_amdgcn_mfma_f32_32x32x2f32(arow0[2 * (4 * m + c)], b, acc0, 0, 0, 0);
                if (two) acc1 = __builtin_amdgcn_mfma_f32_32x32x2f32(arow1[2 * (4 * m + c)], b, acc1, 0, 0, 0);
            }
        }
#pragma unroll
        for (int r = 0; r < 16; ++r) { const int j = (r & 3) + 8 * (r >> 2) + 4 * kk; if (j < kb) top3_insert(acc0[r], j, v0, v1, v2, i0, i1, i2); }
        if (two) {
#pragma unroll
            for (int r = 0; r < 16; ++r) { const int j = 32 + (r & 3) + 8 * (r >> 2) + 4 * kk; if (j < kb) top3_insert(acc1[r], j, v0, v1, v2, i0, i1, i2); }
        }
    }
    {
        const float pv0 = __shfl_xor(v0, 32), pv1 = __shfl_xor(v1, 32), pv2 = __shfl_xor(v2, 32);
        const int pi0 = __shfl_xor(i0, 32), pi1 = __shfl_xor(i1, 32), pi2 = __shfl_xor(i2, 32);
        top3_insert(pv0, pi0, v0, v1, v2, i0, i1, i2); top3_insert(pv1, pi1, v0, v1, v2, i0, i1, i2); top3_insert(pv2, pi2, v0, v1, v2, i0, i1, i2);
    }
    const int nsel = kb < 3 ? kb : 3;
    unsigned lp0 = 0, lp1 = 0, lp2 = 0;
    if (kk == 0) {
        if (nsel > 0) lp0 = atomicAdd((unsigned*)&HIST[i0], 1u);
        if (nsel > 1) lp1 = atomicAdd((unsigned*)&HIST[i1], 1u);
        if (nsel > 2) lp2 = atomicAdd((unsigned*)&HIST[i2], 1u);
    }
    WG_SYNC();
    if (F.tid < 64) { const unsigned n = HIST[F.tid]; BASE[F.tid] = n ? atomicAdd((unsigned*)(F.ctl + CW_CNT + h * 64 + F.tid), n) : 0u; }
    WG_SYNC();
    if (kk == 0) {
        if (nsel > 0) list_g[list_off(h, i0) + BASE[i0] + lp0] = (unsigned)t | (0u << 16);
        if (nsel > 1) list_g[list_off(h, i1) + BASE[i1] + lp1] = (unsigned)t | (1u << 16);
        if (nsel > 2) list_g[list_off(h, i2) + BASE[i2] + lp2] = (unsigned)t | (2u << 16);
    }
    WG_SYNC();
}

__device__ __forceinline__ void moba_load_kv(Frame& F, int h, int j, LAS bf16* KL, LAS bf16* VL) {
    const bf16* zb = (const bf16*)(F.ws + WS_Z); const bf16* vT_g = (const bf16*)((const unsigned char*)F.out + OUT_VT);
#pragma unroll
    for (int i = 0; i < 8; ++i) { const int idx = F.tid + 512 * i, r = idx >> 4, c16 = idx & 15;
        *(LAS v4u*)(KL + (size_t)r * KROW + 8 * c16) = *(const v4u*)(zb + (size_t)(j * 256 + r) * ZW + Z_MK + h * 128 + 8 * c16); }
#pragma unroll
    for (int i = 0; i < 8; ++i) { const int idx = F.tid + 512 * i, e = idx >> 5, c16 = idx & 31;
        *(LAS v4u*)(VL + (size_t)e * VROW + 8 * c16) = *(const v4u*)(vT_g + ((size_t)(h * 64 + j) * 128 + e) * 256 + 8 * c16); }
}
__device__ __forceinline__ void moba_wave_attend(const bf16x8 (&qf)[8], const LAS bf16* KL, const LAS bf16* VL, int nkt, int diag_kt, int i, int hh, float c2, float mc2, f32x16 (&acc)[4], float& lsum) {
    for (int kt = 0; kt < nkt; ++kt) {
        f32x16 St;
#pragma unroll
        for (int r = 0; r < 16; ++r) St[r] = 0.f;
#pragma unroll
        for (int s = 0; s < 8; ++s) { const bf16x8 kf = *(const LAS bf16x8*)(KL + (size_t)(32 * kt + i) * KROW + 16 * s + 8 * hh); St = MFMA32(kf, qf[s], St); }
#pragma unroll
        for (int r = 0; r < 16; ++r) St[r] = __builtin_amdgcn_exp2f(St[r] * c2 - mc2);
        if (kt == diag_kt) {
#pragma unroll
            for (int r = 0; r < 16; ++r) { const int kl = (r & 3) + 8 * (r >> 2) + 4 * hh; if (kl > i) St[r] = 0.f; }
        }
#pragma unroll
        for (int r = 0; r < 16; ++r) lsum += St[r];
#pragma unroll
        for (int s2 = 0; s2 < 2; ++s2) {
            const bf16x8 ps = pack8(St, s2);
#pragma unroll
            for (int et = 0; et < 4; ++et) { const bf16x8 vf = *(const LAS bf16x8*)(VL + (size_t)(32 * et + i) * VROW + 32 * kt + 16 * s2 + 8 * hh); acc[et] = MFMA32(vf, ps, acc[et]); }
        }
    }
}
__device__ __forceinline__ void moba_shift(Frame& F, float& c2, float& mc2) {
    const float* gmq_ = IN_g_mq; const float* gmk_ = IN_g_mk;
    float m1 = fmaxf(fabsf(gmq_[F.lane]), fabsf(gmq_[F.lane + 64])), m2 = fmaxf(fabsf(gmk_[F.lane]), fabsf(gmk_[F.lane + 64]));
#pragma unroll
    for (int o = 1; o < 64; o <<= 1) { m1 = fmaxf(m1, __shfl_xor(m1, o)); m2 = fmaxf(m2, __shfl_xor(m2, o)); }
    c2 = 0.08838834764831845f * 1.4426950408889634f;
    mc2 = 11.313708498984761f * m1 * m2 * 1.4426950408889634f;
}

__device__ __forceinline__ void moba_c_phase(Frame& F) {
    LAS bf16* KL = (LAS bf16*)(F.lds); LAS bf16* VL = (LAS bf16*)(F.lds + 256 * KROW * 2);
    LAS int* PRE = (LAS int*)(F.lds + 256 * KROW * 2 + 128 * VROW * 2);
    LAS int* WT = PRE + 260;
    const bf16* zb = (const bf16*)(F.ws + WS_Z); const unsigned* list_g = (const unsigned*)(F.ws + WS_LIST);
    bf16* part_g = (bf16*)((unsigned char*)F.out + OUT_PART); float* lpart_g = (float*)(F.ws + WS_LPART);
    int mycnt = 0;
    if (F.tid < 256) {
        mycnt = (int)__hip_atomic_load(F.ctl + CW_CNT + F.tid, RLX_AGENT);
        int v = (mycnt + 255) >> 8, incl = v;
#pragma unroll
        for (int o = 1; o < 64; o <<= 1) { const int u = __shfl_up(incl, o); if (F.lane >= o) incl += u; }
        if (F.lane == 63) WT[F.wave] = incl;
        PRE[F.tid] = incl - v;
    }
    WG_SYNC();
    if (F.tid < 256) { int off = 0; for (int w = 0; w < F.wave; ++w) off += WT[w]; PRE[F.tid] += off; if (F.tid == 255) PRE[256] = PRE[255] + ((mycnt + 255) >> 8); }
    WG_SYNC();
    const int T = PRE[256];
    float c2, mc2; moba_shift(F, c2, mc2);
    const int i = F.lane & 31, hh = F.lane >> 5;
    for (int it = F.vcu; it < T; it += F.G) {
        int lo = 0, hi = 255;
        while (lo < hi) { const int mid = (lo + hi + 1) >> 1; if (PRE[mid] <= it) lo = mid; else hi = mid - 1; }
        const int hj = lo, h = hj >> 6, j = hj & 63, chunk = it - PRE[hj];
        const int n = (int)__hip_atomic_load(F.ctl + CW_CNT + hj, RLX_AGENT);
        moba_load_kv(F, h, j, KL, VL);
        WG_SYNC();
        const int base = chunk * 256 + F.wave * 32;
        if (base < n) {
            const int eidx = base + i; const bool valid = eidx < n;
            const unsigned ent = valid ? list_g[list_off(h, j) + eidx] : list_g[list_off(h, j) + base];
            const int tq = (int)(ent & 0xffffu), slot = (int)(ent >> 16);
            bf16x8 qf[8];
            { const bf16* qrow = zb + (size_t)tq * ZW + Z_MQ + h * 128 + 8 * hh;
#pragma unroll
              for (int s = 0; s < 8; ++s) qf[s] = *(const bf16x8*)(qrow + 16 * s); }
            f32x16 acc[4]; float lsum = 0.f;
#pragma unroll
            for (int et = 0; et < 4; ++et)
#pragma unroll
                for (int r = 0; r < 16; ++r) acc[et][r] = 0.f;
            moba_wave_attend(qf, KL, VL, 8, -1, i, hh, c2, mc2, acc, lsum);
            lsum += __shfl_xor(lsum, 32);
            if (valid) {
                bf16* prow = part_g + ((size_t)(slot * 4 + h) * S_ + tq) * 128;
#pragma unroll
                for (int et = 0; et < 4; ++et)
#pragma unroll
                    for (int g = 0; g < 4; ++g) { u2_t w; w.x = pkbf(acc[et][4 * g], acc[et][4 * g + 1]); w.y = pkbf(acc[et][4 * g + 2], acc[et][4 * g + 3]); *(u2_t*)(prow + 32 * et + 8 * g + 4 * hh) = w; }
                if (hh == 0) lpart_g[(size_t)(slot * 4 + h) * S_ + tq] = lsum;
            }
        }
        WG_SYNC();
    }
}

__device__ __forceinline__ void moba_d_item(Frame& F, int item, float c2, float mc2) {
    const int blk = item >> 2, h = item & 3;
    LAS bf16* KL = (LAS bf16*)(F.lds); LAS bf16* VL = (LAS bf16*)(F.lds + 256 * KROW * 2);
    const bf16* zb = (const bf16*)(F.ws + WS_Z); const bf16* part_g = (const bf16*)((const unsigned char*)F.out + OUT_PART); const float* lpart_g = (const float*)(F.ws + WS_LPART);
    bf16* mixb = (bf16*)(F.ws + WS_MIX);
    moba_load_kv(F, h, blk, KL, VL);
    WG_SYNC();
    const int i = F.lane & 31, hh = F.lane >> 5;
    const int tq = blk * 256 + F.wave * 32 + i;
    bf16x8 qf[8];
    { const bf16* qrow = zb + (size_t)tq * ZW + Z_MQ + h * 128 + 8 * hh;
#pragma unroll
      for (int s = 0; s < 8; ++s) qf[s] = *(const bf16x8*)(qrow + 16 * s); }
    f32x16 acc[4]; float lsum = 0.f;
#pragma unroll
    for (int et = 0; et < 4; ++et)
#pragma unroll
        for (int r = 0; r < 16; ++r) acc[et][r] = 0.f;
    moba_wave_attend(qf, KL, VL, F.wave + 1, F.wave, i, hh, c2, mc2, acc, lsum);
    lsum += __shfl_xor(lsum, 32);
    const int nsel = blk < 3 ? blk : 3;
    for (int s = 0; s < nsel; ++s) {
        const bf16* prow = part_g + ((size_t)(s * 4 + h) * S_ + tq) * 128;
        lsum += lpart_g[(size_t)(s * 4 + h) * S_ + tq];
#pragma unroll
        for (int et = 0; et < 4; ++et)
#pragma unroll
            for (int g = 0; g < 4; ++g) { const u2_t w = *(const u2_t*)(prow + 32 * et + 8 * g + 4 * hh);
                acc[et][4 * g] += bf2f(w.x & 0xffffu); acc[et][4 * g + 1] += bf2f(w.x >> 16); acc[et][4 * g + 2] += bf2f(w.y & 0xffffu); acc[et][4 * g + 3] += bf2f(w.y >> 16); }
    }
    const float inv = 1.0f / lsum;
    bf16* orow = mixb + (size_t)tq * D_ + 512 + h * 128;
#pragma unroll
    for (int et = 0; et < 4; ++et)
#pragma unroll
        for (int g = 0; g < 4; ++g) { u2_t w; w.x = pkbf(acc[et][4 * g] * inv, acc[et][4 * g + 1] * inv); w.y = pkbf(acc[et][4 * g + 2] * inv, acc[et][4 * g + 3] * inv); *(u2_t*)(orow + 32 * et + 8 * g + 4 * hh) = w; }
    WG_SYNC();
}

struct Args { const void* in[18]; float* out; unsigned char* ws; int ph_lo, ph_hi, li, pad; };
constexpr int N_PHASES = 10;
__global__ void __launch_bounds__(NWAVES * 64, 2) mk_fwd(Args args) {
    extern __shared__ __attribute__((aligned(16))) unsigned char lds[];
    Frame F;
    F.lds = (LAS unsigned char*)lds;
    F.MISC = (volatile LAS unsigned*)(F.lds + MISC_OFF);
    F.tid = threadIdx.x; F.lane = F.tid & 63; F.wave = __builtin_amdgcn_readfirstlane(F.tid >> 6);
    F.G = gridDim.x; { const int bx = blockIdx.x; F.vcu = (F.G % 8 == 0) ? (bx % 8) * (F.G / 8) + bx / 8 : bx; }
    F.ws = args.ws; F.out = args.out; F.ctl = (gu32*)(args.ws + WS_CTL);
    if (F.tid < 32) F.MISC[F.tid] = 0u;
    if (F.tid == 0) {
#pragma unroll
        for (int k = 0; k < 18; ++k) { const unsigned long long pv = (unsigned long long)args.in[k]; F.MISC[32 + 2 * k] = (unsigned)pv; F.MISC[33 + 2 * k] = (unsigned)(pv >> 32); }
    }
    __syncthreads();
    XcdBarrier bar = xcd_barrier_post((unsigned*)(F.ctl + CW_BAR) + args.li * XCD_BAR_WORDS, F.MISC + 8);
    const int lo = args.ph_lo, hi = args.ph_hi;
#define IN(k) (lo <= (k) && (k) < hi)
#define SEAM(k) do { if (IN(k) && IN((k) + 1)) xcd_barrier(bar); } while (0)
    bf16* xb = (bf16*)(F.ws + WS_AB); bf16* zb = (bf16*)(F.ws + WS_Z); bf16* mixb = (bf16*)(F.ws + WS_MIX); bf16* actb = (bf16*)(F.ws + WS_ACT); bf16* erawb = (bf16*)(F.ws + WS_ERAW);

    if (IN(0)) { p0_prologue(F); } SEAM(0);
    if (IN(1)) {
        { pg8::Gemm g{xb, (const bf16*)(F.ws + WS_WIN), S_, ZW, D_}; pg8::StaticOrder S; S.init(S_, ZW, F.G, (int)blockIdx.x);
          pg8::EpiScale<0, 1> E{zb, ZW, (const float*)(F.ws + WS_RSTDX), EPS_};
          pg8::gemm_phase<pg8::EpiScale<0, 1>, pg8::StaticOrder, PG8_ALIGN, PG8_SP2>(F.lds + RING_OFF, g, S, E); }
        { pg8::Gemm g{(const bf16*)(F.ws + WS_PB), (const bf16*)(F.ws + WS_WPP), S_, D_, PLE_}; pg8::StaticOrder S; S.init(S_, D_, F.G, (int)blockIdx.x);
          pg8::EpiRes<false> E{nullptr, nullptr, erawb, (float*)(F.ws + WS_SSQE), D_};
          pg8::gemm_phase<pg8::EpiRes<false>, pg8::StaticOrder, false, PG8_SP2>(F.lds + RING_OFF, g, S, E); }
    } SEAM(1);
    if (IN(2)) { for (int ch = F.vcu; ch < 256; ch += F.G) gla_a_chunk(F, ch); for (int ch = F.vcu; ch < 256; ch += F.G) moba_a_item(F, ch); } SEAM(2);
    if (IN(3)) { for (int pr = F.vcu; pr < 256; pr += F.G) gla_b_pair(F, pr); for (int pr = F.vcu; pr < 256; pr += F.G) moba_b_item(F, pr); } SEAM(3);
    if (IN(4)) { for (int ch = F.vcu; ch < 256; ch += F.G) gla_c_chunk(F, ch); moba_c_phase(F); } SEAM(4);
    if (IN(5)) { float c2, mc2; moba_shift(F, c2, mc2); for (int it = F.vcu; it < 256; it += F.G) moba_d_item(F, it, c2, mc2); } SEAM(5);
    if (IN(6)) {
        pg8::Gemm g{mixb, (const bf16*)(F.ws + WS_WOUT), S_, D_, D_}; pg8::StaticOrder S; S.init(S_, D_, F.G, (int)blockIdx.x);
        pg8::EpiRes<true> E{IN_x, F.out, xb, (float*)(F.ws + WS_SSQH1), D_};
        pg8::gemm_phase<pg8::EpiRes<true>, pg8::StaticOrder, false, PG8_SP2>(F.lds + RING_OFF, g, S, E);
    } SEAM(6);
    if (IN(7)) {
        pg8::Gemm g{xb, (const bf16*)(F.ws + WS_WUP), S_, FF_, D_}; pg8::StaticOrder S; S.init(S_, FF_, F.G, (int)blockIdx.x);
        pg8::EpiScale<1, 2> E{actb, FF_, (const float*)(F.ws + WS_SSQH1), EPS_};
        pg8::gemm_phase<pg8::EpiScale<1, 2>, pg8::StaticOrder, PG8_ALIGN, PG8_SP2>(F.lds + RING_OFF, g, S, E);
    } SEAM(7);
    if (IN(8)) {
        pg8::Gemm g{actb, (const bf16*)(F.ws + WS_WDOWN), S_, D_, FF_}; pg8::StaticOrder S; S.init(S_, D_, F.G, (int)blockIdx.x);
        pg8::EpiRes<true> E{F.out, F.out, xb, (float*)(F.ws + WS_SSQH2), D_};
        pg8::gemm_phase<pg8::EpiRes<true>, pg8::StaticOrder, false, PG8_SP2>(F.lds + RING_OFF, g, S, E);
    } SEAM(8);
    if (IN(9)) {
        pg8::Gemm g{xb, (const bf16*)(F.ws + WS_WPG), S_, D_, D_}; pg8::StaticOrder S; S.init(S_, D_, F.G, (int)blockIdx.x);
        pg8::EpiGate E{F.out, erawb, (const float*)(F.ws + WS_SSQH2), (const float*)(F.ws + WS_SSQE), IN_g_pe, D_, EPS_};
        pg8::gemm_phase<pg8::EpiGate, pg8::StaticOrder, false, PG8_SP2>(F.lds + RING_OFF, g, S, E);
    }
#undef IN
#undef SEAM
}

namespace nv {
__device__ __forceinline__ float ldz(const bf16* z, int t, int col) { return bf2f(z[(size_t)t * ZW + col]); }
__device__ __forceinline__ float wave_max(float v) {
#pragma unroll
    for (int o = 1; o < 64; o <<= 1) v = fmaxf(v, __shfl_xor(v, o));
    return v;
}
__global__ void k_ga(const bf16* __restrict__ xb, const bf16* __restrict__ wga_t, const float* __restrict__ rstdx, float* __restrict__ ga) {
    const int idx = blockIdx.x * blockDim.x + threadIdx.x; if (idx >= S_ * 16) return;
    const int t = idx >> 4, r = idx & 15; float s = 0.f;
    for (int k = 0; k < D_; ++k) s += bf2f(xb[(size_t)t * D_ + k]) * bf2f(wga_t[r * D_ + k]);
    ga[idx] = s * rstdx[t];
}
__global__ void k_gla_prep(const float* __restrict__ ga, const float* __restrict__ w_a2, const float* __restrict__ b_a, float* __restrict__ a_out) {
    const int idx = blockIdx.x * blockDim.x + threadIdx.x; if (idx >= S_ * 256) return;
    const int t = idx >> 8, c = idx & 255; float s = b_a[c];
#pragma unroll
    for (int r = 0; r < 16; ++r) s += ga[t * 16 + r] * w_a2[r * 256 + c];
    const float ls = fminf(s, 0.f) - log1pf(expf(-fabsf(s)));
    a_out[idx] = expf(ls * (1.0f / 16.0f));
}
__global__ void __launch_bounds__(64) k_gla_rec(const bf16* __restrict__ z, const float* __restrict__ a, float* __restrict__ o_raw) {
    const int h = blockIdx.x >> 1, e = (blockIdx.x & 1) * 64 + threadIdx.x;
    float St[64];
#pragma unroll
    for (int d = 0; d < 64; ++d) St[d] = 0.f;
    for (int t = 0; t < S_; ++t) {
        const bf16* zr = z + (size_t)t * ZW;
        const float v = bf2f(zr[Z_GV + h * 128 + e]);
        const bf16* qr = zr + Z_GQ + h * 64; const bf16* kr = zr + Z_GK + h * 64; const float* ar = a + (size_t)t * 256 + h * 64;
        float o = 0.f;
#pragma unroll
        for (int d = 0; d < 64; ++d) { St[d] = ar[d] * St[d] + bf2f(kr[d]) * v; o += bf2f(qr[d]) * St[d]; }
        o_raw[(size_t)t * 512 + h * 128 + e] = o * 0.125f;
    }
}
__global__ void k_gla_post(const float* __restrict__ o_raw, const bf16* __restrict__ z, const float* __restrict__ g_out, bf16* __restrict__ mix) {
    const int wave = (blockIdx.x * blockDim.x + threadIdx.x) >> 6, lane = threadIdx.x & 63; if (wave >= S_ * 4) return;
    const int t = wave >> 2, h = wave & 3;
    const float o0 = o_raw[(size_t)t * 512 + h * 128 + lane], o1 = o_raw[(size_t)t * 512 + h * 128 + 64 + lane];
    const float ss = wave_sum(o0 * o0 + o1 * o1); const float r = 1.0f / sqrtf(ss * (1.0f / 128.0f) + EPS_);
    const float g0 = ldz(z, t, Z_GG + h * 128 + lane), g1 = ldz(z, t, Z_GG + h * 128 + 64 + lane);
    mix[(size_t)t * D_ + h * 128 + lane] = (bf16)f2bf(o0 * r * g_out[lane] * (g0 / (1.0f + expf(-g0))));
    mix[(size_t)t * D_ + h * 128 + 64 + lane] = (bf16)f2bf(o1 * r * g_out[64 + lane] * (g1 / (1.0f + expf(-g1))));
}
__device__ __forceinline__ void sincos_acc(float angf, float& s, float& c) {
    double r = (double)angf * 0.15915494309189533577; r -= floor(r);
    const double q = floor(4.0 * r + 0.5);
    const float phi = (float)((r - 0.25 * q) * 6.283185307179586477);
    const float p2 = phi * phi;
    const float sn = phi * (1.0f + p2 * (-1.0f / 6.0f + p2 * (1.0f / 120.0f + p2 * (-1.0f / 5040.0f + p2 * (1.0f / 362880.0f)))));
    const float cs = 1.0f + p2 * (-0.5f + p2 * (1.0f / 24.0f + p2 * (-1.0f / 720.0f + p2 * (1.0f / 40320.0f + p2 * (-1.0f / 3628800.0f)))));
    const int qi = ((int)q) & 3;
    s = (qi == 0) ? sn : (qi == 1) ? cs : (qi == 2) ? -sn : -cs;
    c = (qi == 0) ? cs : (qi == 1) ? -sn : (qi == 2) ? -cs : sn;
}
__global__ void k_moba_qk(bf16* __restrict__ z, const int* __restrict__ pos, const float* __restrict__ gq, const float* __restrict__ gk) {
    const int wave = (blockIdx.x * blockDim.x + threadIdx.x) >> 6, lane = threadIdx.x & 63; if (wave >= S_ * 8) return;
    const int t = wave >> 3, h = (wave >> 1) & 3, which = wave & 1;
    bf16* p = z + (size_t)t * ZW + (which ? Z_MK : Z_MQ) + h * 128; const float* g = which ? gk : gq;
    const float x1 = bf2f(p[lane]), x2 = bf2f(p[lane + 64]);
    const float ss = wave_sum(x1 * x1 + x2 * x2); const float r = 1.0f / sqrtf(ss * (1.0f / 128.0f) + EPS_);
    const float y1 = x1 * r * g[lane], y2 = x2 * r * g[lane + 64];
    const float inv = 1.0f / powf(10000.0f, (float)lane / 64.0f); const float ang = (float)pos[t] * inv;
    float sn, cs; sincos_acc(ang, sn, cs);
    p[lane] = (bf16)f2bf(y1 * cs - y2 * sn); p[lane + 64] = (bf16)f2bf(y2 * cs + y1 * sn);
}
__global__ void k_moba_kmean(const bf16* __restrict__ z, float* __restrict__ kmean) {
    const int h = blockIdx.x >> 6, blk = blockIdx.x & 63, d = threadIdx.x; float s = 0.f;
    for (int i = 0; i < 256; ++i) s += ldz(z, blk * 256 + i, Z_MK + h * 128 + d);
    kmean[(size_t)(h * 64 + blk) * 128 + d] = s * (1.0f / 256.0f);
}
__global__ void __launch_bounds__(256) k_moba_attn(const bf16* __restrict__ z, const float* __restrict__ kmean, bf16* __restrict__ mix) {
    __shared__ float pl[4][1024];
    const int w = threadIdx.x >> 6, lane = threadIdx.x & 63; const int wave = blockIdx.x * 4 + w; const int q = wave >> 2, h = wave & 3; const int kb = q >> 8;
    const bf16* qrow = z + (size_t)q * ZW + Z_MQ + h * 128; const float scale = 0.08838834764831845f;
    float g = -INFINITY;
    if (lane < kb) { const float* km = kmean + (size_t)(h * 64 + lane) * 128; float s = 0.f; for (int d = 0; d < 128; ++d) s += bf2f(qrow[d]) * km[d]; g = s; }
    int sel[3];
#pragma unroll
    for (int r = 0; r < 3; ++r) { const float m = wave_max(g); const unsigned long long bal = __ballot(g == m); const int idx = __ffsll((long long)bal) - 1; sel[r] = (m > -INFINITY) ? idx : -1; if (lane == idx) g = -INFINITY; }
    float sc[16];
#pragma unroll
    for (int seg = 0; seg < 4; ++seg) { const int blk = (seg < 3) ? sel[seg] : kb;
#pragma unroll
        for (int r = 0; r < 4; ++r) { float s = -INFINITY;
            if (blk >= 0) { const int key = blk * 256 + r * 64 + lane;
                if (seg < 3 || key <= q) { const bf16* kr = z + (size_t)key * ZW + Z_MK + h * 128; float a = 0.f; for (int d = 0; d < 128; ++d) a += bf2f(qrow[d]) * bf2f(kr[d]); s = a * scale; } }
            sc[seg * 4 + r] = s; } }
    float m = sc[0];
#pragma unroll
    for (int i = 1; i < 16; ++i) m = fmaxf(m, sc[i]);
    m = wave_max(m); float sum = 0.f;
#pragma unroll
    for (int i = 0; i < 16; ++i) { const float p = (sc[i] > -INFINITY) ? expf(sc[i] - m) : 0.f; sum += p; pl[w][i * 64 + lane] = p; }
    sum = wave_sum(sum); __syncthreads();
    float a0 = 0.f, a1 = 0.f;
#pragma unroll
    for (int seg = 0; seg < 4; ++seg) { const int blk = (seg < 3) ? sel[seg] : kb; if (blk < 0) continue; const int nk = (seg < 3) ? 256 : ((q & 255) + 1);
        for (int i = 0; i < nk; ++i) { const float p = pl[w][seg * 256 + i]; const bf16* vr = z + (size_t)(blk * 256 + i) * ZW + Z_MV + h * 128; a0 += p * bf2f(vr[lane]); a1 += p * bf2f(vr[lane + 64]); } }
    const float inv = 1.0f / sum;
    mix[(size_t)q * D_ + 512 + h * 128 + lane] = (bf16)f2bf(a0 * inv); mix[(size_t)q * D_ + 512 + h * 128 + 64 + lane] = (bf16)f2bf(a1 * inv);
}
}

static void launch_range(const Args& a0, int lo, int hi, int li, int grid, hipStream_t stream) {
    Args a = a0; a.ph_lo = lo; a.ph_hi = hi; a.li = li;
    hipLaunchKernelGGL(mk_fwd, dim3(grid), dim3(NWAVES * 64), LDS_BYTES, stream, a);
    const hipError_t le = hipPeekAtLastError();
    if (le != hipSuccess) fprintf(stderr, "kernel_launch: launch [%d,%d) failed: %s\n", lo, hi, hipGetErrorName(le));
}
extern "C" void kernel_launch(void* const* d_in, const int* in_sizes, int n_in, void* d_out, int out_size, void* d_ws, size_t ws_size, hipStream_t stream) {
    static int grid = 0;
    if (grid == 0) {
        if (n_in != 18 || out_size != S_ * D_ || ws_size < WS_END) { fprintf(stderr, "kernel_launch: unexpected shapes (n_in %d out %d ws %zu)\n", n_in, out_size, ws_size); grid = -1; return; }
        int dev = 0, cus = 0, per_cu = 0;
        if (hipGetDevice(&dev) != hipSuccess || hipDeviceGetAttribute(&cus, hipDeviceAttributeMultiprocessorCount, dev) != hipSuccess) { grid = -1; return; }
        if (hipFuncSetAttribute((const void*)mk_fwd, hipFuncAttributeMaxDynamicSharedMemorySize, LDS_BYTES) != hipSuccess) { fprintf(stderr, "kernel_launch: hipFuncSetAttribute failed\n"); grid = -1; return; }
        if (hipOccupancyMaxActiveBlocksPerMultiprocessor(&per_cu, (const void*)mk_fwd, NWAVES * 64, LDS_BYTES) != hipSuccess || per_cu < 1) { fprintf(stderr, "kernel_launch: occupancy query says %d\n", per_cu); per_cu = 1; }
        (void)hipGetLastError();
        grid = cus;
        if (grid != 256) fprintf(stderr, "kernel_launch: note: %d CUs\n", grid);
    }
    if (grid < 0) return;
    (void)hipMemsetAsync((char*)d_ws + WS_CTL, 0, CTL_ZERO_BYTES, stream);
    Args a{};
    for (int i = 0; i < 18; ++i) a.in[i] = d_in[i];
    a.out = (float*)d_out; a.ws = (unsigned char*)d_ws;
    launch_range(a, 0, N_PHASES, 0, grid, stream);
}
```

```cpp
#include <hip/hip_runtime.h>
#include <cstdio>
#include <cstdint>
#include <math.h>
namespace pg8 {
#define PG8_LAS __attribute__((address_space(3)))
typedef unsigned short bf16_t;
typedef short bf16x8 __attribute__((ext_vector_type(8)));
typedef float f32x4 __attribute__((ext_vector_type(4)));
typedef unsigned u32x4 __attribute__((ext_vector_type(4)));
constexpr int BM = 256, BK = 64, HALF = 128, HTB = HALF * BK * 2  , STAGE_BYTES = 8 * HTB, NXCD = 8, WGM = 8;

__host__ __device__ __forceinline__ int lds_byte(int r, int c) { const int st = (r >> 4) * 2 + (c >> 5), rr = r & 15, cc = c & 31, ob = rr * 64 + cc * 2; return st * 1024 + (ob ^ (((ob >> 9) & 1) << 5)); }
__host__ __device__ __forceinline__ void stage_rc(int b, int& R, int& C) { const int st = b / 1024, sb = b % 1024, swz = sb ^ (((sb >> 9) & 1) << 5); R = (st >> 1) * 16 + swz / 64; C = (st & 1) * 32 + (swz % 64) / 2; }
__host__ __device__ __forceinline__ int perm32(int rho) { const int n = rho >> 4, i = rho & 15; return 8 * (i >> 2) + 4 * n + (i & 3); }

struct Unit { int pm, pn; };
struct Gemm { const bf16_t* A; const bf16_t* Bt; int M, N, K; };

struct StaticOrder {
    int nM, nN, nwg, G, c;
    __host__ __device__ void init(int M, int N, int G_, int c_) { nM = M / BM; nN = N / BM; nwg = nM * nN; G = G_; c = c_; }
    __host__ __device__ bool next(int i, Unit& u) const {
        const long L = (long)i * G + c; if (L >= nwg) return false;
        int wgid = (int)L; { const int q = nwg / NXCD, r = nwg % NXCD, xcd = wgid % NXCD, off = wgid / NXCD; wgid = (xcd < r ? xcd * (q + 1) : r * (q + 1) + (xcd - r) * q) + off; }
        const int nig = WGM * nN, gid = wgid / nig, fm = gid * WGM, gsz = (nM - fm) < WGM ? (nM - fm) : WGM;
        u.pm = fm + ((wgid % nig) % gsz); u.pn = (wgid % nig) / gsz; return true;
    }
    __device__ __forceinline__ void a_ready(const Unit&) const {}
    __device__ __forceinline__ void done(const Unit&) const {}
};

__device__ __forceinline__ unsigned cvt_pk_bf16(float lo, float hi) { unsigned r; asm volatile("v_cvt_pk_bf16_f32 %0, %1, %2" : "=v"(r) : "v"(lo), "v"(hi)); return r; }
typedef float f32x2 __attribute__((ext_vector_type(2)));

__device__ __forceinline__ float rstd_from_part(const float* part, int row, float inv_n, float eps) {
    const f32x4 p = *(const f32x4*)(part + (size_t)row * 4);
    return 1.0f / sqrtf(((p[0] + p[1]) + (p[2] + p[3])) * inv_n + eps);
}
template <int ACT, int RS> struct EpiScale {
    static constexpr bool PERM = true, AFTER_DRAIN = false;
    bf16_t* O; int ldc; const float* rsv; float eps;
    __device__ __forceinline__ void operator()(const f32x4 (&acc)[2][2][4][2], const Unit& u, int wr, int wc, int fr, int fq) const {
        const int row0 = u.pm * BM + wr * 64 + fr, col0 = u.pn * BM + wc * 32 + 8 * fq;
#pragma unroll
        for (int ai = 0; ai < 2; ++ai)
#pragma unroll
            for (int m = 0; m < 4; ++m) {
                const int row = row0 + ai * HALF + m * 16;
                float s = 1.f;
                if (RS == 1) s = rsv[row];
                if (RS == 2) s = rstd_from_part(rsv, row, 1.0f / 1024.0f, eps);
                bf16_t* rowp = O + (size_t)row * ldc + col0;
#pragma unroll
                for (int bj = 0; bj < 2; ++bj) {
                    f32x4 v0 = acc[ai][bj][m][0] * s, v1 = acc[ai][bj][m][1] * s;
                    if (ACT == 1) {
#pragma unroll
                        for (int e = 0; e < 4; ++e) { const float a = fmaxf(v0[e], 0.f), b = fmaxf(v1[e], 0.f); v0[e] = a * a; v1[e] = b * b; }
                    }
                    u32x4 w; w.x = cvt_pk_bf16(v0[0], v0[1]); w.y = cvt_pk_bf16(v0[2], v0[3]); w.z = cvt_pk_bf16(v1[0], v1[1]); w.w = cvt_pk_bf16(v1[2], v1[3]);
                    *(u32x4*)(rowp + bj * HALF) = w;
                }
            }
    }
};
template <int RES> struct EpiRes {
    static constexpr bool PERM = true, AFTER_DRAIN = true;
    const float* base; bf16_t* hb; float* part; int ldc;
    __device__ __forceinline__ void fused(f32x4 (&acc)[2][2][4][2], const Unit& u, int wr, int wc, int fr, int fq, PG8_LAS unsigned char* lds, int wid, int lane) const {
        PG8_LAS float* P = (PG8_LAS float*)lds;
        const int row0 = u.pm * BM + wr * 64 + fr, col0 = u.pn * BM + wc * 32 + 8 * fq;
#pragma unroll
        for (int ai = 0; ai < 2; ++ai) {
            f32x4 pre[4][2][2]; u32x4 preb[4][2];
            if (RES == 1) {
#pragma unroll
                for (int m = 0; m < 4; ++m) { const size_t off = (size_t)(row0 + ai * HALF + m * 16) * ldc + col0;
#pragma unroll
                    for (int bj = 0; bj < 2; ++bj) { pre[m][bj][0] = *(const f32x4*)(base + off + bj * HALF); pre[m][bj][1] = *(const f32x4*)(base + off + bj * HALF + 4); } }
            }
            if (RES == 2) {
#pragma unroll
                for (int m = 0; m < 4; ++m) { const size_t off = (size_t)(row0 + ai * HALF + m * 16) * ldc + col0;
#pragma unroll
                    for (int bj = 0; bj < 2; ++bj) preb[m][bj] = *(const u32x4*)(hb + off + bj * HALF); }
            }
#pragma unroll
            for (int m = 0; m < 4; ++m) {
                const int row = row0 + ai * HALF + m * 16;
                const size_t off = (size_t)row * ldc + col0;
                float q = 0.f;
#pragma unroll
                for (int bj = 0; bj < 2; ++bj) {
                    f32x4 v0 = acc[ai][bj][m][0], v1 = acc[ai][bj][m][1];
                    if (RES == 1) { v0 = v0 + pre[m][bj][0]; v1 = v1 + pre[m][bj][1]; }
                    if (RES == 2) { const u32x4 ew = preb[m][bj];
                        v0[0] += __uint_as_float(ew.x << 16); v0[1] += __uint_as_float(ew.x & 0xffff0000u); v0[2] += __uint_as_float(ew.y << 16); v0[3] += __uint_as_float(ew.y & 0xffff0000u);
                        v1[0] += __uint_as_float(ew.z << 16); v1[1] += __uint_as_float(ew.z & 0xffff0000u); v1[2] += __uint_as_float(ew.w << 16); v1[3] += __uint_as_float(ew.w & 0xffff0000u); }
                    u32x4 w; w.x = cvt_pk_bf16(v0[0], v0[1]); w.y = cvt_pk_bf16(v0[2], v0[3]); w.z = cvt_pk_bf16(v1[0], v1[1]); w.w = cvt_pk_bf16(v1[2], v1[3]);
                    *(u32x4*)(hb + off + bj * HALF) = w;
                    q += (v0[0] * v0[0] + v0[1] * v0[1]) + (v0[2] * v0[2] + v0[3] * v0[3]) + (v1[0] * v1[0] + v1[1] * v1[1]) + (v1[2] * v1[2] + v1[3] * v1[3]);
                }
                q += __shfl_xor(q, 16); q += __shfl_xor(q, 32);
                if (fq == 0) P[(ai * HALF + wr * 64 + m * 16 + fr) * 4 + wc] = q;
            }
        }
        asm volatile("s_waitcnt lgkmcnt(0)" ::: "memory"); __builtin_amdgcn_s_barrier(); asm volatile("" ::: "memory");
        const int tid = wid * 64 + lane;
        if (tid < 256) { const f32x4 p = ((const PG8_LAS f32x4*)lds)[tid]; part[(size_t)(u.pm * BM + tid) * 4 + u.pn] = (p[0] + p[1]) + (p[2] + p[3]); }
        asm volatile("s_waitcnt lgkmcnt(0)" ::: "memory"); __builtin_amdgcn_s_barrier(); asm volatile("" ::: "memory");
    }
};
struct EpiGate {
    static constexpr bool PERM = true, AFTER_DRAIN = false;
    float* out; const bf16_t* hb; const bf16_t* eraw; const float* part_h; const float* part_e; const float* g_emb; int ldc; float eps;
    __device__ __forceinline__ void operator()(const f32x4 (&acc)[2][2][4][2], const Unit& u, int wr, int wc, int fr, int fq) const {
        const int row0 = u.pm * BM + wr * 64 + fr, col0 = u.pn * BM + wc * 32 + 8 * fq;
        f32x4 gv[2][2];
#pragma unroll
        for (int bj = 0; bj < 2; ++bj) { gv[bj][0] = *(const f32x4*)(g_emb + col0 + bj * HALF); gv[bj][1] = *(const f32x4*)(g_emb + col0 + bj * HALF + 4); }
#pragma unroll
        for (int ai = 0; ai < 2; ++ai)
#pragma unroll
            for (int mp = 0; mp < 2; ++mp) {
                u32x4 hv[2][2]; u32x4 ewv[2][2]; float sh[2], se[2];
#pragma unroll
                for (int mm = 0; mm < 2; ++mm) { const int row = row0 + ai * HALF + (2 * mp + mm) * 16; const size_t off = (size_t)row * ldc + col0;
                    sh[mm] = rstd_from_part(part_h, row, 1.0f / 1024.0f, eps); se[mm] = rstd_from_part(part_e, row, 1.0f / 1024.0f, eps);
#pragma unroll
                    for (int bj = 0; bj < 2; ++bj) { ewv[mm][bj] = *(const u32x4*)(eraw + off + bj * HALF); hv[mm][bj] = *(const u32x4*)(hb + off + bj * HALF); } }
#pragma unroll
                for (int mm = 0; mm < 2; ++mm) { const int m = 2 * mp + mm; const int row = row0 + ai * HALF + m * 16; const size_t off = (size_t)row * ldc + col0;
#pragma unroll
                    for (int bj = 0; bj < 2; ++bj) {
                        const u32x4 ew = ewv[mm][bj];
                        f32x4 e0, e1;
                        e0[0] = __uint_as_float(ew.x << 16); e0[1] = __uint_as_float(ew.x & 0xffff0000u); e0[2] = __uint_as_float(ew.y << 16); e0[3] = __uint_as_float(ew.y & 0xffff0000u);
                        e1[0] = __uint_as_float(ew.z << 16); e1[1] = __uint_as_float(ew.z & 0xffff0000u); e1[2] = __uint_as_float(ew.w << 16); e1[3] = __uint_as_float(ew.w & 0xffff0000u);
                        const u32x4 hw = hv[mm][bj];
                        f32x4 h0, h1;
                        h0[0] = __uint_as_float(hw.x << 16); h0[1] = __uint_as_float(hw.x & 0xffff0000u); h0[2] = __uint_as_float(hw.y << 16); h0[3] = __uint_as_float(hw.y & 0xffff0000u);
                        h1[0] = __uint_as_float(hw.z << 16); h1[1] = __uint_as_float(hw.z & 0xffff0000u); h1[2] = __uint_as_float(hw.w << 16); h1[3] = __uint_as_float(hw.w & 0xffff0000u);
                        const f32x4 a0 = acc[ai][bj][m][0] * sh[mm], a1 = acc[ai][bj][m][1] * sh[mm];
#pragma unroll
                        for (int e = 0; e < 4; ++e) {
                            const float g0 = __builtin_amdgcn_rcpf(1.0f + __expf(-a0[e])), g1 = __builtin_amdgcn_rcpf(1.0f + __expf(-a1[e]));
                            h0[e] += g0 * (e0[e] * se[mm] * gv[bj][0][e]); h1[e] += g1 * (e1[e] * se[mm] * gv[bj][1][e]);
                        }
                        *(f32x4*)(out + off + bj * HALF) = h0; *(f32x4*)(out + off + bj * HALF + 4) = h1;
                    } }
            }
    }
};
template <class Epi, class Sched, bool ALIGN_EPI = false, bool SP2 = false>
__device__ __forceinline__ void gemm_phase(PG8_LAS unsigned char* lds, const Gemm g, const Sched& S, const Epi& E) {
    const int tid = threadIdx.x, wid = __builtin_amdgcn_readfirstlane(tid >> 6), lane = tid & 63, wr = wid >> 2, wc = wid & 3, fr = lane & 15, fq = lane >> 4;
    const int K = g.K, nt = K / BK;
    unsigned voffA[2], voffB[2];
#pragma unroll
    for (int i = 0; i < 2; ++i) { int R, C; stage_rc(tid * 16 + i * 8192, R, C); const int Rb = Epi::PERM ? ((R & ~31) + perm32(R & 31)) : R;
        voffA[i] = (unsigned)(R * K + C) * 2u; voffB[i] = (unsigned)(Rb * K + C) * 2u; }
    const size_t kstep = (size_t)(BK * 2);
    const size_t hstep = (size_t)HALF * K * 2;
    const size_t tstep = 2 * hstep;
    const unsigned ldsw = (unsigned)wid * 1024u;
    const int aoff = lds_byte(wr * 64 + fr, fq * 8), boff = lds_byte(wc * 32 + fr, fq * 8);
#define PG8_SA(b, h) (((b) * 2 + (h)) * HTB)
#define PG8_SB(b, h) ((4 + (b) * 2 + (h)) * HTB)
#define PG8_STAGE(bufoff, gbase, voff) do { _Pragma("unroll") for (int _i = 0; _i < 2; ++_i) \
        __builtin_amdgcn_global_load_lds((const unsigned*)((const char*)(gbase) + (voff)[_i]), (PG8_LAS unsigned*)(lds + (bufoff) + ldsw + _i * 8192), 16, 0, 0); } while (0)
#define PG8_LDA(dst, b, h) do { _Pragma("unroll") for (int m = 0; m < 4; ++m) _Pragma("unroll") for (int k = 0; k < 2; ++k) dst[m][k] = *(const PG8_LAS bf16x8*)(lds + PG8_SA(b, h) + aoff + m * 2048 + k * 1024); } while (0)
#define PG8_LDB(dst, b, h) do { _Pragma("unroll") for (int n = 0; n < 2; ++n) _Pragma("unroll") for (int k = 0; k < 2; ++k) dst[n][k] = *(const PG8_LAS bf16x8*)(lds + PG8_SB(b, h) + boff + n * 2048 + k * 1024); } while (0)
#define PG8_MMA(ai, bj, At, Bt) do { __builtin_amdgcn_s_setprio(1); _Pragma("unroll") for (int m = 0; m < 4; ++m) _Pragma("unroll") for (int n = 0; n < 2; ++n) _Pragma("unroll") for (int k = 0; k < 2; ++k) \
        acc[ai][bj][m][n] = __builtin_amdgcn_mfma_f32_16x16x32_bf16(Bt[n][k], At[m][k], acc[ai][bj][m][n], 0, 0, 0); __builtin_amdgcn_s_setprio(0); } while (0)
#define PG8_WAIT_V(n) asm volatile("s_waitcnt vmcnt(" #n ")" ::: "memory")
#define PG8_WAIT_L(n) asm volatile("s_waitcnt lgkmcnt(" #n ")" ::: "memory")
#define PG8_BAR __builtin_amdgcn_s_barrier()
#define PG8_SCHED __builtin_amdgcn_sched_barrier(0)
    Unit cur, nxt; int ui = 0;
    if (!S.next(0, cur)) return;
    f32x4 acc[2][2][4][2];
#pragma unroll
    for (int a = 0; a < 2; ++a)
#pragma unroll
        for (int b = 0; b < 2; ++b)
#pragma unroll
            for (int m = 0; m < 4; ++m)
#pragma unroll
                for (int n = 0; n < 2; ++n) acc[a][b][m][n] = (f32x4){0.f, 0.f, 0.f, 0.f};
    bf16x8 At[4][2], B0[2][2], B1[2][2];
    const char* cA = (const char*)g.A + (size_t)cur.pm * tstep; const char* cB = (const char*)g.Bt + (size_t)cur.pn * tstep;
    S.a_ready(cur);
    if constexpr (SP2) {
        PG8_STAGE(PG8_SB(0, 0), cB, voffB); PG8_STAGE(PG8_SB(0, 1), cB + hstep, voffB); PG8_STAGE(PG8_SA(0, 0), cA, voffA); PG8_STAGE(PG8_SA(0, 1), cA + hstep, voffA);
        if (wr == 1) PG8_BAR;
        PG8_WAIT_V(2); PG8_BAR;
        PG8_STAGE(PG8_SB(1, 0), cB + kstep, voffB); PG8_STAGE(PG8_SA(1, 0), cA + kstep, voffA); PG8_STAGE(PG8_SB(1, 1), cB + hstep + kstep, voffB);
        PG8_WAIT_V(6); PG8_BAR;
    } else {
        PG8_STAGE(PG8_SB(0, 0), cB, voffB); PG8_STAGE(PG8_SA(0, 0), cA, voffA); PG8_STAGE(PG8_SB(0, 1), cB + hstep, voffB); PG8_STAGE(PG8_SA(0, 1), cA + hstep, voffA);
        if (wr == 1) PG8_BAR;
        PG8_WAIT_V(4); PG8_BAR;
        PG8_STAGE(PG8_SB(1, 0), cB + kstep, voffB); PG8_STAGE(PG8_SA(1, 0), cA + kstep, voffA); PG8_STAGE(PG8_SB(1, 1), cB + hstep + kstep, voffB);
        PG8_WAIT_V(6); PG8_BAR;
    }
    for (;;) {
        const bool has_next = S.next(ui + 1, nxt);
        const char* nA = has_next ? (const char*)g.A + (size_t)nxt.pm * tstep : cA; const char* nB = has_next ? (const char*)g.Bt + (size_t)nxt.pn * tstep : cB;
        for (int t = 0; t < nt; t += 2) {
            const bool last = (t == nt - 2);
            const char* a1 = cA + (size_t)(t + 1) * kstep;
            const char* a2 = last ? nA : cA + (size_t)(t + 2) * kstep; const char* b2 = last ? nB : cB + (size_t)(t + 2) * kstep;
            const char* a3 = a2 + kstep; const char* b3 = b2 + kstep;
            if (last && has_next) S.a_ready(nxt);
            if constexpr (SP2) {
            PG8_LDB(B0, 0, 0); PG8_LDB(B1, 0, 1); PG8_SCHED; PG8_LDA(At, 0, 0); PG8_STAGE(PG8_SA(1, 1), a1 + hstep, voffA);
            PG8_WAIT_V(8); PG8_WAIT_L(0); PG8_BAR; PG8_MMA(0, 0, At, B0); PG8_MMA(0, 1, At, B1); PG8_BAR; PG8_SCHED;
            PG8_LDA(At, 0, 1); PG8_STAGE(PG8_SB(0, 0), b2, voffB); PG8_STAGE(PG8_SB(0, 1), b2 + hstep, voffB); PG8_STAGE(PG8_SA(0, 0), a2, voffA);
            PG8_WAIT_V(8); PG8_WAIT_L(0); PG8_BAR; PG8_MMA(1, 0, At, B0); PG8_MMA(1, 1, At, B1); PG8_BAR; PG8_SCHED;
            PG8_LDB(B0, 1, 0); PG8_LDB(B1, 1, 1); PG8_SCHED; PG8_LDA(At, 1, 0); PG8_STAGE(PG8_SA(0, 1), a2 + hstep, voffA);
            PG8_WAIT_V(8); PG8_WAIT_L(0); PG8_BAR; PG8_MMA(0, 0, At, B0); PG8_MMA(0, 1, At, B1); PG8_BAR; PG8_SCHED;
            PG8_LDA(At, 1, 1); PG8_STAGE(PG8_SB(1, 0), b3, voffB); PG8_STAGE(PG8_SB(1, 1), b3 + hstep, voffB); PG8_STAGE(PG8_SA(1, 0), a3, voffA);
            PG8_WAIT_V(8); PG8_WAIT_L(0); PG8_BAR; PG8_MMA(1, 0, At, B0); PG8_MMA(1, 1, At, B1); PG8_BAR; PG8_SCHED;
            } else {
            PG8_LDB(B0, 0, 0); PG8_SCHED; PG8_LDA(At, 0, 0); PG8_STAGE(PG8_SA(1, 1), a1 + hstep, voffA);
            PG8_WAIT_L(8); PG8_BAR; PG8_WAIT_L(0); PG8_MMA(0, 0, At, B0); PG8_BAR; PG8_SCHED;
            PG8_LDB(B1, 0, 1); PG8_STAGE(PG8_SB(0, 0), b2, voffB);
            PG8_BAR; PG8_WAIT_L(0); PG8_MMA(0, 1, At, B1); PG8_BAR;
            PG8_LDA(At, 0, 1); PG8_STAGE(PG8_SA(0, 0), a2, voffA);
            PG8_BAR; PG8_WAIT_L(0); PG8_MMA(1, 0, At, B0); PG8_BAR; PG8_SCHED;
            PG8_STAGE(PG8_SB(0, 1), b2 + hstep, voffB);
            PG8_WAIT_V(6); PG8_BAR; PG8_MMA(1, 1, At, B1); PG8_BAR;
            PG8_LDB(B0, 1, 0); PG8_SCHED; PG8_LDA(At, 1, 0); PG8_STAGE(PG8_SA(0, 1), a2 + hstep, voffA);
            PG8_WAIT_L(8); PG8_BAR; PG8_WAIT_L(0); PG8_MMA(0, 0, At, B0); PG8_BAR; PG8_SCHED;
            PG8_LDB(B1, 1, 1); PG8_STAGE(PG8_SB(1, 0), b3, voffB);
            PG8_BAR; PG8_WAIT_L(0); PG8_MMA(0, 1, At, B1); PG8_BAR;
            PG8_LDA(At, 1, 1); PG8_STAGE(PG8_SA(1, 0), a3, voffA);
            PG8_BAR; PG8_WAIT_L(0); PG8_MMA(1, 0, At, B0); PG8_BAR; PG8_SCHED;
            PG8_STAGE(PG8_SB(1, 1), b3 + hstep, voffB);
            PG8_WAIT_V(6); PG8_BAR; PG8_MMA(1, 1, At, B1); PG8_BAR;
            }
        }
        if constexpr (ALIGN_EPI) { if (wr == 0) PG8_BAR; }
        if constexpr (!Epi::AFTER_DRAIN) { E(acc, cur, wr, wc, fr, fq); S.done(cur); }
        if (!has_next) break;
#pragma unroll
        for (int a = 0; a < 2; ++a)
#pragma unroll
            for (int b = 0; b < 2; ++b)
#pragma unroll
                for (int m = 0; m < 4; ++m)
#pragma unroll
                    for (int n = 0; n < 2; ++n) acc[a][b][m][n] = (f32x4){0.f, 0.f, 0.f, 0.f};
        cur = nxt; cA = nA; cB = nB; ++ui;
        if constexpr (ALIGN_EPI) { if (wr == 1) PG8_BAR; }
    }
    PG8_WAIT_V(0);
    if constexpr (!ALIGN_EPI) { if (wr == 0) PG8_BAR; }
    PG8_BAR;
    if constexpr (Epi::AFTER_DRAIN) { E.fused(acc, cur, wr, wc, fr, fq, lds, wid, lane); S.done(cur); }
#undef PG8_SA
#undef PG8_SB
#undef PG8_STAGE
#undef PG8_LDA
#undef PG8_LDB
#undef PG8_MMA
#undef PG8_WAIT_V
#undef PG8_WAIT_L
#undef PG8_BAR
#undef PG8_SCHED
}
}
#ifndef PG8_SP2
#define PG8_SP2 true
#endif
#ifndef PG8_ALIGN
#define PG8_ALIGN true
#endif

constexpr int NWAVES = 8;
constexpr int S_ = 16384, D_ = 1024, FF_ = 4096, PLE_ = 256, INW_ = 3088, ZW = 3072;
constexpr int Z_GQ = 0, Z_GK = 256, Z_GV = 512, Z_GG = 1024, Z_MQ = 1536, Z_MK = 2048, Z_MV = 2560;
constexpr float EPS_ = 1e-6f;

constexpr size_t MiB = 1u << 20, KiB = 1u << 10;
constexpr size_t WS_CTL = 0, CTL_ZERO_BYTES = 64 * KiB;
constexpr size_t WS_WIN = 1 * MiB, WS_WOUT = 7 * MiB, WS_WUP = 9 * MiB, WS_WDOWN = 17 * MiB, WS_WPG = 25 * MiB, WS_WPP = 27 * MiB, WS_WGA = 27 * MiB + 512 * KiB;
constexpr size_t WS_SMALL = 28 * MiB;
constexpr size_t WS_RSTDX = WS_SMALL, WS_GA = WS_SMALL + 64 * KiB, WS_DECAY = WS_SMALL + 1088 * KiB, WS_KMEAN = WS_SMALL + 1344 * KiB,
                 WS_SSQH1 = WS_SMALL + 1472 * KiB, WS_SSQH2 = WS_SMALL + 1728 * KiB, WS_SSQE = WS_SMALL + 1984 * KiB, WS_LPART = WS_SMALL + 2240 * KiB;
constexpr size_t WS_ERAW = 32 * MiB, WS_AB = 64 * MiB, WS_Z = 96 * MiB, WS_MIX = 192 * MiB, WS_PB = 224 * MiB, WS_ACT = 96 * MiB, WS_END = 256 * MiB;
constexpr size_t WS_DS = 224 * MiB, WS_SPREV = 64 * MiB, WS_LIST = 80 * MiB;
constexpr size_t OUT_PART = 0, OUT_VT = 48 * MiB;
constexpr int CW_TMO = 0, CW_CNT = 1024  , CW_BAR = 4096;

constexpr int RING_OFF = 0, RING_BYTES = 131072;
constexpr int LDS_BYTES = 160 * 1024;
constexpr int MISC_OFF = LDS_BYTES - 512;

#define GAS __attribute__((address_space(1)))
#define LAS __attribute__((address_space(3)))
typedef unsigned short bf16;
typedef unsigned v4u __attribute__((ext_vector_type(4)));
typedef float f32x4 __attribute__((ext_vector_type(4)));
typedef short bf16x8 __attribute__((ext_vector_type(8)));
typedef GAS unsigned gu32;
typedef GAS unsigned long long gu64;
#define RLX_AGENT __ATOMIC_RELAXED, __HIP_MEMORY_SCOPE_AGENT
#define LDS_WAIT() asm volatile("s_waitcnt lgkmcnt(0)" ::: "memory")
#define VM_WAIT() asm volatile("s_waitcnt vmcnt(0)" ::: "memory")
__device__ __forceinline__ unsigned long long rt() { return __builtin_amdgcn_s_memrealtime(); }
__device__ __forceinline__ unsigned f2bf(float f) { unsigned u = __builtin_bit_cast(unsigned, f); return (u + 0x7fffu + ((u >> 16) & 1u)) >> 16; }
__device__ __forceinline__ unsigned pk2(float lo, float hi) { return f2bf(lo) | (f2bf(hi) << 16); }

#define XB_TMO      128
#define XB_XCNT(j)  (256  + 64 * (j))
#define XB_XSUB(j)  (1280 + 64 * (j))
#define XB_XGEN(j)  (2304 + 64 * (j))
#define XB_TOP      3328
#define XB_TOPGEN   3392
#define XCD_BAR_WORDS 3456
#define XB_SPIN_CAP (1u << 18)

__device__ __forceinline__ unsigned xb_ld(unsigned* p)              { return __hip_atomic_load(p, __ATOMIC_RELAXED, __HIP_MEMORY_SCOPE_AGENT); }
__device__ __forceinline__ unsigned xb_add(unsigned* p, unsigned v) { return __hip_atomic_fetch_add(p, v, __ATOMIC_RELAXED, __HIP_MEMORY_SCOPE_AGENT); }
__device__ __forceinline__ unsigned xb_xcc_id() { return (unsigned)__builtin_amdgcn_s_getreg((3 << 11) | 20) & 0xFu; }
#define XB_SPIN(cond, bar) do { unsigned _sp = 0; while (cond) { __builtin_amdgcn_s_sleep(1); \
    if ((++_sp & 255u) == 0u) { if (xb_ld(&(bar)[XB_TMO])) break; if (_sp > XB_SPIN_CAP) { atomicAdd(&(bar)[XB_TMO], 1u); break; } } } } while (0)

struct XcdBarrier {
    unsigned* bar; unsigned x;
    volatile LAS unsigned* st;
};

__device__ __forceinline__ XcdBarrier xcd_barrier_post(unsigned* bar, volatile LAS unsigned* st) {
    XcdBarrier b; b.bar = bar; b.x = xb_xcc_id(); b.st = st;
    if (threadIdx.x == 0) (void)xb_add(&bar[XB_XCNT(b.x)], 1u);
    return b;
}
__device__ __forceinline__ void xcd_barrier_complete(unsigned* bar, unsigned x, unsigned& nloc, unsigned& nx) {
    const unsigned G = gridDim.x * gridDim.y * gridDim.z;
    unsigned sum, cnt, mine, sp = 0u;
    for (;;) {
        sum = 0u; cnt = 0u; mine = 0u;
#pragma unroll
        for (unsigned j = 0; j < 16; ++j) { const unsigned c = xb_ld(&bar[XB_XCNT(j)]); sum += c; cnt += (c > 0u) ? 1u : 0u; mine = (j == x) ? c : mine; }
        if (sum == G) break;
        __builtin_amdgcn_s_sleep(1);
        if ((++sp & 255u) == 0u) { if (xb_ld(&bar[XB_TMO])) break; if (sp > XB_SPIN_CAP) { atomicAdd(&bar[XB_TMO], 1u); break; } }
    }
    nloc = mine > 0u ? mine : 1u; nx = cnt > 0u ? cnt : 1u;
}

__device__ __forceinline__ void xcd_barrier(const XcdBarrier& b) {
    asm volatile("s_waitcnt vmcnt(0)" ::: "memory");
    __syncthreads();
    if (threadIdx.x == 0) {
        unsigned* bar = b.bar;
        __builtin_amdgcn_s_waitcnt(0);
        unsigned nloc = b.st[0], nx = b.st[1];
        if (nloc == 0u) { xcd_barrier_complete(bar, b.x, nloc, nx); b.st[0] = nloc; b.st[1] = nx; }
        const unsigned old = xb_add(&bar[XB_XSUB(b.x)], 1u);
        const unsigned gen = old / nloc;
        if (old + 1u == (gen + 1u) * nloc) {
            __builtin_amdgcn_fence(__ATOMIC_RELEASE, "agent");
            asm volatile("s_waitcnt vmcnt(0)" ::: "memory");
            const unsigned og = xb_add(&bar[XB_TOP], 1u);
            const unsigned tg = og / nx;
            if (og + 1u == (tg + 1u) * nx) xb_add(&bar[XB_TOPGEN], 1u);
            else XB_SPIN(xb_ld(&bar[XB_TOPGEN]) == tg, bar);
            __builtin_amdgcn_fence(__ATOMIC_ACQUIRE, "agent");
            xb_add(&bar[XB_XGEN(b.x)], 1u);
            asm volatile("s_waitcnt vmcnt(0)" ::: "memory");
        } else {
            XB_SPIN(xb_ld(&bar[XB_XGEN(b.x)]) == gen, bar);
            __builtin_amdgcn_fence(__ATOMIC_ACQUIRE, "agent");
            asm volatile("s_waitcnt vmcnt(0)" ::: "memory");
        }
    }
    __syncthreads();
}

struct Frame {
    LAS unsigned char* lds;
    volatile LAS unsigned* MISC;
    gu32* ctl;
    int tid, lane, wave, vcu, G;
    unsigned char* ws; float* out;
};
__device__ __forceinline__ const void* in_ptr(const Frame& F, int k) {
    const unsigned lo = __builtin_amdgcn_readfirstlane(F.MISC[32 + 2 * k]), hi = __builtin_amdgcn_readfirstlane(F.MISC[33 + 2 * k]);
    return (const void*)(((unsigned long long)hi << 32) | lo);
}
#define IN_x ((const float*)in_ptr(F, 0))
#define IN_p ((const float*)in_ptr(F, 1))
#define IN_pos ((const int*)in_ptr(F, 2))
#define IN_g_mix ((const float*)in_ptr(F, 3))
#define IN_w_in ((const float*)in_ptr(F, 4))
#define IN_w_a2 ((const float*)in_ptr(F, 5))
#define IN_b_a ((const float*)in_ptr(F, 6))
#define IN_g_gla ((const float*)in_ptr(F, 7))
#define IN_g_mq ((const float*)in_ptr(F, 8))
#define IN_g_mk ((const float*)in_ptr(F, 9))
#define IN_w_out ((const float*)in_ptr(F, 10))
#define IN_g_ffn ((const float*)in_ptr(F, 11))
#define IN_w_up ((const float*)in_ptr(F, 12))
#define IN_w_down ((const float*)in_ptr(F, 13))
#define IN_g_pg ((const float*)in_ptr(F, 14))
#define IN_w_pg ((const float*)in_ptr(F, 15))
#define IN_w_pp ((const float*)in_ptr(F, 16))
#define IN_g_pe ((const float*)in_ptr(F, 17))
template <int CTRL> __device__ __forceinline__ float dpp_mov(float v) { return __builtin_bit_cast(float, __builtin_amdgcn_update_dpp(0, __builtin_bit_cast(int, v), CTRL, 0xf, 0xf, true)); }
__device__ __forceinline__ float row16_sum(float v) { v += dpp_mov<0xB1>(v); v += dpp_mov<0x4E>(v); v += dpp_mov<0x141>(v); v += dpp_mov<0x140>(v); return v; }
__device__ __forceinline__ float wave_sum(float v) {
    v = row16_sum(v);
    const float s0 = __builtin_bit_cast(float, __builtin_amdgcn_readlane(__builtin_bit_cast(int, v), 0)), s1 = __builtin_bit_cast(float, __builtin_amdgcn_readlane(__builtin_bit_cast(int, v), 16));
    const float s2 = __builtin_bit_cast(float, __builtin_amdgcn_readlane(__builtin_bit_cast(int, v), 32)), s3 = __builtin_bit_cast(float, __builtin_amdgcn_readlane(__builtin_bit_cast(int, v), 48));
    return (s0 + s1) + (s2 + s3);
}
__device__ __forceinline__ float bf2f(unsigned v16) { return __uint_as_float(v16 << 16); }

#ifdef PROBE_LO
#define STAMP(k) do { if (blockIdx.x == 0 && F.tid == 0) { const unsigned long long t_ = rt(); F.MISC[80 + 2 * (k)] = (unsigned)t_; F.MISC[81 + 2 * (k)] = (unsigned)(t_ >> 32); } } while (0)
#else
#define STAMP(k) do { } while (0)
#endif
struct TItem { const float* W; const float* gain; bf16* WT; int ldn, src_col, K, n_dst, k0; };
__device__ __forceinline__ TItem p0_decode(const Frame& F, int it) {
    constexpr int I_IN = (D_ / 64) * (ZW / 32), I_OUT = (D_ / 64) * (D_ / 32), I_UP = (D_ / 64) * (FF_ / 32), I_DN = (FF_ / 64) * (D_ / 32), I_PG = I_OUT;
    TItem t; int r = it;
    if (r < I_IN) { const int nb = r % (ZW / 32), kb = r / (ZW / 32), n0 = 32 * nb; t.W = IN_w_in; t.gain = IN_g_mix; t.WT = (bf16*)(F.ws + WS_WIN); t.ldn = INW_; t.src_col = n0 < 1536 ? n0 : n0 + 16; t.K = D_; t.n_dst = n0; t.k0 = 64 * kb; return t; } r -= I_IN;
    if (r < I_OUT) { const int nb = r % (D_ / 32), kb = r / (D_ / 32); t.W = IN_w_out; t.gain = nullptr; t.WT = (bf16*)(F.ws + WS_WOUT); t.ldn = D_; t.src_col = 32 * nb; t.K = D_; t.n_dst = 32 * nb; t.k0 = 64 * kb; return t; } r -= I_OUT;
    if (r < I_UP) { const int nb = r % (FF_ / 32), kb = r / (FF_ / 32); t.W = IN_w_up; t.gain = IN_g_ffn; t.WT = (bf16*)(F.ws + WS_WUP); t.ldn = FF_; t.src_col = 32 * nb; t.K = D_; t.n_dst = 32 * nb; t.k0 = 64 * kb; return t; } r -= I_UP;
    if (r < I_DN) { const int nb = r % (D_ / 32), kb = r / (D_ / 32); t.W = IN_w_down; t.gain = nullptr; t.WT = (bf16*)(F.ws + WS_WDOWN); t.ldn = D_; t.src_col = 32 * nb; t.K = FF_; t.n_dst = 32 * nb; t.k0 = 64 * kb; return t; } r -= I_DN;
    if (r < I_PG) { const int nb = r % (D_ / 32), kb = r / (D_ / 32); t.W = IN_w_pg; t.gain = IN_g_pg; t.WT = (bf16*)(F.ws + WS_WPG); t.ldn = D_; t.src_col = 32 * nb; t.K = D_; t.n_dst = 32 * nb; t.k0 = 64 * kb; return t; } r -= I_PG;
    { const int nb = r % (D_ / 32), kb = r / (D_ / 32); t.W = IN_w_pp; t.gain = nullptr; t.WT = (bf16*)(F.ws + WS_WPP); t.ldn = D_; t.src_col = 32 * nb; t.K = PLE_; t.n_dst = 32 * nb; t.k0 = 64 * kb; return t; }
}
__device__ __forceinline__ void p0_issue(const TItem& t, int lane, float (&w)[32], f32x4 (&g)[2]) {
    const float* src = t.W + (size_t)(t.k0 + (lane >> 5)) * t.ldn + t.src_col + (lane & 31);
#pragma unroll
    for (int i = 0; i < 32; ++i) w[i] = src[(size_t)(2 * i) * t.ldn];
    if (t.gain) { g[0] = *(const f32x4*)(t.gain + t.k0 + 8 * (lane & 7)); g[1] = *(const f32x4*)(t.gain + t.k0 + 8 * (lane & 7) + 4); }
    else { g[0] = (f32x4){1.f, 1.f, 1.f, 1.f}; g[1] = g[0]; }
}
__device__ __forceinline__ void p0_prologue(Frame& F) {
    LAS float* scr = (LAS float*)(F.lds + RING_OFF + F.wave * 16384);
    constexpr int P0_ROWW = 3, P0_TRW = NWAVES - P0_ROWW;
    const bool row_role = F.wave < P0_ROWW;
    const int gw = row_role ? F.vcu * P0_ROWW + F.wave : F.vcu * P0_TRW + (F.wave - P0_ROWW), NGW = F.G * (row_role ? P0_ROWW : P0_TRW);
    bf16* Wga_t = (bf16*)(F.ws + WS_WGA);
    constexpr int NITEMS = (D_ / 64) * (ZW / 32) + 2 * (D_ / 64) * (D_ / 32) + (D_ / 64) * (FF_ / 32) + (FF_ / 64) * (D_ / 32) + (PLE_ / 64) * (D_ / 32);
    if (!row_role) {
        int it = gw; bool have = it < NITEMS;
        float w[32]; f32x4 g[2]; TItem cur;
        if (have) { cur = p0_decode(F, it); p0_issue(cur, F.lane, w, g); }
        while (have) {
#pragma unroll
            for (int i = 0; i < 32; ++i) scr[(2 * i + (F.lane >> 5)) * 33 + (F.lane & 31)] = w[i];
            const f32x4 g0 = g[0], g1 = g[1]; const TItem t = cur;
            LDS_WAIT(); asm volatile("" ::: "memory");
            const int nit = it + NGW; const bool nh = nit < NITEMS;
            if (nh) { cur = p0_decode(F, nit); p0_issue(cur, F.lane, w, g); }
            const int c = F.lane & 7;
#pragma unroll
            for (int j = 0; j < 4; ++j) { const int n = (F.lane >> 3) + 8 * j; const LAS float* s = scr + (8 * c) * 33 + n;
                v4u o; o.x = pk2(s[0 * 33] * g0[0], s[1 * 33] * g0[1]); o.y = pk2(s[2 * 33] * g0[2], s[3 * 33] * g0[3]); o.z = pk2(s[4 * 33] * g1[0], s[5 * 33] * g1[1]); o.w = pk2(s[6 * 33] * g1[2], s[7 * 33] * g1[3]);
                *(GAS v4u*)(t.WT + (size_t)(t.n_dst + n) * t.K + t.k0 + 8 * c) = o; }
            LDS_WAIT(); asm volatile("" ::: "memory");
            it = nit; have = nh;
        }
    }
    STAMP(11);
    if (!row_role) { const float* wi_ = IN_w_in; const float* gm_ = IN_g_mix;
      for (int i = gw * 64 + F.lane; i < 16 * D_; i += NGW * 64) { const int r = i >> 10, k = i & 1023; Wga_t[i] = (bf16)f2bf(wi_[(size_t)k * INW_ + 1536 + r] * gm_[k]); } }
    STAMP(12);
    bf16* xb = (bf16*)(F.ws + WS_AB); bf16* pb = (bf16*)(F.ws + WS_PB); float* rstdx = (float*)(F.ws + WS_RSTDX);
    const float* x_ = IN_x; const float* p_ = IN_p;
    if (row_role) for (int m0 = gw * 4; m0 < S_; m0 += NGW * 4) {
        f32x4 v[4][4], pv[4];
#pragma unroll
        for (int rr = 0; rr < 4; ++rr) { const GAS f32x4* xr = (const GAS f32x4*)(x_ + (size_t)(m0 + rr) * D_) + F.lane;
#pragma unroll
            for (int j = 0; j < 4; ++j) v[rr][j] = xr[64 * j];
            pv[rr] = *((const GAS f32x4*)(p_ + (size_t)(m0 + rr) * PLE_) + F.lane); }
#pragma unroll
        for (int rr = 0; rr < 4; ++rr) { const int m = m0 + rr; float s = 0.f;
#pragma unroll
            for (int j = 0; j < 4; ++j) s += (v[rr][j].x * v[rr][j].x + v[rr][j].y * v[rr][j].y) + (v[rr][j].z * v[rr][j].z + v[rr][j].w * v[rr][j].w);
            s = wave_sum(s);
            GAS unsigned long long* o8 = (GAS unsigned long long*)(xb + (size_t)m * D_) + F.lane;
#pragma unroll
            for (int j = 0; j < 4; ++j) o8[64 * j] = (unsigned long long)pk2(v[rr][j].x, v[rr][j].y) | ((unsigned long long)pk2(v[rr][j].z, v[rr][j].w) << 32);
            if (F.lane == 0) rstdx[m] = 1.0f / sqrtf(s * (1.0f / D_) + EPS_);
            *((GAS unsigned long long*)(pb + (size_t)m * PLE_) + F.lane) = (unsigned long long)pk2(pv[rr].x, pv[rr].y) | ((unsigned long long)pk2(pv[rr].z, pv[rr].w) << 32); }
    }
}

typedef float f32x16 __attribute__((ext_vector_type(16)));
typedef __bf16 bf2_t __attribute__((ext_vector_type(2)));
typedef float f2_t __attribute__((ext_vector_type(2)));
__device__ __forceinline__ unsigned pkbf(float lo, float hi) { f2_t v = {lo, hi}; bf2_t b = __builtin_convertvector(v, bf2_t); return __builtin_bit_cast(unsigned, b); }
#define MFMA32(a, b, c) __builtin_amdgcn_mfma_f32_32x32x16_bf16((a), (b), (c), 0, 0, 0)
#define WG_SYNC() do { asm volatile("s_waitcnt vmcnt(0) lgkmcnt(0)" ::: "memory"); __builtin_amdgcn_s_barrier(); asm volatile("" ::: "memory"); } while (0)
__device__ __forceinline__ bf16x8 pack8(const f32x16& x, int s) {
    v4u p; p.x = pkbf(x[8 * s], x[8 * s + 1]); p.y = pkbf(x[8 * s + 2], x[8 * s + 3]); p.z = pkbf(x[8 * s + 4], x[8 * s + 5]); p.w = pkbf(x[8 * s + 6], x[8 * s + 7]);
    return __builtin_bit_cast(bf16x8, p);
}
__device__ __forceinline__ float log_sigmoid(float s) { return fminf(s, 0.f) - __logf(1.0f + __expf(-fabsf(s))); }
constexpr int GROW = 72;
__device__ __forceinline__ int tperm(int tt) { return (tt & ~15) + 8 * ((tt >> 2) & 1) + 4 * ((tt >> 3) & 1) + (tt & 3); }

__device__ __forceinline__ void gla_load_w2(Frame& F, float (&w2)[16], float& bias) {
    const int c = F.tid & 255;
    const float* wa2_ = IN_w_a2;
#pragma unroll
    for (int r = 0; r < 16; ++r) w2[r] = wa2_[r * 256 + c];
    bias = IN_b_a[c];
}
__device__ __forceinline__ void gla_cumsum(Frame& F, const LAS float* GAS_, LAS float* TOT, const float (&w2)[16], float bias, float (&bl)[32], float& blast, float& boff) {
    const int c = F.tid & 255, half = F.tid >> 8;
    float run = 0.f;
#pragma unroll
    for (int i = 0; i < 32; ++i) {
        const LAS f32x4* g4 = (const LAS f32x4*)(GAS_ + (32 * half + i) * 16);
        const f32x4 g0 = g4[0], g1 = g4[1], g2 = g4[2], g3 = g4[3];
        float a = bias;
        a += g0[0] * w2[0]; a += g0[1] * w2[1]; a += g0[2] * w2[2]; a += g0[3] * w2[3];
        a += g1[0] * w2[4]; a += g1[1] * w2[5]; a += g1[2] * w2[6]; a += g1[3] * w2[7];
        a += g2[0] * w2[8]; a += g2[1] * w2[9]; a += g2[2] * w2[10]; a += g2[3] * w2[11];
        a += g3[0] * w2[12]; a += g3[1] * w2[13]; a += g3[2] * w2[14]; a += g3[3] * w2[15];
        run += log_sigmoid(a) * (1.0f / 16.0f);
        bl[i] = run;
    }
    TOT[half * 256 + c] = run;
    WG_SYNC();
    const float t0 = TOT[c], t1 = TOT[256 + c];
    blast = t0 + t1; boff = half ? t0 : 0.f;
}
__device__ __forceinline__ void gla_vt_load(Frame& F, const bf16* zb, int t0, v4u (&vw)[8]) {
    const int tt = F.tid & 63, grp = F.tid >> 6;
    const bf16* src = zb + (size_t)(t0 + tt) * ZW + Z_GV + 64 * grp;
#pragma unroll
    for (int i = 0; i < 8; ++i) vw[i] = *(const v4u*)(src + 8 * i);
}
__device__ __forceinline__ void gla_vt_write(Frame& F, LAS bf16* VT, const v4u (&vw)[8]) {
    const int tt = F.tid & 63, grp = F.tid >> 6, h = grp >> 1, e0 = (grp & 1) * 64, pt = tperm(tt);
#pragma unroll
    for (int i = 0; i < 8; ++i) {
        const v4u w = vw[i];
        LAS bf16* dst = VT + (size_t)(h * 128 + e0 + 8 * i) * GROW + pt;
        dst[0 * GROW] = (bf16)(w.x & 0xffffu); dst[1 * GROW] = (bf16)(w.x >> 16); dst[2 * GROW] = (bf16)(w.y & 0xffffu); dst[3 * GROW] = (bf16)(w.y >> 16);
        dst[4 * GROW] = (bf16)(w.z & 0xffffu); dst[5 * GROW] = (bf16)(w.z >> 16); dst[6 * GROW] = (bf16)(w.w & 0xffffu); dst[7 * GROW] = (bf16)(w.w >> 16);
    }
}

__device__ __forceinline__ void gla_a_chunk(Frame& F, int ch) {
    LAS float* GA_S = (LAS float*)(F.lds);
    LAS float* TOT = (LAS float*)(F.lds + 8192);
    LAS bf16* KTE = (LAS bf16*)(F.lds + 10240);
    LAS bf16* VT = (LAS bf16*)(F.lds + 10240 + 4 * 64 * GROW * 2);
    const bf16* xb = (const bf16*)(F.ws + WS_AB); const bf16* zb = (const bf16*)(F.ws + WS_Z); const bf16* wga = (const bf16*)(F.ws + WS_WGA);
    const float* rstdx = (const float*)(F.ws + WS_RSTDX); float* ga_g = (float*)(F.ws + WS_GA); float* decay_g = (float*)(F.ws + WS_DECAY); float* dS_g = (float*)(F.ws + WS_DS);
    const int t0 = ch * 64;
    float w2[16], bias; gla_load_w2(F, w2, bias);
    v4u vw[8]; gla_vt_load(F, zb, t0, vw);
    unsigned short kraw[32];
    { const bf16* kcol = zb + (size_t)(t0 + 32 * (F.tid >> 8)) * ZW + Z_GK + (F.tid & 255);
#pragma unroll
      for (int j = 0; j < 32; ++j) kraw[j] = kcol[(size_t)j * ZW]; }
    {
        const int rg = F.wave & 3, kh = F.wave >> 2, r = F.lane & 15, q = F.lane >> 4;
        const bf16* arow = xb + (size_t)(t0 + 16 * rg + r) * D_ + 8 * q; const bf16* brow = wga + (size_t)r * D_ + 8 * q;
        pg8::f32x4 acc = {0.f, 0.f, 0.f, 0.f};
#pragma unroll 8
        for (int s = 16 * kh; s < 16 * kh + 16; ++s) { const bf16x8 a = *(const bf16x8*)(arow + 32 * s), b = *(const bf16x8*)(brow + 32 * s); acc = __builtin_amdgcn_mfma_f32_16x16x32_bf16(a, b, acc, 0, 0, 0); }
#pragma unroll
        for (int g = 0; g < 4; ++g) GA_S[kh * 1024 + (16 * rg + 4 * q + g) * 16 + r] = acc[g];
    }
    WG_SYNC();
    for (int idx = F.tid; idx < 1024; idx += 512) { const float v = (GA_S[idx] + GA_S[1024 + idx]) * rstdx[t0 + (idx >> 4)]; GA_S[idx] = v; ga_g[(size_t)t0 * 16 + idx] = v; }
    WG_SYNC();
    float bl[32], blast, boff;
    gla_cumsum(F, GA_S, TOT, w2, bias, bl, blast, boff);
    {
        const int c = F.tid & 255, half = F.tid >> 8, h = c >> 6, d = c & 63;
        if (half == 0) decay_g[ch * 256 + c] = __expf(blast);
#pragma unroll
        for (int g8 = 0; g8 < 4; ++g8) {
            float v[8];
#pragma unroll
            for (int j = 0; j < 8; ++j) v[j] = bf2f(kraw[8 * g8 + j]) * __expf(blast - (boff + bl[8 * g8 + j]));
            const int tt = 32 * half + 8 * g8, hi = (tt >> 3) & 1;
            LAS bf16* row = KTE + (size_t)(h * 64 + d) * GROW + (tt & ~15) + 4 * hi;
            typedef unsigned u2 __attribute__((ext_vector_type(2)));
            u2 lo, hi2; lo.x = pkbf(v[0], v[1]); lo.y = pkbf(v[2], v[3]); hi2.x = pkbf(v[4], v[5]); hi2.y = pkbf(v[6], v[7]);
            *(LAS u2*)(row) = lo; *(LAS u2*)(row + 8) = hi2;
        }
    }
    gla_vt_write(F, VT, vw);
    WG_SYNC();
    {
        const int h = F.wave >> 1, dt = F.wave & 1, i = F.lane & 31, hh = F.lane >> 5;
        f32x16 acc[4];
#pragma unroll
        for (int et = 0; et < 4; ++et)
#pragma unroll
            for (int r = 0; r < 16; ++r) acc[et][r] = 0.f;
#pragma unroll
        for (int s = 0; s < 4; ++s) {
            const bf16x8 a = *(const LAS bf16x8*)(KTE + (size_t)(h * 64 + 32 * dt + i) * GROW + 16 * s + 8 * hh);
#pragma unroll
            for (int et = 0; et < 4; ++et) { const bf16x8 b = *(const LAS bf16x8*)(VT + (size_t)(h * 128 + 32 * et + i) * GROW + 16 * s + 8 * hh); acc[et] = MFMA32(a, b, acc[et]); }
        }
#pragma unroll
        for (int et = 0; et < 4; ++et) {
            float* dst = dS_g + ((size_t)(ch * 4 + h) * 128 + 32 * et + i) * 64 + 32 * dt + 4 * hh;
#pragma unroll
            for (int g = 0; g < 4; ++g) *(pg8::f32x4*)(dst + 8 * g) = (pg8::f32x4){acc[et][4 * g], acc[et][4 * g + 1], acc[et][4 * g + 2], acc[et][4 * g + 3]};
        }
    }
    WG_SYNC();
}

__device__ __forceinline__ void gla_b_pair(Frame& F, int pair) {
    LAS float* DSL = (LAS float*)(F.lds);
    LAS float* DEC = (LAS float*)(F.lds + 65536);
    LAS float* SEGE = (LAS float*)(F.lds + 131072);
    LAS float* SEGP = (LAS float*)(F.lds + 131072 + 2048);
    const float* decay_g = (const float*)(F.ws + WS_DECAY); const float* dS_g = (const float*)(F.ws + WS_DS); bf16* sp_g = (bf16*)(F.ws + WS_SPREV);
    const int h = pair >> 6, seg = F.tid >> 6, d = F.tid & 63;
#pragma unroll
    for (int i = 0; i < 8; ++i) { const int idx = F.tid + 512 * i, n = idx >> 4, d4 = idx & 15; *(LAS pg8::f32x4*)(DEC + n * 64 + 4 * d4) = *(const pg8::f32x4*)(decay_g + (size_t)n * 256 + h * 64 + 4 * d4); }
    for (int sub = 0; sub < 2; ++sub) {
        const int e = (pair & 63) * 2 + sub;
#pragma unroll
        for (int i = 0; i < 8; ++i) { const int idx = F.tid + 512 * i, n = idx >> 4, d4 = idx & 15; *(LAS pg8::f32x4*)(DSL + n * 64 + 4 * d4) = *(const pg8::f32x4*)(dS_g + ((size_t)(n * 4 + h) * 128 + e) * 64 + 4 * d4); }
        WG_SYNC();
        float Sv = 0.f, P = 1.f;
#pragma unroll 8
        for (int i = 0; i < 32; ++i) { const int n = seg * 32 + i; const float x = DSL[n * 64 + d], a = DEC[n * 64 + d]; DSL[n * 64 + d] = Sv; Sv = a * Sv + x; P *= a; }
        SEGE[seg * 64 + d] = Sv; SEGP[seg * 64 + d] = P;
        WG_SYNC();
        float st = 0.f;
        for (int k = 0; k < seg; ++k) st = SEGP[k * 64 + d] * st + SEGE[k * 64 + d];
        float Pq = 1.f;
#pragma unroll 8
        for (int i = 0; i < 32; ++i) { const int n = seg * 32 + i; const float v = DSL[n * 64 + d] + Pq * st; Pq *= DEC[n * 64 + d]; sp_g[((size_t)(n * 4 + h) * 128 + e) * 64 + d] = (bf16)f2bf(v); }
        WG_SYNC();
    }
}

__device__ __forceinline__ void gla_c_chunk(Frame& F, int ch) {
    LAS float* GA2 = (LAS float*)(F.lds);
    LAS float* TOT = (LAS float*)(F.lds + 4096);
    LAS bf16* QD = (LAS bf16*)(F.lds + 6144);
    LAS bf16* KI = (LAS bf16*)(F.lds + 6144 + 36864);
    LAS bf16* VT = (LAS bf16*)(F.lds + 6144 + 2 * 36864);
    const bf16* zb = (const bf16*)(F.ws + WS_Z); const float* ga_g = (const float*)(F.ws + WS_GA); const bf16* sp_g = (const bf16*)(F.ws + WS_SPREV); bf16* mixb = (bf16*)(F.ws + WS_MIX);
    const int t0 = ch * 64;
    float w2[16], bias; gla_load_w2(F, w2, bias);
    v4u vw[8]; gla_vt_load(F, zb, t0, vw);
    unsigned short qraw[32], kraw[32];
    { const bf16* qcol = zb + (size_t)(t0 + 32 * (F.tid >> 8)) * ZW + Z_GQ + (F.tid & 255); const bf16* kcol = zb + (size_t)(t0 + 32 * (F.tid >> 8)) * ZW + Z_GK + (F.tid & 255);
#pragma unroll
      for (int j = 0; j < 32; ++j) { qraw[j] = qcol[(size_t)j * ZW]; kraw[j] = kcol[(size_t)j * ZW]; } }
    for (int idx = F.tid; idx < 1024; idx += 512) GA2[idx] = ga_g[(size_t)t0 * 16 + idx];
    WG_SYNC();
    float bl[32], blast, boff;
    gla_cumsum(F, GA2, TOT, w2, bias, bl, blast, boff);
    {
        const int c = F.tid & 255, half = F.tid >> 8, h = c >> 6, d = c & 63;
#pragma unroll
        for (int i = 0; i < 32; ++i) {
            const float b = boff + bl[i];
            const float qd = bf2f(qraw[i]) * __expf(b) * 0.125f, ki = bf2f(kraw[i]) * __expf(-b);
            QD[(size_t)(h * 64 + 32 * half + i) * GROW + d] = (bf16)f2bf(qd); KI[(size_t)(h * 64 + 32 * half + i) * GROW + d] = (bf16)f2bf(ki);
        }
    }
    gla_vt_write(F, VT, vw);
    WG_SYNC();
    {
        const int h = F.wave >> 1, ct = F.wave & 1, i = F.lane & 31, hh = F.lane >> 5;
        bf16x8 qf[4];
#pragma unroll
        for (int s = 0; s < 4; ++s) qf[s] = *(const LAS bf16x8*)(QD + (size_t)(h * 64 + 32 * ct + i) * GROW + 16 * s + 8 * hh);
        f32x16 acc[4];
#pragma unroll
        for (int et = 0; et < 4; ++et)
#pragma unroll
            for (int r = 0; r < 16; ++r) acc[et][r] = 0.f;
#pragma unroll
        for (int et = 0; et < 4; ++et) {
            const bf16* srow = sp_g + ((size_t)(ch * 4 + h) * 128 + 32 * et + i) * 64 + 8 * hh;
#pragma unroll
            for (int s = 0; s < 4; ++s) { const bf16x8 sf = *(const bf16x8*)(srow + 16 * s); acc[et] = MFMA32(sf, qf[s], acc[et]); }
        }
        for (int jt = 0; jt <= ct; ++jt) {
            f32x16 X;
#pragma unroll
            for (int r = 0; r < 16; ++r) X[r] = 0.f;
#pragma unroll
            for (int s = 0; s < 4; ++s) { const bf16x8 kf = *(const LAS bf16x8*)(KI + (size_t)(h * 64 + 32 * jt + i) * GROW + 16 * s + 8 * hh); X = MFMA32(kf, qf[s], X); }
            if (jt == ct) {
#pragma unroll
                for (int r = 0; r < 16; ++r) { const int j = (r & 3) + 8 * (r >> 2) + 4 * hh; if (j > i) X[r] = 0.f; }
            }
#pragma unroll
            for (int s2 = 0; s2 < 2; ++s2) {
                const bf16x8 xs = pack8(X, s2);
#pragma unroll
                for (int et = 0; et < 4; ++et) { const bf16x8 vf = *(const LAS bf16x8*)(VT + (size_t)(h * 128 + 32 * et + i) * GROW + 32 * jt + 16 * s2 + 8 * hh); acc[et] = MFMA32(vf, xs, acc[et]); }
            }
        }
        float ss = 0.f;
#pragma unroll
        for (int et = 0; et < 4; ++et)
#pragma unroll
            for (int r = 0; r < 16; ++r) ss += acc[et][r] * acc[et][r];
        ss += __shfl_xor(ss, 32);
        const float rn = 1.0f / sqrtf(ss * (1.0f / 128.0f) + EPS_);
        const int t = t0 + 32 * ct + i;
        const bf16* ggrow = zb + (size_t)t * ZW + Z_GG + h * 128; bf16* orow = mixb + (size_t)t * D_ + h * 128;
        const float* ggl_ = IN_g_gla;
#pragma unroll
        for (int et = 0; et < 4; ++et)
#pragma unroll
            for (int g = 0; g < 4; ++g) {
                const int e0 = 32 * et + 8 * g + 4 * hh;
                typedef unsigned u2 __attribute__((ext_vector_type(2)));
                const u2 gw = *(const u2*)(ggrow + e0);
                const pg8::f32x4 gl = *(const pg8::f32x4*)(ggl_ + e0);
                float gv[4] = {bf2f(gw.x & 0xffffu), bf2f(gw.x >> 16), bf2f(gw.y & 0xffffu), bf2f(gw.y >> 16)};
                float o[4];
#pragma unroll
                for (int j = 0; j < 4; ++j) o[j] = acc[et][4 * g + j] * rn * gl[j] * (gv[j] * __builtin_amdgcn_rcpf(1.0f + __expf(-gv[j])));
                u2 w; w.x = pkbf(o[0], o[1]); w.y = pkbf(o[2], o[3]);
                *(u2*)(orow + e0) = w;
            }
    }
    WG_SYNC();
}

constexpr int KROW = 136;
constexpr int VROW = 264;
constexpr int LIST_PER_HEAD = 256 * 2016;
__device__ __forceinline__ int list_off(int h, int j) { return h * LIST_PER_HEAD + 256 * (63 * j - (j * (j - 1)) / 2); }
typedef unsigned u2_t __attribute__((ext_vector_type(2)));

__device__ __forceinline__ void sincos_acc(float angf, float& s, float& c) {
    double r = (double)angf * 0.15915494309189533577; r -= floor(r);
    const double q = floor(4.0 * r + 0.5);
    const float phi = (float)((r - 0.25 * q) * 6.283185307179586477);
    const float p2 = phi * phi;
    const float sn = phi * (1.0f + p2 * (-1.0f / 6.0f + p2 * (1.0f / 120.0f + p2 * (-1.0f / 5040.0f + p2 * (1.0f / 362880.0f)))));
    const float cs = 1.0f + p2 * (-0.5f + p2 * (1.0f / 24.0f + p2 * (-1.0f / 720.0f + p2 * (1.0f / 40320.0f + p2 * (-1.0f / 3628800.0f)))));
    const int qi = ((int)q) & 3;
    s = (qi == 0) ? sn : (qi == 1) ? cs : (qi == 2) ? -sn : -cs;
    c = (qi == 0) ? cs : (qi == 1) ? -sn : (qi == 2) ? -cs : sn;
}

__device__ __forceinline__ void moba_a_item(Frame& F, int item) {
    const int blk = item >> 2, h = item & 3;
    LAS bf16* VTL = (LAS bf16*)(F.lds);
    LAS float* KM = (LAS float*)(F.lds + 128 * VROW * 2);
    bf16* zb = (bf16*)(F.ws + WS_Z); float* kmean_g = (float*)(F.ws + WS_KMEAN); bf16* vT_g = (bf16*)((unsigned char*)F.out + OUT_VT);
    {
        const int ts = F.lane >> 4, g = F.lane & 15;
        const float* gmq_ = IN_g_mq; const float* gmk_ = IN_g_mk; const int* pos_ = IN_pos;
        float inv[4]; f32x4 gq1 = *(const f32x4*)(gmq_ + 4 * g), gq2 = *(const f32x4*)(gmq_ + 64 + 4 * g), gk1 = *(const f32x4*)(gmk_ + 4 * g), gk2 = *(const f32x4*)(gmk_ + 64 + 4 * g);
#pragma unroll
        for (int c = 0; c < 4; ++c) inv[c] = 1.0f / powf(10000.0f, (float)(4 * g + c) / 64.0f);
        float km1[4] = {0.f, 0.f, 0.f, 0.f}, km2[4] = {0.f, 0.f, 0.f, 0.f};
        for (int b4 = 0; b4 < 2; ++b4) {
            u2_t ql[4], qh[4], kl[4], kh[4]; int ps[4];
#pragma unroll
            for (int u = 0; u < 4; ++u) { const int t = blk * 256 + F.wave * 32 + 16 * b4 + 4 * u + ts;
                const bf16* pq = zb + (size_t)t * ZW + Z_MQ + h * 128 + 4 * g; const bf16* pk = zb + (size_t)t * ZW + Z_MK + h * 128 + 4 * g;
                ps[u] = pos_[t]; ql[u] = *(const u2_t*)pq; qh[u] = *(const u2_t*)(pq + 64); kl[u] = *(const u2_t*)pk; kh[u] = *(const u2_t*)(pk + 64); }
#pragma unroll
            for (int u = 0; u < 4; ++u) { const int t = blk * 256 + F.wave * 32 + 16 * b4 + 4 * u + ts;
                float q1[4] = {bf2f(ql[u].x & 0xffffu), bf2f(ql[u].x >> 16), bf2f(ql[u].y & 0xffffu), bf2f(ql[u].y >> 16)}, q2[4] = {bf2f(qh[u].x & 0xffffu), bf2f(qh[u].x >> 16), bf2f(qh[u].y & 0xffffu), bf2f(qh[u].y >> 16)};
                float k1[4] = {bf2f(kl[u].x & 0xffffu), bf2f(kl[u].x >> 16), bf2f(kl[u].y & 0xffffu), bf2f(kl[u].y >> 16)}, k2[4] = {bf2f(kh[u].x & 0xffffu), bf2f(kh[u].x >> 16), bf2f(kh[u].y & 0xffffu), bf2f(kh[u].y >> 16)};
                float sq = 0.f, sk = 0.f;
#pragma unroll
                for (int c = 0; c < 4; ++c) { sq += q1[c] * q1[c] + q2[c] * q2[c]; sk += k1[c] * k1[c] + k2[c] * k2[c]; }
                sq = row16_sum(sq); sk = row16_sum(sk);
                const float rq = 1.0f / sqrtf(sq * (1.0f / 128.0f) + EPS_), rk = 1.0f / sqrtf(sk * (1.0f / 128.0f) + EPS_);
                float oq1[4], oq2[4], ok1[4], ok2[4];
#pragma unroll
                for (int c = 0; c < 4; ++c) { float sn, cs; sincos_acc((float)ps[u] * inv[c], sn, cs);
                    const float yq1 = q1[c] * rq * gq1[c], yq2 = q2[c] * rq * gq2[c], yk1 = k1[c] * rk * gk1[c], yk2 = k2[c] * rk * gk2[c];
                    oq1[c] = yq1 * cs - yq2 * sn; oq2[c] = yq2 * cs + yq1 * sn; ok1[c] = yk1 * cs - yk2 * sn; ok2[c] = yk2 * cs + yk1 * sn;
                    km1[c] += ok1[c]; km2[c] += ok2[c]; }
                bf16* pq = zb + (size_t)t * ZW + Z_MQ + h * 128 + 4 * g; bf16* pk = zb + (size_t)t * ZW + Z_MK + h * 128 + 4 * g;
                u2_t w; w.x = pkbf(oq1[0], oq1[1]); w.y = pkbf(oq1[2], oq1[3]); *(u2_t*)pq = w; w.x = pkbf(oq2[0], oq2[1]); w.y = pkbf(oq2[2], oq2[3]); *(u2_t*)(pq + 64) = w;
                w.x = pkbf(ok1[0], ok1[1]); w.y = pkbf(ok1[2], ok1[3]); *(u2_t*)pk = w; w.x = pkbf(ok2[0], ok2[1]); w.y = pkbf(ok2[2], ok2[3]); *(u2_t*)(pk + 64) = w;
            }
        }
#pragma unroll
        for (int c = 0; c < 4; ++c) { KM[(F.wave * 4 + ts) * 128 + 4 * g + c] = km1[c]; KM[(F.wave * 4 + ts) * 128 + 64 + 4 * g + c] = km2[c]; }
    }
    {
        const int tt = F.tid & 255, half = F.tid >> 8, pt = tperm(tt);
        const bf16* src = zb + (size_t)(blk * 256 + tt) * ZW + Z_MV + h * 128 + 64 * half;
#pragma unroll
        for (int i = 0; i < 8; ++i) {
            const v4u w = *(const v4u*)(src + 8 * i);
            LAS bf16* dst = VTL + (size_t)(64 * half + 8 * i) * VROW + pt;
            dst[0 * VROW] = (bf16)(w.x & 0xffffu); dst[1 * VROW] = (bf16)(w.x >> 16); dst[2 * VROW] = (bf16)(w.y & 0xffffu); dst[3 * VROW] = (bf16)(w.y >> 16);
            dst[4 * VROW] = (bf16)(w.z & 0xffffu); dst[5 * VROW] = (bf16)(w.z >> 16); dst[6 * VROW] = (bf16)(w.w & 0xffffu); dst[7 * VROW] = (bf16)(w.w >> 16);
        }
    }
    WG_SYNC();
    if (F.tid < 128) { float s = 0.f;
#pragma unroll
        for (int w = 0; w < 32; ++w) s += KM[w * 128 + F.tid];
        kmean_g[(size_t)(h * 64 + blk) * 128 + F.tid] = s * (1.0f / 256.0f); }
#pragma unroll
    for (int i = 0; i < 8; ++i) { const int idx = F.tid + 512 * i, e = idx >> 5, c16 = idx & 31;
        *(v4u*)(vT_g + ((size_t)(h * 64 + blk) * 128 + e) * 256 + 8 * c16) = *(const LAS v4u*)(VTL + (size_t)e * VROW + 8 * c16); }
    WG_SYNC();
}

__device__ __forceinline__ void top3_insert(float v, int j, float& v0, float& v1, float& v2, int& i0, int& i1, int& i2) {
    const bool b0 = (v > v0) || (v == v0 && j < i0), b1 = (v > v1) || (v == v1 && j < i1), b2 = (v > v2) || (v == v2 && j < i2);
    const float n2 = b1 ? v1 : (b2 ? v : v2); const int m2 = b1 ? i1 : (b2 ? j : i2);
    const float n1 = b0 ? v0 : (b1 ? v : v1); const int m1 = b0 ? i0 : (b1 ? j : i1);
    const float n0 = b0 ? v : v0; const int m0 = b0 ? j : i0;
    v0 = n0; v1 = n1; v2 = n2; i0 = m0; i1 = m1; i2 = m2;
}
__device__ __forceinline__ void moba_b_item(Frame& F, int item) {
    const int kb = item >> 2, h = item & 3;
    if (kb == 0) return;
    LAS float* KMF = (LAS float*)(F.lds);
    LAS unsigned* HIST = (LAS unsigned*)(F.lds + 64 * 129 * 4);
    LAS unsigned* BASE = HIST + 64;
    const bf16* zb = (const bf16*)(F.ws + WS_Z); const float* kmean_g = (const float*)(F.ws + WS_KMEAN); unsigned* list_g = (unsigned*)(F.ws + WS_LIST);
    const int t_pre = kb * 256 + F.wave * 32 + (F.lane & 31);
    v4u qpre[16];
    { const v4u* qrow = (const v4u*)(zb + (size_t)t_pre * ZW + Z_MQ + h * 128);
#pragma unroll
      for (int m = 0; m < 16; ++m) qpre[m] = qrow[m]; }
    for (int idx = F.tid; idx < 64 * 128; idx += 512) { const int j = idx >> 7, d = idx & 127; KMF[j * 129 + d] = (j < kb) ? kmean_g[(size_t)(h * 64 + j) * 128 + d] : 0.f; }
    if (F.tid < 64) HIST[F.tid] = 0u;
    WG_SYNC();
    const int i = F.lane & 31, kk = F.lane >> 5;
    const int t = kb * 256 + F.wave * 32 + i;
    float v0 = -INFINITY, v1 = -INFINITY, v2 = -INFINITY; int i0 = 1 << 20, i1 = 1 << 20, i2 = 1 << 20;
    const bool two = kb > 32;
    {
        f32x16 acc0, acc1;
#pragma unroll
        for (int r = 0; r < 16; ++r) { acc0[r] = 0.f; acc1[r] = 0.f; }
        const LAS float* arow0 = KMF + i * 129 + kk; const LAS float* arow1 = KMF + (32 + i) * 129 + kk;
#pragma unroll
        for (int m = 0; m < 16; ++m) {
            const v4u qw = qpre[m];
#pragma unroll
            for (int c = 0; c < 4; ++c) {
                const unsigned w = qw[c];
                const float b = __uint_as_float(kk ? (w & 0xffff0000u) : (w << 16));
                acc0 = __builtin_amdgcn_mfma_f32_32x32x2f32(arow0[2 * (4 * m + c)], b, acc0, 0, 0, 0);
                if (two) acc1 = __builtin_amdgcn_mfma_f32_32x32x2f32(arow1[2 * (4 * m + c)], b, acc1, 0, 0, 0);
            }
        }
#pragma unroll
        for (int r = 0; r < 16; ++r) { const int j = (r & 3) + 8 * (r >> 2) + 4 * kk; if (j < kb) top3_insert(acc0[r], j, v0, v1, v2, i0, i1, i2); }
        if (two) {
#pragma unroll
            for (int r = 0; r < 16; ++r) { const int j = 32 + (r & 3) + 8 * (r >> 2) + 4 * kk; if (j < kb) top3_insert(acc1[r], j, v0, v1, v2, i0, i1, i2); }
        }
    }
    {
        const float pv0 = __shfl_xor(v0, 32), pv1 = __shfl_xor(v1, 32), pv2 = __shfl_xor(v2, 32);
        const int pi0 = __shfl_xor(i0, 32), pi1 = __shfl_xor(i1, 32), pi2 = __shfl_xor(i2, 32);
        top3_insert(pv0, pi0, v0, v1, v2, i0, i1, i2); top3_insert(pv1, pi1, v0, v1, v2, i0, i1, i2); top3_insert(pv2, pi2, v0, v1, v2, i0, i1, i2);
    }
    const int nsel = kb < 3 ? kb : 3;
    unsigned lp0 = 0, lp1 = 0, lp2 = 0;
    if (kk == 0) {
        if (nsel > 0) lp0 = atomicAdd((unsigned*)&HIST[i0], 1u);
        if (nsel > 1) lp1 = atomicAdd((unsigned*)&HIST[i1], 1u);
        if (nsel > 2) lp2 = atomicAdd((unsigned*)&HIST[i2], 1u);
    }
    WG_SYNC();
    if (F.tid < 64) { const unsigned n = HIST[F.tid]; BASE[F.tid] = n ? atomicAdd((unsigned*)(F.ctl + CW_CNT + h * 64 + F.tid), n) : 0u; }
    WG_SYNC();
    if (kk == 0) {
        if (nsel > 0) list_g[list_off(h, i0) + BASE[i0] + lp0] = (unsigned)t | (0u << 16);
        if (nsel > 1) list_g[list_off(h, i1) + BASE[i1] + lp1] = (unsigned)t | (1u << 16);
        if (nsel > 2) list_g[list_off(h, i2) + BASE[i2] + lp2] = (unsigned)t | (2u << 16);
    }
    WG_SYNC();
}

__device__ __forceinline__ void moba_load_kv(Frame& F, int h, int j, LAS bf16* KL, LAS bf16* VL) {
    const bf16* zb = (const bf16*)(F.ws + WS_Z); const bf16* vT_g = (const bf16*)((const unsigned char*)F.out + OUT_VT);
#pragma unroll
    for (int i = 0; i < 8; ++i) { const int idx = F.tid + 512 * i, r = idx >> 4, c16 = idx & 15;
        *(LAS v4u*)(KL + (size_t)r * KROW + 8 * c16) = *(const v4u*)(zb + (size_t)(j * 256 + r) * ZW + Z_MK + h * 128 + 8 * c16); }
#pragma unroll
    for (int i = 0; i < 8; ++i) { const int idx = F.tid + 512 * i, e = idx >> 5, c16 = idx & 31;
        *(LAS v4u*)(VL + (size_t)e * VROW + 8 * c16) = *(const v4u*)(vT_g + ((size_t)(h * 64 + j) * 128 + e) * 256 + 8 * c16); }
}
__device__ __forceinline__ void moba_wave_attend(const bf16x8 (&qf)[8], const LAS bf16* KL, const LAS bf16* VL, int nkt, int diag_kt, int i, int hh, float c2, float mc2, f32x16 (&acc)[4], float& lsum) {
    for (int kt = 0; kt < nkt; ++kt) {
        f32x16 St;
#pragma unroll
        for (int r = 0; r < 16; ++r) St[r] = 0.f;
#pragma unroll
        for (int s = 0; s < 8; ++s) { const bf16x8 kf = *(const LAS bf16x8*)(KL + (size_t)(32 * kt + i) * KROW + 16 * s + 8 * hh); St = MFMA32(kf, qf[s], St); }
#pragma unroll
        for (int r = 0; r < 16; ++r) St[r] = __builtin_amdgcn_exp2f(St[r] * c2 - mc2);
        if (kt == diag_kt) {
#pragma unroll
            for (int r = 0; r < 16; ++r) { const int kl = (r & 3) + 8 * (r >> 2) + 4 * hh; if (kl > i) St[r] = 0.f; }
        }
#pragma unroll
        for (int r = 0; r < 16; ++r) lsum += St[r];
#pragma unroll
        for (int s2 = 0; s2 < 2; ++s2) {
            const bf16x8 ps = pack8(St, s2);
#pragma unroll
            for (int et = 0; et < 4; ++et) { const bf16x8 vf = *(const LAS bf16x8*)(VL + (size_t)(32 * et + i) * VROW + 32 * kt + 16 * s2 + 8 * hh); acc[et] = MFMA32(vf, ps, acc[et]); }
        }
    }
}
__device__ __forceinline__ void moba_shift(Frame& F, float& c2, float& mc2) {
    const float* gmq_ = IN_g_mq; const float* gmk_ = IN_g_mk;
    float m1 = fmaxf(fabsf(gmq_[F.lane]), fabsf(gmq_[F.lane + 64])), m2 = fmaxf(fabsf(gmk_[F.lane]), fabsf(gmk_[F.lane + 64]));
#pragma unroll
    for (int o = 1; o < 64; o <<= 1) { m1 = fmaxf(m1, __shfl_xor(m1, o)); m2 = fmaxf(m2, __shfl_xor(m2, o)); }
    c2 = 0.08838834764831845f * 1.4426950408889634f;
    mc2 = 11.313708498984761f * m1 * m2 * 1.4426950408889634f;
}

__device__ __forceinline__ void mc_decode(const LAS int* PRE, int it, int& hj, int& chunk) {
    int lo = 0, hi = 255;
    while (lo < hi) { const int mid = (lo + hi + 1) >> 1; if (PRE[mid] <= it) lo = mid; else hi = mid - 1; }
    hj = lo; chunk = it - PRE[lo];
}
__device__ __forceinline__ void mc_fetch(const Frame& F, int hj, int chunk, int n, int i, int hh, bool& active, bool& valid, int& tq, int& slot, bf16x8 (&qf)[8]) {
    const bf16* zb = (const bf16*)(F.ws + WS_Z); const unsigned* list_g = (const unsigned*)(F.ws + WS_LIST);
    const int h = hj >> 6, j = hj & 63, base = chunk * 256 + F.wave * 32;
    active = base < n; valid = false; tq = 0; slot = 0;
    if (active) {
        const int eidx = base + i; valid = eidx < n;
        const unsigned ent = list_g[list_off(h, j) + (valid ? eidx : base)];
        tq = (int)(ent & 0xffffu); slot = (int)(ent >> 16);
        const bf16* qrow = zb + (size_t)tq * ZW + Z_MQ + h * 128 + 8 * hh;
#pragma unroll
        for (int s = 0; s < 8; ++s) qf[s] = *(const bf16x8*)(qrow + 16 * s);
    }
}
__device__ __forceinline__ void moba_c_phase(Frame& F) {
    LAS bf16* KL = (LAS bf16*)(F.lds); LAS bf16* VL = (LAS bf16*)(F.lds + 256 * KROW * 2);
    LAS int* PRE = (LAS int*)(F.lds + 256 * KROW * 2 + 128 * VROW * 2);
    LAS int* WT = PRE + 260;
    bf16* part_g = (bf16*)((unsigned char*)F.out + OUT_PART); float* lpart_g = (float*)(F.ws + WS_LPART);
    int mycnt = 0;
    if (F.tid < 256) {
        mycnt = (int)__hip_atomic_load(F.ctl + CW_CNT + F.tid, RLX_AGENT);
        int v = (mycnt + 255) >> 8, incl = v;
#pragma unroll
        for (int o = 1; o < 64; o <<= 1) { const int u = __shfl_up(incl, o); if (F.lane >= o) incl += u; }
        if (F.lane == 63) WT[F.wave] = incl;
        PRE[F.tid] = incl - v;
    }
    WG_SYNC();
    if (F.tid < 256) { int off = 0; for (int w = 0; w < F.wave; ++w) off += WT[w]; PRE[F.tid] += off; if (F.tid == 255) PRE[256] = PRE[255] + ((mycnt + 255) >> 8); }
    WG_SYNC();
    const int T = PRE[256];
    float c2, mc2; moba_shift(F, c2, mc2);
    const int i = F.lane & 31, hh = F.lane >> 5;
    const int it0 = (int)(((long long)F.vcu * T) / F.G), it1 = (int)(((long long)(F.vcu + 1) * T) / F.G);
    int cur_hj = -1;
    int hj = 0, chunk = 0, tq = 0, slot = 0; bool active = false, valid = false; bf16x8 qf[8];
#pragma unroll
    for (int s = 0; s < 8; ++s) qf[s] = (bf16x8){0, 0, 0, 0, 0, 0, 0, 0};
    if (it0 < it1) { mc_decode(PRE, it0, hj, chunk); const int n = (int)__hip_atomic_load(F.ctl + CW_CNT + hj, RLX_AGENT); mc_fetch(F, hj, chunk, n, i, hh, active, valid, tq, slot, qf); }
    for (int it = it0; it < it1; ++it) {
        const int h = hj >> 6, j = hj & 63;
        if (hj != cur_hj) { if (cur_hj >= 0) WG_SYNC(); moba_load_kv(F, h, j, KL, VL); WG_SYNC(); cur_hj = hj; }
        int hj2 = hj, chunk2 = 0, tq2 = 0, slot2 = 0; bool active2 = false, valid2 = false; bf16x8 qf2[8];
#pragma unroll
        for (int s = 0; s < 8; ++s) qf2[s] = qf[s];
        if (it + 1 < it1) { mc_decode(PRE, it + 1, hj2, chunk2); const int n2 = (int)__hip_atomic_load(F.ctl + CW_CNT + hj2, RLX_AGENT); mc_fetch(F, hj2, chunk2, n2, i, hh, active2, valid2, tq2, slot2, qf2); }
        if (active) {
            f32x16 acc[4]; float lsum = 0.f;
#pragma unroll
            for (int et = 0; et < 4; ++et)
#pragma unroll
                for (int r = 0; r < 16; ++r) acc[et][r] = 0.f;
            moba_wave_attend(qf, KL, VL, 8, -1, i, hh, c2, mc2, acc, lsum);
            lsum += __shfl_xor(lsum, 32);
            if (valid) {
                bf16* prow = part_g + ((size_t)(slot * 4 + h) * S_ + tq) * 128;
#pragma unroll
                for (int et = 0; et < 4; ++et)
#pragma unroll
                    for (int g = 0; g < 4; ++g) { u2_t w; w.x = pkbf(acc[et][4 * g], acc[et][4 * g + 1]); w.y = pkbf(acc[et][4 * g + 2], acc[et][4 * g + 3]); *(u2_t*)(prow + 32 * et + 8 * g + 4 * hh) = w; }
                if (hh == 0) lpart_g[(size_t)(slot * 4 + h) * S_ + tq] = lsum;
            }
        }
        hj = hj2; chunk = chunk2; tq = tq2; slot = slot2; active = active2; valid = valid2;
#pragma unroll
        for (int s = 0; s < 8; ++s) qf[s] = qf2[s];
    }
    WG_SYNC();
}

__device__ __forceinline__ void moba_d_item(Frame& F, int item, float c2, float mc2) {
    const int blk = item >> 2, h = item & 3;
    LAS bf16* KL = (LAS bf16*)(F.lds); LAS bf16* VL = (LAS bf16*)(F.lds + 256 * KROW * 2);
    const bf16* zb = (const bf16*)(F.ws + WS_Z); const bf16* part_g = (const bf16*)((const unsigned char*)F.out + OUT_PART); const float* lpart_g = (const float*)(F.ws + WS_LPART);
    bf16* mixb = (bf16*)(F.ws + WS_MIX);
    const int i = F.lane & 31, hh = F.lane >> 5;
    const int tq = blk * 256 + F.wave * 32 + i;
    bf16x8 qf[8];
    { const bf16* qrow = zb + (size_t)tq * ZW + Z_MQ + h * 128 + 8 * hh;
#pragma unroll
      for (int s = 0; s < 8; ++s) qf[s] = *(const bf16x8*)(qrow + 16 * s); }
    moba_load_kv(F, h, blk, KL, VL);
    WG_SYNC();
    f32x16 acc[4]; float lsum = 0.f;
#pragma unroll
    for (int et = 0; et < 4; ++et)
#pragma unroll
        for (int r = 0; r < 16; ++r) acc[et][r] = 0.f;
    moba_wave_attend(qf, KL, VL, F.wave + 1, F.wave, i, hh, c2, mc2, acc, lsum);
    lsum += __shfl_xor(lsum, 32);
    const int nsel = blk < 3 ? blk : 3;
    for (int s = 0; s < nsel; ++s) {
        const bf16* prow = part_g + ((size_t)(s * 4 + h) * S_ + tq) * 128;
        lsum += lpart_g[(size_t)(s * 4 + h) * S_ + tq];
#pragma unroll
        for (int et = 0; et < 4; ++et)
#pragma unroll
            for (int g = 0; g < 4; ++g) { const u2_t w = *(const u2_t*)(prow + 32 * et + 8 * g + 4 * hh);
                acc[et][4 * g] += bf2f(w.x & 0xffffu); acc[et][4 * g + 1] += bf2f(w.x >> 16); acc[et][4 * g + 2] += bf2f(w.y & 0xffffu); acc[et][4 * g + 3] += bf2f(w.y >> 16); }
    }
    const float inv = 1.0f / lsum;
    bf16* orow = mixb + (size_t)tq * D_ + 512 + h * 128;
#pragma unroll
    for (int et = 0; et < 4; ++et)
#pragma unroll
        for (int g = 0; g < 4; ++g) { u2_t w; w.x = pkbf(acc[et][4 * g] * inv, acc[et][4 * g + 1] * inv); w.y = pkbf(acc[et][4 * g + 2] * inv, acc[et][4 * g + 3] * inv); *(u2_t*)(orow + 32 * et + 8 * g + 4 * hh) = w; }
    WG_SYNC();
}

struct Args { const void* in[18]; float* out; unsigned char* ws; int ph_lo, ph_hi, li, pad; };
constexpr int N_PHASES = 10;
__global__ void __launch_bounds__(NWAVES * 64, 2) mk_fwd(Args args) {
    extern __shared__ __attribute__((aligned(16))) unsigned char lds[];
    Frame F;
    F.lds = (LAS unsigned char*)lds;
    F.MISC = (volatile LAS unsigned*)(F.lds + MISC_OFF);
    F.tid = threadIdx.x; F.lane = F.tid & 63; F.wave = __builtin_amdgcn_readfirstlane(F.tid >> 6);
    F.G = gridDim.x; { const int bx = blockIdx.x; F.vcu = (F.G % 8 == 0) ? (bx % 8) * (F.G / 8) + bx / 8 : bx; }
    F.ws = args.ws; F.out = args.out; F.ctl = (gu32*)(args.ws + WS_CTL);
    if (F.tid < 32) F.MISC[F.tid] = 0u;
    if (F.tid == 0) {
#pragma unroll
        for (int k = 0; k < 18; ++k) { const unsigned long long pv = (unsigned long long)args.in[k]; F.MISC[32 + 2 * k] = (unsigned)pv; F.MISC[33 + 2 * k] = (unsigned)(pv >> 32); }
    }
    __syncthreads();
    XcdBarrier bar = xcd_barrier_post((unsigned*)(F.ctl + CW_BAR) + args.li * XCD_BAR_WORDS, F.MISC + 8);
    const int lo = args.ph_lo, hi = args.ph_hi;
#define IN(k) (lo <= (k) && (k) < hi)
#define SEAM(k) do { if (IN(k) && IN((k) + 1)) xcd_barrier(bar); STAMP((k) + 1); } while (0)
    bf16* xb = (bf16*)(F.ws + WS_AB); bf16* zb = (bf16*)(F.ws + WS_Z); bf16* mixb = (bf16*)(F.ws + WS_MIX); bf16* actb = (bf16*)(F.ws + WS_ACT); bf16* erawb = (bf16*)(F.ws + WS_ERAW);

    STAMP(0);
    if (IN(0)) { p0_prologue(F); } SEAM(0);
    if (IN(1)) {
        { pg8::Gemm g{xb, (const bf16*)(F.ws + WS_WIN), S_, ZW, D_}; pg8::StaticOrder S; S.init(S_, ZW, F.G, (int)blockIdx.x);
          pg8::EpiScale<0, 1> E{zb, ZW, (const float*)(F.ws + WS_RSTDX), EPS_};
          pg8::gemm_phase<pg8::EpiScale<0, 1>, pg8::StaticOrder, PG8_ALIGN, PG8_SP2>(F.lds + RING_OFF, g, S, E); }
        { pg8::Gemm g{(const bf16*)(F.ws + WS_PB), (const bf16*)(F.ws + WS_WPP), S_, D_, PLE_}; pg8::StaticOrder S; S.init(S_, D_, F.G, (int)blockIdx.x);
          pg8::EpiRes<0> E{nullptr, erawb, (float*)(F.ws + WS_SSQE), D_};
          pg8::gemm_phase<pg8::EpiRes<0>, pg8::StaticOrder, false, PG8_SP2>(F.lds + RING_OFF, g, S, E); }
    } SEAM(1);
    if (IN(2)) { for (int ch = F.vcu; ch < 256; ch += F.G) gla_a_chunk(F, ch); for (int ch = F.vcu; ch < 256; ch += F.G) moba_a_item(F, ch); } SEAM(2);
    if (IN(3)) { for (int pr = F.vcu; pr < 256; pr += F.G) gla_b_pair(F, pr); for (int pr = F.vcu; pr < 256; pr += F.G) moba_b_item(F, pr); } SEAM(3);
    if (IN(4)) { for (int ch = F.vcu; ch < 256; ch += F.G) gla_c_chunk(F, ch); moba_c_phase(F); } SEAM(4);
    if (IN(5)) { float c2, mc2; moba_shift(F, c2, mc2); for (int it = F.vcu; it < 256; it += F.G) moba_d_item(F, it, c2, mc2); } SEAM(5);
    if (IN(6)) {
        pg8::Gemm g{mixb, (const bf16*)(F.ws + WS_WOUT), S_, D_, D_}; pg8::StaticOrder S; S.init(S_, D_, F.G, (int)blockIdx.x);
        pg8::EpiRes<1> E{IN_x, xb, (float*)(F.ws + WS_SSQH1), D_};
        pg8::gemm_phase<pg8::EpiRes<1>, pg8::StaticOrder, false, PG8_SP2>(F.lds + RING_OFF, g, S, E);
    } SEAM(6);
    if (IN(7)) {
        pg8::Gemm g{xb, (const bf16*)(F.ws + WS_WUP), S_, FF_, D_}; pg8::StaticOrder S; S.init(S_, FF_, F.G, (int)blockIdx.x);
        pg8::EpiScale<1, 2> E{actb, FF_, (const float*)(F.ws + WS_SSQH1), EPS_};
        pg8::gemm_phase<pg8::EpiScale<1, 2>, pg8::StaticOrder, PG8_ALIGN, PG8_SP2>(F.lds + RING_OFF, g, S, E);
    } SEAM(7);
    if (IN(8)) {
        pg8::Gemm g{actb, (const bf16*)(F.ws + WS_WDOWN), S_, D_, FF_}; pg8::StaticOrder S; S.init(S_, D_, F.G, (int)blockIdx.x);
        pg8::EpiRes<2> E{nullptr, xb, (float*)(F.ws + WS_SSQH2), D_};
        pg8::gemm_phase<pg8::EpiRes<2>, pg8::StaticOrder, false, PG8_SP2>(F.lds + RING_OFF, g, S, E);
    } SEAM(8);
    if (IN(9)) {
        pg8::Gemm g{xb, (const bf16*)(F.ws + WS_WPG), S_, D_, D_}; pg8::StaticOrder S; S.init(S_, D_, F.G, (int)blockIdx.x);
        pg8::EpiGate E{F.out, xb, erawb, (const float*)(F.ws + WS_SSQH2), (const float*)(F.ws + WS_SSQE), IN_g_pe, D_, EPS_};
        pg8::gemm_phase<pg8::EpiGate, pg8::StaticOrder, false, PG8_SP2>(F.lds + RING_OFF, g, S, E);
    }
#ifdef PROBE_LO
    STAMP(10);
    if (blockIdx.x == 0 && F.tid == 0) {
        const unsigned long long a_ = ((unsigned long long)F.MISC[81 + 2 * PROBE_LO] << 32) | F.MISC[80 + 2 * PROBE_LO], b_ = ((unsigned long long)F.MISC[81 + 2 * PROBE_HI] << 32) | F.MISC[80 + 2 * PROBE_HI];
        const unsigned long long d_ = (b_ - a_) * PROBE_K, t0_ = rt();
        while (rt() - t0_ < d_) __builtin_amdgcn_s_sleep(8);
    }
#endif
#undef IN
#undef SEAM
}

namespace nv {
__device__ __forceinline__ float ldz(const bf16* z, int t, int col) { return bf2f(z[(size_t)t * ZW + col]); }
__device__ __forceinline__ float wave_max(float v) {
#pragma unroll
    for (int o = 1; o < 64; o <<= 1) v = fmaxf(v, __shfl_xor(v, o));
    return v;
}
__global__ void k_ga(const bf16* __restrict__ xb, const bf16* __restrict__ wga_t, const float* __restrict__ rstdx, float* __restrict__ ga) {
    const int idx = blockIdx.x * blockDim.x + threadIdx.x; if (idx >= S_ * 16) return;
    const int t = idx >> 4, r = idx & 15; float s = 0.f;
    for (int k = 0; k < D_; ++k) s += bf2f(xb[(size_t)t * D_ + k]) * bf2f(wga_t[r * D_ + k]);
    ga[idx] = s * rstdx[t];
}
__global__ void k_gla_prep(const float* __restrict__ ga, const float* __restrict__ w_a2, const float* __restrict__ b_a, float* __restrict__ a_out) {
    const int idx = blockIdx.x * blockDim.x + threadIdx.x; if (idx >= S_ * 256) return;
    const int t = idx >> 8, c = idx & 255; float s = b_a[c];
#pragma unroll
    for (int r = 0; r < 16; ++r) s += ga[t * 16 + r] * w_a2[r * 256 + c];
    const float ls = fminf(s, 0.f) - log1pf(expf(-fabsf(s)));
    a_out[idx] = expf(ls * (1.0f / 16.0f));
}
__global__ void __launch_bounds__(64) k_gla_rec(const bf16* __restrict__ z, const float* __restrict__ a, float* __restrict__ o_raw) {
    const int h = blockIdx.x >> 1, e = (blockIdx.x & 1) * 64 + threadIdx.x;
    float St[64];
#pragma unroll
    for (int d = 0; d < 64; ++d) St[d] = 0.f;
    for (int t = 0; t < S_; ++t) {
        const bf16* zr = z + (size_t)t * ZW;
        const float v = bf2f(zr[Z_GV + h * 128 + e]);
        const bf16* qr = zr + Z_GQ + h * 64; const bf16* kr = zr + Z_GK + h * 64; const float* ar = a + (size_t)t * 256 + h * 64;
        float o = 0.f;
#pragma unroll
        for (int d = 0; d < 64; ++d) { St[d] = ar[d] * St[d] + bf2f(kr[d]) * v; o += bf2f(qr[d]) * St[d]; }
        o_raw[(size_t)t * 512 + h * 128 + e] = o * 0.125f;
    }
}
__global__ void k_gla_post(const float* __restrict__ o_raw, const bf16* __restrict__ z, const float* __restrict__ g_out, bf16* __restrict__ mix) {
    const int wave = (blockIdx.x * blockDim.x + threadIdx.x) >> 6, lane = threadIdx.x & 63; if (wave >= S_ * 4) return;
    const int t = wave >> 2, h = wave & 3;
    const float o0 = o_raw[(size_t)t * 512 + h * 128 + lane], o1 = o_raw[(size_t)t * 512 + h * 128 + 64 + lane];
    const float ss = wave_sum(o0 * o0 + o1 * o1); const float r = 1.0f / sqrtf(ss * (1.0f / 128.0f) + EPS_);
    const float g0 = ldz(z, t, Z_GG + h * 128 + lane), g1 = ldz(z, t, Z_GG + h * 128 + 64 + lane);
    mix[(size_t)t * D_ + h * 128 + lane] = (bf16)f2bf(o0 * r * g_out[lane] * (g0 / (1.0f + expf(-g0))));
    mix[(size_t)t * D_ + h * 128 + 64 + lane] = (bf16)f2bf(o1 * r * g_out[64 + lane] * (g1 / (1.0f + expf(-g1))));
}
__device__ __forceinline__ void sincos_acc(float angf, float& s, float& c) {
    double r = (double)angf * 0.15915494309189533577; r -= floor(r);
    const double q = floor(4.0 * r + 0.5);
    const float phi = (float)((r - 0.25 * q) * 6.283185307179586477);
    const float p2 = phi * phi;
    const float sn = phi * (1.0f + p2 * (-1.0f / 6.0f + p2 * (1.0f / 120.0f + p2 * (-1.0f / 5040.0f + p2 * (1.0f / 362880.0f)))));
    const float cs = 1.0f + p2 * (-0.5f + p2 * (1.0f / 24.0f + p2 * (-1.0f / 720.0f + p2 * (1.0f / 40320.0f + p2 * (-1.0f / 3628800.0f)))));
    const int qi = ((int)q) & 3;
    s = (qi == 0) ? sn : (qi == 1) ? cs : (qi == 2) ? -sn : -cs;
    c = (qi == 0) ? cs : (qi == 1) ? -sn : (qi == 2) ? -cs : sn;
}
__global__ void k_moba_qk(bf16* __restrict__ z, const int* __restrict__ pos, const float* __restrict__ gq, const float* __restrict__ gk) {
    const int wave = (blockIdx.x * blockDim.x + threadIdx.x) >> 6, lane = threadIdx.x & 63; if (wave >= S_ * 8) return;
    const int t = wave >> 3, h = (wave >> 1) & 3, which = wave & 1;
    bf16* p = z + (size_t)t * ZW + (which ? Z_MK : Z_MQ) + h * 128; const float* g = which ? gk : gq;
    const float x1 = bf2f(p[lane]), x2 = bf2f(p[lane + 64]);
    const float ss = wave_sum(x1 * x1 + x2 * x2); const float r = 1.0f / sqrtf(ss * (1.0f / 128.0f) + EPS_);
    const float y1 = x1 * r * g[lane], y2 = x2 * r * g[lane + 64];
    const float inv = 1.0f / powf(10000.0f, (float)lane / 64.0f); const float ang = (float)pos[t] * inv;
    float sn, cs; sincos_acc(ang, sn, cs);
    p[lane] = (bf16)f2bf(y1 * cs - y2 * sn); p[lane + 64] = (bf16)f2bf(y2 * cs + y1 * sn);
}
__global__ void k_moba_kmean(const bf16* __restrict__ z, float* __restrict__ kmean) {
    const int h = blockIdx.x >> 6, blk = blockIdx.x & 63, d = threadIdx.x; float s = 0.f;
    for (int i = 0; i < 256; ++i) s += ldz(z, blk * 256 + i, Z_MK + h * 128 + d);
    kmean[(size_t)(h * 64 + blk) * 128 + d] = s * (1.0f / 256.0f);
}
__global__ void __launch_bounds__(256) k_moba_attn(const bf16* __restrict__ z, const float* __restrict__ kmean, bf16* __restrict__ mix) {
    __shared__ float pl[4][1024];
    const int w = threadIdx.x >> 6, lane = threadIdx.x & 63; const int wave = blockIdx.x * 4 + w; const int q = wave >> 2, h = wave & 3; const int kb = q >> 8;
    const bf16* qrow = z + (size_t)q * ZW + Z_MQ + h * 128; const float scale = 0.08838834764831845f;
    float g = -INFINITY;
    if (lane < kb) { const float* km = kmean + (size_t)(h * 64 + lane) * 128; float s = 0.f; for (int d = 0; d < 128; ++d) s += bf2f(qrow[d]) * km[d]; g = s; }
    int sel[3];
#pragma unroll
    for (int r = 0; r < 3; ++r) { const float m = wave_max(g); const unsigned long long bal = __ballot(g == m); const int idx = __ffsll((long long)bal) - 1; sel[r] = (m > -INFINITY) ? idx : -1; if (lane == idx) g = -INFINITY; }
    float sc[16];
#pragma unroll
    for (int seg = 0; seg < 4; ++seg) { const int blk = (seg < 3) ? sel[seg] : kb;
#pragma unroll
        for (int r = 0; r < 4; ++r) { float s = -INFINITY;
            if (blk >= 0) { const int key = blk * 256 + r * 64 + lane;
                if (seg < 3 || key <= q) { const bf16* kr = z + (size_t)key * ZW + Z_MK + h * 128; float a = 0.f; for (int d = 0; d < 128; ++d) a += bf2f(qrow[d]) * bf2f(kr[d]); s = a * scale; } }
            sc[seg * 4 + r] = s; } }
    float m = sc[0];
#pragma unroll
    for (int i = 1; i < 16; ++i) m = fmaxf(m, sc[i]);
    m = wave_max(m); float sum = 0.f;
#pragma unroll
    for (int i = 0; i < 16; ++i) { const float p = (sc[i] > -INFINITY) ? expf(sc[i] - m) : 0.f; sum += p; pl[w][i * 64 + lane] = p; }
    sum = wave_sum(sum); __syncthreads();
    float a0 = 0.f, a1 = 0.f;
#pragma unroll
    for (int seg = 0; seg < 4; ++seg) { const int blk = (seg < 3) ? sel[seg] : kb; if (blk < 0) continue; const int nk = (seg < 3) ? 256 : ((q & 255) + 1);
        for (int i = 0; i < nk; ++i) { const float p = pl[w][seg * 256 + i]; const bf16* vr = z + (size_t)(blk * 256 + i) * ZW + Z_MV + h * 128; a0 += p * bf2f(vr[lane]); a1 += p * bf2f(vr[lane + 64]); } }
    const float inv = 1.0f / sum;
    mix[(size_t)q * D_ + 512 + h * 128 + lane] = (bf16)f2bf(a0 * inv); mix[(size_t)q * D_ + 512 + h * 128 + 64 + lane] = (bf16)f2bf(a1 * inv);
}
}

static void launch_range(const Args& a0, int lo, int hi, int li, int grid, hipStream_t stream) {
    Args a = a0; a.ph_lo = lo; a.ph_hi = hi; a.li = li;
    hipLaunchKernelGGL(mk_fwd, dim3(grid), dim3(NWAVES * 64), LDS_BYTES, stream, a);
    const hipError_t le = hipPeekAtLastError();
    if (le != hipSuccess) fprintf(stderr, "kernel_launch: launch [%d,%d) failed: %s\n", lo, hi, hipGetErrorName(le));
}
extern "C" void kernel_launch(void* const* d_in, const int* in_sizes, int n_in, void* d_out, int out_size, void* d_ws, size_t ws_size, hipStream_t stream) {
    static int grid = 0;
    if (grid == 0) {
        if (n_in != 18 || out_size != S_ * D_ || ws_size < WS_END) { fprintf(stderr, "kernel_launch: unexpected shapes (n_in %d out %d ws %zu)\n", n_in, out_size, ws_size); grid = -1; return; }
        int dev = 0, cus = 0, per_cu = 0;
        if (hipGetDevice(&dev) != hipSuccess || hipDeviceGetAttribute(&cus, hipDeviceAttributeMultiprocessorCount, dev) != hipSuccess) { grid = -1; return; }
        if (hipFuncSetAttribute((const void*)mk_fwd, hipFuncAttributeMaxDynamicSharedMemorySize, LDS_BYTES) != hipSuccess) { fprintf(stderr, "kernel_launch: hipFuncSetAttribute failed\n"); grid = -1; return; }
        if (hipOccupancyMaxActiveBlocksPerMultiprocessor(&per_cu, (const void*)mk_fwd, NWAVES * 64, LDS_BYTES) != hipSuccess || per_cu < 1) { fprintf(stderr, "kernel_launch: occupancy query says %d\n", per_cu); per_cu = 1; }
        (void)hipGetLastError();
        grid = cus;
        if (grid != 256) fprintf(stderr, "kernel_launch: note: %d CUs\n", grid);
    }
    if (grid < 0) return;
    (void)hipMemsetAsync((char*)d_ws + WS_CTL, 0, CTL_ZERO_BYTES, stream);
    Args a{};
    for (int i = 0; i < 18; ++i) a.in[i] = d_in[i];
    a.out = (float*)d_out; a.ws = (unsigned char*)d_ws;
    launch_range(a, 0, N_PHASES, 0, grid, stream);
}
```

```cpp
#include <hip/hip_runtime.h>
#include <cstdio>
#include <cstdint>
#include <math.h>
namespace pg8 {
#define PG8_LAS __attribute__((address_space(3)))
typedef unsigned short bf16_t;
typedef short bf16x8 __attribute__((ext_vector_type(8)));
typedef float f32x4 __attribute__((ext_vector_type(4)));
typedef unsigned u32x4 __attribute__((ext_vector_type(4)));
constexpr int BM = 256, BK = 64, HALF = 128, HTB = HALF * BK * 2  , STAGE_BYTES = 8 * HTB, NXCD = 8, WGM = 8;

__host__ __device__ __forceinline__ int lds_byte(int r, int c) { const int st = (r >> 4) * 2 + (c >> 5), rr = r & 15, cc = c & 31, ob = rr * 64 + cc * 2; return st * 1024 + (ob ^ (((ob >> 9) & 1) << 5)); }
__host__ __device__ __forceinline__ void stage_rc(int b, int& R, int& C) { const int st = b / 1024, sb = b % 1024, swz = sb ^ (((sb >> 9) & 1) << 5); R = (st >> 1) * 16 + swz / 64; C = (st & 1) * 32 + (swz % 64) / 2; }
__host__ __device__ __forceinline__ int perm32(int rho) { const int n = rho >> 4, i = rho & 15; return 8 * (i >> 2) + 4 * n + (i & 3); }

struct Unit { int pm, pn; };
struct Gemm { const bf16_t* A; const bf16_t* Bt; int M, N, K; };

struct StaticOrder {
    int nM, nN, nwg, G, c;
    __host__ __device__ void init(int M, int N, int G_, int c_) { nM = M / BM; nN = N / BM; nwg = nM * nN; G = G_; c = c_; }
    __host__ __device__ bool next(int i, Unit& u) const {
        const long L = (long)i * G + c; if (L >= nwg) return false;
        int wgid = (int)L; { const int q = nwg / NXCD, r = nwg % NXCD, xcd = wgid % NXCD, off = wgid / NXCD; wgid = (xcd < r ? xcd * (q + 1) : r * (q + 1) + (xcd - r) * q) + off; }
        const int nig = WGM * nN, gid = wgid / nig, fm = gid * WGM, gsz = (nM - fm) < WGM ? (nM - fm) : WGM;
        u.pm = fm + ((wgid % nig) % gsz); u.pn = (wgid % nig) / gsz; return true;
    }
    __device__ __forceinline__ void a_ready(const Unit&) const {}
    __device__ __forceinline__ void done(const Unit&) const {}
};

__device__ __forceinline__ unsigned cvt_pk_bf16(float lo, float hi) { unsigned r; asm volatile("v_cvt_pk_bf16_f32 %0, %1, %2" : "=v"(r) : "v"(lo), "v"(hi)); return r; }
typedef float f32x2 __attribute__((ext_vector_type(2)));

__device__ __forceinline__ void st16_wt(void* p, u32x4 v) { asm volatile("global_store_dwordx4 %0, %1, off sc1\n\ts_nop 1" :: "v"(p), "v"(v) : "memory"); }

__device__ __forceinline__ float rstd_from_part(const float* part, int row, float inv_n, float eps) {
    const f32x4 p = *(const f32x4*)(part + (size_t)row * 4);
    return 1.0f / sqrtf(((p[0] + p[1]) + (p[2] + p[3])) * inv_n + eps);
}
template <int ACT, int RS> struct EpiScale {
    static constexpr bool PERM = true, AFTER_DRAIN = false;
    bf16_t* O; int ldc; const float* rsv; float eps;
    __device__ __forceinline__ void operator()(const f32x4 (&acc)[2][2][4][2], const Unit& u, int wr, int wc, int fr, int fq) const {
        const int row0 = u.pm * BM + wr * 64 + fr, col0 = u.pn * BM + wc * 32 + 8 * fq;
#pragma unroll
        for (int ai = 0; ai < 2; ++ai)
#pragma unroll
            for (int m = 0; m < 4; ++m) {
                const int row = row0 + ai * HALF + m * 16;
                float s = 1.f;
                if (RS == 1) s = rsv[row];
                if (RS == 2) s = rstd_from_part(rsv, row, 1.0f / 1024.0f, eps);
                bf16_t* rowp = O + (size_t)row * ldc + col0;
#pragma unroll
                for (int bj = 0; bj < 2; ++bj) {
                    f32x4 v0 = acc[ai][bj][m][0] * s, v1 = acc[ai][bj][m][1] * s;
                    if (ACT == 1) {
#pragma unroll
                        for (int e = 0; e < 4; ++e) { const float a = fmaxf(v0[e], 0.f), b = fmaxf(v1[e], 0.f); v0[e] = a * a; v1[e] = b * b; }
                    }
                    u32x4 w; w.x = cvt_pk_bf16(v0[0], v0[1]); w.y = cvt_pk_bf16(v0[2], v0[3]); w.z = cvt_pk_bf16(v1[0], v1[1]); w.w = cvt_pk_bf16(v1[2], v1[3]);
                    *(u32x4*)(rowp + bj * HALF) = w;
                }
            }
    }
};
template <int RES> struct EpiRes {
    static constexpr bool PERM = true, AFTER_DRAIN = true;
    const float* base; bf16_t* hb; float* part; int ldc;
    __device__ __forceinline__ void fused(f32x4 (&acc)[2][2][4][2], const Unit& u, int wr, int wc, int fr, int fq, PG8_LAS unsigned char* lds, int wid, int lane) const {
        PG8_LAS float* P = (PG8_LAS float*)lds;
        const int row0 = u.pm * BM + wr * 64 + fr, col0 = u.pn * BM + wc * 32 + 8 * fq;
#pragma unroll
        for (int ai = 0; ai < 2; ++ai) {
            f32x4 pre[4][2][2]; u32x4 preb[4][2];
            if (RES == 1) {
#pragma unroll
                for (int m = 0; m < 4; ++m) { const size_t off = (size_t)(row0 + ai * HALF + m * 16) * ldc + col0;
#pragma unroll
                    for (int bj = 0; bj < 2; ++bj) { pre[m][bj][0] = __builtin_nontemporal_load((const f32x4*)(base + off + bj * HALF)); pre[m][bj][1] = __builtin_nontemporal_load((const f32x4*)(base + off + bj * HALF + 4)); } }
            }
            if (RES == 2) {
#pragma unroll
                for (int m = 0; m < 4; ++m) { const size_t off = (size_t)(row0 + ai * HALF + m * 16) * ldc + col0;
#pragma unroll
                    for (int bj = 0; bj < 2; ++bj) preb[m][bj] = *(const u32x4*)(hb + off + bj * HALF); }
            }
#pragma unroll
            for (int m = 0; m < 4; ++m) {
                const int row = row0 + ai * HALF + m * 16;
                const size_t off = (size_t)row * ldc + col0;
                float q = 0.f;
#pragma unroll
                for (int bj = 0; bj < 2; ++bj) {
                    f32x4 v0 = acc[ai][bj][m][0], v1 = acc[ai][bj][m][1];
                    if (RES == 1) { v0 = v0 + pre[m][bj][0]; v1 = v1 + pre[m][bj][1]; }
                    if (RES == 2) { const u32x4 ew = preb[m][bj];
                        v0[0] += __uint_as_float(ew.x << 16); v0[1] += __uint_as_float(ew.x & 0xffff0000u); v0[2] += __uint_as_float(ew.y << 16); v0[3] += __uint_as_float(ew.y & 0xffff0000u);
                        v1[0] += __uint_as_float(ew.z << 16); v1[1] += __uint_as_float(ew.z & 0xffff0000u); v1[2] += __uint_as_float(ew.w << 16); v1[3] += __uint_as_float(ew.w & 0xffff0000u); }
                    u32x4 w; w.x = cvt_pk_bf16(v0[0], v0[1]); w.y = cvt_pk_bf16(v0[2], v0[3]); w.z = cvt_pk_bf16(v1[0], v1[1]); w.w = cvt_pk_bf16(v1[2], v1[3]);
                    *(u32x4*)(hb + off + bj * HALF) = w;
                    q += (v0[0] * v0[0] + v0[1] * v0[1]) + (v0[2] * v0[2] + v0[3] * v0[3]) + (v1[0] * v1[0] + v1[1] * v1[1]) + (v1[2] * v1[2] + v1[3] * v1[3]);
                }
                q += __shfl_xor(q, 16); q += __shfl_xor(q, 32);
                if (fq == 0) P[(ai * HALF + wr * 64 + m * 16 + fr) * 4 + wc] = q;
            }
        }
        asm volatile("s_waitcnt lgkmcnt(0)" ::: "memory"); __builtin_amdgcn_s_barrier(); asm volatile("" ::: "memory");
        const int tid = wid * 64 + lane;
        if (tid < 256) { const f32x4 p = ((const PG8_LAS f32x4*)lds)[tid]; part[(size_t)(u.pm * BM + tid) * 4 + u.pn] = (p[0] + p[1]) + (p[2] + p[3]); }
        asm volatile("s_waitcnt lgkmcnt(0)" ::: "memory"); __builtin_amdgcn_s_barrier(); asm volatile("" ::: "memory");
    }
};
struct EpiGate {
    static constexpr bool PERM = true, AFTER_DRAIN = false;
    float* out; const bf16_t* hb; const bf16_t* eraw; const float* part_h; const float* part_e; const float* g_emb; int ldc; float eps;
    __device__ __forceinline__ void operator()(const f32x4 (&acc)[2][2][4][2], const Unit& u, int wr, int wc, int fr, int fq) const {
        const int row0 = u.pm * BM + wr * 64 + fr, col0 = u.pn * BM + wc * 32 + 8 * fq;
        f32x4 gv[2][2];
#pragma unroll
        for (int bj = 0; bj < 2; ++bj) { gv[bj][0] = *(const f32x4*)(g_emb + col0 + bj * HALF); gv[bj][1] = *(const f32x4*)(g_emb + col0 + bj * HALF + 4); }
#pragma unroll
        for (int ai = 0; ai < 2; ++ai)
#pragma unroll
            for (int mp = 0; mp < 2; ++mp) {
                u32x4 hv[2][2]; u32x4 ewv[2][2]; float sh[2], se[2];
#pragma unroll
                for (int mm = 0; mm < 2; ++mm) { const int row = row0 + ai * HALF + (2 * mp + mm) * 16; const size_t off = (size_t)row * ldc + col0;
                    sh[mm] = rstd_from_part(part_h, row, 1.0f / 1024.0f, eps); se[mm] = rstd_from_part(part_e, row, 1.0f / 1024.0f, eps);
#pragma unroll
                    for (int bj = 0; bj < 2; ++bj) { ewv[mm][bj] = __builtin_nontemporal_load((const u32x4*)(eraw + off + bj * HALF)); hv[mm][bj] = __builtin_nontemporal_load((const u32x4*)(hb + off + bj * HALF)); } }
#pragma unroll
                for (int mm = 0; mm < 2; ++mm) { const int m = 2 * mp + mm; const int row = row0 + ai * HALF + m * 16; const size_t off = (size_t)row * ldc + col0;
#pragma unroll
                    for (int bj = 0; bj < 2; ++bj) {
                        const u32x4 ew = ewv[mm][bj];
                        f32x4 e0, e1;
                        e0[0] = __uint_as_float(ew.x << 16); e0[1] = __uint_as_float(ew.x & 0xffff0000u); e0[2] = __uint_as_float(ew.y << 16); e0[3] = __uint_as_float(ew.y & 0xffff0000u);
                        e1[0] = __uint_as_float(ew.z << 16); e1[1] = __uint_as_float(ew.z & 0xffff0000u); e1[2] = __uint_as_float(ew.w << 16); e1[3] = __uint_as_float(ew.w & 0xffff0000u);
                        const u32x4 hw = hv[mm][bj];
                        f32x4 h0, h1;
                        h0[0] = __uint_as_float(hw.x << 16); h0[1] = __uint_as_float(hw.x & 0xffff0000u); h0[2] = __uint_as_float(hw.y << 16); h0[3] = __uint_as_float(hw.y & 0xffff0000u);
                        h1[0] = __uint_as_float(hw.z << 16); h1[1] = __uint_as_float(hw.z & 0xffff0000u); h1[2] = __uint_as_float(hw.w << 16); h1[3] = __uint_as_float(hw.w & 0xffff0000u);
                        const f32x4 a0 = acc[ai][bj][m][0] * sh[mm], a1 = acc[ai][bj][m][1] * sh[mm];
#pragma unroll
                        for (int e = 0; e < 4; ++e) {
                            const float g0 = __builtin_amdgcn_rcpf(1.0f + __expf(-a0[e])), g1 = __builtin_amdgcn_rcpf(1.0f + __expf(-a1[e]));
                            h0[e] += g0 * (e0[e] * se[mm] * gv[bj][0][e]); h1[e] += g1 * (e1[e] * se[mm] * gv[bj][1][e]);
                        }
                        __builtin_nontemporal_store(h0, (f32x4*)(out + off + bj * HALF)); __builtin_nontemporal_store(h1, (f32x4*)(out + off + bj * HALF + 4));
                    } }
            }
    }
};
template <class Epi, class Sched, bool ALIGN_EPI = false, bool SP2 = false>
__device__ __forceinline__ void gemm_phase(PG8_LAS unsigned char* lds, const Gemm g, const Sched& S, const Epi& E) {
    const int tid = threadIdx.x, wid = __builtin_amdgcn_readfirstlane(tid >> 6), lane = tid & 63, wr = wid >> 2, wc = wid & 3, fr = lane & 15, fq = lane >> 4;
    const int K = g.K, nt = K / BK;
    unsigned voffA[2], voffB[2];
#pragma unroll
    for (int i = 0; i < 2; ++i) { int R, C; stage_rc(tid * 16 + i * 8192, R, C); const int Rb = Epi::PERM ? ((R & ~31) + perm32(R & 31)) : R;
        voffA[i] = (unsigned)(R * K + C) * 2u; voffB[i] = (unsigned)(Rb * K + C) * 2u; }
    const size_t kstep = (size_t)(BK * 2);
    const size_t hstep = (size_t)HALF * K * 2;
    const size_t tstep = 2 * hstep;
    const unsigned ldsw = (unsigned)wid * 1024u;
    const int aoff = lds_byte(wr * 64 + fr, fq * 8), boff = lds_byte(wc * 32 + fr, fq * 8);
#define PG8_SA(b, h) (((b) * 2 + (h)) * HTB)
#define PG8_SB(b, h) ((4 + (b) * 2 + (h)) * HTB)
#define PG8_STAGE(bufoff, gbase, voff) do { _Pragma("unroll") for (int _i = 0; _i < 2; ++_i) \
        __builtin_amdgcn_global_load_lds((const unsigned*)((const char*)(gbase) + (voff)[_i]), (PG8_LAS unsigned*)(lds + (bufoff) + ldsw + _i * 8192), 16, 0, 0); } while (0)
#define PG8_LDA(dst, b, h) do { _Pragma("unroll") for (int m = 0; m < 4; ++m) _Pragma("unroll") for (int k = 0; k < 2; ++k) dst[m][k] = *(const PG8_LAS bf16x8*)(lds + PG8_SA(b, h) + aoff + m * 2048 + k * 1024); } while (0)
#define PG8_LDB(dst, b, h) do { _Pragma("unroll") for (int n = 0; n < 2; ++n) _Pragma("unroll") for (int k = 0; k < 2; ++k) dst[n][k] = *(const PG8_LAS bf16x8*)(lds + PG8_SB(b, h) + boff + n * 2048 + k * 1024); } while (0)
#define PG8_MMA(ai, bj, At, Bt) do { __builtin_amdgcn_s_setprio(1); _Pragma("unroll") for (int m = 0; m < 4; ++m) _Pragma("unroll") for (int n = 0; n < 2; ++n) _Pragma("unroll") for (int k = 0; k < 2; ++k) \
        acc[ai][bj][m][n] = __builtin_amdgcn_mfma_f32_16x16x32_bf16(Bt[n][k], At[m][k], acc[ai][bj][m][n], 0, 0, 0); __builtin_amdgcn_s_setprio(0); } while (0)
#define PG8_WAIT_V(n) asm volatile("s_waitcnt vmcnt(" #n ")" ::: "memory")
#define PG8_WAIT_L(n) asm volatile("s_waitcnt lgkmcnt(" #n ")" ::: "memory")
#define PG8_BAR __builtin_amdgcn_s_barrier()
#define PG8_SCHED __builtin_amdgcn_sched_barrier(0)
    Unit cur, nxt; int ui = 0;
    if (!S.next(0, cur)) return;
    f32x4 acc[2][2][4][2];
#pragma unroll
    for (int a = 0; a < 2; ++a)
#pragma unroll
        for (int b = 0; b < 2; ++b)
#pragma unroll
            for (int m = 0; m < 4; ++m)
#pragma unroll
                for (int n = 0; n < 2; ++n) acc[a][b][m][n] = (f32x4){0.f, 0.f, 0.f, 0.f};
    bf16x8 At[4][2], B0[2][2], B1[2][2];
    const char* cA = (const char*)g.A + (size_t)cur.pm * tstep; const char* cB = (const char*)g.Bt + (size_t)cur.pn * tstep;
    S.a_ready(cur);
    if constexpr (SP2) {
        PG8_STAGE(PG8_SB(0, 0), cB, voffB); PG8_STAGE(PG8_SB(0, 1), cB + hstep, voffB); PG8_STAGE(PG8_SA(0, 0), cA, voffA); PG8_STAGE(PG8_SA(0, 1), cA + hstep, voffA);
        if (wr == 1) PG8_BAR;
        PG8_WAIT_V(2); PG8_BAR;
        PG8_STAGE(PG8_SB(1, 0), cB + kstep, voffB); PG8_STAGE(PG8_SA(1, 0), cA + kstep, voffA); PG8_STAGE(PG8_SB(1, 1), cB + hstep + kstep, voffB);
        PG8_WAIT_V(6); PG8_BAR;
    } else {
        PG8_STAGE(PG8_SB(0, 0), cB, voffB); PG8_STAGE(PG8_SA(0, 0), cA, voffA); PG8_STAGE(PG8_SB(0, 1), cB + hstep, voffB); PG8_STAGE(PG8_SA(0, 1), cA + hstep, voffA);
        if (wr == 1) PG8_BAR;
        PG8_WAIT_V(4); PG8_BAR;
        PG8_STAGE(PG8_SB(1, 0), cB + kstep, voffB); PG8_STAGE(PG8_SA(1, 0), cA + kstep, voffA); PG8_STAGE(PG8_SB(1, 1), cB + hstep + kstep, voffB);
        PG8_WAIT_V(6); PG8_BAR;
    }
    for (;;) {
        const bool has_next = S.next(ui + 1, nxt);
        const char* nA = has_next ? (const char*)g.A + (size_t)nxt.pm * tstep : cA; const char* nB = has_next ? (const char*)g.Bt + (size_t)nxt.pn * tstep : cB;
        for (int t = 0; t < nt; t += 2) {
            const bool last = (t == nt - 2);
            const char* a1 = cA + (size_t)(t + 1) * kstep;
            const char* a2 = last ? nA : cA + (size_t)(t + 2) * kstep; const char* b2 = last ? nB : cB + (size_t)(t + 2) * kstep;
            const char* a3 = a2 + kstep; const char* b3 = b2 + kstep;
            if (last && has_next) S.a_ready(nxt);
            if constexpr (SP2) {
            PG8_LDB(B0, 0, 0); PG8_LDB(B1, 0, 1); PG8_SCHED; PG8_LDA(At, 0, 0); PG8_STAGE(PG8_SA(1, 1), a1 + hstep, voffA);
            PG8_WAIT_V(8); PG8_WAIT_L(0); PG8_BAR; PG8_MMA(0, 0, At, B0); PG8_MMA(0, 1, At, B1); PG8_BAR; PG8_SCHED;
            PG8_LDA(At, 0, 1); PG8_STAGE(PG8_SB(0, 0), b2, voffB); PG8_STAGE(PG8_SB(0, 1), b2 + hstep, voffB); PG8_STAGE(PG8_SA(0, 0), a2, voffA);
            PG8_WAIT_V(8); PG8_WAIT_L(0); PG8_BAR; PG8_MMA(1, 0, At, B0); PG8_MMA(1, 1, At, B1); PG8_BAR; PG8_SCHED;
            PG8_LDB(B0, 1, 0); PG8_LDB(B1, 1, 1); PG8_SCHED; PG8_LDA(At, 1, 0); PG8_STAGE(PG8_SA(0, 1), a2 + hstep, voffA);
            PG8_WAIT_V(8); PG8_WAIT_L(0); PG8_BAR; PG8_MMA(0, 0, At, B0); PG8_MMA(0, 1, At, B1); PG8_BAR; PG8_SCHED;
            PG8_LDA(At, 1, 1); PG8_STAGE(PG8_SB(1, 0), b3, voffB); PG8_STAGE(PG8_SB(1, 1), b3 + hstep, voffB); PG8_STAGE(PG8_SA(1, 0), a3, voffA);
            PG8_WAIT_V(8); PG8_WAIT_L(0); PG8_BAR; PG8_MMA(1, 0, At, B0); PG8_MMA(1, 1, At, B1); PG8_BAR; PG8_SCHED;
            } else {
            PG8_LDB(B0, 0, 0); PG8_SCHED; PG8_LDA(At, 0, 0); PG8_STAGE(PG8_SA(1, 1), a1 + hstep, voffA);
            PG8_WAIT_L(8); PG8_BAR; PG8_WAIT_L(0); PG8_MMA(0, 0, At, B0); PG8_BAR; PG8_SCHED;
            PG8_LDB(B1, 0, 1); PG8_STAGE(PG8_SB(0, 0), b2, voffB);
            PG8_BAR; PG8_WAIT_L(0); PG8_MMA(0, 1, At, B1); PG8_BAR;
            PG8_LDA(At, 0, 1); PG8_STAGE(PG8_SA(0, 0), a2, voffA);
            PG8_BAR; PG8_WAIT_L(0); PG8_MMA(1, 0, At, B0); PG8_BAR; PG8_SCHED;
            PG8_STAGE(PG8_SB(0, 1), b2 + hstep, voffB);
            PG8_WAIT_V(6); PG8_BAR; PG8_MMA(1, 1, At, B1); PG8_BAR;
            PG8_LDB(B0, 1, 0); PG8_SCHED; PG8_LDA(At, 1, 0); PG8_STAGE(PG8_SA(0, 1), a2 + hstep, voffA);
            PG8_WAIT_L(8); PG8_BAR; PG8_WAIT_L(0); PG8_MMA(0, 0, At, B0); PG8_BAR; PG8_SCHED;
            PG8_LDB(B1, 1, 1); PG8_STAGE(PG8_SB(1, 0), b3, voffB);
            PG8_BAR; PG8_WAIT_L(0); PG8_MMA(0, 1, At, B1); PG8_BAR;
            PG8_LDA(At, 1, 1); PG8_STAGE(PG8_SA(1, 0), a3, voffA);
            PG8_BAR; PG8_WAIT_L(0); PG8_MMA(1, 0, At, B0); PG8_BAR; PG8_SCHED;
            PG8_STAGE(PG8_SB(1, 1), b3 + hstep, voffB);
            PG8_WAIT_V(6); PG8_BAR; PG8_MMA(1, 1, At, B1); PG8_BAR;
            }
        }
        if constexpr (ALIGN_EPI) { if (wr == 0) PG8_BAR; }
        if constexpr (!Epi::AFTER_DRAIN) { E(acc, cur, wr, wc, fr, fq); S.done(cur); }
        if (!has_next) break;
#pragma unroll
        for (int a = 0; a < 2; ++a)
#pragma unroll
            for (int b = 0; b < 2; ++b)
#pragma unroll
                for (int m = 0; m < 4; ++m)
#pragma unroll
                    for (int n = 0; n < 2; ++n) acc[a][b][m][n] = (f32x4){0.f, 0.f, 0.f, 0.f};
        cur = nxt; cA = nA; cB = nB; ++ui;
        if constexpr (ALIGN_EPI) { if (wr == 1) PG8_BAR; }
    }
    PG8_WAIT_V(0);
    if constexpr (!ALIGN_EPI) { if (wr == 0) PG8_BAR; }
    PG8_BAR;
    if constexpr (Epi::AFTER_DRAIN) { E.fused(acc, cur, wr, wc, fr, fq, lds, wid, lane); S.done(cur); }
#undef PG8_SA
#undef PG8_SB
#undef PG8_STAGE
#undef PG8_LDA
#undef PG8_LDB
#undef PG8_MMA
#undef PG8_WAIT_V
#undef PG8_WAIT_L
#undef PG8_BAR
#undef PG8_SCHED
}
}
#ifndef PG8_SP2
#define PG8_SP2 true
#endif
#ifndef PG8_ALIGN
#define PG8_ALIGN true
#endif

constexpr int NWAVES = 8;
constexpr int S_ = 16384, D_ = 1024, FF_ = 4096, PLE_ = 256, INW_ = 3088, ZW = 3072;
constexpr int Z_GQ = 0, Z_GK = 256, Z_GV = 512, Z_GG = 1024, Z_MQ = 1536, Z_MK = 2048, Z_MV = 2560;
constexpr float EPS_ = 1e-6f;

constexpr size_t MiB = 1u << 20, KiB = 1u << 10;
constexpr size_t WS_CTL = 0, CTL_ZERO_BYTES = 64 * KiB;
constexpr size_t WS_WIN = 1 * MiB, WS_WOUT = 7 * MiB, WS_WUP = 9 * MiB, WS_WDOWN = 17 * MiB, WS_WPG = 25 * MiB, WS_WPP = 27 * MiB, WS_WGA = 27 * MiB + 512 * KiB;
constexpr size_t WS_SMALL = 28 * MiB;
constexpr size_t WS_RSTDX = WS_SMALL, WS_GA = WS_SMALL + 64 * KiB, WS_DECAY = WS_SMALL + 1088 * KiB, WS_KMEAN = WS_SMALL + 1344 * KiB,
                 WS_SSQH1 = WS_SMALL + 1472 * KiB, WS_SSQH2 = WS_SMALL + 1728 * KiB, WS_SSQE = WS_SMALL + 1984 * KiB, WS_LPART = WS_SMALL + 2240 * KiB;
constexpr size_t WS_ERAW = 32 * MiB, WS_AB = 64 * MiB, WS_Z = 96 * MiB, WS_MIX = 192 * MiB, WS_PB = 224 * MiB, WS_ACT = 96 * MiB, WS_END = 256 * MiB;
constexpr size_t WS_DS = 224 * MiB, WS_SPREV = 64 * MiB, WS_LIST = 80 * MiB;
constexpr size_t OUT_PART = 0, OUT_VT = 48 * MiB;
constexpr int CW_TMO = 0, CW_CNT = 1024  , CW_BAR = 4096;

constexpr int RING_OFF = 0, RING_BYTES = 131072;
constexpr int LDS_BYTES = 160 * 1024;
constexpr int MISC_OFF = LDS_BYTES - 512;

#define GAS __attribute__((address_space(1)))
#define LAS __attribute__((address_space(3)))
typedef unsigned short bf16;
typedef unsigned v4u __attribute__((ext_vector_type(4)));
typedef float f32x4 __attribute__((ext_vector_type(4)));
typedef short bf16x8 __attribute__((ext_vector_type(8)));
typedef GAS unsigned gu32;
typedef GAS unsigned long long gu64;
#define RLX_AGENT __ATOMIC_RELAXED, __HIP_MEMORY_SCOPE_AGENT
#define LDS_WAIT() asm volatile("s_waitcnt lgkmcnt(0)" ::: "memory")
#define VM_WAIT() asm volatile("s_waitcnt vmcnt(0)" ::: "memory")
__device__ __forceinline__ unsigned long long rt() { return __builtin_amdgcn_s_memrealtime(); }
__device__ __forceinline__ unsigned f2bf(float f) { unsigned u = __builtin_bit_cast(unsigned, f); return (u + 0x7fffu + ((u >> 16) & 1u)) >> 16; }
__device__ __forceinline__ unsigned pk2(float lo, float hi) { return f2bf(lo) | (f2bf(hi) << 16); }

#define XB_TMO      128
#define XB_XCNT(j)  (256  + 64 * (j))
#define XB_XSUB(j)  (1280 + 64 * (j))
#define XB_XGEN(j)  (2304 + 64 * (j))
#define XB_TOP      3328
#define XB_TOPGEN   3392
#define XCD_BAR_WORDS 3456
#define XB_SPIN_CAP (1u << 18)

__device__ __forceinline__ unsigned xb_ld(unsigned* p)              { return __hip_atomic_load(p, __ATOMIC_RELAXED, __HIP_MEMORY_SCOPE_AGENT); }
__device__ __forceinline__ unsigned xb_add(unsigned* p, unsigned v) { return __hip_atomic_fetch_add(p, v, __ATOMIC_RELAXED, __HIP_MEMORY_SCOPE_AGENT); }
__device__ __forceinline__ unsigned xb_xcc_id() { return (unsigned)__builtin_amdgcn_s_getreg((3 << 11) | 20) & 0xFu; }
#define XB_SPIN(cond, bar) do { unsigned _sp = 0; while (cond) { __builtin_amdgcn_s_sleep(1); \
    if ((++_sp & 255u) == 0u) { if (xb_ld(&(bar)[XB_TMO])) break; if (_sp > XB_SPIN_CAP) { atomicAdd(&(bar)[XB_TMO], 1u); break; } } } } while (0)

struct XcdBarrier {
    unsigned* bar; unsigned x;
    volatile LAS unsigned* st;
};

__device__ __forceinline__ XcdBarrier xcd_barrier_post(unsigned* bar, volatile LAS unsigned* st) {
    XcdBarrier b; b.bar = bar; b.x = xb_xcc_id(); b.st = st;
    if (threadIdx.x == 0) (void)xb_add(&bar[XB_XCNT(b.x)], 1u);
    return b;
}
__device__ __forceinline__ void xcd_barrier_complete(unsigned* bar, unsigned x, unsigned& nloc, unsigned& nx) {
    const unsigned G = gridDim.x * gridDim.y * gridDim.z;
    unsigned sum, cnt, mine, sp = 0u;
    for (;;) {
        sum = 0u; cnt = 0u; mine = 0u;
#pragma unroll
        for (unsigned j = 0; j < 16; ++j) { const unsigned c = xb_ld(&bar[XB_XCNT(j)]); sum += c; cnt += (c > 0u) ? 1u : 0u; mine = (j == x) ? c : mine; }
        if (sum == G) break;
        __builtin_amdgcn_s_sleep(1);
        if ((++sp & 255u) == 0u) { if (xb_ld(&bar[XB_TMO])) break; if (sp > XB_SPIN_CAP) { atomicAdd(&bar[XB_TMO], 1u); break; } }
    }
    nloc = mine > 0u ? mine : 1u; nx = cnt > 0u ? cnt : 1u;
}

__device__ __forceinline__ void xcd_barrier(const XcdBarrier& b) {
    asm volatile("s_waitcnt vmcnt(0)" ::: "memory");
    __syncthreads();
    if (threadIdx.x == 0) {
        unsigned* bar = b.bar;
        __builtin_amdgcn_s_waitcnt(0);
        unsigned nloc = b.st[0], nx = b.st[1];
        if (nloc == 0u) { xcd_barrier_complete(bar, b.x, nloc, nx); b.st[0] = nloc; b.st[1] = nx; }
        const unsigned old = xb_add(&bar[XB_XSUB(b.x)], 1u);
        const unsigned gen = old / nloc;
        if (old + 1u == (gen + 1u) * nloc) {
            __builtin_amdgcn_fence(__ATOMIC_RELEASE, "agent");
            asm volatile("s_waitcnt vmcnt(0)" ::: "memory");
            const unsigned og = xb_add(&bar[XB_TOP], 1u);
            const unsigned tg = og / nx;
            if (og + 1u == (tg + 1u) * nx) xb_add(&bar[XB_TOPGEN], 1u);
            else XB_SPIN(xb_ld(&bar[XB_TOPGEN]) == tg, bar);
            __builtin_amdgcn_fence(__ATOMIC_ACQUIRE, "agent");
            xb_add(&bar[XB_XGEN(b.x)], 1u);
            asm volatile("s_waitcnt vmcnt(0)" ::: "memory");
        } else {
            XB_SPIN(xb_ld(&bar[XB_XGEN(b.x)]) == gen, bar);
            __builtin_amdgcn_fence(__ATOMIC_ACQUIRE, "agent");
            asm volatile("s_waitcnt vmcnt(0)" ::: "memory");
        }
    }
    __syncthreads();
}

struct Frame {
    LAS unsigned char* lds;
    volatile LAS unsigned* MISC;
    gu32* ctl;
    int tid, lane, wave, vcu, G;
    unsigned char* ws; float* out;
};
__device__ __forceinline__ const void* in_ptr(const Frame& F, int k) {
    const unsigned lo = __builtin_amdgcn_readfirstlane(F.MISC[32 + 2 * k]), hi = __builtin_amdgcn_readfirstlane(F.MISC[33 + 2 * k]);
    return (const void*)(((unsigned long long)hi << 32) | lo);
}
#define IN_x ((const float*)in_ptr(F, 0))
#define IN_p ((const float*)in_ptr(F, 1))
#define IN_pos ((const int*)in_ptr(F, 2))
#define IN_g_mix ((const float*)in_ptr(F, 3))
#define IN_w_in ((const float*)in_ptr(F, 4))
#define IN_w_a2 ((const float*)in_ptr(F, 5))
#define IN_b_a ((const float*)in_ptr(F, 6))
#define IN_g_gla ((const float*)in_ptr(F, 7))
#define IN_g_mq ((const float*)in_ptr(F, 8))
#define IN_g_mk ((const float*)in_ptr(F, 9))
#define IN_w_out ((const float*)in_ptr(F, 10))
#define IN_g_ffn ((const float*)in_ptr(F, 11))
#define IN_w_up ((const float*)in_ptr(F, 12))
#define IN_w_down ((const float*)in_ptr(F, 13))
#define IN_g_pg ((const float*)in_ptr(F, 14))
#define IN_w_pg ((const float*)in_ptr(F, 15))
#define IN_w_pp ((const float*)in_ptr(F, 16))
#define IN_g_pe ((const float*)in_ptr(F, 17))
template <int CTRL> __device__ __forceinline__ float dpp_mov(float v) { return __builtin_bit_cast(float, __builtin_amdgcn_update_dpp(0, __builtin_bit_cast(int, v), CTRL, 0xf, 0xf, true)); }
__device__ __forceinline__ float row16_sum(float v) { v += dpp_mov<0xB1>(v); v += dpp_mov<0x4E>(v); v += dpp_mov<0x141>(v); v += dpp_mov<0x140>(v); return v; }
__device__ __forceinline__ float wave_sum(float v) {
    v = row16_sum(v);
    const float s0 = __builtin_bit_cast(float, __builtin_amdgcn_readlane(__builtin_bit_cast(int, v), 0)), s1 = __builtin_bit_cast(float, __builtin_amdgcn_readlane(__builtin_bit_cast(int, v), 16));
    const float s2 = __builtin_bit_cast(float, __builtin_amdgcn_readlane(__builtin_bit_cast(int, v), 32)), s3 = __builtin_bit_cast(float, __builtin_amdgcn_readlane(__builtin_bit_cast(int, v), 48));
    return (s0 + s1) + (s2 + s3);
}
__device__ __forceinline__ float bf2f(unsigned v16) { return __uint_as_float(v16 << 16); }

#ifdef PROBE_LO
#define STAMP(k) do { if (blockIdx.x == 0 && F.tid == 0) { const unsigned long long t_ = rt(); F.MISC[80 + 2 * (k)] = (unsigned)t_; F.MISC[81 + 2 * (k)] = (unsigned)(t_ >> 32); } } while (0)
#else
#define STAMP(k) do { } while (0)
#endif
struct TItem { const float* W; const float* gain; bf16* WT; int ldn, src_col, K, n_dst, k0; };
__device__ __forceinline__ TItem p0_decode(const Frame& F, int it) {
    constexpr int I_IN = (D_ / 64) * (ZW / 32), I_OUT = (D_ / 64) * (D_ / 32), I_UP = (D_ / 64) * (FF_ / 32), I_DN = (FF_ / 64) * (D_ / 32), I_PG = I_OUT;
    TItem t; int r = it;
    if (r < I_IN) { const int nb = r % (ZW / 32), kb = r / (ZW / 32), n0 = 32 * nb; t.W = IN_w_in; t.gain = IN_g_mix; t.WT = (bf16*)(F.ws + WS_WIN); t.ldn = INW_; t.src_col = n0 < 1536 ? n0 : n0 + 16; t.K = D_; t.n_dst = n0; t.k0 = 64 * kb; return t; } r -= I_IN;
    if (r < I_OUT) { const int nb = r % (D_ / 32), kb = r / (D_ / 32); t.W = IN_w_out; t.gain = nullptr; t.WT = (bf16*)(F.ws + WS_WOUT); t.ldn = D_; t.src_col = 32 * nb; t.K = D_; t.n_dst = 32 * nb; t.k0 = 64 * kb; return t; } r -= I_OUT;
    if (r < I_UP) { const int nb = r % (FF_ / 32), kb = r / (FF_ / 32); t.W = IN_w_up; t.gain = IN_g_ffn; t.WT = (bf16*)(F.ws + WS_WUP); t.ldn = FF_; t.src_col = 32 * nb; t.K = D_; t.n_dst = 32 * nb; t.k0 = 64 * kb; return t; } r -= I_UP;
    if (r < I_DN) { const int nb = r % (D_ / 32), kb = r / (D_ / 32); t.W = IN_w_down; t.gain = nullptr; t.WT = (bf16*)(F.ws + WS_WDOWN); t.ldn = D_; t.src_col = 32 * nb; t.K = FF_; t.n_dst = 32 * nb; t.k0 = 64 * kb; return t; } r -= I_DN;
    if (r < I_PG) { const int nb = r % (D_ / 32), kb = r / (D_ / 32); t.W = IN_w_pg; t.gain = IN_g_pg; t.WT = (bf16*)(F.ws + WS_WPG); t.ldn = D_; t.src_col = 32 * nb; t.K = D_; t.n_dst = 32 * nb; t.k0 = 64 * kb; return t; } r -= I_PG;
    { const int nb = r % (D_ / 32), kb = r / (D_ / 32); t.W = IN_w_pp; t.gain = nullptr; t.WT = (bf16*)(F.ws + WS_WPP); t.ldn = D_; t.src_col = 32 * nb; t.K = PLE_; t.n_dst = 32 * nb; t.k0 = 64 * kb; return t; }
}
__device__ __forceinline__ void p0_issue(const TItem& t, int lane, float (&w)[32], f32x4 (&g)[2]) {
    const float* src = t.W + (size_t)(t.k0 + (lane >> 5)) * t.ldn + t.src_col + (lane & 31);
#pragma unroll
    for (int i = 0; i < 32; ++i) w[i] = __builtin_nontemporal_load(src + (size_t)(2 * i) * t.ldn);
    if (t.gain) { g[0] = *(const f32x4*)(t.gain + t.k0 + 8 * (lane & 7)); g[1] = *(const f32x4*)(t.gain + t.k0 + 8 * (lane & 7) + 4); }
    else { g[0] = (f32x4){1.f, 1.f, 1.f, 1.f}; g[1] = g[0]; }
}
__device__ __forceinline__ void p0_prologue(Frame& F) {
    LAS float* scr = (LAS float*)(F.lds + RING_OFF + F.wave * 16384);
    constexpr int P0_ROWW = 5, P0_TRW = NWAVES - P0_ROWW;
    const bool row_role = F.wave < P0_ROWW;
    const int gw = row_role ? F.vcu * P0_ROWW + F.wave : F.vcu * P0_TRW + (F.wave - P0_ROWW), NGW = F.G * (row_role ? P0_ROWW : P0_TRW);
    bf16* Wga_t = (bf16*)(F.ws + WS_WGA);
    constexpr int NITEMS = (D_ / 64) * (ZW / 32) + 2 * (D_ / 64) * (D_ / 32) + (D_ / 64) * (FF_ / 32) + (FF_ / 64) * (D_ / 32) + (PLE_ / 64) * (D_ / 32);
    if (!row_role) {
        int it = gw; bool have = it < NITEMS;
        float w[32]; f32x4 g[2]; TItem cur;
        if (have) { cur = p0_decode(F, it); p0_issue(cur, F.lane, w, g); }
        while (have) {
#pragma unroll
            for (int i = 0; i < 32; ++i) scr[(2 * i + (F.lane >> 5)) * 33 + (F.lane & 31)] = w[i];
            const f32x4 g0 = g[0], g1 = g[1]; const TItem t = cur;
            LDS_WAIT(); asm volatile("" ::: "memory");
            const int nit = it + NGW; const bool nh = nit < NITEMS;
            if (nh) { cur = p0_decode(F, nit); p0_issue(cur, F.lane, w, g); }
            const int c = F.lane & 7;
#pragma unroll
            for (int j = 0; j < 4; ++j) { const int n = (F.lane >> 3) + 8 * j; const LAS float* s = scr + (8 * c) * 33 + n;
                v4u o; o.x = pk2(s[0 * 33] * g0[0], s[1 * 33] * g0[1]); o.y = pk2(s[2 * 33] * g0[2], s[3 * 33] * g0[3]); o.z = pk2(s[4 * 33] * g1[0], s[5 * 33] * g1[1]); o.w = pk2(s[6 * 33] * g1[2], s[7 * 33] * g1[3]);
                *(GAS v4u*)(t.WT + (size_t)(t.n_dst + n) * t.K + t.k0 + 8 * c) = o; }
            LDS_WAIT(); asm volatile("" ::: "memory");
            it = nit; have = nh;
        }
    }
    if (!row_role) { const float* wi_ = IN_w_in; const float* gm_ = IN_g_mix;
      for (int i = gw * 64 + F.lane; i < 16 * D_; i += NGW * 64) { const int r = i >> 10, k = i & 1023; Wga_t[i] = (bf16)f2bf(wi_[(size_t)k * INW_ + 1536 + r] * gm_[k]); } }
    bf16* xb = (bf16*)(F.ws + WS_AB); bf16* pb = (bf16*)(F.ws + WS_PB); float* rstdx = (float*)(F.ws + WS_RSTDX);
    const float* x_ = IN_x; const float* p_ = IN_p;
    if (row_role) {
        f32x4 v[4][4], pv[4], vn[4][4], pvn[4];
        int m0 = gw * 4; bool have = m0 < S_;
        if (have) {
#pragma unroll
            for (int rr = 0; rr < 4; ++rr) { const GAS f32x4* xr = (const GAS f32x4*)(x_ + (size_t)(m0 + rr) * D_) + F.lane;
#pragma unroll
                for (int j = 0; j < 4; ++j) v[rr][j] = __builtin_nontemporal_load(xr + 64 * j);
                pv[rr] = __builtin_nontemporal_load((const GAS f32x4*)(p_ + (size_t)(m0 + rr) * PLE_) + F.lane); }
        }
        while (have) {
            const int m1 = m0 + NGW * 4; const bool nh = m1 < S_;
            if (nh) {
#pragma unroll
                for (int rr = 0; rr < 4; ++rr) { const GAS f32x4* xr = (const GAS f32x4*)(x_ + (size_t)(m1 + rr) * D_) + F.lane;
#pragma unroll
                    for (int j = 0; j < 4; ++j) vn[rr][j] = __builtin_nontemporal_load(xr + 64 * j);
                    pvn[rr] = __builtin_nontemporal_load((const GAS f32x4*)(p_ + (size_t)(m1 + rr) * PLE_) + F.lane); }
            }
#pragma unroll
            for (int rr = 0; rr < 4; ++rr) { const int m = m0 + rr; float s = 0.f;
#pragma unroll
                for (int j = 0; j < 4; ++j) s += (v[rr][j].x * v[rr][j].x + v[rr][j].y * v[rr][j].y) + (v[rr][j].z * v[rr][j].z + v[rr][j].w * v[rr][j].w);
                s = wave_sum(s);
                GAS unsigned long long* o8 = (GAS unsigned long long*)(xb + (size_t)m * D_) + F.lane;
#pragma unroll
                for (int j = 0; j < 4; ++j) o8[64 * j] = (unsigned long long)pk2(v[rr][j].x, v[rr][j].y) | ((unsigned long long)pk2(v[rr][j].z, v[rr][j].w) << 32);
                if (F.lane == 0) rstdx[m] = 1.0f / sqrtf(s * (1.0f / D_) + EPS_);
                *((GAS unsigned long long*)(pb + (size_t)m * PLE_) + F.lane) = (unsigned long long)pk2(pv[rr].x, pv[rr].y) | ((unsigned long long)pk2(pv[rr].z, pv[rr].w) << 32); }
#pragma unroll
            for (int rr = 0; rr < 4; ++rr) { pv[rr] = pvn[rr];
#pragma unroll
                for (int j = 0; j < 4; ++j) v[rr][j] = vn[rr][j]; }
            m0 = m1; have = nh;
        }
    }
}

typedef float f32x16 __attribute__((ext_vector_type(16)));
typedef __bf16 bf2_t __attribute__((ext_vector_type(2)));
typedef float f2_t __attribute__((ext_vector_type(2)));
__device__ __forceinline__ unsigned pkbf(float lo, float hi) { f2_t v = {lo, hi}; bf2_t b = __builtin_convertvector(v, bf2_t); return __builtin_bit_cast(unsigned, b); }
#define MFMA32(a, b, c) __builtin_amdgcn_mfma_f32_32x32x16_bf16((a), (b), (c), 0, 0, 0)
#define WG_SYNC() do { asm volatile("s_waitcnt lgkmcnt(0)" ::: "memory"); __builtin_amdgcn_s_barrier(); asm volatile("" ::: "memory"); } while (0)
__device__ __forceinline__ bf16x8 pack8(const f32x16& x, int s) {
    v4u p; p.x = pkbf(x[8 * s], x[8 * s + 1]); p.y = pkbf(x[8 * s + 2], x[8 * s + 3]); p.z = pkbf(x[8 * s + 4], x[8 * s + 5]); p.w = pkbf(x[8 * s + 6], x[8 * s + 7]);
    return __builtin_bit_cast(bf16x8, p);
}
__device__ __forceinline__ float log_sigmoid(float s) { return fminf(s, 0.f) - __logf(1.0f + __expf(-fabsf(s))); }
constexpr int GROW = 72;
__device__ __forceinline__ int tperm(int tt) { return (tt & ~15) + 8 * ((tt >> 2) & 1) + 4 * ((tt >> 3) & 1) + (tt & 3); }

__device__ __forceinline__ void gla_load_w2(Frame& F, float (&w2)[16], float& bias) {
    const int c = F.tid & 255;
    const float* wa2_ = IN_w_a2;
#pragma unroll
    for (int r = 0; r < 16; ++r) w2[r] = wa2_[r * 256 + c];
    bias = IN_b_a[c];
}
__device__ __forceinline__ void gla_cumsum(Frame& F, const LAS float* GAS_, LAS float* TOT, const float (&w2)[16], float bias, float (&bl)[32], float& blast, float& boff) {
    const int c = F.tid & 255, half = F.tid >> 8;
    float run = 0.f;
#pragma unroll
    for (int i = 0; i < 32; ++i) {
        const LAS f32x4* g4 = (const LAS f32x4*)(GAS_ + (32 * half + i) * 16);
        const f32x4 g0 = g4[0], g1 = g4[1], g2 = g4[2], g3 = g4[3];
        float a = bias;
        a += g0[0] * w2[0]; a += g0[1] * w2[1]; a += g0[2] * w2[2]; a += g0[3] * w2[3];
        a += g1[0] * w2[4]; a += g1[1] * w2[5]; a += g1[2] * w2[6]; a += g1[3] * w2[7];
        a += g2[0] * w2[8]; a += g2[1] * w2[9]; a += g2[2] * w2[10]; a += g2[3] * w2[11];
        a += g3[0] * w2[12]; a += g3[1] * w2[13]; a += g3[2] * w2[14]; a += g3[3] * w2[15];
        run += log_sigmoid(a) * (1.0f / 16.0f);
        bl[i] = run;
    }
    TOT[half * 256 + c] = run;
    WG_SYNC();
    const float t0 = TOT[c], t1 = TOT[256 + c];
    blast = t0 + t1; boff = half ? t0 : 0.f;
}
__device__ __forceinline__ void gla_vt_load(Frame& F, const bf16* zb, int t0, v4u (&vw)[8]) {
    const int tt = F.tid & 63, grp = F.tid >> 6;
    const bf16* src = zb + (size_t)(t0 + tt) * ZW + Z_GV + 64 * grp;
#pragma unroll
    for (int i = 0; i < 8; ++i) vw[i] = *(const v4u*)(src + 8 * i);
}
__device__ __forceinline__ void gla_vt_write(Frame& F, LAS bf16* VT, const v4u (&vw)[8]) {
    const int tt = F.tid & 63, grp = F.tid >> 6, h = grp >> 1, e0 = (grp & 1) * 64, pt = tperm(tt);
#pragma unroll
    for (int i = 0; i < 8; ++i) {
        const v4u w = vw[i];
        LAS bf16* dst = VT + (size_t)(h * 128 + e0 + 8 * i) * GROW + pt;
        dst[0 * GROW] = (bf16)(w.x & 0xffffu); dst[1 * GROW] = (bf16)(w.x >> 16); dst[2 * GROW] = (bf16)(w.y & 0xffffu); dst[3 * GROW] = (bf16)(w.y >> 16);
        dst[4 * GROW] = (bf16)(w.z & 0xffffu); dst[5 * GROW] = (bf16)(w.z >> 16); dst[6 * GROW] = (bf16)(w.w & 0xffffu); dst[7 * GROW] = (bf16)(w.w >> 16);
    }
}

__device__ __forceinline__ void gla_a_chunk(Frame& F, int ch) {
    LAS float* GA_S = (LAS float*)(F.lds);
    LAS float* TOT = (LAS float*)(F.lds + 8192);
    LAS bf16* KTE = (LAS bf16*)(F.lds + 10240);
    LAS bf16* VT = (LAS bf16*)(F.lds + 10240 + 4 * 64 * GROW * 2);
    const bf16* xb = (const bf16*)(F.ws + WS_AB); const bf16* zb = (const bf16*)(F.ws + WS_Z); const bf16* wga = (const bf16*)(F.ws + WS_WGA);
    const float* rstdx = (const float*)(F.ws + WS_RSTDX); float* ga_g = (float*)(F.ws + WS_GA); float* decay_g = (float*)(F.ws + WS_DECAY); bf16* dS_g = (bf16*)(F.ws + WS_DS);
    const int t0 = ch * 64;
    float w2[16], bias; gla_load_w2(F, w2, bias);
    v4u vw[8]; gla_vt_load(F, zb, t0, vw);
    unsigned short kraw[32];
    { const bf16* kcol = zb + (size_t)(t0 + 32 * (F.tid >> 8)) * ZW + Z_GK + (F.tid & 255);
#pragma unroll
      for (int j = 0; j < 32; ++j) kraw[j] = kcol[(size_t)j * ZW]; }
    {
        const int rg = F.wave & 3, kh = F.wave >> 2, r = F.lane & 15, q = F.lane >> 4;
        const bf16* arow = xb + (size_t)(t0 + 16 * rg + r) * D_ + 8 * q; const bf16* brow = wga + (size_t)r * D_ + 8 * q;
        pg8::f32x4 acc = {0.f, 0.f, 0.f, 0.f};
#pragma unroll
        for (int s = 16 * kh; s < 16 * kh + 16; ++s) { const bf16x8 a = *(const bf16x8*)(arow + 32 * s), b = *(const bf16x8*)(brow + 32 * s); acc = __builtin_amdgcn_mfma_f32_16x16x32_bf16(a, b, acc, 0, 0, 0); }
#pragma unroll
        for (int g = 0; g < 4; ++g) GA_S[kh * 1024 + (16 * rg + 4 * q + g) * 16 + r] = acc[g];
    }
    WG_SYNC();
    for (int idx = F.tid; idx < 1024; idx += 512) { const float v = (GA_S[idx] + GA_S[1024 + idx]) * rstdx[t0 + (idx >> 4)]; GA_S[idx] = v; ga_g[(size_t)t0 * 16 + idx] = v; }
    WG_SYNC();
    float bl[32], blast, boff;
    gla_cumsum(F, GA_S, TOT, w2, bias, bl, blast, boff);
    {
        const int c = F.tid & 255, half = F.tid >> 8, h = c >> 6, d = c & 63;
        if (half == 0) decay_g[ch * 256 + c] = __expf(blast);
#pragma unroll
        for (int g8 = 0; g8 < 4; ++g8) {
            float v[8];
#pragma unroll
            for (int j = 0; j < 8; ++j) v[j] = bf2f(kraw[8 * g8 + j]) * __expf(blast - (boff + bl[8 * g8 + j]));
            const int tt = 32 * half + 8 * g8, hi = (tt >> 3) & 1;
            LAS bf16* row = KTE + (size_t)(h * 64 + d) * GROW + (tt & ~15) + 4 * hi;
            typedef unsigned u2 __attribute__((ext_vector_type(2)));
            u2 lo, hi2; lo.x = pkbf(v[0], v[1]); lo.y = pkbf(v[2], v[3]); hi2.x = pkbf(v[4], v[5]); hi2.y = pkbf(v[6], v[7]);
            *(LAS u2*)(row) = lo; *(LAS u2*)(row + 8) = hi2;
        }
    }
    gla_vt_write(F, VT, vw);
    WG_SYNC();
    {
        const int h = F.wave >> 1, dt = F.wave & 1, i = F.lane & 31, hh = F.lane >> 5;
        f32x16 acc[4];
#pragma unroll
        for (int et = 0; et < 4; ++et)
#pragma unroll
            for (int r = 0; r < 16; ++r) acc[et][r] = 0.f;
#pragma unroll
        for (int s = 0; s < 4; ++s) {
            const bf16x8 a = *(const LAS bf16x8*)(KTE + (size_t)(h * 64 + 32 * dt + i) * GROW + 16 * s + 8 * hh);
#pragma unroll
            for (int et = 0; et < 4; ++et) { const bf16x8 b = *(const LAS bf16x8*)(VT + (size_t)(h * 128 + 32 * et + i) * GROW + 16 * s + 8 * hh); acc[et] = MFMA32(a, b, acc[et]); }
        }
#pragma unroll
        for (int et = 0; et < 4; ++et) {
            bf16* dst = dS_g + ((size_t)(ch * 4 + h) * 128 + 32 * et + i) * 64 + 32 * dt + 4 * hh;
            typedef unsigned u2 __attribute__((ext_vector_type(2)));
#pragma unroll
            for (int g = 0; g < 4; ++g) { u2 w; w.x = pkbf(acc[et][4 * g], acc[et][4 * g + 1]); w.y = pkbf(acc[et][4 * g + 2], acc[et][4 * g + 3]); *(u2*)(dst + 8 * g) = w; }
        }
    }
    WG_SYNC();
}

__device__ __forceinline__ void gla_b_pair(Frame& F, int pair) {
    LAS float* DSL = (LAS float*)(F.lds);
    LAS float* DEC = (LAS float*)(F.lds + 65536);
    LAS float* SEGE = (LAS float*)(F.lds + 131072);
    LAS float* SEGP = (LAS float*)(F.lds + 131072 + 2048);
    const float* decay_g = (const float*)(F.ws + WS_DECAY); const bf16* dS_g = (const bf16*)(F.ws + WS_DS); bf16* sp_g = (bf16*)(F.ws + WS_SPREV);
    const int h = pair >> 6, seg = F.tid >> 6, d = F.tid & 63;
#pragma unroll
    for (int i = 0; i < 8; ++i) { const int idx = F.tid + 512 * i, n = idx >> 4, d4 = idx & 15; *(LAS pg8::f32x4*)(DEC + n * 64 + 4 * d4) = *(const pg8::f32x4*)(decay_g + (size_t)n * 256 + h * 64 + 4 * d4); }
    for (int sub = 0; sub < 2; ++sub) {
        const int e = (pair & 63) * 2 + sub;
#pragma unroll
        for (int i = 0; i < 4; ++i) { const int idx = F.tid + 512 * i, n = idx >> 3, d8 = idx & 7;
            const v4u w = *(const v4u*)(dS_g + ((size_t)(n * 4 + h) * 128 + e) * 64 + 8 * d8);
            LAS pg8::f32x4* dp = (LAS pg8::f32x4*)(DSL + n * 64 + 8 * d8);
            dp[0] = (pg8::f32x4){bf2f(w.x & 0xffffu), bf2f(w.x >> 16), bf2f(w.y & 0xffffu), bf2f(w.y >> 16)}; dp[1] = (pg8::f32x4){bf2f(w.z & 0xffffu), bf2f(w.z >> 16), bf2f(w.w & 0xffffu), bf2f(w.w >> 16)}; }
        WG_SYNC();
        float Sv = 0.f, P = 1.f;
#pragma unroll 8
        for (int i = 0; i < 32; ++i) { const int n = seg * 32 + i; const float x = DSL[n * 64 + d], a = DEC[n * 64 + d]; DSL[n * 64 + d] = Sv; Sv = a * Sv + x; P *= a; }
        SEGE[seg * 64 + d] = Sv; SEGP[seg * 64 + d] = P;
        WG_SYNC();
        float st = 0.f;
        for (int k = 0; k < seg; ++k) st = SEGP[k * 64 + d] * st + SEGE[k * 64 + d];
        float Pq = 1.f;
#pragma unroll 8
        for (int i = 0; i < 32; ++i) { const int n = seg * 32 + i; const float v = DSL[n * 64 + d] + Pq * st; Pq *= DEC[n * 64 + d]; sp_g[((size_t)(n * 4 + h) * 128 + e) * 64 + d] = (bf16)f2bf(v); }
        WG_SYNC();
    }
}

__device__ __forceinline__ void gla_c_chunk(Frame& F, int ch) {
    LAS float* GA2 = (LAS float*)(F.lds);
    LAS float* TOT = (LAS float*)(F.lds + 4096);
    LAS bf16* QD = (LAS bf16*)(F.lds + 6144);
    LAS bf16* KI = (LAS bf16*)(F.lds + 6144 + 36864);
    LAS bf16* VT = (LAS bf16*)(F.lds + 6144 + 2 * 36864);
    const bf16* zb = (const bf16*)(F.ws + WS_Z); const float* ga_g = (const float*)(F.ws + WS_GA); const bf16* sp_g = (const bf16*)(F.ws + WS_SPREV); bf16* mixb = (bf16*)(F.ws + WS_MIX);
    const int t0 = ch * 64;
    float w2[16], bias; gla_load_w2(F, w2, bias);
    v4u vw[8]; gla_vt_load(F, zb, t0, vw);
    unsigned short qraw[32], kraw[32];
    { const bf16* qcol = zb + (size_t)(t0 + 32 * (F.tid >> 8)) * ZW + Z_GQ + (F.tid & 255); const bf16* kcol = zb + (size_t)(t0 + 32 * (F.tid >> 8)) * ZW + Z_GK + (F.tid & 255);
#pragma unroll
      for (int j = 0; j < 32; ++j) { qraw[j] = qcol[(size_t)j * ZW]; kraw[j] = kcol[(size_t)j * ZW]; } }
    for (int idx = F.tid; idx < 1024; idx += 512) GA2[idx] = ga_g[(size_t)t0 * 16 + idx];
    WG_SYNC();
    float bl[32], blast, boff;
    gla_cumsum(F, GA2, TOT, w2, bias, bl, blast, boff);
    {
        const int c = F.tid & 255, half = F.tid >> 8, h = c >> 6, d = c & 63;
#pragma unroll
        for (int i = 0; i < 32; ++i) {
            const float b = boff + bl[i];
            const float qd = bf2f(qraw[i]) * __expf(b) * 0.125f, ki = bf2f(kraw[i]) * __expf(-b);
            QD[(size_t)(h * 64 + 32 * half + i) * GROW + d] = (bf16)f2bf(qd); KI[(size_t)(h * 64 + 32 * half + i) * GROW + d] = (bf16)f2bf(ki);
        }
    }
    gla_vt_write(F, VT, vw);
    WG_SYNC();
    {
        const int h = F.wave >> 1, ct = F.wave & 1, i = F.lane & 31, hh = F.lane >> 5;
        bf16x8 qf[4];
#pragma unroll
        for (int s = 0; s < 4; ++s) qf[s] = *(const LAS bf16x8*)(QD + (size_t)(h * 64 + 32 * ct + i) * GROW + 16 * s + 8 * hh);
        f32x16 acc[4];
#pragma unroll
        for (int et = 0; et < 4; ++et)
#pragma unroll
            for (int r = 0; r < 16; ++r) acc[et][r] = 0.f;
#pragma unroll
        for (int et = 0; et < 4; ++et) {
            const bf16* srow = sp_g + ((size_t)(ch * 4 + h) * 128 + 32 * et + i) * 64 + 8 * hh;
#pragma unroll
            for (int s = 0; s < 4; ++s) { const bf16x8 sf = *(const bf16x8*)(srow + 16 * s); acc[et] = MFMA32(sf, qf[s], acc[et]); }
        }
        for (int jt = 0; jt <= ct; ++jt) {
            f32x16 X;
#pragma unroll
            for (int r = 0; r < 16; ++r) X[r] = 0.f;
#pragma unroll
            for (int s = 0; s < 4; ++s) { const bf16x8 kf = *(const LAS bf16x8*)(KI + (size_t)(h * 64 + 32 * jt + i) * GROW + 16 * s + 8 * hh); X = MFMA32(kf, qf[s], X); }
            if (jt == ct) {
#pragma unroll
                for (int r = 0; r < 16; ++r) { const int j = (r & 3) + 8 * (r >> 2) + 4 * hh; if (j > i) X[r] = 0.f; }
            }
#pragma unroll
            for (int s2 = 0; s2 < 2; ++s2) {
                const bf16x8 xs = pack8(X, s2);
#pragma unroll
                for (int et = 0; et < 4; ++et) { const bf16x8 vf = *(const LAS bf16x8*)(VT + (size_t)(h * 128 + 32 * et + i) * GROW + 32 * jt + 16 * s2 + 8 * hh); acc[et] = MFMA32(vf, xs, acc[et]); }
            }
        }
        float ss = 0.f;
#pragma unroll
        for (int et = 0; et < 4; ++et)
#pragma unroll
            for (int r = 0; r < 16; ++r) ss += acc[et][r] * acc[et][r];
        ss += __shfl_xor(ss, 32);
        const float rn = 1.0f / sqrtf(ss * (1.0f / 128.0f) + EPS_);
        const int t = t0 + 32 * ct + i;
        const bf16* ggrow = zb + (size_t)t * ZW + Z_GG + h * 128; bf16* orow = mixb + (size_t)t * D_ + h * 128;
        const float* ggl_ = IN_g_gla;
#pragma unroll
        for (int et = 0; et < 4; ++et)
#pragma unroll
            for (int g = 0; g < 4; ++g) {
                const int e0 = 32 * et + 8 * g + 4 * hh;
                typedef unsigned u2 __attribute__((ext_vector_type(2)));
                const u2 gw = *(const u2*)(ggrow + e0);
                const pg8::f32x4 gl = *(const pg8::f32x4*)(ggl_ + e0);
                float gv[4] = {bf2f(gw.x & 0xffffu), bf2f(gw.x >> 16), bf2f(gw.y & 0xffffu), bf2f(gw.y >> 16)};
                float o[4];
#pragma unroll
                for (int j = 0; j < 4; ++j) o[j] = acc[et][4 * g + j] * rn * gl[j] * (gv[j] * __builtin_amdgcn_rcpf(1.0f + __expf(-gv[j])));
                u2 w; w.x = pkbf(o[0], o[1]); w.y = pkbf(o[2], o[3]);
                *(u2*)(orow + e0) = w;
            }
    }
    WG_SYNC();
}

constexpr int KROW = 136;
constexpr int VROW = 264;
constexpr int LIST_PER_HEAD = 256 * 2016;
__device__ __forceinline__ int list_off(int h, int j) { return h * LIST_PER_HEAD + 256 * (63 * j - (j * (j - 1)) / 2); }
typedef unsigned u2_t __attribute__((ext_vector_type(2)));

__device__ __forceinline__ void sincos_acc(float a, float& s, float& c) {
    const float k = __builtin_rintf(a * 0.15915494309189535f);
    float r = __builtin_fmaf(-k, 6.28125f, a);
    r = __builtin_fmaf(-k, 0.0019353071693331003f, r);
    r = __builtin_fmaf(-k, 1.0253131677018246e-11f, r);
    const float rev = r * 0.15915494309189535f;
    s = __builtin_amdgcn_sinf(rev); c = __builtin_amdgcn_cosf(rev);
}

__device__ __forceinline__ void moba_a_item(Frame& F, int item) {
    const int blk = item >> 2, h = item & 3;
    LAS bf16* VTL = (LAS bf16*)(F.lds);
    LAS float* KM = (LAS float*)(F.lds + 128 * VROW * 2);
    bf16* zb = (bf16*)(F.ws + WS_Z); float* kmean_g = (float*)(F.ws + WS_KMEAN); bf16* vT_g = (bf16*)((unsigned char*)F.out + OUT_VT);
    v4u vsrc[8];
    { const int tt = F.tid & 255, half = F.tid >> 8; const bf16* src = zb + (size_t)(blk * 256 + tt) * ZW + Z_MV + h * 128 + 64 * half;
#pragma unroll
      for (int i = 0; i < 8; ++i) vsrc[i] = *(const v4u*)(src + 8 * i); }
    {
        const int ts = F.lane >> 4, g = F.lane & 15;
        const float* gmq_ = IN_g_mq; const float* gmk_ = IN_g_mk; const int* pos_ = IN_pos;
        LAS float* INVT = KM + 32 * 128;
        if (F.tid < 64) INVT[F.tid] = 1.0f / powf(10000.0f, (float)F.tid / 64.0f);
        WG_SYNC();
        float inv[4]; f32x4 gq1 = *(const f32x4*)(gmq_ + 4 * g), gq2 = *(const f32x4*)(gmq_ + 64 + 4 * g), gk1 = *(const f32x4*)(gmk_ + 4 * g), gk2 = *(const f32x4*)(gmk_ + 64 + 4 * g);
#pragma unroll
        for (int c = 0; c < 4; ++c) inv[c] = INVT[4 * g + c];
        float km1[4] = {0.f, 0.f, 0.f, 0.f}, km2[4] = {0.f, 0.f, 0.f, 0.f};
        for (int b4 = 0; b4 < 2; ++b4) {
            u2_t ql[4], qh[4], kl[4], kh[4]; int ps[4];
#pragma unroll
            for (int u = 0; u < 4; ++u) { const int t = blk * 256 + F.wave * 32 + 16 * b4 + 4 * u + ts;
                const bf16* pq = zb + (size_t)t * ZW + Z_MQ + h * 128 + 4 * g; const bf16* pk = zb + (size_t)t * ZW + Z_MK + h * 128 + 4 * g;
                ps[u] = pos_[t]; ql[u] = *(const u2_t*)pq; qh[u] = *(const u2_t*)(pq + 64); kl[u] = *(const u2_t*)pk; kh[u] = *(const u2_t*)(pk + 64); }
#pragma unroll
            for (int u = 0; u < 4; ++u) { const int t = blk * 256 + F.wave * 32 + 16 * b4 + 4 * u + ts;
                float q1[4] = {bf2f(ql[u].x & 0xffffu), bf2f(ql[u].x >> 16), bf2f(ql[u].y & 0xffffu), bf2f(ql[u].y >> 16)}, q2[4] = {bf2f(qh[u].x & 0xffffu), bf2f(qh[u].x >> 16), bf2f(qh[u].y & 0xffffu), bf2f(qh[u].y >> 16)};
                float k1[4] = {bf2f(kl[u].x & 0xffffu), bf2f(kl[u].x >> 16), bf2f(kl[u].y & 0xffffu), bf2f(kl[u].y >> 16)}, k2[4] = {bf2f(kh[u].x & 0xffffu), bf2f(kh[u].x >> 16), bf2f(kh[u].y & 0xffffu), bf2f(kh[u].y >> 16)};
                float sq = 0.f, sk = 0.f;
#pragma unroll
                for (int c = 0; c < 4; ++c) { sq += q1[c] * q1[c] + q2[c] * q2[c]; sk += k1[c] * k1[c] + k2[c] * k2[c]; }
                sq = row16_sum(sq); sk = row16_sum(sk);
                const float rq = __builtin_amdgcn_rsqf(sq * (1.0f / 128.0f) + EPS_), rk = __builtin_amdgcn_rsqf(sk * (1.0f / 128.0f) + EPS_);
                float oq1[4], oq2[4], ok1[4], ok2[4];
#pragma unroll
                for (int c = 0; c < 4; ++c) { float sn, cs; sincos_acc((float)ps[u] * inv[c], sn, cs);
                    const float yq1 = q1[c] * rq * gq1[c], yq2 = q2[c] * rq * gq2[c], yk1 = k1[c] * rk * gk1[c], yk2 = k2[c] * rk * gk2[c];
                    oq1[c] = yq1 * cs - yq2 * sn; oq2[c] = yq2 * cs + yq1 * sn; ok1[c] = yk1 * cs - yk2 * sn; ok2[c] = yk2 * cs + yk1 * sn;
                    km1[c] += ok1[c]; km2[c] += ok2[c]; }
                bf16* pq = zb + (size_t)t * ZW + Z_MQ + h * 128 + 4 * g; bf16* pk = zb + (size_t)t * ZW + Z_MK + h * 128 + 4 * g;
                u2_t w; w.x = pkbf(oq1[0], oq1[1]); w.y = pkbf(oq1[2], oq1[3]); *(u2_t*)pq = w; w.x = pkbf(oq2[0], oq2[1]); w.y = pkbf(oq2[2], oq2[3]); *(u2_t*)(pq + 64) = w;
                w.x = pkbf(ok1[0], ok1[1]); w.y = pkbf(ok1[2], ok1[3]); *(u2_t*)pk = w; w.x = pkbf(ok2[0], ok2[1]); w.y = pkbf(ok2[2], ok2[3]); *(u2_t*)(pk + 64) = w;
            }
        }
#pragma unroll
        for (int c = 0; c < 4; ++c) { KM[(F.wave * 4 + ts) * 128 + 4 * g + c] = km1[c]; KM[(F.wave * 4 + ts) * 128 + 64 + 4 * g + c] = km2[c]; }
    }
    {
        const int tt = F.tid & 255, half = F.tid >> 8, pt = tperm(tt);
#pragma unroll
        for (int i = 0; i < 8; ++i) {
            const v4u w = vsrc[i];
            LAS bf16* dst = VTL + (size_t)(64 * half + 8 * i) * VROW + pt;
            dst[0 * VROW] = (bf16)(w.x & 0xffffu); dst[1 * VROW] = (bf16)(w.x >> 16); dst[2 * VROW] = (bf16)(w.y & 0xffffu); dst[3 * VROW] = (bf16)(w.y >> 16);
            dst[4 * VROW] = (bf16)(w.z & 0xffffu); dst[5 * VROW] = (bf16)(w.z >> 16); dst[6 * VROW] = (bf16)(w.w & 0xffffu); dst[7 * VROW] = (bf16)(w.w >> 16);
        }
    }
    WG_SYNC();
    if (F.tid < 128) { float s = 0.f;
#pragma unroll
        for (int w = 0; w < 32; ++w) s += KM[w * 128 + F.tid];
        kmean_g[(size_t)(h * 64 + blk) * 128 + F.tid] = s * (1.0f / 256.0f); }
#pragma unroll
    for (int i = 0; i < 8; ++i) { const int idx = F.tid + 512 * i, e = idx >> 5, c16 = idx & 31;
        *(v4u*)(vT_g + ((size_t)(h * 64 + blk) * 128 + e) * 256 + 8 * c16) = *(const LAS v4u*)(VTL + (size_t)e * VROW + 8 * c16); }
    WG_SYNC();
}

__device__ __forceinline__ void top3_insert(float v, int j, float& v0, float& v1, float& v2, int& i0, int& i1, int& i2) {
    const bool b0 = (v > v0) || (v == v0 && j < i0), b1 = (v > v1) || (v == v1 && j < i1), b2 = (v > v2) || (v == v2 && j < i2);
    const float n2 = b1 ? v1 : (b2 ? v : v2); const int m2 = b1 ? i1 : (b2 ? j : i2);
    const float n1 = b0 ? v0 : (b1 ? v : v1); const int m1 = b0 ? i0 : (b1 ? j : i1);
    const float n0 = b0 ? v : v0; const int m0 = b0 ? j : i0;
    v0 = n0; v1 = n1; v2 = n2; i0 = m0; i1 = m1; i2 = m2;
}
__device__ __forceinline__ void moba_b_item(Frame& F, int item) {
    const int kb = item >> 2, h = item & 3;
    if (kb == 0) return;
    LAS bf16* KMH = (LAS bf16*)(F.lds);
    LAS bf16* KML = (LAS bf16*)(F.lds + 64 * KROW * 2);
    LAS unsigned* HIST = (LAS unsigned*)(F.lds + 2 * 64 * KROW * 2);
    LAS unsigned* BASE = HIST + 64;
    const bf16* zb = (const bf16*)(F.ws + WS_Z); const float* kmean_g = (const float*)(F.ws + WS_KMEAN); unsigned* list_g = (unsigned*)(F.ws + WS_LIST);
    const int i = F.lane & 31, kk = F.lane >> 5;
    const int t = kb * 256 + F.wave * 32 + i;
    bf16x8 qf[8];
    { const bf16* qrow = zb + (size_t)t * ZW + Z_MQ + h * 128 + 8 * kk;
#pragma unroll
      for (int s = 0; s < 8; ++s) qf[s] = *(const bf16x8*)(qrow + 16 * s); }
    for (int idx = F.tid; idx < 64 * 128; idx += 512) { const int j = idx >> 7, d = idx & 127; const float v = (j < kb) ? kmean_g[(size_t)(h * 64 + j) * 128 + d] : 0.f;
        const unsigned hi = f2bf(v); const float rem = v - bf2f(hi); KMH[j * KROW + d] = (bf16)hi; KML[j * KROW + d] = (bf16)f2bf(rem); }
    if (F.tid < 64) HIST[F.tid] = 0u;
    WG_SYNC();
    float v0 = -INFINITY, v1 = -INFINITY, v2 = -INFINITY; int i0 = 1 << 20, i1 = 1 << 20, i2 = 1 << 20;
    const int njt = (kb + 31) >> 5;
    for (int jt = 0; jt < njt; ++jt) {
        f32x16 acc;
#pragma unroll
        for (int r = 0; r < 16; ++r) acc[r] = 0.f;
#pragma unroll
        for (int s = 0; s < 8; ++s) {
            const bf16x8 ah = *(const LAS bf16x8*)(KMH + (size_t)(32 * jt + i) * KROW + 16 * s + 8 * kk), al = *(const LAS bf16x8*)(KML + (size_t)(32 * jt + i) * KROW + 16 * s + 8 * kk);
            acc = MFMA32(ah, qf[s], acc); acc = MFMA32(al, qf[s], acc);
        }
#pragma unroll
        for (int r = 0; r < 16; ++r) { const int j = 32 * jt + (r & 3) + 8 * (r >> 2) + 4 * kk; if (j < kb) top3_insert(acc[r], j, v0, v1, v2, i0, i1, i2); }
    }
    {
        const float pv0 = __shfl_xor(v0, 32), pv1 = __shfl_xor(v1, 32), pv2 = __shfl_xor(v2, 32);
        const int pi0 = __shfl_xor(i0, 32), pi1 = __shfl_xor(i1, 32), pi2 = __shfl_xor(i2, 32);
        top3_insert(pv0, pi0, v0, v1, v2, i0, i1, i2); top3_insert(pv1, pi1, v0, v1, v2, i0, i1, i2); top3_insert(pv2, pi2, v0, v1, v2, i0, i1, i2);
    }
    const int nsel = kb < 3 ? kb : 3;
    unsigned lp0 = 0, lp1 = 0, lp2 = 0;
    if (kk == 0) {
        if (nsel > 0) lp0 = atomicAdd((unsigned*)&HIST[i0], 1u);
        if (nsel > 1) lp1 = atomicAdd((unsigned*)&HIST[i1], 1u);
        if (nsel > 2) lp2 = atomicAdd((unsigned*)&HIST[i2], 1u);
    }
    WG_SYNC();
    if (F.tid < 64) { const unsigned n = HIST[F.tid]; BASE[F.tid] = n ? atomicAdd((unsigned*)(F.ctl + CW_CNT + h * 64 + F.tid), n) : 0u; }
    WG_SYNC();
    if (kk == 0) {
        if (nsel > 0) list_g[list_off(h, i0) + BASE[i0] + lp0] = (unsigned)t | (0u << 16);
        if (nsel > 1) list_g[list_off(h, i1) + BASE[i1] + lp1] = (unsigned)t | (1u << 16);
        if (nsel > 2) list_g[list_off(h, i2) + BASE[i2] + lp2] = (unsigned)t | (2u << 16);
    }
    WG_SYNC();
}

__device__ __forceinline__ void moba_load_kv(Frame& F, int h, int j, LAS bf16* KL, LAS bf16* VL) {
    const bf16* zb = (const bf16*)(F.ws + WS_Z); const bf16* vT_g = (const bf16*)((const unsigned char*)F.out + OUT_VT);
#pragma unroll
    for (int i = 0; i < 8; ++i) { const int idx = F.tid + 512 * i, r = idx >> 4, c16 = idx & 15;
        *(LAS v4u*)(KL + (size_t)r * KROW + 8 * c16) = *(const v4u*)(zb + (size_t)(j * 256 + r) * ZW + Z_MK + h * 128 + 8 * c16); }
#pragma unroll
    for (int i = 0; i < 8; ++i) { const int idx = F.tid + 512 * i, e = idx >> 5, c16 = idx & 31;
        *(LAS v4u*)(VL + (size_t)e * VROW + 8 * c16) = *(const v4u*)(vT_g + ((size_t)(h * 64 + j) * 128 + e) * 256 + 8 * c16); }
}
__device__ __forceinline__ void moba_wave_attend(const bf16x8 (&qf)[8], const LAS bf16* KL, const LAS bf16* VL, int nkt, int diag_kt, int i, int hh, float c2, float mc2, f32x16 (&acc)[4], float& lsum) {
    for (int kt = 0; kt < nkt; ++kt) {
        f32x16 St;
#pragma unroll
        for (int r = 0; r < 16; ++r) St[r] = 0.f;
#pragma unroll
        for (int s = 0; s < 8; ++s) { const bf16x8 kf = *(const LAS bf16x8*)(KL + (size_t)(32 * kt + i) * KROW + 16 * s + 8 * hh); St = MFMA32(kf, qf[s], St); }
#pragma unroll
        for (int r = 0; r < 16; ++r) St[r] = __builtin_amdgcn_exp2f(St[r] * c2 - mc2);
        if (kt == diag_kt) {
#pragma unroll
            for (int r = 0; r < 16; ++r) { const int kl = (r & 3) + 8 * (r >> 2) + 4 * hh; if (kl > i) St[r] = 0.f; }
        }
#pragma unroll
        for (int r = 0; r < 16; ++r) lsum += St[r];
#pragma unroll
        for (int s2 = 0; s2 < 2; ++s2) {
            const bf16x8 ps = pack8(St, s2);
#pragma unroll
            for (int et = 0; et < 4; ++et) { const bf16x8 vf = *(const LAS bf16x8*)(VL + (size_t)(32 * et + i) * VROW + 32 * kt + 16 * s2 + 8 * hh); acc[et] = MFMA32(vf, ps, acc[et]); }
        }
    }
}
__device__ __forceinline__ void moba_shift(Frame& F, float& c2, float& mc2) {
    const float* gmq_ = IN_g_mq; const float* gmk_ = IN_g_mk;
    float m1 = fmaxf(fabsf(gmq_[F.lane]), fabsf(gmq_[F.lane + 64])), m2 = fmaxf(fabsf(gmk_[F.lane]), fabsf(gmk_[F.lane + 64]));
#pragma unroll
    for (int o = 1; o < 64; o <<= 1) { m1 = fmaxf(m1, __shfl_xor(m1, o)); m2 = fmaxf(m2, __shfl_xor(m2, o)); }
    c2 = 0.08838834764831845f * 1.4426950408889634f;
    mc2 = 11.313708498984761f * m1 * m2 * 1.4426950408889634f;
}

__device__ __forceinline__ void mc_decode(const LAS int* PRE, int it, int& hj, int& chunk) {
    int lo = 0, hi = 255;
    while (lo < hi) { const int mid = (lo + hi + 1) >> 1; if (PRE[mid] <= it) lo = mid; else hi = mid - 1; }
    hj = lo; chunk = it - PRE[lo];
}
__device__ __forceinline__ void mc_fetch(const Frame& F, int hj, int chunk, int n, int i, int hh, bool& active, bool& valid, int& tq, int& slot, bf16x8 (&qf)[8]) {
    const bf16* zb = (const bf16*)(F.ws + WS_Z); const unsigned* list_g = (const unsigned*)(F.ws + WS_LIST);
    const int h = hj >> 6, j = hj & 63, base = chunk * 256 + F.wave * 32;
    active = base < n; valid = false; tq = 0; slot = 0;
    if (active) {
        const int eidx = base + i; valid = eidx < n;
        const unsigned ent = list_g[list_off(h, j) + (valid ? eidx : base)];
        tq = (int)(ent & 0xffffu); slot = (int)(ent >> 16);
        const bf16* qrow = zb + (size_t)tq * ZW + Z_MQ + h * 128 + 8 * hh;
#pragma unroll
        for (int s = 0; s < 8; ++s) qf[s] = *(const bf16x8*)(qrow + 16 * s);
    }
}
__device__ __forceinline__ void moba_c_phase(Frame& F) {
    LAS bf16* KL = (LAS bf16*)(F.lds); LAS bf16* VL = (LAS bf16*)(F.lds + 256 * KROW * 2);
    LAS int* PRE = (LAS int*)(F.lds + 256 * KROW * 2 + 128 * VROW * 2);
    LAS int* WT = PRE + 260;
    bf16* part_g = (bf16*)((unsigned char*)F.out + OUT_PART); float* lpart_g = (float*)(F.ws + WS_LPART);
    int mycnt = 0;
    if (F.tid < 256) {
        mycnt = (int)__hip_atomic_load(F.ctl + CW_CNT + F.tid, RLX_AGENT);
        int v = (mycnt + 255) >> 8, incl = v;
#pragma unroll
        for (int o = 1; o < 64; o <<= 1) { const int u = __shfl_up(incl, o); if (F.lane >= o) incl += u; }
        if (F.lane == 63) WT[F.wave] = incl;
        PRE[F.tid] = incl - v;
    }
    WG_SYNC();
    if (F.tid < 256) { int off = 0; for (int w = 0; w < F.wave; ++w) off += WT[w]; PRE[F.tid] += off; if (F.tid == 255) PRE[256] = PRE[255] + ((mycnt + 255) >> 8); }
    WG_SYNC();
    const int T = PRE[256];
    float c2, mc2; moba_shift(F, c2, mc2);
    const int i = F.lane & 31, hh = F.lane >> 5;
    const int it0 = (int)(((long long)F.vcu * T) / F.G), it1 = (int)(((long long)(F.vcu + 1) * T) / F.G);
    int cur_hj = -1;
    int hj = 0, chunk = 0, tq = 0, slot = 0; bool active = false, valid = false; bf16x8 qf[8];
#pragma unroll
    for (int s = 0; s < 8; ++s) qf[s] = (bf16x8){0, 0, 0, 0, 0, 0, 0, 0};
    if (it0 < it1) { mc_decode(PRE, it0, hj, chunk); const int n = (int)__hip_atomic_load(F.ctl + CW_CNT + hj, RLX_AGENT); mc_fetch(F, hj, chunk, n, i, hh, active, valid, tq, slot, qf); }
    for (int it = it0; it < it1; ++it) {
        const int h = hj >> 6, j = hj & 63;
        if (hj != cur_hj) { if (cur_hj >= 0) WG_SYNC(); moba_load_kv(F, h, j, KL, VL); WG_SYNC(); cur_hj = hj; }
        int hj2 = hj, chunk2 = 0, tq2 = 0, slot2 = 0; bool active2 = false, valid2 = false; bf16x8 qf2[8];
#pragma unroll
        for (int s = 0; s < 8; ++s) qf2[s] = qf[s];
        if (it + 1 < it1) { mc_decode(PRE, it + 1, hj2, chunk2); const int n2 = (int)__hip_atomic_load(F.ctl + CW_CNT + hj2, RLX_AGENT); mc_fetch(F, hj2, chunk2, n2, i, hh, active2, valid2, tq2, slot2, qf2); }
        if (active) {
            f32x16 acc[4]; float lsum = 0.f;
#pragma unroll
            for (int et = 0; et < 4; ++et)
#pragma unroll
                for (int r = 0; r < 16; ++r) acc[et][r] = 0.f;
            moba_wave_attend(qf, KL, VL, 8, -1, i, hh, c2, mc2, acc, lsum);
            lsum += __shfl_xor(lsum, 32);
            if (valid) {
                bf16* prow = part_g + ((size_t)(slot * 4 + h) * S_ + tq) * 128;
#pragma unroll
                for (int et = 0; et < 4; ++et)
#pragma unroll
                    for (int g = 0; g < 4; ++g) { u2_t w; w.x = pkbf(acc[et][4 * g], acc[et][4 * g + 1]); w.y = pkbf(acc[et][4 * g + 2], acc[et][4 * g + 3]); *(u2_t*)(prow + 32 * et + 8 * g + 4 * hh) = w; }
                if (hh == 0) lpart_g[(size_t)(slot * 4 + h) * S_ + tq] = lsum;
            }
        }
        hj = hj2; chunk = chunk2; tq = tq2; slot = slot2; active = active2; valid = valid2;
#pragma unroll
        for (int s = 0; s < 8; ++s) qf[s] = qf2[s];
    }
    WG_SYNC();
}

__device__ __forceinline__ void moba_d_item(Frame& F, int item, float c2, float mc2) {
    const int blk = item >> 2, h = item & 3;
    LAS bf16* KL = (LAS bf16*)(F.lds); LAS bf16* VL = (LAS bf16*)(F.lds + 256 * KROW * 2);
    const bf16* zb = (const bf16*)(F.ws + WS_Z); const bf16* part_g = (const bf16*)((const unsigned char*)F.out + OUT_PART); const float* lpart_g = (const float*)(F.ws + WS_LPART);
    bf16* mixb = (bf16*)(F.ws + WS_MIX);
    const int i = F.lane & 31, hh = F.lane >> 5;
    const int tq = blk * 256 + F.wave * 32 + i;
    bf16x8 qf[8];
    { const bf16* qrow = zb + (size_t)tq * ZW + Z_MQ + h * 128 + 8 * hh;
#pragma unroll
      for (int s = 0; s < 8; ++s) qf[s] = *(const bf16x8*)(qrow + 16 * s); }
    moba_load_kv(F, h, blk, KL, VL);
    WG_SYNC();
    f32x16 acc[4]; float lsum = 0.f;
#pragma unroll
    for (int et = 0; et < 4; ++et)
#pragma unroll
        for (int r = 0; r < 16; ++r) acc[et][r] = 0.f;
    moba_wave_attend(qf, KL, VL, F.wave + 1, F.wave, i, hh, c2, mc2, acc, lsum);
    lsum += __shfl_xor(lsum, 32);
    const int nsel = blk < 3 ? blk : 3;
    {
        u2_t pw[3][16]; float lp[3];
#pragma unroll
        for (int s = 0; s < 3; ++s) { if (s < nsel) { const bf16* prow = part_g + ((size_t)(s * 4 + h) * S_ + tq) * 128; lp[s] = lpart_g[(size_t)(s * 4 + h) * S_ + tq];
#pragma unroll
                for (int et = 0; et < 4; ++et)
#pragma unroll
                    for (int g = 0; g < 4; ++g) pw[s][4 * et + g] = *(const u2_t*)(prow + 32 * et + 8 * g + 4 * hh); } }
#pragma unroll
        for (int s = 0; s < 3; ++s) { if (s < nsel) { lsum += lp[s];
#pragma unroll
                for (int et = 0; et < 4; ++et)
#pragma unroll
                    for (int g = 0; g < 4; ++g) { const u2_t w = pw[s][4 * et + g];
                        acc[et][4 * g] += bf2f(w.x & 0xffffu); acc[et][4 * g + 1] += bf2f(w.x >> 16); acc[et][4 * g + 2] += bf2f(w.y & 0xffffu); acc[et][4 * g + 3] += bf2f(w.y >> 16); } } }
    }
    const float inv = 1.0f / lsum;
    bf16* orow = mixb + (size_t)tq * D_ + 512 + h * 128;
#pragma unroll
    for (int et = 0; et < 4; ++et)
#pragma unroll
        for (int g = 0; g < 4; ++g) { u2_t w; w.x = pkbf(acc[et][4 * g] * inv, acc[et][4 * g + 1] * inv); w.y = pkbf(acc[et][4 * g + 2] * inv, acc[et][4 * g + 3] * inv); *(u2_t*)(orow + 32 * et + 8 * g + 4 * hh) = w; }
    WG_SYNC();
}

struct Args { const void* in[18]; float* out; unsigned char* ws; int ph_lo, ph_hi, li, pad; };
constexpr int N_PHASES = 10;
__global__ void __launch_bounds__(NWAVES * 64, 2) mk_fwd(Args args) {
    extern __shared__ __attribute__((aligned(16))) unsigned char lds[];
    Frame F;
    F.lds = (LAS unsigned char*)lds;
    F.MISC = (volatile LAS unsigned*)(F.lds + MISC_OFF);
    F.tid = threadIdx.x; F.lane = F.tid & 63; F.wave = __builtin_amdgcn_readfirstlane(F.tid >> 6);
    F.G = gridDim.x; { const int bx = blockIdx.x; F.vcu = (F.G % 8 == 0) ? (bx % 8) * (F.G / 8) + bx / 8 : bx; }
    F.ws = args.ws; F.out = args.out; F.ctl = (gu32*)(args.ws + WS_CTL);
    if (F.tid < 32) F.MISC[F.tid] = 0u;
    if (F.tid == 0) {
#pragma unroll
        for (int k = 0; k < 18; ++k) { const unsigned long long pv = (unsigned long long)args.in[k]; F.MISC[32 + 2 * k] = (unsigned)pv; F.MISC[33 + 2 * k] = (unsigned)(pv >> 32); }
    }
    __syncthreads();
    XcdBarrier bar = xcd_barrier_post((unsigned*)(F.ctl + CW_BAR) + args.li * XCD_BAR_WORDS, F.MISC + 8);
    const int lo = args.ph_lo, hi = args.ph_hi;
#define IN(k) (lo <= (k) && (k) < hi)
#define SEAM(k) do { if (IN(k) && IN((k) + 1)) xcd_barrier(bar); STAMP((k) + 1); } while (0)
    bf16* xb = (bf16*)(F.ws + WS_AB); bf16* zb = (bf16*)(F.ws + WS_Z); bf16* mixb = (bf16*)(F.ws + WS_MIX); bf16* actb = (bf16*)(F.ws + WS_ACT); bf16* erawb = (bf16*)(F.ws + WS_ERAW);

    STAMP(0);
    if (IN(0)) { p0_prologue(F); } SEAM(0);
    if (IN(1)) {
        { pg8::Gemm g{xb, (const bf16*)(F.ws + WS_WIN), S_, ZW, D_}; pg8::StaticOrder S; S.init(S_, ZW, F.G, (int)blockIdx.x);
          pg8::EpiScale<0, 1> E{zb, ZW, (const float*)(F.ws + WS_RSTDX), EPS_};
          pg8::gemm_phase<pg8::EpiScale<0, 1>, pg8::StaticOrder, PG8_ALIGN, PG8_SP2>(F.lds + RING_OFF, g, S, E); }
        { pg8::Gemm g{(const bf16*)(F.ws + WS_PB), (const bf16*)(F.ws + WS_WPP), S_, D_, PLE_}; pg8::StaticOrder S; S.init(S_, D_, F.G, (int)blockIdx.x);
          pg8::EpiRes<0> E{nullptr, erawb, (float*)(F.ws + WS_SSQE), D_};
          pg8::gemm_phase<pg8::EpiRes<0>, pg8::StaticOrder, false, PG8_SP2>(F.lds + RING_OFF, g, S, E); }
    } SEAM(1);
    if (IN(2)) { for (int ch = F.vcu; ch < 256; ch += F.G) gla_a_chunk(F, ch); for (int ch = F.vcu; ch < 256; ch += F.G) moba_a_item(F, ch); } SEAM(2);
    if (IN(3)) { for (int pr = F.vcu; pr < 256; pr += F.G) gla_b_pair(F, pr); for (int pr = F.vcu; pr < 256; pr += F.G) moba_b_item(F, pr); } SEAM(3);
    if (IN(4)) { for (int ch = F.vcu; ch < 256; ch += F.G) gla_c_chunk(F, ch); moba_c_phase(F); } SEAM(4);
    if (IN(5)) { float c2, mc2; moba_shift(F, c2, mc2); for (int it = F.vcu; it < 256; it += F.G) moba_d_item(F, it, c2, mc2); } SEAM(5);
    if (IN(6)) {
        pg8::Gemm g{mixb, (const bf16*)(F.ws + WS_WOUT), S_, D_, D_}; pg8::StaticOrder S; S.init(S_, D_, F.G, (int)blockIdx.x);
        pg8::EpiRes<1> E{IN_x, xb, (float*)(F.ws + WS_SSQH1), D_};
        pg8::gemm_phase<pg8::EpiRes<1>, pg8::StaticOrder, false, PG8_SP2>(F.lds + RING_OFF, g, S, E);
    } SEAM(6);
    if (IN(7)) {
        pg8::Gemm g{xb, (const bf16*)(F.ws + WS_WUP), S_, FF_, D_}; pg8::StaticOrder S; S.init(S_, FF_, F.G, (int)blockIdx.x);
        pg8::EpiScale<1, 2> E{actb, FF_, (const float*)(F.ws + WS_SSQH1), EPS_};
        pg8::gemm_phase<pg8::EpiScale<1, 2>, pg8::StaticOrder, PG8_ALIGN, PG8_SP2>(F.lds + RING_OFF, g, S, E);
    } SEAM(7);
    if (IN(8)) {
        pg8::Gemm g{actb, (const bf16*)(F.ws + WS_WDOWN), S_, D_, FF_}; pg8::StaticOrder S; S.init(S_, D_, F.G, (int)blockIdx.x);
        pg8::EpiRes<2> E{nullptr, xb, (float*)(F.ws + WS_SSQH2), D_};
        pg8::gemm_phase<pg8::EpiRes<2>, pg8::StaticOrder, false, PG8_SP2>(F.lds + RING_OFF, g, S, E);
    } SEAM(8);
    if (IN(9)) {
        pg8::Gemm g{xb, (const bf16*)(F.ws + WS_WPG), S_, D_, D_}; pg8::StaticOrder S; S.init(S_, D_, F.G, (int)blockIdx.x);
        pg8::EpiGate E{F.out, xb, erawb, (const float*)(F.ws + WS_SSQH2), (const float*)(F.ws + WS_SSQE), IN_g_pe, D_, EPS_};
        pg8::gemm_phase<pg8::EpiGate, pg8::StaticOrder, false, PG8_SP2>(F.lds + RING_OFF, g, S, E);
    }
#ifdef PROBE_LO
    STAMP(10);
    if (blockIdx.x == 0 && F.tid == 0) {
        const unsigned long long a_ = ((unsigned long long)F.MISC[81 + 2 * PROBE_LO] << 32) | F.MISC[80 + 2 * PROBE_LO], b_ = ((unsigned long long)F.MISC[81 + 2 * PROBE_HI] << 32) | F.MISC[80 + 2 * PROBE_HI];
        const unsigned long long d_ = (b_ - a_) * PROBE_K, t0_ = rt();
        while (rt() - t0_ < d_) __builtin_amdgcn_s_sleep(8);
    }
#endif
#undef IN
#undef SEAM
}

namespace nv {
__device__ __forceinline__ float ldz(const bf16* z, int t, int col) { return bf2f(z[(size_t)t * ZW + col]); }
__device__ __forceinline__ float wave_max(float v) {
#pragma unroll
    for (int o = 1; o < 64; o <<= 1) v = fmaxf(v, __shfl_xor(v, o));
    return v;
}
__global__ void k_ga(const bf16* __restrict__ xb, const bf16* __restrict__ wga_t, const float* __restrict__ rstdx, float* __restrict__ ga) {
    const int idx = blockIdx.x * blockDim.x + threadIdx.x; if (idx >= S_ * 16) return;
    const int t = idx >> 4, r = idx & 15; float s = 0.f;
    for (int k = 0; k < D_; ++k) s += bf2f(xb[(size_t)t * D_ + k]) * bf2f(wga_t[r * D_ + k]);
    ga[idx] = s * rstdx[t];
}
__global__ void k_gla_prep(const float* __restrict__ ga, const float* __restrict__ w_a2, const float* __restrict__ b_a, float* __restrict__ a_out) {
    const int idx = blockIdx.x * blockDim.x + threadIdx.x; if (idx >= S_ * 256) return;
    const int t = idx >> 8, c = idx & 255; float s = b_a[c];
#pragma unroll
    for (int r = 0; r < 16; ++r) s += ga[t * 16 + r] * w_a2[r * 256 + c];
    const float ls = fminf(s, 0.f) - log1pf(expf(-fabsf(s)));
    a_out[idx] = expf(ls * (1.0f / 16.0f));
}
__global__ void __launch_bounds__(64) k_gla_rec(const bf16* __restrict__ z, const float* __restrict__ a, float* __restrict__ o_raw) {
    const int h = blockIdx.x >> 1, e = (blockIdx.x & 1) * 64 + threadIdx.x;
    float St[64];
#pragma unroll
    for (int d = 0; d < 64; ++d) St[d] = 0.f;
    for (int t = 0; t < S_; ++t) {
        const bf16* zr = z + (size_t)t * ZW;
        const float v = bf2f(zr[Z_GV + h * 128 + e]);
        const bf16* qr = zr + Z_GQ + h * 64; const bf16* kr = zr + Z_GK + h * 64; const float* ar = a + (size_t)t * 256 + h * 64;
        float o = 0.f;
#pragma unroll
        for (int d = 0; d < 64; ++d) { St[d] = ar[d] * St[d] + bf2f(kr[d]) * v; o += bf2f(qr[d]) * St[d]; }
        o_raw[(size_t)t * 512 + h * 128 + e] = o * 0.125f;
    }
}
__global__ void k_gla_post(const float* __restrict__ o_raw, const bf16* __restrict__ z, const float* __restrict__ g_out, bf16* __restrict__ mix) {
    const int wave = (blockIdx.x * blockDim.x + threadIdx.x) >> 6, lane = threadIdx.x & 63; if (wave >= S_ * 4) return;
    const int t = wave >> 2, h = wave & 3;
    const float o0 = o_raw[(size_t)t * 512 + h * 128 + lane], o1 = o_raw[(size_t)t * 512 + h * 128 + 64 + lane];
    const float ss = wave_sum(o0 * o0 + o1 * o1); const float r = 1.0f / sqrtf(ss * (1.0f / 128.0f) + EPS_);
    const float g0 = ldz(z, t, Z_GG + h * 128 + lane), g1 = ldz(z, t, Z_GG + h * 128 + 64 + lane);
    mix[(size_t)t * D_ + h * 128 + lane] = (bf16)f2bf(o0 * r * g_out[lane] * (g0 / (1.0f + expf(-g0))));
    mix[(size_t)t * D_ + h * 128 + 64 + lane] = (bf16)f2bf(o1 * r * g_out[64 + lane] * (g1 / (1.0f + expf(-g1))));
}
__device__ __forceinline__ void sincos_acc(float angf, float& s, float& c) {
    double r = (double)angf * 0.15915494309189533577; r -= floor(r);
    const double q = floor(4.0 * r + 0.5);
    const float phi = (float)((r - 0.25 * q) * 6.283185307179586477);
    const float p2 = phi * phi;
    const float sn = phi * (1.0f + p2 * (-1.0f / 6.0f + p2 * (1.0f / 120.0f + p2 * (-1.0f / 5040.0f + p2 * (1.0f / 362880.0f)))));
    const float cs = 1.0f + p2 * (-0.5f + p2 * (1.0f / 24.0f + p2 * (-1.0f / 720.0f + p2 * (1.0f / 40320.0f + p2 * (-1.0f / 3628800.0f)))));
    const int qi = ((int)q) & 3;
    s = (qi == 0) ? sn : (qi == 1) ? cs : (qi == 2) ? -sn : -cs;
    c = (qi == 0) ? cs : (qi == 1) ? -sn : (qi == 2) ? -cs : sn;
}
__global__ void k_moba_qk(bf16* __restrict__ z, const int* __restrict__ pos, const float* __restrict__ gq, const float* __restrict__ gk) {
    const int wave = (blockIdx.x * blockDim.x + threadIdx.x) >> 6, lane = threadIdx.x & 63; if (wave >= S_ * 8) return;
    const int t = wave >> 3, h = (wave >> 1) & 3, which = wave & 1;
    bf16* p = z + (size_t)t * ZW + (which ? Z_MK : Z_MQ) + h * 128; const float* g = which ? gk : gq;
    const float x1 = bf2f(p[lane]), x2 = bf2f(p[lane + 64]);
    const float ss = wave_sum(x1 * x1 + x2 * x2); const float r = 1.0f / sqrtf(ss * (1.0f / 128.0f) + EPS_);
    const float y1 = x1 * r * g[lane], y2 = x2 * r * g[lane + 64];
    const float inv = 1.0f / powf(10000.0f, (float)lane / 64.0f); const float ang = (float)pos[t] * inv;
    float sn, cs; sincos_acc(ang, sn, cs);
    p[lane] = (bf16)f2bf(y1 * cs - y2 * sn); p[lane + 64] = (bf16)f2bf(y2 * cs + y1 * sn);
}
__global__ void k_moba_kmean(const bf16* __restrict__ z, float* __restrict__ kmean) {
    const int h = blockIdx.x >> 6, blk = blockIdx.x & 63, d = threadIdx.x; float s = 0.f;
    for (int i = 0; i < 256; ++i) s += ldz(z, blk * 256 + i, Z_MK + h * 128 + d);
    kmean[(size_t)(h * 64 + blk) * 128 + d] = s * (1.0f / 256.0f);
}
__global__ void __launch_bounds__(256) k_moba_attn(const bf16* __restrict__ z, const float* __restrict__ kmean, bf16* __restrict__ mix) {
    __shared__ float pl[4][1024];
    const int w = threadIdx.x >> 6, lane = threadIdx.x & 63; const int wave = blockIdx.x * 4 + w; const int q = wave >> 2, h = wave & 3; const int kb = q >> 8;
    const bf16* qrow = z + (size_t)q * ZW + Z_MQ + h * 128; const float scale = 0.08838834764831845f;
    float g = -INFINITY;
    if (lane < kb) { const float* km = kmean + (size_t)(h * 64 + lane) * 128; float s = 0.f; for (int d = 0; d < 128; ++d) s += bf2f(qrow[d]) * km[d]; g = s; }
    int sel[3];
#pragma unroll
    for (int r = 0; r < 3; ++r) { const float m = wave_max(g); const unsigned long long bal = __ballot(g == m); const int idx = __ffsll((long long)bal) - 1; sel[r] = (m > -INFINITY) ? idx : -1; if (lane == idx) g = -INFINITY; }
    float sc[16];
#pragma unroll
    for (int seg = 0; seg < 4; ++seg) { const int blk = (seg < 3) ? sel[seg] : kb;
#pragma unroll
        for (int r = 0; r < 4; ++r) { float s = -INFINITY;
            if (blk >= 0) { const int key = blk * 256 + r * 64 + lane;
                if (seg < 3 || key <= q) { const bf16* kr = z + (size_t)key * ZW + Z_MK + h * 128; float a = 0.f; for (int d = 0; d < 128; ++d) a += bf2f(qrow[d]) * bf2f(kr[d]); s = a * scale; } }
            sc[seg * 4 + r] = s; } }
    float m = sc[0];
#pragma unroll
    for (int i = 1; i < 16; ++i) m = fmaxf(m, sc[i]);
    m = wave_max(m); float sum = 0.f;
#pragma unroll
    for (int i = 0; i < 16; ++i) { const float p = (sc[i] > -INFINITY) ? expf(sc[i] - m) : 0.f; sum += p; pl[w][i * 64 + lane] = p; }
    sum = wave_sum(sum); __syncthreads();
    float a0 = 0.f, a1 = 0.f;
#pragma unroll
    for (int seg = 0; seg < 4; ++seg) { const int blk = (seg < 3) ? sel[seg] : kb; if (blk < 0) continue; const int nk = (seg < 3) ? 256 : ((q & 255) + 1);
        for (int i = 0; i < nk; ++i) { const float p = pl[w][seg * 256 + i]; const bf16* vr = z + (size_t)(blk * 256 + i) * ZW + Z_MV + h * 128; a0 += p * bf2f(vr[lane]); a1 += p * bf2f(vr[lane + 64]); } }
    const float inv = 1.0f / sum;
    mix[(size_t)q * D_ + 512 + h * 128 + lane] = (bf16)f2bf(a0 * inv); mix[(size_t)q * D_ + 512 + h * 128 + 64 + lane] = (bf16)f2bf(a1 * inv);
}
}

static void launch_range(const Args& a0, int lo, int hi, int li, int grid, hipStream_t stream) {
    Args a = a0; a.ph_lo = lo; a.ph_hi = hi; a.li = li;
    hipLaunchKernelGGL(mk_fwd, dim3(grid), dim3(NWAVES * 64), LDS_BYTES, stream, a);
    const hipError_t le = hipPeekAtLastError();
    if (le != hipSuccess) fprintf(stderr, "kernel_launch: launch [%d,%d) failed: %s\n", lo, hi, hipGetErrorName(le));
}
extern "C" void kernel_launch(void* const* d_in, const int* in_sizes, int n_in, void* d_out, int out_size, void* d_ws, size_t ws_size, hipStream_t stream) {
    static int grid = 0;
    if (grid == 0) {
        if (n_in != 18 || out_size != S_ * D_ || ws_size < WS_END) { fprintf(stderr, "kernel_launch: unexpected shapes (n_in %d out %d ws %zu)\n", n_in, out_size, ws_size); grid = -1; return; }
        int dev = 0, cus = 0, per_cu = 0;
        if (hipGetDevice(&dev) != hipSuccess || hipDeviceGetAttribute(&cus, hipDeviceAttributeMultiprocessorCount, dev) != hipSuccess) { grid = -1; return; }
        if (hipFuncSetAttribute((const void*)mk_fwd, hipFuncAttributeMaxDynamicSharedMemorySize, LDS_BYTES) != hipSuccess) { fprintf(stderr, "kernel_launch: hipFuncSetAttribute failed\n"); grid = -1; return; }
        if (hipOccupancyMaxActiveBlocksPerMultiprocessor(&per_cu, (const void*)mk_fwd, NWAVES * 64, LDS_BYTES) != hipSuccess || per_cu < 1) { fprintf(stderr, "kernel_launch: occupancy query says %d\n", per_cu); per_cu = 1; }
        (void)hipGetLastError();
        grid = cus;
        if (grid != 256) fprintf(stderr, "kernel_launch: note: %d CUs\n", grid);
    }
    if (grid < 0) return;
    (void)hipMemsetAsync((char*)d_ws + WS_CTL, 0, CTL_ZERO_BYTES, stream);
    Args a{};
    for (int i = 0; i < 18; ++i) a.in[i] = d_in[i];
    a.out = (float*)d_out; a.ws = (unsigned char*)d_ws;
    launch_range(a, 0, N_PHASES, 0, grid, stream);
}
```

```cpp
#include <hip/hip_runtime.h>
#include <cstdio>
#include <cstdint>
#include <math.h>
namespace pg8 {
#define PG8_LAS __attribute__((address_space(3)))
typedef unsigned short bf16_t;
typedef short bf16x8 __attribute__((ext_vector_type(8)));
typedef float f32x4 __attribute__((ext_vector_type(4)));
typedef unsigned u32x4 __attribute__((ext_vector_type(4)));
constexpr int BM = 256, BK = 64, HALF = 128, HTB = HALF * BK * 2  , STAGE_BYTES = 8 * HTB, NXCD = 8, WGM = 8;

__host__ __device__ __forceinline__ int lds_byte(int r, int c) { const int st = (r >> 4) * 2 + (c >> 5), rr = r & 15, cc = c & 31, ob = rr * 64 + cc * 2; return st * 1024 + (ob ^ (((ob >> 9) & 1) << 5)); }
__host__ __device__ __forceinline__ void stage_rc(int b, int& R, int& C) { const int st = b / 1024, sb = b % 1024, swz = sb ^ (((sb >> 9) & 1) << 5); R = (st >> 1) * 16 + swz / 64; C = (st & 1) * 32 + (swz % 64) / 2; }
__host__ __device__ __forceinline__ int perm32(int rho) { const int n = rho >> 4, i = rho & 15; return 8 * (i >> 2) + 4 * n + (i & 3); }

struct Unit { int pm, pn; };
struct Gemm { const bf16_t* A; const bf16_t* Bt; int M, N, K; };

struct StaticOrder {
    int nM, nN, nwg, G, c;
    __host__ __device__ void init(int M, int N, int G_, int c_) { nM = M / BM; nN = N / BM; nwg = nM * nN; G = G_; c = c_; }
    __host__ __device__ bool next(int i, Unit& u) const {
        const long L = (long)i * G + c; if (L >= nwg) return false;
        int wgid = (int)L; { const int q = nwg / NXCD, r = nwg % NXCD, xcd = wgid % NXCD, off = wgid / NXCD; wgid = (xcd < r ? xcd * (q + 1) : r * (q + 1) + (xcd - r) * q) + off; }
        const int nig = WGM * nN, gid = wgid / nig, fm = gid * WGM, gsz = (nM - fm) < WGM ? (nM - fm) : WGM;
        u.pm = fm + ((wgid % nig) % gsz); u.pn = (wgid % nig) / gsz; return true;
    }
    __device__ __forceinline__ void a_ready(const Unit&) const {}
    __device__ __forceinline__ void done(const Unit&) const {}
};

__device__ __forceinline__ unsigned cvt_pk_bf16(float lo, float hi) { unsigned r; asm volatile("v_cvt_pk_bf16_f32 %0, %1, %2" : "=v"(r) : "v"(lo), "v"(hi)); return r; }
typedef float f32x2 __attribute__((ext_vector_type(2)));

__device__ __forceinline__ void st16_wt(void* p, u32x4 v) { asm volatile("global_store_dwordx4 %0, %1, off sc1\n\ts_nop 1" :: "v"(p), "v"(v) : "memory"); }

__device__ __forceinline__ float rstd_from_part(const float* part, int row, float inv_n, float eps) {
    const f32x4 p = *(const f32x4*)(part + (size_t)row * 4);
    return __builtin_amdgcn_rsqf(((p[0] + p[1]) + (p[2] + p[3])) * inv_n + eps);
}
template <int ACT, int RS> struct EpiScale {
    static constexpr bool PERM = true, AFTER_DRAIN = false;
    bf16_t* O; int ldc; const float* rsv; float eps;
    __device__ __forceinline__ void operator()(const f32x4 (&acc)[2][2][4][2], const Unit& u, int wr, int wc, int fr, int fq) const {
        const int row0 = u.pm * BM + wr * 64 + fr, col0 = u.pn * BM + wc * 32 + 8 * fq;
#pragma unroll
        for (int ai = 0; ai < 2; ++ai)
#pragma unroll
            for (int m = 0; m < 4; ++m) {
                const int row = row0 + ai * HALF + m * 16;
                float s = 1.f;
                if (RS == 1) s = rsv[row];
                if (RS == 2) s = rstd_from_part(rsv, row, 1.0f / 1024.0f, eps);
                bf16_t* rowp = O + (size_t)row * ldc + col0;
#pragma unroll
                for (int bj = 0; bj < 2; ++bj) {
                    f32x4 v0 = acc[ai][bj][m][0] * s, v1 = acc[ai][bj][m][1] * s;
                    if (ACT == 1) {
#pragma unroll
                        for (int e = 0; e < 4; ++e) { const float a = fmaxf(v0[e], 0.f), b = fmaxf(v1[e], 0.f); v0[e] = a * a; v1[e] = b * b; }
                    }
                    u32x4 w; w.x = cvt_pk_bf16(v0[0], v0[1]); w.y = cvt_pk_bf16(v0[2], v0[3]); w.z = cvt_pk_bf16(v1[0], v1[1]); w.w = cvt_pk_bf16(v1[2], v1[3]);
                    *(u32x4*)(rowp + bj * HALF) = w;
                }
            }
    }
};
template <int RES> struct EpiRes {
    static constexpr bool PERM = true, AFTER_DRAIN = true;
    const float* base; bf16_t* hb; float* part; int ldc;
    __device__ __forceinline__ void fused(f32x4 (&acc)[2][2][4][2], const Unit& u, int wr, int wc, int fr, int fq, PG8_LAS unsigned char* lds, int wid, int lane) const {
        PG8_LAS float* P = (PG8_LAS float*)lds;
        const int row0 = u.pm * BM + wr * 64 + fr, col0 = u.pn * BM + wc * 32 + 8 * fq;
#pragma unroll
        for (int ai = 0; ai < 2; ++ai) {
            f32x4 pre[4][2][2]; u32x4 preb[4][2];
            if (RES == 1) {
#pragma unroll
                for (int m = 0; m < 4; ++m) { const size_t off = (size_t)(row0 + ai * HALF + m * 16) * ldc + col0;
#pragma unroll
                    for (int bj = 0; bj < 2; ++bj) { pre[m][bj][0] = __builtin_nontemporal_load((const f32x4*)(base + off + bj * HALF)); pre[m][bj][1] = __builtin_nontemporal_load((const f32x4*)(base + off + bj * HALF + 4)); } }
            }
            if (RES == 2) {
#pragma unroll
                for (int m = 0; m < 4; ++m) { const size_t off = (size_t)(row0 + ai * HALF + m * 16) * ldc + col0;
#pragma unroll
                    for (int bj = 0; bj < 2; ++bj) preb[m][bj] = *(const u32x4*)(hb + off + bj * HALF); }
            }
#pragma unroll
            for (int m = 0; m < 4; ++m) {
                const int row = row0 + ai * HALF + m * 16;
                const size_t off = (size_t)row * ldc + col0;
                float q = 0.f;
#pragma unroll
                for (int bj = 0; bj < 2; ++bj) {
                    f32x4 v0 = acc[ai][bj][m][0], v1 = acc[ai][bj][m][1];
                    if (RES == 1) { v0 = v0 + pre[m][bj][0]; v1 = v1 + pre[m][bj][1]; }
                    if (RES == 2) { const u32x4 ew = preb[m][bj];
                        v0[0] += __uint_as_float(ew.x << 16); v0[1] += __uint_as_float(ew.x & 0xffff0000u); v0[2] += __uint_as_float(ew.y << 16); v0[3] += __uint_as_float(ew.y & 0xffff0000u);
                        v1[0] += __uint_as_float(ew.z << 16); v1[1] += __uint_as_float(ew.z & 0xffff0000u); v1[2] += __uint_as_float(ew.w << 16); v1[3] += __uint_as_float(ew.w & 0xffff0000u); }
                    u32x4 w; w.x = cvt_pk_bf16(v0[0], v0[1]); w.y = cvt_pk_bf16(v0[2], v0[3]); w.z = cvt_pk_bf16(v1[0], v1[1]); w.w = cvt_pk_bf16(v1[2], v1[3]);
                    *(u32x4*)(hb + off + bj * HALF) = w;
                    q += (v0[0] * v0[0] + v0[1] * v0[1]) + (v0[2] * v0[2] + v0[3] * v0[3]) + (v1[0] * v1[0] + v1[1] * v1[1]) + (v1[2] * v1[2] + v1[3] * v1[3]);
                }
                q += __shfl_xor(q, 16); q += __shfl_xor(q, 32);
                if (fq == 0) P[(ai * HALF + wr * 64 + m * 16 + fr) * 4 + wc] = q;
            }
        }
        asm volatile("s_waitcnt lgkmcnt(0)" ::: "memory"); __builtin_amdgcn_s_barrier(); asm volatile("" ::: "memory");
        const int tid = wid * 64 + lane;
        if (tid < 256) { const f32x4 p = ((const PG8_LAS f32x4*)lds)[tid]; part[(size_t)(u.pm * BM + tid) * 4 + u.pn] = (p[0] + p[1]) + (p[2] + p[3]); }
        asm volatile("s_waitcnt lgkmcnt(0)" ::: "memory"); __builtin_amdgcn_s_barrier(); asm volatile("" ::: "memory");
    }
};
struct EpiGate {
    static constexpr bool PERM = true, AFTER_DRAIN = false;
    float* out; const bf16_t* hb; const bf16_t* eraw; const float* part_h; const float* part_e; const float* g_emb; int ldc; float eps;
    __device__ __forceinline__ void operator()(const f32x4 (&acc)[2][2][4][2], const Unit& u, int wr, int wc, int fr, int fq) const {
        const int row0 = u.pm * BM + wr * 64 + fr, col0 = u.pn * BM + wc * 32 + 8 * fq;
        f32x4 gv[2][2];
#pragma unroll
        for (int bj = 0; bj < 2; ++bj) { gv[bj][0] = *(const f32x4*)(g_emb + col0 + bj * HALF); gv[bj][1] = *(const f32x4*)(g_emb + col0 + bj * HALF + 4); }
#pragma unroll
        for (int ai = 0; ai < 2; ++ai)
#pragma unroll
            for (int mp = 0; mp < 2; ++mp) {
                u32x4 hv[2][2]; u32x4 ewv[2][2]; float sh[2], se[2];
#pragma unroll
                for (int mm = 0; mm < 2; ++mm) { const int row = row0 + ai * HALF + (2 * mp + mm) * 16; const size_t off = (size_t)row * ldc + col0;
                    sh[mm] = rstd_from_part(part_h, row, 1.0f / 1024.0f, eps); se[mm] = rstd_from_part(part_e, row, 1.0f / 1024.0f, eps);
#pragma unroll
                    for (int bj = 0; bj < 2; ++bj) { ewv[mm][bj] = __builtin_nontemporal_load((const u32x4*)(eraw + off + bj * HALF)); hv[mm][bj] = __builtin_nontemporal_load((const u32x4*)(hb + off + bj * HALF)); } }
#pragma unroll
                for (int mm = 0; mm < 2; ++mm) { const int m = 2 * mp + mm; const int row = row0 + ai * HALF + m * 16; const size_t off = (size_t)row * ldc + col0;
#pragma unroll
                    for (int bj = 0; bj < 2; ++bj) {
                        const u32x4 ew = ewv[mm][bj];
                        f32x4 e0, e1;
                        e0[0] = __uint_as_float(ew.x << 16); e0[1] = __uint_as_float(ew.x & 0xffff0000u); e0[2] = __uint_as_float(ew.y << 16); e0[3] = __uint_as_float(ew.y & 0xffff0000u);
                        e1[0] = __uint_as_float(ew.z << 16); e1[1] = __uint_as_float(ew.z & 0xffff0000u); e1[2] = __uint_as_float(ew.w << 16); e1[3] = __uint_as_float(ew.w & 0xffff0000u);
                        const u32x4 hw = hv[mm][bj];
                        f32x4 h0, h1;
                        h0[0] = __uint_as_float(hw.x << 16); h0[1] = __uint_as_float(hw.x & 0xffff0000u); h0[2] = __uint_as_float(hw.y << 16); h0[3] = __uint_as_float(hw.y & 0xffff0000u);
                        h1[0] = __uint_as_float(hw.z << 16); h1[1] = __uint_as_float(hw.z & 0xffff0000u); h1[2] = __uint_as_float(hw.w << 16); h1[3] = __uint_as_float(hw.w & 0xffff0000u);
                        const f32x4 a0 = acc[ai][bj][m][0] * sh[mm], a1 = acc[ai][bj][m][1] * sh[mm];
#pragma unroll
                        for (int e = 0; e < 4; ++e) {
                            const float g0 = __builtin_amdgcn_rcpf(1.0f + __expf(-a0[e])), g1 = __builtin_amdgcn_rcpf(1.0f + __expf(-a1[e]));
                            h0[e] += g0 * (e0[e] * se[mm] * gv[bj][0][e]); h1[e] += g1 * (e1[e] * se[mm] * gv[bj][1][e]);
                        }
                        __builtin_nontemporal_store(h0, (f32x4*)(out + off + bj * HALF)); __builtin_nontemporal_store(h1, (f32x4*)(out + off + bj * HALF + 4));
                    } }
            }
    }
};
template <class Epi, class Sched, bool ALIGN_EPI = false, bool SP2 = false>
__device__ __forceinline__ void gemm_phase(PG8_LAS unsigned char* lds, const Gemm g, const Sched& S, const Epi& E) {
    const int tid = threadIdx.x, wid = __builtin_amdgcn_readfirstlane(tid >> 6), lane = tid & 63, wr = wid >> 2, wc = wid & 3, fr = lane & 15, fq = lane >> 4;
    const int K = g.K, nt = K / BK;
    unsigned voffA[2], voffB[2];
#pragma unroll
    for (int i = 0; i < 2; ++i) { int R, C; stage_rc(tid * 16 + i * 8192, R, C); const int Rb = Epi::PERM ? ((R & ~31) + perm32(R & 31)) : R;
        voffA[i] = (unsigned)(R * K + C) * 2u; voffB[i] = (unsigned)(Rb * K + C) * 2u; }
    const size_t kstep = (size_t)(BK * 2);
    const size_t hstep = (size_t)HALF * K * 2;
    const size_t tstep = 2 * hstep;
    const unsigned ldsw = (unsigned)wid * 1024u;
    const int aoff = lds_byte(wr * 64 + fr, fq * 8), boff = lds_byte(wc * 32 + fr, fq * 8);
#define PG8_SA(b, h) (((b) * 2 + (h)) * HTB)
#define PG8_SB(b, h) ((4 + (b) * 2 + (h)) * HTB)
#define PG8_STAGE(bufoff, gbase, voff) do { _Pragma("unroll") for (int _i = 0; _i < 2; ++_i) \
        __builtin_amdgcn_global_load_lds((const unsigned*)((const char*)(gbase) + (voff)[_i]), (PG8_LAS unsigned*)(lds + (bufoff) + ldsw + _i * 8192), 16, 0, 0); } while (0)
#define PG8_LDA(dst, b, h) do { _Pragma("unroll") for (int m = 0; m < 4; ++m) _Pragma("unroll") for (int k = 0; k < 2; ++k) dst[m][k] = *(const PG8_LAS bf16x8*)(lds + PG8_SA(b, h) + aoff + m * 2048 + k * 1024); } while (0)
#define PG8_LDB(dst, b, h) do { _Pragma("unroll") for (int n = 0; n < 2; ++n) _Pragma("unroll") for (int k = 0; k < 2; ++k) dst[n][k] = *(const PG8_LAS bf16x8*)(lds + PG8_SB(b, h) + boff + n * 2048 + k * 1024); } while (0)
#define PG8_MMA(ai, bj, At, Bt) do { __builtin_amdgcn_s_setprio(1); _Pragma("unroll") for (int m = 0; m < 4; ++m) _Pragma("unroll") for (int n = 0; n < 2; ++n) _Pragma("unroll") for (int k = 0; k < 2; ++k) \
        acc[ai][bj][m][n] = __builtin_amdgcn_mfma_f32_16x16x32_bf16(Bt[n][k], At[m][k], acc[ai][bj][m][n], 0, 0, 0); __builtin_amdgcn_s_setprio(0); } while (0)
#define PG8_WAIT_V(n) asm volatile("s_waitcnt vmcnt(" #n ")" ::: "memory")
#define PG8_WAIT_L(n) asm volatile("s_waitcnt lgkmcnt(" #n ")" ::: "memory")
#define PG8_BAR __builtin_amdgcn_s_barrier()
#define PG8_SCHED __builtin_amdgcn_sched_barrier(0)
    Unit cur, nxt; int ui = 0;
    if (!S.next(0, cur)) return;
    f32x4 acc[2][2][4][2];
#pragma unroll
    for (int a = 0; a < 2; ++a)
#pragma unroll
        for (int b = 0; b < 2; ++b)
#pragma unroll
            for (int m = 0; m < 4; ++m)
#pragma unroll
                for (int n = 0; n < 2; ++n) acc[a][b][m][n] = (f32x4){0.f, 0.f, 0.f, 0.f};
    bf16x8 At[4][2], B0[2][2], B1[2][2];
    const char* cA = (const char*)g.A + (size_t)cur.pm * tstep; const char* cB = (const char*)g.Bt + (size_t)cur.pn * tstep;
    S.a_ready(cur);
    if constexpr (SP2) {
        PG8_STAGE(PG8_SB(0, 0), cB, voffB); PG8_STAGE(PG8_SB(0, 1), cB + hstep, voffB); PG8_STAGE(PG8_SA(0, 0), cA, voffA); PG8_STAGE(PG8_SA(0, 1), cA + hstep, voffA);
        if (wr == 1) PG8_BAR;
        PG8_WAIT_V(2); PG8_BAR;
        PG8_STAGE(PG8_SB(1, 0), cB + kstep, voffB); PG8_STAGE(PG8_SA(1, 0), cA + kstep, voffA); PG8_STAGE(PG8_SB(1, 1), cB + hstep + kstep, voffB);
        PG8_WAIT_V(6); PG8_BAR;
    } else {
        PG8_STAGE(PG8_SB(0, 0), cB, voffB); PG8_STAGE(PG8_SA(0, 0), cA, voffA); PG8_STAGE(PG8_SB(0, 1), cB + hstep, voffB); PG8_STAGE(PG8_SA(0, 1), cA + hstep, voffA);
        if (wr == 1) PG8_BAR;
        PG8_WAIT_V(4); PG8_BAR;
        PG8_STAGE(PG8_SB(1, 0), cB + kstep, voffB); PG8_STAGE(PG8_SA(1, 0), cA + kstep, voffA); PG8_STAGE(PG8_SB(1, 1), cB + hstep + kstep, voffB);
        PG8_WAIT_V(6); PG8_BAR;
    }
    for (;;) {
        const bool has_next = S.next(ui + 1, nxt);
        const char* nA = has_next ? (const char*)g.A + (size_t)nxt.pm * tstep : cA; const char* nB = has_next ? (const char*)g.Bt + (size_t)nxt.pn * tstep : cB;
        for (int t = 0; t < nt; t += 2) {
            const bool last = (t == nt - 2);
            const char* a1 = cA + (size_t)(t + 1) * kstep;
            const char* a2 = last ? nA : cA + (size_t)(t + 2) * kstep; const char* b2 = last ? nB : cB + (size_t)(t + 2) * kstep;
            const char* a3 = a2 + kstep; const char* b3 = b2 + kstep;
            if (last && has_next) S.a_ready(nxt);
            if constexpr (SP2) {
            PG8_LDB(B0, 0, 0); PG8_LDB(B1, 0, 1); PG8_SCHED; PG8_LDA(At, 0, 0); PG8_STAGE(PG8_SA(1, 1), a1 + hstep, voffA);
            PG8_WAIT_V(8); PG8_WAIT_L(0); PG8_BAR; PG8_MMA(0, 0, At, B0); PG8_MMA(0, 1, At, B1); PG8_BAR; PG8_SCHED;
            PG8_LDA(At, 0, 1); PG8_STAGE(PG8_SB(0, 0), b2, voffB); PG8_STAGE(PG8_SB(0, 1), b2 + hstep, voffB); PG8_STAGE(PG8_SA(0, 0), a2, voffA);
            PG8_WAIT_V(8); PG8_WAIT_L(0); PG8_BAR; PG8_MMA(1, 0, At, B0); PG8_MMA(1, 1, At, B1); PG8_BAR; PG8_SCHED;
            PG8_LDB(B0, 1, 0); PG8_LDB(B1, 1, 1); PG8_SCHED; PG8_LDA(At, 1, 0); PG8_STAGE(PG8_SA(0, 1), a2 + hstep, voffA);
            PG8_WAIT_V(8); PG8_WAIT_L(0); PG8_BAR; PG8_MMA(0, 0, At, B0); PG8_MMA(0, 1, At, B1); PG8_BAR; PG8_SCHED;
            PG8_LDA(At, 1, 1); PG8_STAGE(PG8_SB(1, 0), b3, voffB); PG8_STAGE(PG8_SB(1, 1), b3 + hstep, voffB); PG8_STAGE(PG8_SA(1, 0), a3, voffA);
            PG8_WAIT_V(8); PG8_WAIT_L(0); PG8_BAR; PG8_MMA(1, 0, At, B0); PG8_MMA(1, 1, At, B1); PG8_BAR; PG8_SCHED;
            } else {
            PG8_LDB(B0, 0, 0); PG8_SCHED; PG8_LDA(At, 0, 0); PG8_STAGE(PG8_SA(1, 1), a1 + hstep, voffA);
            PG8_WAIT_L(8); PG8_BAR; PG8_WAIT_L(0); PG8_MMA(0, 0, At, B0); PG8_BAR; PG8_SCHED;
            PG8_LDB(B1, 0, 1); PG8_STAGE(PG8_SB(0, 0), b2, voffB);
            PG8_BAR; PG8_WAIT_L(0); PG8_MMA(0, 1, At, B1); PG8_BAR;
            PG8_LDA(At, 0, 1); PG8_STAGE(PG8_SA(0, 0), a2, voffA);
            PG8_BAR; PG8_WAIT_L(0); PG8_MMA(1, 0, At, B0); PG8_BAR; PG8_SCHED;
            PG8_STAGE(PG8_SB(0, 1), b2 + hstep, voffB);
            PG8_WAIT_V(6); PG8_BAR; PG8_MMA(1, 1, At, B1); PG8_BAR;
            PG8_LDB(B0, 1, 0); PG8_SCHED; PG8_LDA(At, 1, 0); PG8_STAGE(PG8_SA(0, 1), a2 + hstep, voffA);
            PG8_WAIT_L(8); PG8_BAR; PG8_WAIT_L(0); PG8_MMA(0, 0, At, B0); PG8_BAR; PG8_SCHED;
            PG8_LDB(B1, 1, 1); PG8_STAGE(PG8_SB(1, 0), b3, voffB);
            PG8_BAR; PG8_WAIT_L(0); PG8_MMA(0, 1, At, B1); PG8_BAR;
            PG8_LDA(At, 1, 1); PG8_STAGE(PG8_SA(1, 0), a3, voffA);
            PG8_BAR; PG8_WAIT_L(0); PG8_MMA(1, 0, At, B0); PG8_BAR; PG8_SCHED;
            PG8_STAGE(PG8_SB(1, 1), b3 + hstep, voffB);
            PG8_WAIT_V(6); PG8_BAR; PG8_MMA(1, 1, At, B1); PG8_BAR;
            }
        }
        if constexpr (ALIGN_EPI) { if (wr == 0) PG8_BAR; }
        if constexpr (!Epi::AFTER_DRAIN) { E(acc, cur, wr, wc, fr, fq); S.done(cur); }
        if (!has_next) break;
#pragma unroll
        for (int a = 0; a < 2; ++a)
#pragma unroll
            for (int b = 0; b < 2; ++b)
#pragma unroll
                for (int m = 0; m < 4; ++m)
#pragma unroll
                    for (int n = 0; n < 2; ++n) acc[a][b][m][n] = (f32x4){0.f, 0.f, 0.f, 0.f};
        cur = nxt; cA = nA; cB = nB; ++ui;
        if constexpr (ALIGN_EPI) { if (wr == 1) PG8_BAR; }
    }
    PG8_WAIT_V(0);
    if constexpr (!ALIGN_EPI) { if (wr == 0) PG8_BAR; }
    PG8_BAR;
    if constexpr (Epi::AFTER_DRAIN) { E.fused(acc, cur, wr, wc, fr, fq, lds, wid, lane); S.done(cur); }
#undef PG8_SA
#undef PG8_SB
#undef PG8_STAGE
#undef PG8_LDA
#undef PG8_LDB
#undef PG8_MMA
#undef PG8_WAIT_V
#undef PG8_WAIT_L
#undef PG8_BAR
#undef PG8_SCHED
}
}
#ifndef PG8_SP2
#define PG8_SP2 true
#endif
#ifndef PG8_ALIGN
#define PG8_ALIGN true
#endif

constexpr int NWAVES = 8;
constexpr int S_ = 16384, D_ = 1024, FF_ = 4096, PLE_ = 256, INW_ = 3088, ZW = 3072;
constexpr int Z_GQ = 0, Z_GK = 256, Z_GV = 512, Z_GG = 1024, Z_MQ = 1536, Z_MK = 2048, Z_MV = 2560;
constexpr float EPS_ = 1e-6f;

constexpr size_t MiB = 1u << 20, KiB = 1u << 10;
constexpr size_t WS_CTL = 0, CTL_ZERO_BYTES = 64 * KiB;
constexpr size_t WS_WIN = 1 * MiB, WS_WOUT = 7 * MiB, WS_WUP = 9 * MiB, WS_WDOWN = 17 * MiB, WS_WPG = 25 * MiB, WS_WPP = 27 * MiB, WS_WGA = 27 * MiB + 512 * KiB;
constexpr size_t WS_SMALL = 28 * MiB;
constexpr size_t WS_RSTDX = WS_SMALL, WS_GA = WS_SMALL + 64 * KiB, WS_DECAY = WS_SMALL + 1088 * KiB, WS_KMEAN = WS_SMALL + 1344 * KiB,
                 WS_SSQH1 = WS_SMALL + 1472 * KiB, WS_SSQH2 = WS_SMALL + 1728 * KiB, WS_SSQE = WS_SMALL + 1984 * KiB, WS_LPART = WS_SMALL + 2240 * KiB;
constexpr size_t WS_ERAW = 32 * MiB, WS_AB = 64 * MiB, WS_Z = 96 * MiB, WS_MIX = 192 * MiB, WS_PB = 224 * MiB, WS_ACT = 96 * MiB, WS_END = 256 * MiB;
constexpr size_t WS_DS = 224 * MiB, WS_SPREV = 64 * MiB, WS_LIST = 80 * MiB;
constexpr size_t OUT_PART = 0, OUT_VT = 48 * MiB;
constexpr int CW_TMO = 0, CW_CNT = 1024  , CW_BAR = 4096;

constexpr int RING_OFF = 0, RING_BYTES = 131072;
constexpr int LDS_BYTES = 160 * 1024;
constexpr int MISC_OFF = LDS_BYTES - 512;

#define GAS __attribute__((address_space(1)))
#define LAS __attribute__((address_space(3)))
typedef unsigned short bf16;
typedef unsigned v4u __attribute__((ext_vector_type(4)));
typedef float f32x4 __attribute__((ext_vector_type(4)));
typedef short bf16x8 __attribute__((ext_vector_type(8)));
typedef GAS unsigned gu32;
typedef GAS unsigned long long gu64;
#define RLX_AGENT __ATOMIC_RELAXED, __HIP_MEMORY_SCOPE_AGENT
#define LDS_WAIT() asm volatile("s_waitcnt lgkmcnt(0)" ::: "memory")
#define VM_WAIT() asm volatile("s_waitcnt vmcnt(0)" ::: "memory")
__device__ __forceinline__ unsigned long long rt() { return __builtin_amdgcn_s_memrealtime(); }
__device__ __forceinline__ unsigned f2bf(float f) { unsigned u = __builtin_bit_cast(unsigned, f); return (u + 0x7fffu + ((u >> 16) & 1u)) >> 16; }
__device__ __forceinline__ unsigned pk2(float lo, float hi) { return f2bf(lo) | (f2bf(hi) << 16); }

#define XB_TMO      128
#define XB_XCNT(j)  (256  + 64 * (j))
#define XB_XSUB(j)  (1280 + 64 * (j))
#define XB_XGEN(j)  (2304 + 64 * (j))
#define XB_TOP      3328
#define XB_TOPGEN   3392
#define XCD_BAR_WORDS 3456
#define XB_SPIN_CAP (1u << 18)

__device__ __forceinline__ unsigned xb_ld(unsigned* p)              { return __hip_atomic_load(p, __ATOMIC_RELAXED, __HIP_MEMORY_SCOPE_AGENT); }
__device__ __forceinline__ unsigned xb_add(unsigned* p, unsigned v) { return __hip_atomic_fetch_add(p, v, __ATOMIC_RELAXED, __HIP_MEMORY_SCOPE_AGENT); }
__device__ __forceinline__ unsigned xb_xcc_id() { return (unsigned)__builtin_amdgcn_s_getreg((3 << 11) | 20) & 0xFu; }
#define XB_SPIN(cond, bar) do { unsigned _sp = 0; while (cond) { __builtin_amdgcn_s_sleep(1); \
    if ((++_sp & 255u) == 0u) { if (xb_ld(&(bar)[XB_TMO])) break; if (_sp > XB_SPIN_CAP) { atomicAdd(&(bar)[XB_TMO], 1u); break; } } } } while (0)

struct XcdBarrier {
    unsigned* bar; unsigned x;
    volatile LAS unsigned* st;
};

__device__ __forceinline__ XcdBarrier xcd_barrier_post(unsigned* bar, volatile LAS unsigned* st) {
    XcdBarrier b; b.bar = bar; b.x = xb_xcc_id(); b.st = st;
    if (threadIdx.x == 0) (void)xb_add(&bar[XB_XCNT(b.x)], 1u);
    return b;
}
__device__ __forceinline__ void xcd_barrier_complete(unsigned* bar, unsigned x, unsigned& nloc, unsigned& nx) {
    const unsigned G = gridDim.x * gridDim.y * gridDim.z;
    unsigned sum, cnt, mine, sp = 0u;
    for (;;) {
        sum = 0u; cnt = 0u; mine = 0u;
#pragma unroll
        for (unsigned j = 0; j < 16; ++j) { const unsigned c = xb_ld(&bar[XB_XCNT(j)]); sum += c; cnt += (c > 0u) ? 1u : 0u; mine = (j == x) ? c : mine; }
        if (sum == G) break;
        __builtin_amdgcn_s_sleep(1);
        if ((++sp & 255u) == 0u) { if (xb_ld(&bar[XB_TMO])) break; if (sp > XB_SPIN_CAP) { atomicAdd(&bar[XB_TMO], 1u); break; } }
    }
    nloc = mine > 0u ? mine : 1u; nx = cnt > 0u ? cnt : 1u;
}

__device__ __forceinline__ void xcd_barrier(const XcdBarrier& b) {
    asm volatile("s_waitcnt vmcnt(0)" ::: "memory");
    __syncthreads();
    if (threadIdx.x == 0) {
        unsigned* bar = b.bar;
        __builtin_amdgcn_s_waitcnt(0);
        unsigned nloc = b.st[0], nx = b.st[1];
        if (nloc == 0u) { xcd_barrier_complete(bar, b.x, nloc, nx); b.st[0] = nloc; b.st[1] = nx; }
        const unsigned old = xb_add(&bar[XB_XSUB(b.x)], 1u);
        const unsigned gen = old / nloc;
        if (old + 1u == (gen + 1u) * nloc) {
            __builtin_amdgcn_fence(__ATOMIC_RELEASE, "agent");
            asm volatile("s_waitcnt vmcnt(0)" ::: "memory");
            const unsigned og = xb_add(&bar[XB_TOP], 1u);
            const unsigned tg = og / nx;
            if (og + 1u == (tg + 1u) * nx) xb_add(&bar[XB_TOPGEN], 1u);
            else XB_SPIN(xb_ld(&bar[XB_TOPGEN]) == tg, bar);
            __builtin_amdgcn_fence(__ATOMIC_ACQUIRE, "agent");
            xb_add(&bar[XB_XGEN(b.x)], 1u);
            asm volatile("s_waitcnt vmcnt(0)" ::: "memory");
        } else {
            XB_SPIN(xb_ld(&bar[XB_XGEN(b.x)]) == gen, bar);
            __builtin_amdgcn_fence(__ATOMIC_ACQUIRE, "agent");
            asm volatile("s_waitcnt vmcnt(0)" ::: "memory");
        }
    }
    __syncthreads();
}

struct Frame {
    LAS unsigned char* lds;
    volatile LAS unsigned* MISC;
    gu32* ctl;
    int tid, lane, wave, vcu, G;
    unsigned char* ws; float* out;
};
__device__ __forceinline__ const void* in_ptr(const Frame& F, int k) {
    const unsigned lo = __builtin_amdgcn_readfirstlane(F.MISC[32 + 2 * k]), hi = __builtin_amdgcn_readfirstlane(F.MISC[33 + 2 * k]);
    return (const void*)(((unsigned long long)hi << 32) | lo);
}
#define IN_x ((const float*)in_ptr(F, 0))
#define IN_p ((const float*)in_ptr(F, 1))
#define IN_pos ((const int*)in_ptr(F, 2))
#define IN_g_mix ((const float*)in_ptr(F, 3))
#define IN_w_in ((const float*)in_ptr(F, 4))
#define IN_w_a2 ((const float*)in_ptr(F, 5))
#define IN_b_a ((const float*)in_ptr(F, 6))
#define IN_g_gla ((const float*)in_ptr(F, 7))
#define IN_g_mq ((const float*)in_ptr(F, 8))
#define IN_g_mk ((const float*)in_ptr(F, 9))
#define IN_w_out ((const float*)in_ptr(F, 10))
#define IN_g_ffn ((const float*)in_ptr(F, 11))
#define IN_w_up ((const float*)in_ptr(F, 12))
#define IN_w_down ((const float*)in_ptr(F, 13))
#define IN_g_pg ((const float*)in_ptr(F, 14))
#define IN_w_pg ((const float*)in_ptr(F, 15))
#define IN_w_pp ((const float*)in_ptr(F, 16))
#define IN_g_pe ((const float*)in_ptr(F, 17))
template <int CTRL> __device__ __forceinline__ float dpp_mov(float v) { return __builtin_bit_cast(float, __builtin_amdgcn_update_dpp(0, __builtin_bit_cast(int, v), CTRL, 0xf, 0xf, true)); }
__device__ __forceinline__ float row16_sum(float v) { v += dpp_mov<0xB1>(v); v += dpp_mov<0x4E>(v); v += dpp_mov<0x141>(v); v += dpp_mov<0x140>(v); return v; }
__device__ __forceinline__ float wave_sum(float v) {
    v = row16_sum(v);
    const float s0 = __builtin_bit_cast(float, __builtin_amdgcn_readlane(__builtin_bit_cast(int, v), 0)), s1 = __builtin_bit_cast(float, __builtin_amdgcn_readlane(__builtin_bit_cast(int, v), 16));
    const float s2 = __builtin_bit_cast(float, __builtin_amdgcn_readlane(__builtin_bit_cast(int, v), 32)), s3 = __builtin_bit_cast(float, __builtin_amdgcn_readlane(__builtin_bit_cast(int, v), 48));
    return (s0 + s1) + (s2 + s3);
}
__device__ __forceinline__ float bf2f(unsigned v16) { return __uint_as_float(v16 << 16); }

#ifdef PROBE_LO
#define STAMP(k) do { if (blockIdx.x == 0 && F.tid == 0) { const unsigned long long t_ = rt(); F.MISC[80 + 2 * (k)] = (unsigned)t_; F.MISC[81 + 2 * (k)] = (unsigned)(t_ >> 32); } } while (0)
#else
#define STAMP(k) do { } while (0)
#endif
struct TItem { const float* W; const float* gain; bf16* WT; int ldn, src_col, K, n_dst, k0; };
__device__ __forceinline__ TItem p0_decode(const Frame& F, int it) {
    constexpr int I_IN = (D_ / 64) * (ZW / 32), I_OUT = (D_ / 64) * (D_ / 32), I_UP = (D_ / 64) * (FF_ / 32), I_DN = (FF_ / 64) * (D_ / 32), I_PG = I_OUT;
    TItem t; int r = it;
    if (r < I_IN) { const int nb = r % (ZW / 32), kb = r / (ZW / 32), n0 = 32 * nb; t.W = IN_w_in; t.gain = IN_g_mix; t.WT = (bf16*)(F.ws + WS_WIN); t.ldn = INW_; t.src_col = n0 < 1536 ? n0 : n0 + 16; t.K = D_; t.n_dst = n0; t.k0 = 64 * kb; return t; } r -= I_IN;
    if (r < I_OUT) { const int nb = r % (D_ / 32), kb = r / (D_ / 32); t.W = IN_w_out; t.gain = nullptr; t.WT = (bf16*)(F.ws + WS_WOUT); t.ldn = D_; t.src_col = 32 * nb; t.K = D_; t.n_dst = 32 * nb; t.k0 = 64 * kb; return t; } r -= I_OUT;
    if (r < I_UP) { const int nb = r % (FF_ / 32), kb = r / (FF_ / 32); t.W = IN_w_up; t.gain = IN_g_ffn; t.WT = (bf16*)(F.ws + WS_WUP); t.ldn = FF_; t.src_col = 32 * nb; t.K = D_; t.n_dst = 32 * nb; t.k0 = 64 * kb; return t; } r -= I_UP;
    if (r < I_DN) { const int nb = r % (D_ / 32), kb = r / (D_ / 32); t.W = IN_w_down; t.gain = nullptr; t.WT = (bf16*)(F.ws + WS_WDOWN); t.ldn = D_; t.src_col = 32 * nb; t.K = FF_; t.n_dst = 32 * nb; t.k0 = 64 * kb; return t; } r -= I_DN;
    if (r < I_PG) { const int nb = r % (D_ / 32), kb = r / (D_ / 32); t.W = IN_w_pg; t.gain = IN_g_pg; t.WT = (bf16*)(F.ws + WS_WPG); t.ldn = D_; t.src_col = 32 * nb; t.K = D_; t.n_dst = 32 * nb; t.k0 = 64 * kb; return t; } r -= I_PG;
    { const int nb = r % (D_ / 32), kb = r / (D_ / 32); t.W = IN_w_pp; t.gain = nullptr; t.WT = (bf16*)(F.ws + WS_WPP); t.ldn = D_; t.src_col = 32 * nb; t.K = PLE_; t.n_dst = 32 * nb; t.k0 = 64 * kb; return t; }
}
__device__ __forceinline__ void p0_issue(const TItem& t, int lane, float (&w)[32], f32x4 (&g)[2]) {
    const float* src = t.W + (size_t)(t.k0 + (lane >> 5)) * t.ldn + t.src_col + (lane & 31);
#pragma unroll
    for (int i = 0; i < 32; ++i) w[i] = __builtin_nontemporal_load(src + (size_t)(2 * i) * t.ldn);
    if (t.gain) { g[0] = *(const f32x4*)(t.gain + t.k0 + 8 * (lane & 7)); g[1] = *(const f32x4*)(t.gain + t.k0 + 8 * (lane & 7) + 4); }
    else { g[0] = (f32x4){1.f, 1.f, 1.f, 1.f}; g[1] = g[0]; }
}
__device__ __forceinline__ void p0_prologue(Frame& F) {
    LAS float* scr = (LAS float*)(F.lds + RING_OFF + F.wave * 16384);
    constexpr int P0_ROWW = 5, P0_TRW = NWAVES - P0_ROWW;
    const bool row_role = F.wave < P0_ROWW;
    const int gw = row_role ? F.vcu * P0_ROWW + F.wave : F.vcu * P0_TRW + (F.wave - P0_ROWW), NGW = F.G * (row_role ? P0_ROWW : P0_TRW);
    bf16* Wga_t = (bf16*)(F.ws + WS_WGA);
    constexpr int NITEMS = (D_ / 64) * (ZW / 32) + 2 * (D_ / 64) * (D_ / 32) + (D_ / 64) * (FF_ / 32) + (FF_ / 64) * (D_ / 32) + (PLE_ / 64) * (D_ / 32);
    if (!row_role) {
        int it = gw; bool have = it < NITEMS;
        float w[32]; f32x4 g[2]; TItem cur;
        if (have) { cur = p0_decode(F, it); p0_issue(cur, F.lane, w, g); }
        while (have) {
#pragma unroll
            for (int i = 0; i < 32; ++i) scr[(2 * i + (F.lane >> 5)) * 33 + (F.lane & 31)] = w[i];
            const f32x4 g0 = g[0], g1 = g[1]; const TItem t = cur;
            LDS_WAIT(); asm volatile("" ::: "memory");
            const int nit = it + NGW; const bool nh = nit < NITEMS;
            if (nh) { cur = p0_decode(F, nit); p0_issue(cur, F.lane, w, g); }
            const int c = F.lane & 7;
#pragma unroll
            for (int j = 0; j < 4; ++j) { const int n = (F.lane >> 3) + 8 * j; const LAS float* s = scr + (8 * c) * 33 + n;
                v4u o; o.x = pk2(s[0 * 33] * g0[0], s[1 * 33] * g0[1]); o.y = pk2(s[2 * 33] * g0[2], s[3 * 33] * g0[3]); o.z = pk2(s[4 * 33] * g1[0], s[5 * 33] * g1[1]); o.w = pk2(s[6 * 33] * g1[2], s[7 * 33] * g1[3]);
                *(GAS v4u*)(t.WT + (size_t)(t.n_dst + n) * t.K + t.k0 + 8 * c) = o; }
            LDS_WAIT(); asm volatile("" ::: "memory");
            it = nit; have = nh;
        }
    }
    if (!row_role) { const float* wi_ = IN_w_in; const float* gm_ = IN_g_mix;
      for (int i = gw * 64 + F.lane; i < 16 * D_; i += NGW * 64) { const int r = i >> 10, k = i & 1023; Wga_t[i] = (bf16)f2bf(wi_[(size_t)k * INW_ + 1536 + r] * gm_[k]); } }
    bf16* xb = (bf16*)(F.ws + WS_AB); bf16* pb = (bf16*)(F.ws + WS_PB); float* rstdx = (float*)(F.ws + WS_RSTDX);
    const float* x_ = IN_x; const float* p_ = IN_p;
    if (row_role) {
        f32x4 v[4][4], pv[4], vn[4][4], pvn[4];
        int m0 = gw * 4; bool have = m0 < S_;
        if (have) {
#pragma unroll
            for (int rr = 0; rr < 4; ++rr) { const GAS f32x4* xr = (const GAS f32x4*)(x_ + (size_t)(m0 + rr) * D_) + F.lane;
#pragma unroll
                for (int j = 0; j < 4; ++j) v[rr][j] = __builtin_nontemporal_load(xr + 64 * j);
                pv[rr] = __builtin_nontemporal_load((const GAS f32x4*)(p_ + (size_t)(m0 + rr) * PLE_) + F.lane); }
        }
        while (have) {
            const int m1 = m0 + NGW * 4; const bool nh = m1 < S_;
            if (nh) {
#pragma unroll
                for (int rr = 0; rr < 4; ++rr) { const GAS f32x4* xr = (const GAS f32x4*)(x_ + (size_t)(m1 + rr) * D_) + F.lane;
#pragma unroll
                    for (int j = 0; j < 4; ++j) vn[rr][j] = __builtin_nontemporal_load(xr + 64 * j);
                    pvn[rr] = __builtin_nontemporal_load((const GAS f32x4*)(p_ + (size_t)(m1 + rr) * PLE_) + F.lane); }
            }
#pragma unroll
            for (int rr = 0; rr < 4; ++rr) { const int m = m0 + rr; float s = 0.f;
#pragma unroll
                for (int j = 0; j < 4; ++j) s += (v[rr][j].x * v[rr][j].x + v[rr][j].y * v[rr][j].y) + (v[rr][j].z * v[rr][j].z + v[rr][j].w * v[rr][j].w);
                s = wave_sum(s);
                GAS unsigned long long* o8 = (GAS unsigned long long*)(xb + (size_t)m * D_) + F.lane;
#pragma unroll
                for (int j = 0; j < 4; ++j) o8[64 * j] = (unsigned long long)pk2(v[rr][j].x, v[rr][j].y) | ((unsigned long long)pk2(v[rr][j].z, v[rr][j].w) << 32);
                if (F.lane == 0) rstdx[m] = 1.0f / sqrtf(s * (1.0f / D_) + EPS_);
                *((GAS unsigned long long*)(pb + (size_t)m * PLE_) + F.lane) = (unsigned long long)pk2(pv[rr].x, pv[rr].y) | ((unsigned long long)pk2(pv[rr].z, pv[rr].w) << 32); }
#pragma unroll
            for (int rr = 0; rr < 4; ++rr) { pv[rr] = pvn[rr];
#pragma unroll
                for (int j = 0; j < 4; ++j) v[rr][j] = vn[rr][j]; }
            m0 = m1; have = nh;
        }
    }
}

typedef float f32x16 __attribute__((ext_vector_type(16)));
typedef __bf16 bf2_t __attribute__((ext_vector_type(2)));
typedef float f2_t __attribute__((ext_vector_type(2)));
__device__ __forceinline__ unsigned pkbf(float lo, float hi) { f2_t v = {lo, hi}; bf2_t b = __builtin_convertvector(v, bf2_t); return __builtin_bit_cast(unsigned, b); }
#define MFMA32(a, b, c) __builtin_amdgcn_mfma_f32_32x32x16_bf16((a), (b), (c), 0, 0, 0)
#define WG_SYNC() do { asm volatile("s_waitcnt lgkmcnt(0)" ::: "memory"); __builtin_amdgcn_s_barrier(); asm volatile("" ::: "memory"); } while (0)
__device__ __forceinline__ bf16x8 pack8(const f32x16& x, int s) {
    v4u p; p.x = pkbf(x[8 * s], x[8 * s + 1]); p.y = pkbf(x[8 * s + 2], x[8 * s + 3]); p.z = pkbf(x[8 * s + 4], x[8 * s + 5]); p.w = pkbf(x[8 * s + 6], x[8 * s + 7]);
    return __builtin_bit_cast(bf16x8, p);
}
__device__ __forceinline__ float log_sigmoid(float s) { return fminf(s, 0.f) - __logf(1.0f + __expf(-fabsf(s))); }
constexpr int GROW = 72;
__device__ __forceinline__ int tperm(int tt) { return (tt & ~15) + 8 * ((tt >> 2) & 1) + 4 * ((tt >> 3) & 1) + (tt & 3); }

__device__ __forceinline__ void gla_load_w2(Frame& F, float (&w2)[16], float& bias) {
    const int c = F.tid & 255;
    const float* wa2_ = IN_w_a2;
#pragma unroll
    for (int r = 0; r < 16; ++r) w2[r] = wa2_[r * 256 + c];
    bias = IN_b_a[c];
}
__device__ __forceinline__ void gla_cumsum(Frame& F, const LAS float* GAS_, LAS float* TOT, const float (&w2)[16], float bias, float (&bl)[32], float& blast, float& boff) {
    const int c = F.tid & 255, half = F.tid >> 8;
    float run = 0.f;
#pragma unroll
    for (int i = 0; i < 32; ++i) {
        const LAS f32x4* g4 = (const LAS f32x4*)(GAS_ + (32 * half + i) * 16);
        const f32x4 g0 = g4[0], g1 = g4[1], g2 = g4[2], g3 = g4[3];
        float a = bias;
        a += g0[0] * w2[0]; a += g0[1] * w2[1]; a += g0[2] * w2[2]; a += g0[3] * w2[3];
        a += g1[0] * w2[4]; a += g1[1] * w2[5]; a += g1[2] * w2[6]; a += g1[3] * w2[7];
        a += g2[0] * w2[8]; a += g2[1] * w2[9]; a += g2[2] * w2[10]; a += g2[3] * w2[11];
        a += g3[0] * w2[12]; a += g3[1] * w2[13]; a += g3[2] * w2[14]; a += g3[3] * w2[15];
        run += log_sigmoid(a) * (1.0f / 16.0f);
        bl[i] = run;
    }
    TOT[half * 256 + c] = run;
    WG_SYNC();
    const float t0 = TOT[c], t1 = TOT[256 + c];
    blast = t0 + t1; boff = half ? t0 : 0.f;
}
__device__ __forceinline__ void gla_vt_load(Frame& F, const bf16* zb, int t0, v4u (&vw)[8]) {
    const int tt = F.tid & 63, grp = F.tid >> 6;
    const bf16* src = zb + (size_t)(t0 + tt) * ZW + Z_GV + 64 * grp;
#pragma unroll
    for (int i = 0; i < 8; ++i) vw[i] = *(const v4u*)(src + 8 * i);
}
__device__ __forceinline__ void gla_vt_write(Frame& F, LAS bf16* VT, const v4u (&vw)[8]) {
    const int tt = F.tid & 63, grp = F.tid >> 6, h = grp >> 1, e0 = (grp & 1) * 64, pt = tperm(tt);
#pragma unroll
    for (int i = 0; i < 8; ++i) {
        const v4u w = vw[i];
        LAS bf16* dst = VT + (size_t)(h * 128 + e0 + 8 * i) * GROW + pt;
        dst[0 * GROW] = (bf16)(w.x & 0xffffu); dst[1 * GROW] = (bf16)(w.x >> 16); dst[2 * GROW] = (bf16)(w.y & 0xffffu); dst[3 * GROW] = (bf16)(w.y >> 16);
        dst[4 * GROW] = (bf16)(w.z & 0xffffu); dst[5 * GROW] = (bf16)(w.z >> 16); dst[6 * GROW] = (bf16)(w.w & 0xffffu); dst[7 * GROW] = (bf16)(w.w >> 16);
    }
}

__device__ __forceinline__ void gla_a_chunk(Frame& F, int ch) {
    LAS float* GA_S = (LAS float*)(F.lds);
    LAS float* TOT = (LAS float*)(F.lds + 8192);
    LAS bf16* KTE = (LAS bf16*)(F.lds + 10240);
    LAS bf16* VT = (LAS bf16*)(F.lds + 10240 + 4 * 64 * GROW * 2);
    const bf16* xb = (const bf16*)(F.ws + WS_AB); const bf16* zb = (const bf16*)(F.ws + WS_Z); const bf16* wga = (const bf16*)(F.ws + WS_WGA);
    const float* rstdx = (const float*)(F.ws + WS_RSTDX); float* ga_g = (float*)(F.ws + WS_GA); float* decay_g = (float*)(F.ws + WS_DECAY); bf16* dS_g = (bf16*)(F.ws + WS_DS);
    const int t0 = ch * 64;
    float w2[16], bias; gla_load_w2(F, w2, bias);
    v4u vw[8]; gla_vt_load(F, zb, t0, vw);
    unsigned short kraw[32];
    { const bf16* kcol = zb + (size_t)(t0 + 32 * (F.tid >> 8)) * ZW + Z_GK + (F.tid & 255);
#pragma unroll
      for (int j = 0; j < 32; ++j) kraw[j] = kcol[(size_t)j * ZW]; }
    {
        const int rg = F.wave & 3, kh = F.wave >> 2, r = F.lane & 15, q = F.lane >> 4;
        const bf16* arow = xb + (size_t)(t0 + 16 * rg + r) * D_ + 8 * q; const bf16* brow = wga + (size_t)r * D_ + 8 * q;
        pg8::f32x4 acc = {0.f, 0.f, 0.f, 0.f};
#pragma unroll
        for (int s = 16 * kh; s < 16 * kh + 16; ++s) { const bf16x8 a = *(const bf16x8*)(arow + 32 * s), b = *(const bf16x8*)(brow + 32 * s); acc = __builtin_amdgcn_mfma_f32_16x16x32_bf16(a, b, acc, 0, 0, 0); }
#pragma unroll
        for (int g = 0; g < 4; ++g) GA_S[kh * 1024 + (16 * rg + 4 * q + g) * 16 + r] = acc[g];
    }
    WG_SYNC();
    for (int idx = F.tid; idx < 1024; idx += 512) { const float v = (GA_S[idx] + GA_S[1024 + idx]) * rstdx[t0 + (idx >> 4)]; GA_S[idx] = v; ga_g[(size_t)t0 * 16 + idx] = v; }
    WG_SYNC();
    float bl[32], blast, boff;
    gla_cumsum(F, GA_S, TOT, w2, bias, bl, blast, boff);
    {
        const int c = F.tid & 255, half = F.tid >> 8, h = c >> 6, d = c & 63;
        if (half == 0) decay_g[ch * 256 + c] = __expf(blast);
#pragma unroll
        for (int g8 = 0; g8 < 4; ++g8) {
            float v[8];
#pragma unroll
            for (int j = 0; j < 8; ++j) v[j] = bf2f(kraw[8 * g8 + j]) * __expf(blast - (boff + bl[8 * g8 + j]));
            const int tt = 32 * half + 8 * g8, hi = (tt >> 3) & 1;
            LAS bf16* row = KTE + (size_t)(h * 64 + d) * GROW + (tt & ~15) + 4 * hi;
            typedef unsigned u2 __attribute__((ext_vector_type(2)));
            u2 lo, hi2; lo.x = pkbf(v[0], v[1]); lo.y = pkbf(v[2], v[3]); hi2.x = pkbf(v[4], v[5]); hi2.y = pkbf(v[6], v[7]);
            *(LAS u2*)(row) = lo; *(LAS u2*)(row + 8) = hi2;
        }
    }
    gla_vt_write(F, VT, vw);
    WG_SYNC();
    {
        const int h = F.wave >> 1, dt = F.wave & 1, i = F.lane & 31, hh = F.lane >> 5;
        f32x16 acc[4];
#pragma unroll
        for (int et = 0; et < 4; ++et)
#pragma unroll
            for (int r = 0; r < 16; ++r) acc[et][r] = 0.f;
#pragma unroll
        for (int s = 0; s < 4; ++s) {
            const bf16x8 a = *(const LAS bf16x8*)(KTE + (size_t)(h * 64 + 32 * dt + i) * GROW + 16 * s + 8 * hh);
#pragma unroll
            for (int et = 0; et < 4; ++et) { const bf16x8 b = *(const LAS bf16x8*)(VT + (size_t)(h * 128 + 32 * et + i) * GROW + 16 * s + 8 * hh); acc[et] = MFMA32(a, b, acc[et]); }
        }
#pragma unroll
        for (int et = 0; et < 4; ++et) {
            bf16* dst = dS_g + ((size_t)(ch * 4 + h) * 128 + 32 * et + i) * 64 + 32 * dt + 4 * hh;
            typedef unsigned u2 __attribute__((ext_vector_type(2)));
#pragma unroll
            for (int g = 0; g < 4; ++g) { u2 w; w.x = pkbf(acc[et][4 * g], acc[et][4 * g + 1]); w.y = pkbf(acc[et][4 * g + 2], acc[et][4 * g + 3]); *(u2*)(dst + 8 * g) = w; }
        }
    }
    WG_SYNC();
}

__device__ __forceinline__ void gla_b_pair(Frame& F, int pair) {
    LAS float* DSL = (LAS float*)(F.lds);
    LAS float* DEC = (LAS float*)(F.lds + 65536);
    LAS float* SEGE = (LAS float*)(F.lds + 131072);
    LAS float* SEGP = (LAS float*)(F.lds + 131072 + 2048);
    const float* decay_g = (const float*)(F.ws + WS_DECAY); const bf16* dS_g = (const bf16*)(F.ws + WS_DS); bf16* sp_g = (bf16*)(F.ws + WS_SPREV);
    const int h = pair >> 6, seg = F.tid >> 6, d = F.tid & 63;
#pragma unroll
    for (int i = 0; i < 8; ++i) { const int idx = F.tid + 512 * i, n = idx >> 4, d4 = idx & 15; *(LAS pg8::f32x4*)(DEC + n * 64 + 4 * d4) = *(const pg8::f32x4*)(decay_g + (size_t)n * 256 + h * 64 + 4 * d4); }
    for (int sub = 0; sub < 2; ++sub) {
        const int e = (pair & 63) * 2 + sub;
#pragma unroll
        for (int i = 0; i < 4; ++i) { const int idx = F.tid + 512 * i, n = idx >> 3, d8 = idx & 7;
            const v4u w = *(const v4u*)(dS_g + ((size_t)(n * 4 + h) * 128 + e) * 64 + 8 * d8);
            LAS pg8::f32x4* dp = (LAS pg8::f32x4*)(DSL + n * 64 + 8 * d8);
            dp[0] = (pg8::f32x4){bf2f(w.x & 0xffffu), bf2f(w.x >> 16), bf2f(w.y & 0xffffu), bf2f(w.y >> 16)}; dp[1] = (pg8::f32x4){bf2f(w.z & 0xffffu), bf2f(w.z >> 16), bf2f(w.w & 0xffffu), bf2f(w.w >> 16)}; }
        WG_SYNC();
        float Sv = 0.f, P = 1.f;
#pragma unroll 8
        for (int i = 0; i < 32; ++i) { const int n = seg * 32 + i; const float x = DSL[n * 64 + d], a = DEC[n * 64 + d]; DSL[n * 64 + d] = Sv; Sv = a * Sv + x; P *= a; }
        SEGE[seg * 64 + d] = Sv; SEGP[seg * 64 + d] = P;
        WG_SYNC();
        float st = 0.f;
        for (int k = 0; k < seg; ++k) st = SEGP[k * 64 + d] * st + SEGE[k * 64 + d];
        float Pq = 1.f;
#pragma unroll 8
        for (int i = 0; i < 32; ++i) { const int n = seg * 32 + i; const float v = DSL[n * 64 + d] + Pq * st; Pq *= DEC[n * 64 + d]; sp_g[((size_t)(n * 4 + h) * 128 + e) * 64 + d] = (bf16)f2bf(v); }
        WG_SYNC();
    }
}

__device__ __forceinline__ void gla_c_chunk(Frame& F, int ch) {
    LAS float* GA2 = (LAS float*)(F.lds);
    LAS float* TOT = (LAS float*)(F.lds + 4096);
    LAS bf16* QD = (LAS bf16*)(F.lds + 6144);
    LAS bf16* KI = (LAS bf16*)(F.lds + 6144 + 36864);
    LAS bf16* VT = (LAS bf16*)(F.lds + 6144 + 2 * 36864);
    const bf16* zb = (const bf16*)(F.ws + WS_Z); const float* ga_g = (const float*)(F.ws + WS_GA); const bf16* sp_g = (const bf16*)(F.ws + WS_SPREV); bf16* mixb = (bf16*)(F.ws + WS_MIX);
    const int t0 = ch * 64;
    float w2[16], bias; gla_load_w2(F, w2, bias);
    v4u vw[8]; gla_vt_load(F, zb, t0, vw);
    unsigned short qraw[32], kraw[32];
    { const bf16* qcol = zb + (size_t)(t0 + 32 * (F.tid >> 8)) * ZW + Z_GQ + (F.tid & 255); const bf16* kcol = zb + (size_t)(t0 + 32 * (F.tid >> 8)) * ZW + Z_GK + (F.tid & 255);
#pragma unroll
      for (int j = 0; j < 32; ++j) { qraw[j] = qcol[(size_t)j * ZW]; kraw[j] = kcol[(size_t)j * ZW]; } }
    for (int idx = F.tid; idx < 1024; idx += 512) GA2[idx] = ga_g[(size_t)t0 * 16 + idx];
    WG_SYNC();
    float bl[32], blast, boff;
    gla_cumsum(F, GA2, TOT, w2, bias, bl, blast, boff);
    {
        const int c = F.tid & 255, half = F.tid >> 8, h = c >> 6, d = c & 63;
#pragma unroll
        for (int i = 0; i < 32; ++i) {
            const float b = boff + bl[i];
            const float qd = bf2f(qraw[i]) * __expf(b) * 0.125f, ki = bf2f(kraw[i]) * __expf(-b);
            QD[(size_t)(h * 64 + 32 * half + i) * GROW + d] = (bf16)f2bf(qd); KI[(size_t)(h * 64 + 32 * half + i) * GROW + d] = (bf16)f2bf(ki);
        }
    }
    gla_vt_write(F, VT, vw);
    WG_SYNC();
    {
        const int h = F.wave >> 1, ct = F.wave & 1, i = F.lane & 31, hh = F.lane >> 5;
        bf16x8 qf[4];
#pragma unroll
        for (int s = 0; s < 4; ++s) qf[s] = *(const LAS bf16x8*)(QD + (size_t)(h * 64 + 32 * ct + i) * GROW + 16 * s + 8 * hh);
        f32x16 acc[4];
#pragma unroll
        for (int et = 0; et < 4; ++et)
#pragma unroll
            for (int r = 0; r < 16; ++r) acc[et][r] = 0.f;
#pragma unroll
        for (int et = 0; et < 4; ++et) {
            const bf16* srow = sp_g + ((size_t)(ch * 4 + h) * 128 + 32 * et + i) * 64 + 8 * hh;
#pragma unroll
            for (int s = 0; s < 4; ++s) { const bf16x8 sf = *(const bf16x8*)(srow + 16 * s); acc[et] = MFMA32(sf, qf[s], acc[et]); }
        }
        for (int jt = 0; jt <= ct; ++jt) {
            f32x16 X;
#pragma unroll
            for (int r = 0; r < 16; ++r) X[r] = 0.f;
#pragma unroll
            for (int s = 0; s < 4; ++s) { const bf16x8 kf = *(const LAS bf16x8*)(KI + (size_t)(h * 64 + 32 * jt + i) * GROW + 16 * s + 8 * hh); X = MFMA32(kf, qf[s], X); }
            if (jt == ct) {
#pragma unroll
                for (int r = 0; r < 16; ++r) { const int j = (r & 3) + 8 * (r >> 2) + 4 * hh; if (j > i) X[r] = 0.f; }
            }
#pragma unroll
            for (int s2 = 0; s2 < 2; ++s2) {
                const bf16x8 xs = pack8(X, s2);
#pragma unroll
                for (int et = 0; et < 4; ++et) { const bf16x8 vf = *(const LAS bf16x8*)(VT + (size_t)(h * 128 + 32 * et + i) * GROW + 32 * jt + 16 * s2 + 8 * hh); acc[et] = MFMA32(vf, xs, acc[et]); }
            }
        }
        float ss = 0.f;
#pragma unroll
        for (int et = 0; et < 4; ++et)
#pragma unroll
            for (int r = 0; r < 16; ++r) ss += acc[et][r] * acc[et][r];
        ss += __shfl_xor(ss, 32);
        const float rn = __builtin_amdgcn_rsqf(ss * (1.0f / 128.0f) + EPS_);
        const int t = t0 + 32 * ct + i;
        const bf16* ggrow = zb + (size_t)t * ZW + Z_GG + h * 128; bf16* orow = mixb + (size_t)t * D_ + h * 128;
        const float* ggl_ = IN_g_gla;
#pragma unroll
        for (int et = 0; et < 4; ++et)
#pragma unroll
            for (int g = 0; g < 4; ++g) {
                const int e0 = 32 * et + 8 * g + 4 * hh;
                typedef unsigned u2 __attribute__((ext_vector_type(2)));
                const u2 gw = *(const u2*)(ggrow + e0);
                const pg8::f32x4 gl = *(const pg8::f32x4*)(ggl_ + e0);
                float gv[4] = {bf2f(gw.x & 0xffffu), bf2f(gw.x >> 16), bf2f(gw.y & 0xffffu), bf2f(gw.y >> 16)};
                float o[4];
#pragma unroll
                for (int j = 0; j < 4; ++j) o[j] = acc[et][4 * g + j] * rn * gl[j] * (gv[j] * __builtin_amdgcn_rcpf(1.0f + __expf(-gv[j])));
                u2 w; w.x = pkbf(o[0], o[1]); w.y = pkbf(o[2], o[3]);
                *(u2*)(orow + e0) = w;
            }
    }
    WG_SYNC();
}

constexpr int KROW = 136;
constexpr int VROW = 264;
constexpr int LIST_PER_HEAD = 256 * 2016;
__device__ __forceinline__ int list_off(int h, int j) { return h * LIST_PER_HEAD + 256 * (63 * j - (j * (j - 1)) / 2); }
typedef unsigned u2_t __attribute__((ext_vector_type(2)));

__device__ __forceinline__ void sincos_acc(float a, float& s, float& c) {
    const float k = __builtin_rintf(a * 0.15915494309189535f);
    float r = __builtin_fmaf(-k, 6.28125f, a);
    r = __builtin_fmaf(-k, 0.0019353071693331003f, r);
    r = __builtin_fmaf(-k, 1.0253131677018246e-11f, r);
    const float rev = r * 0.15915494309189535f;
    s = __builtin_amdgcn_sinf(rev); c = __builtin_amdgcn_cosf(rev);
}

__device__ __forceinline__ void moba_a_item(Frame& F, int item) {
    const int blk = item >> 2, h = item & 3;
    LAS bf16* VTL = (LAS bf16*)(F.lds);
    LAS float* KM = (LAS float*)(F.lds + 128 * VROW * 2);
    bf16* zb = (bf16*)(F.ws + WS_Z); float* kmean_g = (float*)(F.ws + WS_KMEAN); bf16* vT_g = (bf16*)((unsigned char*)F.out + OUT_VT);
    v4u vsrc[8];
    { const int tt = F.tid & 255, half = F.tid >> 8; const bf16* src = zb + (size_t)(blk * 256 + tt) * ZW + Z_MV + h * 128 + 64 * half;
#pragma unroll
      for (int i = 0; i < 8; ++i) vsrc[i] = *(const v4u*)(src + 8 * i); }
    {
        const int ts = F.lane >> 4, g = F.lane & 15;
        const float* gmq_ = IN_g_mq; const float* gmk_ = IN_g_mk; const int* pos_ = IN_pos;
        LAS float* INVT = KM + 32 * 128;
        if (F.tid < 64) INVT[F.tid] = 1.0f / powf(10000.0f, (float)F.tid / 64.0f);
        WG_SYNC();
        float inv[4]; f32x4 gq1 = *(const f32x4*)(gmq_ + 4 * g), gq2 = *(const f32x4*)(gmq_ + 64 + 4 * g), gk1 = *(const f32x4*)(gmk_ + 4 * g), gk2 = *(const f32x4*)(gmk_ + 64 + 4 * g);
#pragma unroll
        for (int c = 0; c < 4; ++c) inv[c] = INVT[4 * g + c];
        float km1[4] = {0.f, 0.f, 0.f, 0.f}, km2[4] = {0.f, 0.f, 0.f, 0.f};
        for (int b4 = 0; b4 < 2; ++b4) {
            u2_t ql[4], qh[4], kl[4], kh[4]; int ps[4];
#pragma unroll
            for (int u = 0; u < 4; ++u) { const int t = blk * 256 + F.wave * 32 + 16 * b4 + 4 * u + ts;
                const bf16* pq = zb + (size_t)t * ZW + Z_MQ + h * 128 + 4 * g; const bf16* pk = zb + (size_t)t * ZW + Z_MK + h * 128 + 4 * g;
                ps[u] = pos_[t]; ql[u] = *(const u2_t*)pq; qh[u] = *(const u2_t*)(pq + 64); kl[u] = *(const u2_t*)pk; kh[u] = *(const u2_t*)(pk + 64); }
#pragma unroll
            for (int u = 0; u < 4; ++u) { const int t = blk * 256 + F.wave * 32 + 16 * b4 + 4 * u + ts;
                float q1[4] = {bf2f(ql[u].x & 0xffffu), bf2f(ql[u].x >> 16), bf2f(ql[u].y & 0xffffu), bf2f(ql[u].y >> 16)}, q2[4] = {bf2f(qh[u].x & 0xffffu), bf2f(qh[u].x >> 16), bf2f(qh[u].y & 0xffffu), bf2f(qh[u].y >> 16)};
                float k1[4] = {bf2f(kl[u].x & 0xffffu), bf2f(kl[u].x >> 16), bf2f(kl[u].y & 0xffffu), bf2f(kl[u].y >> 16)}, k2[4] = {bf2f(kh[u].x & 0xffffu), bf2f(kh[u].x >> 16), bf2f(kh[u].y & 0xffffu), bf2f(kh[u].y >> 16)};
                float sq = 0.f, sk = 0.f;
#pragma unroll
                for (int c = 0; c < 4; ++c) { sq += q1[c] * q1[c] + q2[c] * q2[c]; sk += k1[c] * k1[c] + k2[c] * k2[c]; }
                sq = row16_sum(sq); sk = row16_sum(sk);
                const float rq = __builtin_amdgcn_rsqf(sq * (1.0f / 128.0f) + EPS_), rk = __builtin_amdgcn_rsqf(sk * (1.0f / 128.0f) + EPS_);
                float oq1[4], oq2[4], ok1[4], ok2[4];
#pragma unroll
                for (int c = 0; c < 4; ++c) { float sn, cs; sincos_acc((float)ps[u] * inv[c], sn, cs);
                    const float yq1 = q1[c] * rq * gq1[c], yq2 = q2[c] * rq * gq2[c], yk1 = k1[c] * rk * gk1[c], yk2 = k2[c] * rk * gk2[c];
                    oq1[c] = yq1 * cs - yq2 * sn; oq2[c] = yq2 * cs + yq1 * sn; ok1[c] = yk1 * cs - yk2 * sn; ok2[c] = yk2 * cs + yk1 * sn;
                    km1[c] += ok1[c]; km2[c] += ok2[c]; }
                bf16* pq = zb + (size_t)t * ZW + Z_MQ + h * 128 + 4 * g; bf16* pk = zb + (size_t)t * ZW + Z_MK + h * 128 + 4 * g;
                u2_t w; w.x = pkbf(oq1[0], oq1[1]); w.y = pkbf(oq1[2], oq1[3]); *(u2_t*)pq = w; w.x = pkbf(oq2[0], oq2[1]); w.y = pkbf(oq2[2], oq2[3]); *(u2_t*)(pq + 64) = w;
                w.x = pkbf(ok1[0], ok1[1]); w.y = pkbf(ok1[2], ok1[3]); *(u2_t*)pk = w; w.x = pkbf(ok2[0], ok2[1]); w.y = pkbf(ok2[2], ok2[3]); *(u2_t*)(pk + 64) = w;
            }
        }
#pragma unroll
        for (int c = 0; c < 4; ++c) { KM[(F.wave * 4 + ts) * 128 + 4 * g + c] = km1[c]; KM[(F.wave * 4 + ts) * 128 + 64 + 4 * g + c] = km2[c]; }
    }
    {
        const int tt = F.tid & 255, half = F.tid >> 8, pt = tperm(tt);
#pragma unroll
        for (int i = 0; i < 8; ++i) {
            const v4u w = vsrc[i];
            LAS bf16* dst = VTL + (size_t)(64 * half + 8 * i) * VROW + pt;
            dst[0 * VROW] = (bf16)(w.x & 0xffffu); dst[1 * VROW] = (bf16)(w.x >> 16); dst[2 * VROW] = (bf16)(w.y & 0xffffu); dst[3 * VROW] = (bf16)(w.y >> 16);
            dst[4 * VROW] = (bf16)(w.z & 0xffffu); dst[5 * VROW] = (bf16)(w.z >> 16); dst[6 * VROW] = (bf16)(w.w & 0xffffu); dst[7 * VROW] = (bf16)(w.w >> 16);
        }
    }
    WG_SYNC();
    if (F.tid < 128) { float s = 0.f;
#pragma unroll
        for (int w = 0; w < 32; ++w) s += KM[w * 128 + F.tid];
        kmean_g[(size_t)(h * 64 + blk) * 128 + F.tid] = s * (1.0f / 256.0f); }
#pragma unroll
    for (int i = 0; i < 8; ++i) { const int idx = F.tid + 512 * i, e = idx >> 5, c16 = idx & 31;
        *(v4u*)(vT_g + ((size_t)(h * 64 + blk) * 128 + e) * 256 + 8 * c16) = *(const LAS v4u*)(VTL + (size_t)e * VROW + 8 * c16); }
    WG_SYNC();
}

__device__ __forceinline__ void top3_insert(float v, int j, float& v0, float& v1, float& v2, int& i0, int& i1, int& i2) {
    const bool b0 = (v > v0) || (v == v0 && j < i0), b1 = (v > v1) || (v == v1 && j < i1), b2 = (v > v2) || (v == v2 && j < i2);
    const float n2 = b1 ? v1 : (b2 ? v : v2); const int m2 = b1 ? i1 : (b2 ? j : i2);
    const float n1 = b0 ? v0 : (b1 ? v : v1); const int m1 = b0 ? i0 : (b1 ? j : i1);
    const float n0 = b0 ? v : v0; const int m0 = b0 ? j : i0;
    v0 = n0; v1 = n1; v2 = n2; i0 = m0; i1 = m1; i2 = m2;
}
__device__ __forceinline__ void moba_b_item(Frame& F, int item) {
    const int kb = item >> 2, h = item & 3;
    if (kb == 0) return;
    LAS bf16* KMH = (LAS bf16*)(F.lds);
    LAS bf16* KML = (LAS bf16*)(F.lds + 64 * KROW * 2);
    LAS unsigned* HIST = (LAS unsigned*)(F.lds + 2 * 64 * KROW * 2);
    LAS unsigned* BASE = HIST + 64;
    const bf16* zb = (const bf16*)(F.ws + WS_Z); const float* kmean_g = (const float*)(F.ws + WS_KMEAN); unsigned* list_g = (unsigned*)(F.ws + WS_LIST);
    const int i = F.lane & 31, kk = F.lane >> 5;
    const int t = kb * 256 + F.wave * 32 + i;
    bf16x8 qf[8];
    { const bf16* qrow = zb + (size_t)t * ZW + Z_MQ + h * 128 + 8 * kk;
#pragma unroll
      for (int s = 0; s < 8; ++s) qf[s] = *(const bf16x8*)(qrow + 16 * s); }
    for (int idx = F.tid; idx < 64 * 128; idx += 512) { const int j = idx >> 7, d = idx & 127; const float v = (j < kb) ? kmean_g[(size_t)(h * 64 + j) * 128 + d] : 0.f;
        const unsigned hi = f2bf(v); const float rem = v - bf2f(hi); KMH[j * KROW + d] = (bf16)hi; KML[j * KROW + d] = (bf16)f2bf(rem); }
    if (F.tid < 64) HIST[F.tid] = 0u;
    WG_SYNC();
    float v0 = -INFINITY, v1 = -INFINITY, v2 = -INFINITY; int i0 = 1 << 20, i1 = 1 << 20, i2 = 1 << 20;
    const int njt = (kb + 31) >> 5;
    for (int jt = 0; jt < njt; ++jt) {
        f32x16 acc;
#pragma unroll
        for (int r = 0; r < 16; ++r) acc[r] = 0.f;
#pragma unroll
        for (int s = 0; s < 8; ++s) {
            const bf16x8 ah = *(const LAS bf16x8*)(KMH + (size_t)(32 * jt + i) * KROW + 16 * s + 8 * kk), al = *(const LAS bf16x8*)(KML + (size_t)(32 * jt + i) * KROW + 16 * s + 8 * kk);
            acc = MFMA32(ah, qf[s], acc); acc = MFMA32(al, qf[s], acc);
        }
#pragma unroll
        for (int r = 0; r < 16; ++r) { const int j = 32 * jt + (r & 3) + 8 * (r >> 2) + 4 * kk; if (j < kb) top3_insert(acc[r], j, v0, v1, v2, i0, i1, i2); }
    }
    {
        const float pv0 = __shfl_xor(v0, 32), pv1 = __shfl_xor(v1, 32), pv2 = __shfl_xor(v2, 32);
        const int pi0 = __shfl_xor(i0, 32), pi1 = __shfl_xor(i1, 32), pi2 = __shfl_xor(i2, 32);
        top3_insert(pv0, pi0, v0, v1, v2, i0, i1, i2); top3_insert(pv1, pi1, v0, v1, v2, i0, i1, i2); top3_insert(pv2, pi2, v0, v1, v2, i0, i1, i2);
    }
    const int nsel = kb < 3 ? kb : 3;
    unsigned lp0 = 0, lp1 = 0, lp2 = 0;
    if (kk == 0) {
        if (nsel > 0) lp0 = atomicAdd((unsigned*)&HIST[i0], 1u);
        if (nsel > 1) lp1 = atomicAdd((unsigned*)&HIST[i1], 1u);
        if (nsel > 2) lp2 = atomicAdd((unsigned*)&HIST[i2], 1u);
    }
    WG_SYNC();
    if (F.tid < 64) { const unsigned n = HIST[F.tid]; BASE[F.tid] = n ? atomicAdd((unsigned*)(F.ctl + CW_CNT + h * 64 + F.tid), n) : 0u; }
    WG_SYNC();
    if (kk == 0) {
        if (nsel > 0) list_g[list_off(h, i0) + BASE[i0] + lp0] = (unsigned)t | (0u << 16);
        if (nsel > 1) list_g[list_off(h, i1) + BASE[i1] + lp1] = (unsigned)t | (1u << 16);
        if (nsel > 2) list_g[list_off(h, i2) + BASE[i2] + lp2] = (unsigned)t | (2u << 16);
    }
    WG_SYNC();
}

__device__ __forceinline__ void moba_load_kv(Frame& F, int h, int j, LAS bf16* KL, LAS bf16* VL) {
    const bf16* zb = (const bf16*)(F.ws + WS_Z); const bf16* vT_g = (const bf16*)((const unsigned char*)F.out + OUT_VT);
#pragma unroll
    for (int i = 0; i < 8; ++i) { const int idx = F.tid + 512 * i, r = idx >> 4, c16 = idx & 15;
        *(LAS v4u*)(KL + (size_t)r * KROW + 8 * c16) = *(const v4u*)(zb + (size_t)(j * 256 + r) * ZW + Z_MK + h * 128 + 8 * c16); }
#pragma unroll
    for (int i = 0; i < 8; ++i) { const int idx = F.tid + 512 * i, e = idx >> 5, c16 = idx & 31;
        *(LAS v4u*)(VL + (size_t)e * VROW + 8 * c16) = *(const v4u*)(vT_g + ((size_t)(h * 64 + j) * 128 + e) * 256 + 8 * c16); }
}
__device__ __forceinline__ void moba_wave_attend(const bf16x8 (&qf)[8], const LAS bf16* KL, const LAS bf16* VL, int nkt, int diag_kt, int i, int hh, float c2, float mc2, f32x16 (&acc)[4], float& lsum) {
    for (int kt = 0; kt < nkt; ++kt) {
        f32x16 St;
#pragma unroll
        for (int r = 0; r < 16; ++r) St[r] = 0.f;
#pragma unroll
        for (int s = 0; s < 8; ++s) { const bf16x8 kf = *(const LAS bf16x8*)(KL + (size_t)(32 * kt + i) * KROW + 16 * s + 8 * hh); St = MFMA32(kf, qf[s], St); }
#pragma unroll
        for (int r = 0; r < 16; ++r) St[r] = __builtin_amdgcn_exp2f(St[r] * c2 - mc2);
        if (kt == diag_kt) {
#pragma unroll
            for (int r = 0; r < 16; ++r) { const int kl = (r & 3) + 8 * (r >> 2) + 4 * hh; if (kl > i) St[r] = 0.f; }
        }
#pragma unroll
        for (int r = 0; r < 16; ++r) lsum += St[r];
#pragma unroll
        for (int s2 = 0; s2 < 2; ++s2) {
            const bf16x8 ps = pack8(St, s2);
#pragma unroll
            for (int et = 0; et < 4; ++et) { const bf16x8 vf = *(const LAS bf16x8*)(VL + (size_t)(32 * et + i) * VROW + 32 * kt + 16 * s2 + 8 * hh); acc[et] = MFMA32(vf, ps, acc[et]); }
        }
    }
}
__device__ __forceinline__ void moba_shift(Frame& F, float& c2, float& mc2) {
    const float* gmq_ = IN_g_mq; const float* gmk_ = IN_g_mk;
    float m1 = fmaxf(fabsf(gmq_[F.lane]), fabsf(gmq_[F.lane + 64])), m2 = fmaxf(fabsf(gmk_[F.lane]), fabsf(gmk_[F.lane + 64]));
#pragma unroll
    for (int o = 1; o < 64; o <<= 1) { m1 = fmaxf(m1, __shfl_xor(m1, o)); m2 = fmaxf(m2, __shfl_xor(m2, o)); }
    c2 = 0.08838834764831845f * 1.4426950408889634f;
    mc2 = 11.313708498984761f * m1 * m2 * 1.4426950408889634f;
}

__device__ __forceinline__ void mc_decode(const LAS int* PRE, int it, int& hj, int& chunk) {
    int lo = 0, hi = 255;
    while (lo < hi) { const int mid = (lo + hi + 1) >> 1; if (PRE[mid] <= it) lo = mid; else hi = mid - 1; }
    hj = lo; chunk = it - PRE[lo];
}
__device__ __forceinline__ void mc_fetch(const Frame& F, int hj, int chunk, int n, int i, int hh, bool& active, bool& valid, int& tq, int& slot, bf16x8 (&qf)[8]) {
    const bf16* zb = (const bf16*)(F.ws + WS_Z); const unsigned* list_g = (const unsigned*)(F.ws + WS_LIST);
    const int h = hj >> 6, j = hj & 63, base = chunk * 256 + F.wave * 32;
    active = base < n; valid = false; tq = 0; slot = 0;
    if (active) {
        const int eidx = base + i; valid = eidx < n;
        const unsigned ent = list_g[list_off(h, j) + (valid ? eidx : base)];
        tq = (int)(ent & 0xffffu); slot = (int)(ent >> 16);
        const bf16* qrow = zb + (size_t)tq * ZW + Z_MQ + h * 128 + 8 * hh;
#pragma unroll
        for (int s = 0; s < 8; ++s) qf[s] = *(const bf16x8*)(qrow + 16 * s);
    }
}
__device__ __forceinline__ void moba_c_phase(Frame& F) {
    LAS bf16* KL = (LAS bf16*)(F.lds); LAS bf16* VL = (LAS bf16*)(F.lds + 256 * KROW * 2);
    LAS int* PRE = (LAS int*)(F.lds + 256 * KROW * 2 + 128 * VROW * 2);
    LAS int* WT = PRE + 260;
    bf16* part_g = (bf16*)((unsigned char*)F.out + OUT_PART); float* lpart_g = (float*)(F.ws + WS_LPART);
    int mycnt = 0;
    if (F.tid < 256) {
        mycnt = (int)__hip_atomic_load(F.ctl + CW_CNT + F.tid, RLX_AGENT);
        int v = (mycnt + 255) >> 8, incl = v;
#pragma unroll
        for (int o = 1; o < 64; o <<= 1) { const int u = __shfl_up(incl, o); if (F.lane >= o) incl += u; }
        if (F.lane == 63) WT[F.wave] = incl;
        PRE[F.tid] = incl - v;
    }
    WG_SYNC();
    if (F.tid < 256) { int off = 0; for (int w = 0; w < F.wave; ++w) off += WT[w]; PRE[F.tid] += off; if (F.tid == 255) PRE[256] = PRE[255] + ((mycnt + 255) >> 8); }
    WG_SYNC();
    const int T = PRE[256];
    float c2, mc2; moba_shift(F, c2, mc2);
    const int i = F.lane & 31, hh = F.lane >> 5;
    const int it0 = (int)(((long long)F.vcu * T) / F.G), it1 = (int)(((long long)(F.vcu + 1) * T) / F.G);
    int cur_hj = -1;
    int hj = 0, chunk = 0, tq = 0, slot = 0; bool active = false, valid = false; bf16x8 qf[8];
#pragma unroll
    for (int s = 0; s < 8; ++s) qf[s] = (bf16x8){0, 0, 0, 0, 0, 0, 0, 0};
    if (it0 < it1) { mc_decode(PRE, it0, hj, chunk); const int n = (int)__hip_atomic_load(F.ctl + CW_CNT + hj, RLX_AGENT); mc_fetch(F, hj, chunk, n, i, hh, active, valid, tq, slot, qf); }
    for (int it = it0; it < it1; ++it) {
        const int h = hj >> 6, j = hj & 63;
        if (hj != cur_hj) { if (cur_hj >= 0) WG_SYNC(); moba_load_kv(F, h, j, KL, VL); WG_SYNC(); cur_hj = hj; }
        int hj2 = hj, chunk2 = 0, tq2 = 0, slot2 = 0; bool active2 = false, valid2 = false; bf16x8 qf2[8];
#pragma unroll
        for (int s = 0; s < 8; ++s) qf2[s] = qf[s];
        if (it + 1 < it1) { mc_decode(PRE, it + 1, hj2, chunk2); const int n2 = (int)__hip_atomic_load(F.ctl + CW_CNT + hj2, RLX_AGENT); mc_fetch(F, hj2, chunk2, n2, i, hh, active2, valid2, tq2, slot2, qf2); }
        if (active) {
            f32x16 acc[4]; float lsum = 0.f;
#pragma unroll
            for (int et = 0; et < 4; ++et)
#pragma unroll
                for (int r = 0; r < 16; ++r) acc[et][r] = 0.f;
            moba_wave_attend(qf, KL, VL, 8, -1, i, hh, c2, mc2, acc, lsum);
            lsum += __shfl_xor(lsum, 32);
            if (valid) {
                bf16* prow = part_g + ((size_t)(slot * 4 + h) * S_ + tq) * 128;
#pragma unroll
                for (int et = 0; et < 4; ++et)
#pragma unroll
                    for (int g = 0; g < 4; ++g) { u2_t w; w.x = pkbf(acc[et][4 * g], acc[et][4 * g + 1]); w.y = pkbf(acc[et][4 * g + 2], acc[et][4 * g + 3]); *(u2_t*)(prow + 32 * et + 8 * g + 4 * hh) = w; }
                if (hh == 0) lpart_g[(size_t)(slot * 4 + h) * S_ + tq] = lsum;
            }
        }
        hj = hj2; chunk = chunk2; tq = tq2; slot = slot2; active = active2; valid = valid2;
#pragma unroll
        for (int s = 0; s < 8; ++s) qf[s] = qf2[s];
    }
    WG_SYNC();
}

__device__ __forceinline__ void moba_d_item(Frame& F, int item, float c2, float mc2) {
    const int blk = item >> 2, h = item & 3;
    LAS bf16* KL = (LAS bf16*)(F.lds); LAS bf16* VL = (LAS bf16*)(F.lds + 256 * KROW * 2);
    const bf16* zb = (const bf16*)(F.ws + WS_Z); const bf16* part_g = (const bf16*)((const unsigned char*)F.out + OUT_PART); const float* lpart_g = (const float*)(F.ws + WS_LPART);
    bf16* mixb = (bf16*)(F.ws + WS_MIX);
    const int i = F.lane & 31, hh = F.lane >> 5;
    const int tq = blk * 256 + F.wave * 32 + i;
    bf16x8 qf[8];
    { const bf16* qrow = zb + (size_t)tq * ZW + Z_MQ + h * 128 + 8 * hh;
#pragma unroll
      for (int s = 0; s < 8; ++s) qf[s] = *(const bf16x8*)(qrow + 16 * s); }
    moba_load_kv(F, h, blk, KL, VL);
    WG_SYNC();
    f32x16 acc[4]; float lsum = 0.f;
#pragma unroll
    for (int et = 0; et < 4; ++et)
#pragma unroll
        for (int r = 0; r < 16; ++r) acc[et][r] = 0.f;
    moba_wave_attend(qf, KL, VL, F.wave + 1, F.wave, i, hh, c2, mc2, acc, lsum);
    lsum += __shfl_xor(lsum, 32);
    const int nsel = blk < 3 ? blk : 3;
    {
        u2_t pw[3][16]; float lp[3];
#pragma unroll
        for (int s = 0; s < 3; ++s) { if (s < nsel) { const bf16* prow = part_g + ((size_t)(s * 4 + h) * S_ + tq) * 128; lp[s] = lpart_g[(size_t)(s * 4 + h) * S_ + tq];
#pragma unroll
                for (int et = 0; et < 4; ++et)
#pragma unroll
                    for (int g = 0; g < 4; ++g) pw[s][4 * et + g] = *(const u2_t*)(prow + 32 * et + 8 * g + 4 * hh); } }
#pragma unroll
        for (int s = 0; s < 3; ++s) { if (s < nsel) { lsum += lp[s];
#pragma unroll
                for (int et = 0; et < 4; ++et)
#pragma unroll
                    for (int g = 0; g < 4; ++g) { const u2_t w = pw[s][4 * et + g];
                        acc[et][4 * g] += bf2f(w.x & 0xffffu); acc[et][4 * g + 1] += bf2f(w.x >> 16); acc[et][4 * g + 2] += bf2f(w.y & 0xffffu); acc[et][4 * g + 3] += bf2f(w.y >> 16); } } }
    }
    const float inv = 1.0f / lsum;
    bf16* orow = mixb + (size_t)tq * D_ + 512 + h * 128;
#pragma unroll
    for (int et = 0; et < 4; ++et)
#pragma unroll
        for (int g = 0; g < 4; ++g) { u2_t w; w.x = pkbf(acc[et][4 * g] * inv, acc[et][4 * g + 1] * inv); w.y = pkbf(acc[et][4 * g + 2] * inv, acc[et][4 * g + 3] * inv); *(u2_t*)(orow + 32 * et + 8 * g + 4 * hh) = w; }
    WG_SYNC();
}

struct Args { const void* in[18]; float* out; unsigned char* ws; int ph_lo, ph_hi, li, pad; };
constexpr int N_PHASES = 10;
__global__ void __launch_bounds__(NWAVES * 64, 2) mk_fwd(Args args) {
    extern __shared__ __attribute__((aligned(16))) unsigned char lds[];
    Frame F;
    F.lds = (LAS unsigned char*)lds;
    F.MISC = (volatile LAS unsigned*)(F.lds + MISC_OFF);
    F.tid = threadIdx.x; F.lane = F.tid & 63; F.wave = __builtin_amdgcn_readfirstlane(F.tid >> 6);
    F.G = gridDim.x; { const int bx = blockIdx.x; F.vcu = (F.G % 8 == 0) ? (bx % 8) * (F.G / 8) + bx / 8 : bx; }
    F.ws = args.ws; F.out = args.out; F.ctl = (gu32*)(args.ws + WS_CTL);
    if (F.tid < 32) F.MISC[F.tid] = 0u;
    if (F.tid == 0) {
#pragma unroll
        for (int k = 0; k < 18; ++k) { const unsigned long long pv = (unsigned long long)args.in[k]; F.MISC[32 + 2 * k] = (unsigned)pv; F.MISC[33 + 2 * k] = (unsigned)(pv >> 32); }
    }
    __syncthreads();
    XcdBarrier bar = xcd_barrier_post((unsigned*)(F.ctl + CW_BAR) + args.li * XCD_BAR_WORDS, F.MISC + 8);
    const int lo = args.ph_lo, hi = args.ph_hi;
#define IN(k) (lo <= (k) && (k) < hi)
#define SEAM(k) do { if (IN(k) && IN((k) + 1)) xcd_barrier(bar); STAMP((k) + 1); } while (0)
    bf16* xb = (bf16*)(F.ws + WS_AB); bf16* zb = (bf16*)(F.ws + WS_Z); bf16* mixb = (bf16*)(F.ws + WS_MIX); bf16* actb = (bf16*)(F.ws + WS_ACT); bf16* erawb = (bf16*)(F.ws + WS_ERAW);

    STAMP(0);
    if (IN(0)) { p0_prologue(F); } SEAM(0);
    if (IN(1)) {
        { pg8::Gemm g{xb, (const bf16*)(F.ws + WS_WIN), S_, ZW, D_}; pg8::StaticOrder S; S.init(S_, ZW, F.G, (int)blockIdx.x);
          pg8::EpiScale<0, 1> E{zb, ZW, (const float*)(F.ws + WS_RSTDX), EPS_};
          pg8::gemm_phase<pg8::EpiScale<0, 1>, pg8::StaticOrder, PG8_ALIGN, PG8_SP2>(F.lds + RING_OFF, g, S, E); }
        { pg8::Gemm g{(const bf16*)(F.ws + WS_PB), (const bf16*)(F.ws + WS_WPP), S_, D_, PLE_}; pg8::StaticOrder S; S.init(S_, D_, F.G, (int)blockIdx.x);
          pg8::EpiRes<0> E{nullptr, erawb, (float*)(F.ws + WS_SSQE), D_};
          pg8::gemm_phase<pg8::EpiRes<0>, pg8::StaticOrder, false, PG8_SP2>(F.lds + RING_OFF, g, S, E); }
    } SEAM(1);
    if (IN(2)) { for (int ch = F.vcu; ch < 256; ch += F.G) gla_a_chunk(F, ch); for (int ch = F.vcu; ch < 256; ch += F.G) moba_a_item(F, ch); } SEAM(2);
    if (IN(3)) { for (int pr = F.vcu; pr < 256; pr += F.G) gla_b_pair(F, pr); for (int pr = F.vcu; pr < 256; pr += F.G) moba_b_item(F, pr); } SEAM(3);
    if (IN(4)) { for (int ch = F.vcu; ch < 256; ch += F.G) gla_c_chunk(F, ch); moba_c_phase(F); } SEAM(4);
    if (IN(5)) { float c2, mc2; moba_shift(F, c2, mc2); for (int it = F.vcu; it < 256; it += F.G) moba_d_item(F, it, c2, mc2); } SEAM(5);
    if (IN(6)) {
        pg8::Gemm g{mixb, (const bf16*)(F.ws + WS_WOUT), S_, D_, D_}; pg8::StaticOrder S; S.init(S_, D_, F.G, (int)blockIdx.x);
        pg8::EpiRes<1> E{IN_x, xb, (float*)(F.ws + WS_SSQH1), D_};
        pg8::gemm_phase<pg8::EpiRes<1>, pg8::StaticOrder, false, PG8_SP2>(F.lds + RING_OFF, g, S, E);
    } SEAM(6);
    if (IN(7)) {
        pg8::Gemm g{xb, (const bf16*)(F.ws + WS_WUP), S_, FF_, D_}; pg8::StaticOrder S; S.init(S_, FF_, F.G, (int)blockIdx.x);
        pg8::EpiScale<1, 2> E{actb, FF_, (const float*)(F.ws + WS_SSQH1), EPS_};
        pg8::gemm_phase<pg8::EpiScale<1, 2>, pg8::StaticOrder, PG8_ALIGN, PG8_SP2>(F.lds + RING_OFF, g, S, E);
    } SEAM(7);
    if (IN(8)) {
        pg8::Gemm g{actb, (const bf16*)(F.ws + WS_WDOWN), S_, D_, FF_}; pg8::StaticOrder S; S.init(S_, D_, F.G, (int)blockIdx.x);
        pg8::EpiRes<2> E{nullptr, xb, (float*)(F.ws + WS_SSQH2), D_};
        pg8::gemm_phase<pg8::EpiRes<2>, pg8::StaticOrder, false, PG8_SP2>(F.lds + RING_OFF, g, S, E);
    } SEAM(8);
    if (IN(9)) {
        pg8::Gemm g{xb, (const bf16*)(F.ws + WS_WPG), S_, D_, D_}; pg8::StaticOrder S; S.init(S_, D_, F.G, (int)blockIdx.x);
        pg8::EpiGate E{F.out, xb, erawb, (const float*)(F.ws + WS_SSQH2), (const float*)(F.ws + WS_SSQE), IN_g_pe, D_, EPS_};
        pg8::gemm_phase<pg8::EpiGate, pg8::StaticOrder, false, PG8_SP2>(F.lds + RING_OFF, g, S, E);
    }
#ifdef PROBE_LO
    STAMP(10);
    if (blockIdx.x == 0 && F.tid == 0) {
        const unsigned long long a_ = ((unsigned long long)F.MISC[81 + 2 * PROBE_LO] << 32) | F.MISC[80 + 2 * PROBE_LO], b_ = ((unsigned long long)F.MISC[81 + 2 * PROBE_HI] << 32) | F.MISC[80 + 2 * PROBE_HI];
        const unsigned long long d_ = (b_ - a_) * PROBE_K, t0_ = rt();
        while (rt() - t0_ < d_) __builtin_amdgcn_s_sleep(8);
    }
#endif
#undef IN
#undef SEAM
}

static void launch_range(const Args& a0, int lo, int hi, int li, int grid, hipStream_t stream) {
    Args a = a0; a.ph_lo = lo; a.ph_hi = hi; a.li = li;
    hipLaunchKernelGGL(mk_fwd, dim3(grid), dim3(NWAVES * 64), LDS_BYTES, stream, a);
    const hipError_t le = hipPeekAtLastError();
    if (le != hipSuccess) fprintf(stderr, "kernel_launch: launch [%d,%d) failed: %s\n", lo, hi, hipGetErrorName(le));
}
extern "C" void kernel_launch(void* const* d_in, const int* in_sizes, int n_in, void* d_out, int out_size, void* d_ws, size_t ws_size, hipStream_t stream) {
    static int grid = 0;
    if (grid == 0) {
        if (n_in != 18 || out_size != S_ * D_ || ws_size < WS_END) { fprintf(stderr, "kernel_launch: unexpected shapes (n_in %d out %d ws %zu)\n", n_in, out_size, ws_size); grid = -1; return; }
        int dev = 0, cus = 0, per_cu = 0;
        if (hipGetDevice(&dev) != hipSuccess || hipDeviceGetAttribute(&cus, hipDeviceAttributeMultiprocessorCount, dev) != hipSuccess) { grid = -1; return; }
        if (hipFuncSetAttribute((const void*)mk_fwd, hipFuncAttributeMaxDynamicSharedMemorySize, LDS_BYTES) != hipSuccess) { fprintf(stderr, "kernel_launch: hipFuncSetAttribute failed\n"); grid = -1; return; }
        if (hipOccupancyMaxActiveBlocksPerMultiprocessor(&per_cu, (const void*)mk_fwd, NWAVES * 64, LDS_BYTES) != hipSuccess || per_cu < 1) { fprintf(stderr, "kernel_launch: occupancy query says %d\n", per_cu); per_cu = 1; }
        (void)hipGetLastError();
        grid = cus;
        if (grid != 256) fprintf(stderr, "kernel_launch: note: %d CUs\n", grid);
    }
    if (grid < 0) return;
    (void)hipMemsetAsync((char*)d_ws + WS_CTL, 0, CTL_ZERO_BYTES, stream);
    Args a{};
    for (int i = 0; i < 18; ++i) a.in[i] = d_in[i];
    a.out = (float*)d_out; a.ws = (unsigned char*)d_ws;
    launch_range(a, 0, N_PHASES, 0, grid, stream);
}
```

```cpp
#include <hip/hip_runtime.h>
#include <cstdio>
#include <cstdint>
#include <math.h>
namespace pg8 {
#define PG8_LAS __attribute__((address_space(3)))
typedef unsigned short bf16_t;
typedef short bf16x8 __attribute__((ext_vector_type(8)));
typedef float f32x4 __attribute__((ext_vector_type(4)));
typedef unsigned u32x4 __attribute__((ext_vector_type(4)));
constexpr int BM = 256, BK = 64, HALF = 128, HTB = HALF * BK * 2  , STAGE_BYTES = 8 * HTB, NXCD = 8, WGM = 8;

__host__ __device__ __forceinline__ int lds_byte(int r, int c) { const int st = (r >> 4) * 2 + (c >> 5), rr = r & 15, cc = c & 31, ob = rr * 64 + cc * 2; return st * 1024 + (ob ^ (((ob >> 9) & 1) << 5)); }
__host__ __device__ __forceinline__ void stage_rc(int b, int& R, int& C) { const int st = b / 1024, sb = b % 1024, swz = sb ^ (((sb >> 9) & 1) << 5); R = (st >> 1) * 16 + swz / 64; C = (st & 1) * 32 + (swz % 64) / 2; }
__host__ __device__ __forceinline__ int perm32(int rho) { const int n = rho >> 4, i = rho & 15; return 8 * (i >> 2) + 4 * n + (i & 3); }

struct Unit { int pm, pn; };
struct Gemm { const bf16_t* A; const bf16_t* Bt; int M, N, K; };

struct StaticOrder {
    int nM, nN, nwg, G, c;
    __host__ __device__ void init(int M, int N, int G_, int c_) { nM = M / BM; nN = N / BM; nwg = nM * nN; G = G_; c = c_; }
    __host__ __device__ bool next(int i, Unit& u) const {
        const long L = (long)i * G + c; if (L >= nwg) return false;
        int wgid = (int)L; { const int q = nwg / NXCD, r = nwg % NXCD, xcd = wgid % NXCD, off = wgid / NXCD; wgid = (xcd < r ? xcd * (q + 1) : r * (q + 1) + (xcd - r) * q) + off; }
        const int nig = WGM * nN, gid = wgid / nig, fm = gid * WGM, gsz = (nM - fm) < WGM ? (nM - fm) : WGM;
        u.pm = fm + ((wgid % nig) % gsz); u.pn = (wgid % nig) / gsz; return true;
    }
    __device__ __forceinline__ void a_ready(const Unit&) const {}
    __device__ __forceinline__ void done(const Unit&) const {}
};

__device__ __forceinline__ unsigned cvt_pk_bf16(float lo, float hi) { unsigned r; asm volatile("v_cvt_pk_bf16_f32 %0, %1, %2" : "=v"(r) : "v"(lo), "v"(hi)); return r; }
typedef float f32x2 __attribute__((ext_vector_type(2)));

__device__ __forceinline__ void st16_wt(void* p, u32x4 v) { asm volatile("global_store_dwordx4 %0, %1, off sc1\n\ts_nop 1" :: "v"(p), "v"(v) : "memory"); }

__device__ __forceinline__ float rstd_from_part(const float* part, int row, float inv_n, float eps) {
    const f32x4 p = *(const f32x4*)(part + (size_t)row * 4);
    return __builtin_amdgcn_rsqf(((p[0] + p[1]) + (p[2] + p[3])) * inv_n + eps);
}
template <int ACT, int RS> struct EpiScale {
    static constexpr bool PERM = true, AFTER_DRAIN = false;
    bf16_t* O; int ldc; const float* rsv; float eps;
    __device__ __forceinline__ void operator()(const f32x4 (&acc)[2][2][4][2], const Unit& u, int wr, int wc, int fr, int fq) const {
        const int row0 = u.pm * BM + wr * 64 + fr, col0 = u.pn * BM + wc * 32 + 8 * fq;
#pragma unroll
        for (int ai = 0; ai < 2; ++ai)
#pragma unroll
            for (int m = 0; m < 4; ++m) {
                const int row = row0 + ai * HALF + m * 16;
                float s = 1.f;
                if (RS == 1) s = rsv[row];
                if (RS == 2) s = rstd_from_part(rsv, row, 1.0f / 1024.0f, eps);
                bf16_t* rowp = O + (size_t)row * ldc + col0;
#pragma unroll
                for (int bj = 0; bj < 2; ++bj) {
                    f32x4 v0 = acc[ai][bj][m][0] * s, v1 = acc[ai][bj][m][1] * s;
                    if (ACT == 1) {
#pragma unroll
                        for (int e = 0; e < 4; ++e) { const float a = fmaxf(v0[e], 0.f), b = fmaxf(v1[e], 0.f); v0[e] = a * a; v1[e] = b * b; }
                    }
                    u32x4 w; w.x = cvt_pk_bf16(v0[0], v0[1]); w.y = cvt_pk_bf16(v0[2], v0[3]); w.z = cvt_pk_bf16(v1[0], v1[1]); w.w = cvt_pk_bf16(v1[2], v1[3]);
                    *(u32x4*)(rowp + bj * HALF) = w;
                }
            }
    }
};
template <int RES> struct EpiRes {
    static constexpr bool PERM = true, AFTER_DRAIN = true;
    const float* base; bf16_t* hb; float* part; int ldc;
    __device__ __forceinline__ void fused(f32x4 (&acc)[2][2][4][2], const Unit& u, int wr, int wc, int fr, int fq, PG8_LAS unsigned char* lds, int wid, int lane) const {
        PG8_LAS float* P = (PG8_LAS float*)lds;
        const int row0 = u.pm * BM + wr * 64 + fr, col0 = u.pn * BM + wc * 32 + 8 * fq;
#pragma unroll
        for (int ai = 0; ai < 2; ++ai) {
            f32x4 pre[4][2][2]; u32x4 preb[4][2];
            if (RES == 1) {
#pragma unroll
                for (int m = 0; m < 4; ++m) { const size_t off = (size_t)(row0 + ai * HALF + m * 16) * ldc + col0;
#pragma unroll
                    for (int bj = 0; bj < 2; ++bj) { pre[m][bj][0] = __builtin_nontemporal_load((const f32x4*)(base + off + bj * HALF)); pre[m][bj][1] = __builtin_nontemporal_load((const f32x4*)(base + off + bj * HALF + 4)); } }
            }
            if (RES == 2) {
#pragma unroll
                for (int m = 0; m < 4; ++m) { const size_t off = (size_t)(row0 + ai * HALF + m * 16) * ldc + col0;
#pragma unroll
                    for (int bj = 0; bj < 2; ++bj) preb[m][bj] = *(const u32x4*)(hb + off + bj * HALF); }
            }
#pragma unroll
            for (int m = 0; m < 4; ++m) {
                const int row = row0 + ai * HALF + m * 16;
                const size_t off = (size_t)row * ldc + col0;
                float q = 0.f;
#pragma unroll
                for (int bj = 0; bj < 2; ++bj) {
                    f32x4 v0 = acc[ai][bj][m][0], v1 = acc[ai][bj][m][1];
                    if (RES == 1) { v0 = v0 + pre[m][bj][0]; v1 = v1 + pre[m][bj][1]; }
                    if (RES == 2) { const u32x4 ew = preb[m][bj];
                        v0[0] += __uint_as_float(ew.x << 16); v0[1] += __uint_as_float(ew.x & 0xffff0000u); v0[2] += __uint_as_float(ew.y << 16); v0[3] += __uint_as_float(ew.y & 0xffff0000u);
                        v1[0] += __uint_as_float(ew.z << 16); v1[1] += __uint_as_float(ew.z & 0xffff0000u); v1[2] += __uint_as_float(ew.w << 16); v1[3] += __uint_as_float(ew.w & 0xffff0000u); }
                    u32x4 w; w.x = cvt_pk_bf16(v0[0], v0[1]); w.y = cvt_pk_bf16(v0[2], v0[3]); w.z = cvt_pk_bf16(v1[0], v1[1]); w.w = cvt_pk_bf16(v1[2], v1[3]);
                    *(u32x4*)(hb + off + bj * HALF) = w;
                    q += (v0[0] * v0[0] + v0[1] * v0[1]) + (v0[2] * v0[2] + v0[3] * v0[3]) + (v1[0] * v1[0] + v1[1] * v1[1]) + (v1[2] * v1[2] + v1[3] * v1[3]);
                }
                q += __shfl_xor(q, 16); q += __shfl_xor(q, 32);
                if (fq == 0) P[(ai * HALF + wr * 64 + m * 16 + fr) * 4 + wc] = q;
            }
        }
        asm volatile("s_waitcnt lgkmcnt(0)" ::: "memory"); __builtin_amdgcn_s_barrier(); asm volatile("" ::: "memory");
        const int tid = wid * 64 + lane;
        if (tid < 256) { const f32x4 p = ((const PG8_LAS f32x4*)lds)[tid]; part[(size_t)(u.pm * BM + tid) * 4 + u.pn] = (p[0] + p[1]) + (p[2] + p[3]); }
        asm volatile("s_waitcnt lgkmcnt(0)" ::: "memory"); __builtin_amdgcn_s_barrier(); asm volatile("" ::: "memory");
    }
};
struct EpiGate {
    static constexpr bool PERM = true, AFTER_DRAIN = false;
    float* out; const bf16_t* hb; const bf16_t* eraw; const float* part_h; const float* part_e; const float* g_emb; int ldc; float eps;
    __device__ __forceinline__ void operator()(const f32x4 (&acc)[2][2][4][2], const Unit& u, int wr, int wc, int fr, int fq) const {
        const int row0 = u.pm * BM + wr * 64 + fr, col0 = u.pn * BM + wc * 32 + 8 * fq;
        f32x4 gv[2][2];
#pragma unroll
        for (int bj = 0; bj < 2; ++bj) { gv[bj][0] = *(const f32x4*)(g_emb + col0 + bj * HALF); gv[bj][1] = *(const f32x4*)(g_emb + col0 + bj * HALF + 4); }
#pragma unroll
        for (int ai = 0; ai < 2; ++ai)
#pragma unroll
            for (int mp = 0; mp < 2; ++mp) {
                u32x4 hv[2][2]; u32x4 ewv[2][2]; float sh[2], se[2];
#pragma unroll
                for (int mm = 0; mm < 2; ++mm) { const int row = row0 + ai * HALF + (2 * mp + mm) * 16; const size_t off = (size_t)row * ldc + col0;
                    sh[mm] = rstd_from_part(part_h, row, 1.0f / 1024.0f, eps); se[mm] = rstd_from_part(part_e, row, 1.0f / 1024.0f, eps);
#pragma unroll
                    for (int bj = 0; bj < 2; ++bj) { ewv[mm][bj] = __builtin_nontemporal_load((const u32x4*)(eraw + off + bj * HALF)); hv[mm][bj] = __builtin_nontemporal_load((const u32x4*)(hb + off + bj * HALF)); } }
#pragma unroll
                for (int mm = 0; mm < 2; ++mm) { const int m = 2 * mp + mm; const int row = row0 + ai * HALF + m * 16; const size_t off = (size_t)row * ldc + col0;
#pragma unroll
                    for (int bj = 0; bj < 2; ++bj) {
                        const u32x4 ew = ewv[mm][bj];
                        f32x4 e0, e1;
                        e0[0] = __uint_as_float(ew.x << 16); e0[1] = __uint_as_float(ew.x & 0xffff0000u); e0[2] = __uint_as_float(ew.y << 16); e0[3] = __uint_as_float(ew.y & 0xffff0000u);
                        e1[0] = __uint_as_float(ew.z << 16); e1[1] = __uint_as_float(ew.z & 0xffff0000u); e1[2] = __uint_as_float(ew.w << 16); e1[3] = __uint_as_float(ew.w & 0xffff0000u);
                        const u32x4 hw = hv[mm][bj];
                        f32x4 h0, h1;
                        h0[0] = __uint_as_float(hw.x << 16); h0[1] = __uint_as_float(hw.x & 0xffff0000u); h0[2] = __uint_as_float(hw.y << 16); h0[3] = __uint_as_float(hw.y & 0xffff0000u);
                        h1[0] = __uint_as_float(hw.z << 16); h1[1] = __uint_as_float(hw.z & 0xffff0000u); h1[2] = __uint_as_float(hw.w << 16); h1[3] = __uint_as_float(hw.w & 0xffff0000u);
                        const f32x4 a0 = acc[ai][bj][m][0] * sh[mm], a1 = acc[ai][bj][m][1] * sh[mm];
#pragma unroll
                        for (int e = 0; e < 4; ++e) {
                            const float g0 = __builtin_amdgcn_rcpf(1.0f + __expf(-a0[e])), g1 = __builtin_amdgcn_rcpf(1.0f + __expf(-a1[e]));
                            h0[e] += g0 * (e0[e] * se[mm] * gv[bj][0][e]); h1[e] += g1 * (e1[e] * se[mm] * gv[bj][1][e]);
                        }
                        __builtin_nontemporal_store(h0, (f32x4*)(out + off + bj * HALF)); __builtin_nontemporal_store(h1, (f32x4*)(out + off + bj * HALF + 4));
                    } }
            }
    }
};
template <class Epi, class Sched, bool ALIGN_EPI = false, bool SP2 = false>
__device__ __forceinline__ void gemm_phase(PG8_LAS unsigned char* lds, const Gemm g, const Sched& S, const Epi& E) {
    const int tid = threadIdx.x, wid = __builtin_amdgcn_readfirstlane(tid >> 6), lane = tid & 63, wr = wid >> 2, wc = wid & 3, fr = lane & 15, fq = lane >> 4;
    const int K = g.K, nt = K / BK;
    unsigned voffA[2], voffB[2];
#pragma unroll
    for (int i = 0; i < 2; ++i) { int R, C; stage_rc(tid * 16 + i * 8192, R, C); const int Rb = Epi::PERM ? ((R & ~31) + perm32(R & 31)) : R;
        voffA[i] = (unsigned)(R * K + C) * 2u; voffB[i] = (unsigned)(Rb * K + C) * 2u; }
    const size_t kstep = (size_t)(BK * 2);
    const size_t hstep = (size_t)HALF * K * 2;
    const size_t tstep = 2 * hstep;
    const unsigned ldsw = (unsigned)wid * 1024u;
    const int aoff = lds_byte(wr * 64 + fr, fq * 8), boff = lds_byte(wc * 32 + fr, fq * 8);
#define PG8_SA(b, h) (((b) * 2 + (h)) * HTB)
#define PG8_SB(b, h) ((4 + (b) * 2 + (h)) * HTB)
#define PG8_STAGE(bufoff, gbase, voff) do { _Pragma("unroll") for (int _i = 0; _i < 2; ++_i) \
        __builtin_amdgcn_global_load_lds((const unsigned*)((const char*)(gbase) + (voff)[_i]), (PG8_LAS unsigned*)(lds + (bufoff) + ldsw + _i * 8192), 16, 0, 0); } while (0)
#define PG8_LDA(dst, b, h) do { _Pragma("unroll") for (int m = 0; m < 4; ++m) _Pragma("unroll") for (int k = 0; k < 2; ++k) dst[m][k] = *(const PG8_LAS bf16x8*)(lds + PG8_SA(b, h) + aoff + m * 2048 + k * 1024); } while (0)
#define PG8_LDB(dst, b, h) do { _Pragma("unroll") for (int n = 0; n < 2; ++n) _Pragma("unroll") for (int k = 0; k < 2; ++k) dst[n][k] = *(const PG8_LAS bf16x8*)(lds + PG8_SB(b, h) + boff + n * 2048 + k * 1024); } while (0)
#define PG8_MMA(ai, bj, At, Bt) do { __builtin_amdgcn_s_setprio(1); _Pragma("unroll") for (int m = 0; m < 4; ++m) _Pragma("unroll") for (int n = 0; n < 2; ++n) _Pragma("unroll") for (int k = 0; k < 2; ++k) \
        acc[ai][bj][m][n] = __builtin_amdgcn_mfma_f32_16x16x32_bf16(Bt[n][k], At[m][k], acc[ai][bj][m][n], 0, 0, 0); __builtin_amdgcn_s_setprio(0); } while (0)
#define PG8_WAIT_V(n) asm volatile("s_waitcnt vmcnt(" #n ")" ::: "memory")
#define PG8_WAIT_L(n) asm volatile("s_waitcnt lgkmcnt(" #n ")" ::: "memory")
#define PG8_BAR __builtin_amdgcn_s_barrier()
#define PG8_SCHED __builtin_amdgcn_sched_barrier(0)
    Unit cur, nxt; int ui = 0;
    if (!S.next(0, cur)) return;
    f32x4 acc[2][2][4][2];
#pragma unroll
    for (int a = 0; a < 2; ++a)
#pragma unroll
        for (int b = 0; b < 2; ++b)
#pragma unroll
            for (int m = 0; m < 4; ++m)
#pragma unroll
                for (int n = 0; n < 2; ++n) acc[a][b][m][n] = (f32x4){0.f, 0.f, 0.f, 0.f};
    bf16x8 At[4][2], B0[2][2], B1[2][2];
    const char* cA = (const char*)g.A + (size_t)cur.pm * tstep; const char* cB = (const char*)g.Bt + (size_t)cur.pn * tstep;
    S.a_ready(cur);
    if constexpr (SP2) {
        PG8_STAGE(PG8_SB(0, 0), cB, voffB); PG8_STAGE(PG8_SB(0, 1), cB + hstep, voffB); PG8_STAGE(PG8_SA(0, 0), cA, voffA); PG8_STAGE(PG8_SA(0, 1), cA + hstep, voffA);
        if (wr == 1) PG8_BAR;
        PG8_WAIT_V(2); PG8_BAR;
        PG8_STAGE(PG8_SB(1, 0), cB + kstep, voffB); PG8_STAGE(PG8_SA(1, 0), cA + kstep, voffA); PG8_STAGE(PG8_SB(1, 1), cB + hstep + kstep, voffB);
        PG8_WAIT_V(6); PG8_BAR;
    } else {
        PG8_STAGE(PG8_SB(0, 0), cB, voffB); PG8_STAGE(PG8_SA(0, 0), cA, voffA); PG8_STAGE(PG8_SB(0, 1), cB + hstep, voffB); PG8_STAGE(PG8_SA(0, 1), cA + hstep, voffA);
        if (wr == 1) PG8_BAR;
        PG8_WAIT_V(4); PG8_BAR;
        PG8_STAGE(PG8_SB(1, 0), cB + kstep, voffB); PG8_STAGE(PG8_SA(1, 0), cA + kstep, voffA); PG8_STAGE(PG8_SB(1, 1), cB + hstep + kstep, voffB);
        PG8_WAIT_V(6); PG8_BAR;
    }
    for (;;) {
        const bool has_next = S.next(ui + 1, nxt);
        const char* nA = has_next ? (const char*)g.A + (size_t)nxt.pm * tstep : cA; const char* nB = has_next ? (const char*)g.Bt + (size_t)nxt.pn * tstep : cB;
        for (int t = 0; t < nt; t += 2) {
            const bool last = (t == nt - 2);
            const char* a1 = cA + (size_t)(t + 1) * kstep;
            const char* a2 = last ? nA : cA + (size_t)(t + 2) * kstep; const char* b2 = last ? nB : cB + (size_t)(t + 2) * kstep;
            const char* a3 = a2 + kstep; const char* b3 = b2 + kstep;
            if (last && has_next) S.a_ready(nxt);
            if constexpr (SP2) {
            PG8_LDB(B0, 0, 0); PG8_LDB(B1, 0, 1); PG8_SCHED; PG8_LDA(At, 0, 0); PG8_STAGE(PG8_SA(1, 1), a1 + hstep, voffA);
            PG8_WAIT_V(8); PG8_WAIT_L(0); PG8_BAR; PG8_MMA(0, 0, At, B0); PG8_MMA(0, 1, At, B1); PG8_BAR; PG8_SCHED;
            PG8_LDA(At, 0, 1); PG8_STAGE(PG8_SB(0, 0), b2, voffB); PG8_STAGE(PG8_SB(0, 1), b2 + hstep, voffB); PG8_STAGE(PG8_SA(0, 0), a2, voffA);
            PG8_WAIT_V(8); PG8_WAIT_L(0); PG8_BAR; PG8_MMA(1, 0, At, B0); PG8_MMA(1, 1, At, B1); PG8_BAR; PG8_SCHED;
            PG8_LDB(B0, 1, 0); PG8_LDB(B1, 1, 1); PG8_SCHED; PG8_LDA(At, 1, 0); PG8_STAGE(PG8_SA(0, 1), a2 + hstep, voffA);
            PG8_WAIT_V(8); PG8_WAIT_L(0); PG8_BAR; PG8_MMA(0, 0, At, B0); PG8_MMA(0, 1, At, B1); PG8_BAR; PG8_SCHED;
            PG8_LDA(At, 1, 1); PG8_STAGE(PG8_SB(1, 0), b3, voffB); PG8_STAGE(PG8_SB(1, 1), b3 + hstep, voffB); PG8_STAGE(PG8_SA(1, 0), a3, voffA);
            PG8_WAIT_V(8); PG8_WAIT_L(0); PG8_BAR; PG8_MMA(1, 0, At, B0); PG8_MMA(1, 1, At, B1); PG8_BAR; PG8_SCHED;
            } else {
            PG8_LDB(B0, 0, 0); PG8_SCHED; PG8_LDA(At, 0, 0); PG8_STAGE(PG8_SA(1, 1), a1 + hstep, voffA);
            PG8_WAIT_L(8); PG8_BAR; PG8_WAIT_L(0); PG8_MMA(0, 0, At, B0); PG8_BAR; PG8_SCHED;
            PG8_LDB(B1, 0, 1); PG8_STAGE(PG8_SB(0, 0), b2, voffB);
            PG8_BAR; PG8_WAIT_L(0); PG8_MMA(0, 1, At, B1); PG8_BAR;
            PG8_LDA(At, 0, 1); PG8_STAGE(PG8_SA(0, 0), a2, voffA);
            PG8_BAR; PG8_WAIT_L(0); PG8_MMA(1, 0, At, B0); PG8_BAR; PG8_SCHED;
            PG8_STAGE(PG8_SB(0, 1), b2 + hstep, voffB);
            PG8_WAIT_V(6); PG8_BAR; PG8_MMA(1, 1, At, B1); PG8_BAR;
            PG8_LDB(B0, 1, 0); PG8_SCHED; PG8_LDA(At, 1, 0); PG8_STAGE(PG8_SA(0, 1), a2 + hstep, voffA);
            PG8_WAIT_L(8); PG8_BAR; PG8_WAIT_L(0); PG8_MMA(0, 0, At, B0); PG8_BAR; PG8_SCHED;
            PG8_LDB(B1, 1, 1); PG8_STAGE(PG8_SB(1, 0), b3, voffB);
            PG8_BAR; PG8_WAIT_L(0); PG8_MMA(0, 1, At, B1); PG8_BAR;
            PG8_LDA(At, 1, 1); PG8_STAGE(PG8_SA(1, 0), a3, voffA);
            PG8_BAR; PG8_WAIT_L(0); PG8_MMA(1, 0, At, B0); PG8_BAR; PG8_SCHED;
            PG8_STAGE(PG8_SB(1, 1), b3 + hstep, voffB);
            PG8_WAIT_V(6); PG8_BAR; PG8_MMA(1, 1, At, B1); PG8_BAR;
            }
        }
        if constexpr (ALIGN_EPI) { if (wr == 0) PG8_BAR; }
        if constexpr (!Epi::AFTER_DRAIN) { E(acc, cur, wr, wc, fr, fq); S.done(cur); }
        if (!has_next) break;
#pragma unroll
        for (int a = 0; a < 2; ++a)
#pragma unroll
            for (int b = 0; b < 2; ++b)
#pragma unroll
                for (int m = 0; m < 4; ++m)
#pragma unroll
                    for (int n = 0; n < 2; ++n) acc[a][b][m][n] = (f32x4){0.f, 0.f, 0.f, 0.f};
        cur = nxt; cA = nA; cB = nB; ++ui;
        if constexpr (ALIGN_EPI) { if (wr == 1) PG8_BAR; }
    }
    PG8_WAIT_V(0);
    if constexpr (!ALIGN_EPI) { if (wr == 0) PG8_BAR; }
    PG8_BAR;
    if constexpr (Epi::AFTER_DRAIN) { E.fused(acc, cur, wr, wc, fr, fq, lds, wid, lane); S.done(cur); }
#undef PG8_SA
#undef PG8_SB
#undef PG8_STAGE
#undef PG8_LDA
#undef PG8_LDB
#undef PG8_MMA
#undef PG8_WAIT_V
#undef PG8_WAIT_L
#undef PG8_BAR
#undef PG8_SCHED
}
}
#ifndef PG8_SP2
#define PG8_SP2 true
#endif
#ifndef PG8_ALIGN
#define PG8_ALIGN true
#endif

constexpr int NWAVES = 8;
constexpr int S_ = 16384, D_ = 1024, FF_ = 4096, PLE_ = 256, INW_ = 3088, ZW = 3072;
constexpr int Z_GQ = 0, Z_GK = 256, Z_GV = 512, Z_GG = 1024, Z_MQ = 1536, Z_MK = 2048, Z_MV = 2560;
constexpr float EPS_ = 1e-6f;

constexpr size_t MiB = 1u << 20, KiB = 1u << 10;
constexpr size_t WS_CTL = 0, CTL_ZERO_BYTES = 64 * KiB;
constexpr size_t WS_WIN = 1 * MiB, WS_WOUT = 7 * MiB, WS_WUP = 9 * MiB, WS_WDOWN = 17 * MiB, WS_WPG = 25 * MiB, WS_WPP = 27 * MiB, WS_WGA = 27 * MiB + 512 * KiB;
constexpr size_t WS_SMALL = 28 * MiB;
constexpr size_t WS_RSTDX = WS_SMALL, WS_GA = WS_SMALL + 64 * KiB, WS_DECAY = WS_SMALL + 1088 * KiB, WS_KMEAN = WS_SMALL + 1344 * KiB,
                 WS_SSQH1 = WS_SMALL + 1472 * KiB, WS_SSQH2 = WS_SMALL + 1728 * KiB, WS_SSQE = WS_SMALL + 1984 * KiB, WS_LPART = WS_SMALL + 2240 * KiB;
constexpr size_t WS_ERAW = 32 * MiB, WS_AB = 64 * MiB, WS_Z = 96 * MiB, WS_MIX = 192 * MiB, WS_PB = 224 * MiB, WS_ACT = 96 * MiB, WS_END = 256 * MiB;
constexpr size_t WS_DS = 224 * MiB, WS_SPREV = 64 * MiB, WS_LIST = 80 * MiB;
constexpr size_t OUT_PART = 0, OUT_VT = 48 * MiB;
constexpr int CW_TMO = 0, CW_CNT = 1024  , CW_BAR = 4096;

constexpr int RING_OFF = 0, RING_BYTES = 131072;
constexpr int LDS_BYTES = 160 * 1024;
constexpr int MISC_OFF = LDS_BYTES - 512;

#define GAS __attribute__((address_space(1)))
#define LAS __attribute__((address_space(3)))
typedef unsigned short bf16;
typedef unsigned v4u __attribute__((ext_vector_type(4)));
typedef float f32x4 __attribute__((ext_vector_type(4)));
typedef short bf16x8 __attribute__((ext_vector_type(8)));
typedef GAS unsigned gu32;
typedef GAS unsigned long long gu64;
#define RLX_AGENT __ATOMIC_RELAXED, __HIP_MEMORY_SCOPE_AGENT
#define LDS_WAIT() asm volatile("s_waitcnt lgkmcnt(0)" ::: "memory")
#define VM_WAIT() asm volatile("s_waitcnt vmcnt(0)" ::: "memory")
__device__ __forceinline__ unsigned long long rt() { return __builtin_amdgcn_s_memrealtime(); }
__device__ __forceinline__ unsigned f2bf(float f) { unsigned u = __builtin_bit_cast(unsigned, f); return (u + 0x7fffu + ((u >> 16) & 1u)) >> 16; }
__device__ __forceinline__ unsigned pk2(float lo, float hi) { return f2bf(lo) | (f2bf(hi) << 16); }

#define XB_TMO      128
#define XB_XCNT(j)  (256  + 64 * (j))
#define XB_XSUB(j)  (1280 + 64 * (j))
#define XB_XGEN(j)  (2304 + 64 * (j))
#define XB_TOP      3328
#define XB_TOPGEN   3392
#define XCD_BAR_WORDS 3456
#define XB_SPIN_CAP (1u << 18)

__device__ __forceinline__ unsigned xb_ld(unsigned* p)              { return __hip_atomic_load(p, __ATOMIC_RELAXED, __HIP_MEMORY_SCOPE_AGENT); }
__device__ __forceinline__ unsigned xb_add(unsigned* p, unsigned v) { return __hip_atomic_fetch_add(p, v, __ATOMIC_RELAXED, __HIP_MEMORY_SCOPE_AGENT); }
__device__ __forceinline__ unsigned xb_xcc_id() { return (unsigned)__builtin_amdgcn_s_getreg((3 << 11) | 20) & 0xFu; }
#define XB_SPIN(cond, bar) do { unsigned _sp = 0; while (cond) { __builtin_amdgcn_s_sleep(1); \
    if ((++_sp & 255u) == 0u) { if (xb_ld(&(bar)[XB_TMO])) break; if (_sp > XB_SPIN_CAP) { atomicAdd(&(bar)[XB_TMO], 1u); break; } } } } while (0)

struct XcdBarrier {
    unsigned* bar; unsigned x;
    volatile LAS unsigned* st;
};

__device__ __forceinline__ XcdBarrier xcd_barrier_post(unsigned* bar, volatile LAS unsigned* st) {
    XcdBarrier b; b.bar = bar; b.x = xb_xcc_id(); b.st = st;
    if (threadIdx.x == 0) (void)xb_add(&bar[XB_XCNT(b.x)], 1u);
    return b;
}
__device__ __forceinline__ void xcd_barrier_complete(unsigned* bar, unsigned x, unsigned& nloc, unsigned& nx) {
    const unsigned G = gridDim.x * gridDim.y * gridDim.z;
    unsigned sum, cnt, mine, sp = 0u;
    for (;;) {
        sum = 0u; cnt = 0u; mine = 0u;
#pragma unroll
        for (unsigned j = 0; j < 16; ++j) { const unsigned c = xb_ld(&bar[XB_XCNT(j)]); sum += c; cnt += (c > 0u) ? 1u : 0u; mine = (j == x) ? c : mine; }
        if (sum == G) break;
        __builtin_amdgcn_s_sleep(1);
        if ((++sp & 255u) == 0u) { if (xb_ld(&bar[XB_TMO])) break; if (sp > XB_SPIN_CAP) { atomicAdd(&bar[XB_TMO], 1u); break; } }
    }
    nloc = mine > 0u ? mine : 1u; nx = cnt > 0u ? cnt : 1u;
}

__device__ __forceinline__ void xcd_barrier(const XcdBarrier& b) {
    asm volatile("s_waitcnt vmcnt(0)" ::: "memory");
    __syncthreads();
    if (threadIdx.x == 0) {
        unsigned* bar = b.bar;
        __builtin_amdgcn_s_waitcnt(0);
        unsigned nloc = b.st[0], nx = b.st[1];
        if (nloc == 0u) { xcd_barrier_complete(bar, b.x, nloc, nx); b.st[0] = nloc; b.st[1] = nx; }
        const unsigned old = xb_add(&bar[XB_XSUB(b.x)], 1u);
        const unsigned gen = old / nloc;
        if (old + 1u == (gen + 1u) * nloc) {
            __builtin_amdgcn_fence(__ATOMIC_RELEASE, "agent");
            asm volatile("s_waitcnt vmcnt(0)" ::: "memory");
            const unsigned og = xb_add(&bar[XB_TOP], 1u);
            const unsigned tg = og / nx;
            if (og + 1u == (tg + 1u) * nx) xb_add(&bar[XB_TOPGEN], 1u);
            else XB_SPIN(xb_ld(&bar[XB_TOPGEN]) == tg, bar);
            __builtin_amdgcn_fence(__ATOMIC_ACQUIRE, "agent");
            xb_add(&bar[XB_XGEN(b.x)], 1u);
            asm volatile("s_waitcnt vmcnt(0)" ::: "memory");
        } else {
            XB_SPIN(xb_ld(&bar[XB_XGEN(b.x)]) == gen, bar);
            __builtin_amdgcn_fence(__ATOMIC_ACQUIRE, "agent");
            asm volatile("s_waitcnt vmcnt(0)" ::: "memory");
        }
    }
    __syncthreads();
}

struct Frame {
    LAS unsigned char* lds;
    volatile LAS unsigned* MISC;
    gu32* ctl;
    int tid, lane, wave, vcu, G;
    unsigned char* ws; float* out;
};
__device__ __forceinline__ const void* in_ptr(const Frame& F, int k) {
    const unsigned lo = __builtin_amdgcn_readfirstlane(F.MISC[32 + 2 * k]), hi = __builtin_amdgcn_readfirstlane(F.MISC[33 + 2 * k]);
    return (const void*)(((unsigned long long)hi << 32) | lo);
}
#define IN_x ((const float*)in_ptr(F, 0))
#define IN_p ((const float*)in_ptr(F, 1))
#define IN_pos ((const int*)in_ptr(F, 2))
#define IN_g_mix ((const float*)in_ptr(F, 3))
#define IN_w_in ((const float*)in_ptr(F, 4))
#define IN_w_a2 ((const float*)in_ptr(F, 5))
#define IN_b_a ((const float*)in_ptr(F, 6))
#define IN_g_gla ((const float*)in_ptr(F, 7))
#define IN_g_mq ((const float*)in_ptr(F, 8))
#define IN_g_mk ((const float*)in_ptr(F, 9))
#define IN_w_out ((const float*)in_ptr(F, 10))
#define IN_g_ffn ((const float*)in_ptr(F, 11))
#define IN_w_up ((const float*)in_ptr(F, 12))
#define IN_w_down ((const float*)in_ptr(F, 13))
#define IN_g_pg ((const float*)in_ptr(F, 14))
#define IN_w_pg ((const float*)in_ptr(F, 15))
#define IN_w_pp ((const float*)in_ptr(F, 16))
#define IN_g_pe ((const float*)in_ptr(F, 17))
template <int CTRL> __device__ __forceinline__ float dpp_mov(float v) { return __builtin_bit_cast(float, __builtin_amdgcn_update_dpp(0, __builtin_bit_cast(int, v), CTRL, 0xf, 0xf, true)); }
__device__ __forceinline__ float row16_sum(float v) { v += dpp_mov<0xB1>(v); v += dpp_mov<0x4E>(v); v += dpp_mov<0x141>(v); v += dpp_mov<0x140>(v); return v; }
__device__ __forceinline__ float wave_sum(float v) {
    v = row16_sum(v);
    const float s0 = __builtin_bit_cast(float, __builtin_amdgcn_readlane(__builtin_bit_cast(int, v), 0)), s1 = __builtin_bit_cast(float, __builtin_amdgcn_readlane(__builtin_bit_cast(int, v), 16));
    const float s2 = __builtin_bit_cast(float, __builtin_amdgcn_readlane(__builtin_bit_cast(int, v), 32)), s3 = __builtin_bit_cast(float, __builtin_amdgcn_readlane(__builtin_bit_cast(int, v), 48));
    return (s0 + s1) + (s2 + s3);
}
__device__ __forceinline__ float bf2f(unsigned v16) { return __uint_as_float(v16 << 16); }

#ifdef PROBE_LO
#define STAMP(k) do { if (blockIdx.x == 0 && F.tid == 0) { const unsigned long long t_ = rt(); F.MISC[80 + 2 * (k)] = (unsigned)t_; F.MISC[81 + 2 * (k)] = (unsigned)(t_ >> 32); } } while (0)
#else
#define STAMP(k) do { } while (0)
#endif
struct TItem { const float* W; const float* gain; bf16* WT; int ldn, src_col, K, n_dst, k0; };
__device__ __forceinline__ TItem p0_decode(const Frame& F, int it) {
    constexpr int I_IN = (D_ / 64) * (ZW / 32), I_OUT = (D_ / 64) * (D_ / 32), I_UP = (D_ / 64) * (FF_ / 32), I_DN = (FF_ / 64) * (D_ / 32), I_PG = I_OUT;
    TItem t; int r = it;
    if (r < I_IN) { const int nb = r % (ZW / 32), kb = r / (ZW / 32), n0 = 32 * nb; t.W = IN_w_in; t.gain = IN_g_mix; t.WT = (bf16*)(F.ws + WS_WIN); t.ldn = INW_; t.src_col = n0 < 1536 ? n0 : n0 + 16; t.K = D_; t.n_dst = n0; t.k0 = 64 * kb; return t; } r -= I_IN;
    if (r < I_OUT) { const int nb = r % (D_ / 32), kb = r / (D_ / 32); t.W = IN_w_out; t.gain = nullptr; t.WT = (bf16*)(F.ws + WS_WOUT); t.ldn = D_; t.src_col = 32 * nb; t.K = D_; t.n_dst = 32 * nb; t.k0 = 64 * kb; return t; } r -= I_OUT;
    if (r < I_UP) { const int nb = r % (FF_ / 32), kb = r / (FF_ / 32); t.W = IN_w_up; t.gain = IN_g_ffn; t.WT = (bf16*)(F.ws + WS_WUP); t.ldn = FF_; t.src_col = 32 * nb; t.K = D_; t.n_dst = 32 * nb; t.k0 = 64 * kb; return t; } r -= I_UP;
    if (r < I_DN) { const int nb = r % (D_ / 32), kb = r / (D_ / 32); t.W = IN_w_down; t.gain = nullptr; t.WT = (bf16*)(F.ws + WS_WDOWN); t.ldn = D_; t.src_col = 32 * nb; t.K = FF_; t.n_dst = 32 * nb; t.k0 = 64 * kb; return t; } r -= I_DN;
    if (r < I_PG) { const int nb = r % (D_ / 32), kb = r / (D_ / 32); t.W = IN_w_pg; t.gain = IN_g_pg; t.WT = (bf16*)(F.ws + WS_WPG); t.ldn = D_; t.src_col = 32 * nb; t.K = D_; t.n_dst = 32 * nb; t.k0 = 64 * kb; return t; } r -= I_PG;
    { const int nb = r % (D_ / 32), kb = r / (D_ / 32); t.W = IN_w_pp; t.gain = nullptr; t.WT = (bf16*)(F.ws + WS_WPP); t.ldn = D_; t.src_col = 32 * nb; t.K = PLE_; t.n_dst = 32 * nb; t.k0 = 64 * kb; return t; }
}
__device__ __forceinline__ void p0_issue(const TItem& t, int lane, float (&w)[32], f32x4 (&g)[2]) {
    const float* src = t.W + (size_t)(t.k0 + (lane >> 5)) * t.ldn + t.src_col + (lane & 31);
#pragma unroll
    for (int i = 0; i < 32; ++i) w[i] = __builtin_nontemporal_load(src + (size_t)(2 * i) * t.ldn);
    if (t.gain) { g[0] = *(const f32x4*)(t.gain + t.k0 + 8 * (lane & 7)); g[1] = *(const f32x4*)(t.gain + t.k0 + 8 * (lane & 7) + 4); }
    else { g[0] = (f32x4){1.f, 1.f, 1.f, 1.f}; g[1] = g[0]; }
}
__device__ __forceinline__ void p0_prologue(Frame& F) {
    LAS float* scr = (LAS float*)(F.lds + RING_OFF + F.wave * 16384);
    constexpr int P0_ROWW = 5, P0_TRW = NWAVES - P0_ROWW;
    const bool row_role = F.wave < P0_ROWW;
    const int gw = row_role ? F.vcu * P0_ROWW + F.wave : F.vcu * P0_TRW + (F.wave - P0_ROWW), NGW = F.G * (row_role ? P0_ROWW : P0_TRW);
    bf16* Wga_t = (bf16*)(F.ws + WS_WGA);
    constexpr int NITEMS = (D_ / 64) * (ZW / 32) + 2 * (D_ / 64) * (D_ / 32) + (D_ / 64) * (FF_ / 32) + (FF_ / 64) * (D_ / 32) + (PLE_ / 64) * (D_ / 32);
    if (!row_role) {
        int it = gw; bool have = it < NITEMS;
        float w[32]; f32x4 g[2]; TItem cur;
        if (have) { cur = p0_decode(F, it); p0_issue(cur, F.lane, w, g); }
        while (have) {
#pragma unroll
            for (int i = 0; i < 32; ++i) scr[(2 * i + (F.lane >> 5)) * 33 + (F.lane & 31)] = w[i];
            const f32x4 g0 = g[0], g1 = g[1]; const TItem t = cur;
            LDS_WAIT(); asm volatile("" ::: "memory");
            const int nit = it + NGW; const bool nh = nit < NITEMS;
            if (nh) { cur = p0_decode(F, nit); p0_issue(cur, F.lane, w, g); }
            const int c = F.lane & 7;
#pragma unroll
            for (int j = 0; j < 4; ++j) { const int n = (F.lane >> 3) + 8 * j; const LAS float* s = scr + (8 * c) * 33 + n;
                v4u o; o.x = pk2(s[0 * 33] * g0[0], s[1 * 33] * g0[1]); o.y = pk2(s[2 * 33] * g0[2], s[3 * 33] * g0[3]); o.z = pk2(s[4 * 33] * g1[0], s[5 * 33] * g1[1]); o.w = pk2(s[6 * 33] * g1[2], s[7 * 33] * g1[3]);
                *(GAS v4u*)(t.WT + (size_t)(t.n_dst + n) * t.K + t.k0 + 8 * c) = o; }
            LDS_WAIT(); asm volatile("" ::: "memory");
            it = nit; have = nh;
        }
    }
    if (!row_role) { const float* wi_ = IN_w_in; const float* gm_ = IN_g_mix;
      for (int i = gw * 64 + F.lane; i < 16 * D_; i += NGW * 64) { const int r = i >> 10, k = i & 1023; Wga_t[i] = (bf16)f2bf(wi_[(size_t)k * INW_ + 1536 + r] * gm_[k]); } }
    bf16* xb = (bf16*)(F.ws + WS_AB); bf16* pb = (bf16*)(F.ws + WS_PB); float* rstdx = (float*)(F.ws + WS_RSTDX);
    const float* x_ = IN_x; const float* p_ = IN_p;
    if (row_role) {
        f32x4 v[4][4], pv[4], vn[4][4], pvn[4];
        int m0 = gw * 4; bool have = m0 < S_;
        if (have) {
#pragma unroll
            for (int rr = 0; rr < 4; ++rr) { const GAS f32x4* xr = (const GAS f32x4*)(x_ + (size_t)(m0 + rr) * D_) + F.lane;
#pragma unroll
                for (int j = 0; j < 4; ++j) v[rr][j] = __builtin_nontemporal_load(xr + 64 * j);
                pv[rr] = __builtin_nontemporal_load((const GAS f32x4*)(p_ + (size_t)(m0 + rr) * PLE_) + F.lane); }
        }
        while (have) {
            const int m1 = m0 + NGW * 4; const bool nh = m1 < S_;
            if (nh) {
#pragma unroll
                for (int rr = 0; rr < 4; ++rr) { const GAS f32x4* xr = (const GAS f32x4*)(x_ + (size_t)(m1 + rr) * D_) + F.lane;
#pragma unroll
                    for (int j = 0; j < 4; ++j) vn[rr][j] = __builtin_nontemporal_load(xr + 64 * j);
                    pvn[rr] = __builtin_nontemporal_load((const GAS f32x4*)(p_ + (size_t)(m1 + rr) * PLE_) + F.lane); }
            }
#pragma unroll
            for (int rr = 0; rr < 4; ++rr) { const int m = m0 + rr; float s = 0.f;
#pragma unroll
                for (int j = 0; j < 4; ++j) s += (v[rr][j].x * v[rr][j].x + v[rr][j].y * v[rr][j].y) + (v[rr][j].z * v[rr][j].z + v[rr][j].w * v[rr][j].w);
                s = wave_sum(s);
                GAS unsigned long long* o8 = (GAS unsigned long long*)(xb + (size_t)m * D_) + F.lane;
#pragma unroll
                for (int j = 0; j < 4; ++j) o8[64 * j] = (unsigned long long)pk2(v[rr][j].x, v[rr][j].y) | ((unsigned long long)pk2(v[rr][j].z, v[rr][j].w) << 32);
                if (F.lane == 0) rstdx[m] = 1.0f / sqrtf(s * (1.0f / D_) + EPS_);
                *((GAS unsigned long long*)(pb + (size_t)m * PLE_) + F.lane) = (unsigned long long)pk2(pv[rr].x, pv[rr].y) | ((unsigned long long)pk2(pv[rr].z, pv[rr].w) << 32); }
#pragma unroll
            for (int rr = 0; rr < 4; ++rr) { pv[rr] = pvn[rr];
#pragma unroll
                for (int j = 0; j < 4; ++j) v[rr][j] = vn[rr][j]; }
            m0 = m1; have = nh;
        }
    }
}

typedef float f32x16 __attribute__((ext_vector_type(16)));
typedef __bf16 bf2_t __attribute__((ext_vector_type(2)));
typedef float f2_t __attribute__((ext_vector_type(2)));
__device__ __forceinline__ unsigned pkbf(float lo, float hi) { f2_t v = {lo, hi}; bf2_t b = __builtin_convertvector(v, bf2_t); return __builtin_bit_cast(unsigned, b); }
#define MFMA32(a, b, c) __builtin_amdgcn_mfma_f32_32x32x16_bf16((a), (b), (c), 0, 0, 0)
#define WG_SYNC() do { asm volatile("s_waitcnt lgkmcnt(0)" ::: "memory"); __builtin_amdgcn_s_barrier(); asm volatile("" ::: "memory"); } while (0)
__device__ __forceinline__ bf16x8 pack8(const f32x16& x, int s) {
    v4u p; p.x = pkbf(x[8 * s], x[8 * s + 1]); p.y = pkbf(x[8 * s + 2], x[8 * s + 3]); p.z = pkbf(x[8 * s + 4], x[8 * s + 5]); p.w = pkbf(x[8 * s + 6], x[8 * s + 7]);
    return __builtin_bit_cast(bf16x8, p);
}
__device__ __forceinline__ float log_sigmoid(float s) { return fminf(s, 0.f) - __logf(1.0f + __expf(-fabsf(s))); }
constexpr int GROW = 72;
__device__ __forceinline__ int tperm(int tt) { return (tt & ~15) + 8 * ((tt >> 2) & 1) + 4 * ((tt >> 3) & 1) + (tt & 3); }
typedef short s16x4_t __attribute__((ext_vector_type(4)));
__device__ __forceinline__ unsigned voff_b(unsigned row, unsigned ch) { return 256u * row + 16u * (ch ^ (((row & 3u) << 2) | ((row >> 2) & 3u))); }
__device__ __forceinline__ bf16x8 v_tr_frag(const LAS unsigned char* VL, int kb0, int et, int lane) {
    const unsigned hh = lane >> 5, blk = (lane >> 4) & 1, q = (lane & 15) >> 2, p = lane & 3;
    const unsigned r0 = kb0 + 4 * hh + q, ch = 4 * et + 2 * blk + (p >> 1);
    const s16x4_t lo = __builtin_amdgcn_ds_read_tr16_b64_v4i16((LAS s16x4_t*)(VL + voff_b(r0, ch) + 8 * (p & 1)));
    const s16x4_t hi = __builtin_amdgcn_ds_read_tr16_b64_v4i16((LAS s16x4_t*)(VL + voff_b(r0 + 8, ch) + 8 * (p & 1)));
    return __builtin_shufflevector(lo, hi, 0, 1, 2, 3, 4, 5, 6, 7);
}

__device__ __forceinline__ void gla_load_w2(Frame& F, float (&w2)[16], float& bias) {
    const int c = F.tid & 255;
    const float* wa2_ = IN_w_a2;
#pragma unroll
    for (int r = 0; r < 16; ++r) w2[r] = wa2_[r * 256 + c];
    bias = IN_b_a[c];
}
__device__ __forceinline__ void gla_cumsum(Frame& F, const LAS float* GAS_, LAS float* TOT, const float (&w2)[16], float bias, float (&bl)[32], float& blast, float& boff) {
    const int c = F.tid & 255, half = F.tid >> 8;
    float run = 0.f;
#pragma unroll
    for (int i = 0; i < 32; ++i) {
        const LAS f32x4* g4 = (const LAS f32x4*)(GAS_ + (32 * half + i) * 16);
        const f32x4 g0 = g4[0], g1 = g4[1], g2 = g4[2], g3 = g4[3];
        float a = bias;
        a += g0[0] * w2[0]; a += g0[1] * w2[1]; a += g0[2] * w2[2]; a += g0[3] * w2[3];
        a += g1[0] * w2[4]; a += g1[1] * w2[5]; a += g1[2] * w2[6]; a += g1[3] * w2[7];
        a += g2[0] * w2[8]; a += g2[1] * w2[9]; a += g2[2] * w2[10]; a += g2[3] * w2[11];
        a += g3[0] * w2[12]; a += g3[1] * w2[13]; a += g3[2] * w2[14]; a += g3[3] * w2[15];
        run += log_sigmoid(a) * (1.0f / 16.0f);
        bl[i] = run;
    }
    TOT[half * 256 + c] = run;
    WG_SYNC();
    const float t0 = TOT[c], t1 = TOT[256 + c];
    blast = t0 + t1; boff = half ? t0 : 0.f;
}
__device__ __forceinline__ void gla_vt_load(Frame& F, const bf16* zb, int t0, v4u (&vw)[8]) {
#pragma unroll
    for (int i = 0; i < 8; ++i) { const int idx = F.tid + 512 * i, t = idx >> 6, c64 = idx & 63; vw[i] = *(const v4u*)(zb + (size_t)(t0 + t) * ZW + Z_GV + 8 * c64); }
}
__device__ __forceinline__ void gla_vt_write(Frame& F, LAS unsigned char* VL, const v4u (&vw)[8]) {
#pragma unroll
    for (int i = 0; i < 8; ++i) { const int idx = F.tid + 512 * i, t = idx >> 6, c64 = idx & 63; *(LAS v4u*)(VL + (c64 >> 4) * 16384 + voff_b(t, c64 & 15)) = vw[i]; }
}

__device__ __forceinline__ void gla_a_chunk(Frame& F, int ch) {
    LAS float* GA_S = (LAS float*)(F.lds);
    LAS float* TOT = (LAS float*)(F.lds + 8192);
    LAS bf16* KTE = (LAS bf16*)(F.lds + 10240);
    LAS unsigned char* VT = F.lds + 10240 + 4 * 64 * GROW * 2;
    const bf16* xb = (const bf16*)(F.ws + WS_AB); const bf16* zb = (const bf16*)(F.ws + WS_Z); const bf16* wga = (const bf16*)(F.ws + WS_WGA);
    const float* rstdx = (const float*)(F.ws + WS_RSTDX); float* ga_g = (float*)(F.ws + WS_GA); float* decay_g = (float*)(F.ws + WS_DECAY); bf16* dS_g = (bf16*)(F.ws + WS_DS);
    const int t0 = ch * 64;
    float w2[16], bias; gla_load_w2(F, w2, bias);
    v4u vw[8]; gla_vt_load(F, zb, t0, vw);
    LAS bf16* KRAW = (LAS bf16*)(VT + 65536);
    v4u kw[4];
#pragma unroll
    for (int i = 0; i < 4; ++i) { const int idx = F.tid + 512 * i, t = idx >> 5, c32 = idx & 31; kw[i] = *(const v4u*)(zb + (size_t)(t0 + t) * ZW + Z_GK + 8 * c32); }
    {
        const int rg = F.wave & 3, kh = F.wave >> 2, r = F.lane & 15, q = F.lane >> 4;
        const bf16* arow = xb + (size_t)(t0 + 16 * rg + r) * D_ + 8 * q; const bf16* brow = wga + (size_t)r * D_ + 8 * q;
        pg8::f32x4 acc = {0.f, 0.f, 0.f, 0.f};
#pragma unroll
        for (int s = 16 * kh; s < 16 * kh + 16; ++s) { const bf16x8 a = *(const bf16x8*)(arow + 32 * s), b = *(const bf16x8*)(brow + 32 * s); acc = __builtin_amdgcn_mfma_f32_16x16x32_bf16(a, b, acc, 0, 0, 0); }
#pragma unroll
        for (int g = 0; g < 4; ++g) GA_S[kh * 1024 + (16 * rg + 4 * q + g) * 16 + r] = acc[g];
    }
#pragma unroll
    for (int i = 0; i < 4; ++i) { const int idx = F.tid + 512 * i, t = idx >> 5, c32 = idx & 31; *(LAS v4u*)(KRAW + (size_t)((c32 >> 3) * 64 + t) * GROW + 8 * (c32 & 7)) = kw[i]; }
    gla_vt_write(F, VT, vw);
    WG_SYNC();
    for (int idx = F.tid; idx < 1024; idx += 512) { const float v = (GA_S[idx] + GA_S[1024 + idx]) * rstdx[t0 + (idx >> 4)]; GA_S[idx] = v; ga_g[(size_t)t0 * 16 + idx] = v; }
    WG_SYNC();
    float bl[32], blast, boff;
    gla_cumsum(F, GA_S, TOT, w2, bias, bl, blast, boff);
    {
        const int c = F.tid & 255, half = F.tid >> 8, h = c >> 6, d = c & 63;
        if (half == 0) decay_g[ch * 256 + c] = __expf(blast);
#pragma unroll
        for (int g8 = 0; g8 < 4; ++g8) {
            float v[8];
#pragma unroll
            for (int j = 0; j < 8; ++j) v[j] = bf2f(KRAW[(size_t)(h * 64 + 32 * half + 8 * g8 + j) * GROW + d]) * __expf(blast - (boff + bl[8 * g8 + j]));
            const int tt = 32 * half + 8 * g8, hi = (tt >> 3) & 1;
            LAS bf16* row = KTE + (size_t)(h * 64 + d) * GROW + (tt & ~15) + 4 * hi;
            typedef unsigned u2 __attribute__((ext_vector_type(2)));
            u2 lo, hi2; lo.x = pkbf(v[0], v[1]); lo.y = pkbf(v[2], v[3]); hi2.x = pkbf(v[4], v[5]); hi2.y = pkbf(v[6], v[7]);
            *(LAS u2*)(row) = lo; *(LAS u2*)(row + 8) = hi2;
        }
    }
    WG_SYNC();
    {
        const int h = F.wave >> 1, dt = F.wave & 1, i = F.lane & 31, hh = F.lane >> 5;
        f32x16 acc[4];
#pragma unroll
        for (int et = 0; et < 4; ++et)
#pragma unroll
            for (int r = 0; r < 16; ++r) acc[et][r] = 0.f;
#pragma unroll
        for (int s = 0; s < 4; ++s) {
            const bf16x8 a = *(const LAS bf16x8*)(KTE + (size_t)(h * 64 + 32 * dt + i) * GROW + 16 * s + 8 * hh);
#pragma unroll
            for (int et = 0; et < 4; ++et) { const bf16x8 b = v_tr_frag(VT + h * 16384, 16 * s, et, F.lane); acc[et] = MFMA32(a, b, acc[et]); }
        }
#pragma unroll
        for (int et = 0; et < 4; ++et) {
            bf16* dst = dS_g + ((size_t)(ch * 4 + h) * 128 + 32 * et + i) * 64 + 32 * dt + 4 * hh;
            typedef unsigned u2 __attribute__((ext_vector_type(2)));
#pragma unroll
            for (int g = 0; g < 4; ++g) { u2 w; w.x = pkbf(acc[et][4 * g], acc[et][4 * g + 1]); w.y = pkbf(acc[et][4 * g + 2], acc[et][4 * g + 3]); *(u2*)(dst + 8 * g) = w; }
        }
    }
    WG_SYNC();
}

__device__ __forceinline__ void gla_b_pair(Frame& F, int pair) {
    LAS float* DSL = (LAS float*)(F.lds);
    LAS float* DEC = (LAS float*)(F.lds + 65536);
    LAS float* SEGE = (LAS float*)(F.lds + 131072);
    LAS float* SEGP = (LAS float*)(F.lds + 131072 + 2048);
    const float* decay_g = (const float*)(F.ws + WS_DECAY); const bf16* dS_g = (const bf16*)(F.ws + WS_DS); bf16* sp_g = (bf16*)(F.ws + WS_SPREV);
    const int h = pair >> 6, seg = F.tid >> 6, d = F.tid & 63;
#pragma unroll
    for (int i = 0; i < 8; ++i) { const int idx = F.tid + 512 * i, n = idx >> 4, d4 = idx & 15; *(LAS pg8::f32x4*)(DEC + n * 64 + 4 * d4) = *(const pg8::f32x4*)(decay_g + (size_t)n * 256 + h * 64 + 4 * d4); }
    for (int sub = 0; sub < 2; ++sub) {
        const int e = (pair & 63) * 2 + sub;
#pragma unroll
        for (int i = 0; i < 4; ++i) { const int idx = F.tid + 512 * i, n = idx >> 3, d8 = idx & 7;
            const v4u w = *(const v4u*)(dS_g + ((size_t)(n * 4 + h) * 128 + e) * 64 + 8 * d8);
            LAS pg8::f32x4* dp = (LAS pg8::f32x4*)(DSL + n * 64 + 8 * d8);
            dp[0] = (pg8::f32x4){bf2f(w.x & 0xffffu), bf2f(w.x >> 16), bf2f(w.y & 0xffffu), bf2f(w.y >> 16)}; dp[1] = (pg8::f32x4){bf2f(w.z & 0xffffu), bf2f(w.z >> 16), bf2f(w.w & 0xffffu), bf2f(w.w >> 16)}; }
        WG_SYNC();
        float Sv = 0.f, P = 1.f;
#pragma unroll 8
        for (int i = 0; i < 32; ++i) { const int n = seg * 32 + i; const float x = DSL[n * 64 + d], a = DEC[n * 64 + d]; DSL[n * 64 + d] = Sv; Sv = a * Sv + x; P *= a; }
        SEGE[seg * 64 + d] = Sv; SEGP[seg * 64 + d] = P;
        WG_SYNC();
        float st = 0.f;
        for (int k = 0; k < seg; ++k) st = SEGP[k * 64 + d] * st + SEGE[k * 64 + d];
        float Pq = 1.f;
#pragma unroll 8
        for (int i = 0; i < 32; ++i) { const int n = seg * 32 + i; const float v = DSL[n * 64 + d] + Pq * st; Pq *= DEC[n * 64 + d]; sp_g[((size_t)(n * 4 + h) * 128 + e) * 64 + d] = (bf16)f2bf(v); }
        WG_SYNC();
    }
}

__device__ __forceinline__ void gla_c_chunk(Frame& F, int ch) {
    LAS float* GA2 = (LAS float*)(F.lds);
    LAS float* TOT = (LAS float*)(F.lds + 4096);
    LAS bf16* QD = (LAS bf16*)(F.lds + 6144);
    LAS bf16* KI = (LAS bf16*)(F.lds + 6144 + 36864);
    LAS unsigned char* VT = F.lds + 6144 + 2 * 36864;
    const bf16* zb = (const bf16*)(F.ws + WS_Z); const float* ga_g = (const float*)(F.ws + WS_GA); const bf16* sp_g = (const bf16*)(F.ws + WS_SPREV); bf16* mixb = (bf16*)(F.ws + WS_MIX);
    const int t0 = ch * 64;
    float w2[16], bias; gla_load_w2(F, w2, bias);
    v4u vw[8]; gla_vt_load(F, zb, t0, vw);
    v4u qw[4], kw[4];
#pragma unroll
    for (int i = 0; i < 4; ++i) { const int idx = F.tid + 512 * i, t = idx >> 5, c32 = idx & 31; qw[i] = *(const v4u*)(zb + (size_t)(t0 + t) * ZW + Z_GQ + 8 * c32); kw[i] = *(const v4u*)(zb + (size_t)(t0 + t) * ZW + Z_GK + 8 * c32); }
    for (int idx = F.tid; idx < 1024; idx += 512) GA2[idx] = ga_g[(size_t)t0 * 16 + idx];
    bf16x8 sfr[4][4];
    { const int h_ = F.wave >> 1, i_ = F.lane & 31, hh_ = F.lane >> 5;
#pragma unroll
      for (int et = 0; et < 4; ++et) { const bf16* srow = sp_g + ((size_t)(ch * 4 + h_) * 128 + 32 * et + i_) * 64 + 8 * hh_;
#pragma unroll
          for (int s = 0; s < 4; ++s) sfr[et][s] = *(const bf16x8*)(srow + 16 * s); } }
#pragma unroll
    for (int i = 0; i < 4; ++i) { const int idx = F.tid + 512 * i, t = idx >> 5, c32 = idx & 31; const size_t o = (size_t)((c32 >> 3) * 64 + t) * GROW + 8 * (c32 & 7); *(LAS v4u*)(QD + o) = qw[i]; *(LAS v4u*)(KI + o) = kw[i]; }
    gla_vt_write(F, VT, vw);
    WG_SYNC();
    float bl[32], blast, boff;
    gla_cumsum(F, GA2, TOT, w2, bias, bl, blast, boff);
    {
        const int c = F.tid & 255, half = F.tid >> 8, h = c >> 6, d = c & 63;
#pragma unroll
        for (int i = 0; i < 32; ++i) {
            const float b = boff + bl[i];
            const size_t o = (size_t)(h * 64 + 32 * half + i) * GROW + d;
            const float qd = bf2f(QD[o]) * __expf(b) * 0.125f, ki = bf2f(KI[o]) * __expf(-b);
            QD[o] = (bf16)f2bf(qd); KI[o] = (bf16)f2bf(ki);
        }
    }
    v4u ggw[8];
#pragma unroll
    for (int k = 0; k < 8; ++k) { const int idx = F.tid + 512 * k, t = idx >> 6, c64 = idx & 63; ggw[k] = *(const v4u*)(zb + (size_t)(t0 + t) * ZW + Z_GG + 8 * c64); }
    WG_SYNC();
    {
        const int h = F.wave >> 1, ct = F.wave & 1, i = F.lane & 31, hh = F.lane >> 5;
        bf16x8 qf[4];
#pragma unroll
        for (int s = 0; s < 4; ++s) qf[s] = *(const LAS bf16x8*)(QD + (size_t)(h * 64 + 32 * ct + i) * GROW + 16 * s + 8 * hh);
        f32x16 acc[4];
#pragma unroll
        for (int et = 0; et < 4; ++et)
#pragma unroll
            for (int r = 0; r < 16; ++r) acc[et][r] = 0.f;
#pragma unroll
        for (int et = 0; et < 4; ++et) {
#pragma unroll
            for (int s = 0; s < 4; ++s) acc[et] = MFMA32(sfr[et][s], qf[s], acc[et]);
        }
        for (int jt = 0; jt <= ct; ++jt) {
            f32x16 X;
#pragma unroll
            for (int r = 0; r < 16; ++r) X[r] = 0.f;
#pragma unroll
            for (int s = 0; s < 4; ++s) { const bf16x8 kf = *(const LAS bf16x8*)(KI + (size_t)(h * 64 + 32 * jt + i) * GROW + 16 * s + 8 * hh); X = MFMA32(kf, qf[s], X); }
            if (jt == ct) {
#pragma unroll
                for (int r = 0; r < 16; ++r) { const int j = (r & 3) + 8 * (r >> 2) + 4 * hh; if (j > i) X[r] = 0.f; }
            }
#pragma unroll
            for (int s2 = 0; s2 < 2; ++s2) {
                const bf16x8 xs = pack8(X, s2);
#pragma unroll
                for (int et = 0; et < 4; ++et) { const bf16x8 vf = v_tr_frag(VT + h * 16384, 32 * jt + 16 * s2, et, F.lane); acc[et] = MFMA32(vf, xs, acc[et]); }
            }
        }
        float ss = 0.f;
#pragma unroll
        for (int et = 0; et < 4; ++et)
#pragma unroll
            for (int r = 0; r < 16; ++r) ss += acc[et][r] * acc[et][r];
        ss += __shfl_xor(ss, 32);
        const float rn = __builtin_amdgcn_rsqf(ss * (1.0f / 128.0f) + EPS_);
        const float* ggl_ = IN_g_gla;
        WG_SYNC();
        const int t = 32 * ct + i;
#pragma unroll
        for (int et = 0; et < 4; ++et)
#pragma unroll
            for (int g = 0; g < 4; ++g) {
                const int e0 = 32 * et + 8 * g + 4 * hh;
                const pg8::f32x4 gl = *(const pg8::f32x4*)(ggl_ + e0);
                typedef unsigned u2 __attribute__((ext_vector_type(2)));
                u2 w; w.x = pkbf(acc[et][4 * g] * rn * gl[0], acc[et][4 * g + 1] * rn * gl[1]); w.y = pkbf(acc[et][4 * g + 2] * rn * gl[2], acc[et][4 * g + 3] * rn * gl[3]);
                *(LAS u2*)(VT + h * 16384 + voff_b(t, e0 >> 3) + 8 * hh) = w;
            }
    }
    WG_SYNC();
#pragma unroll
    for (int k = 0; k < 8; ++k) { const int idx = F.tid + 512 * k, t = idx >> 6, c64 = idx & 63;
        const v4u on = *(const LAS v4u*)(VT + (c64 >> 4) * 16384 + voff_b(t, c64 & 15)), gw = ggw[k];
        float o[8] = {bf2f(on.x & 0xffffu), bf2f(on.x >> 16), bf2f(on.y & 0xffffu), bf2f(on.y >> 16), bf2f(on.z & 0xffffu), bf2f(on.z >> 16), bf2f(on.w & 0xffffu), bf2f(on.w >> 16)};
        float gv[8] = {bf2f(gw.x & 0xffffu), bf2f(gw.x >> 16), bf2f(gw.y & 0xffffu), bf2f(gw.y >> 16), bf2f(gw.z & 0xffffu), bf2f(gw.z >> 16), bf2f(gw.w & 0xffffu), bf2f(gw.w >> 16)};
#pragma unroll
        for (int j = 0; j < 8; ++j) o[j] *= gv[j] * __builtin_amdgcn_rcpf(1.0f + __expf(-gv[j]));
        v4u w; w.x = pkbf(o[0], o[1]); w.y = pkbf(o[2], o[3]); w.z = pkbf(o[4], o[5]); w.w = pkbf(o[6], o[7]);
        *(v4u*)(mixb + (size_t)(t0 + t) * D_ + 8 * c64) = w; }
    WG_SYNC();
}

constexpr int KROW = 136;
constexpr int LIST_PER_HEAD = 256 * 2016;
__device__ __forceinline__ int list_off(int h, int j) { return h * LIST_PER_HEAD + 256 * (63 * j - (j * (j - 1)) / 2); }
typedef unsigned u2_t __attribute__((ext_vector_type(2)));

__device__ __forceinline__ void sincos_acc(float a, float& s, float& c) {
    const float k = __builtin_rintf(a * 0.15915494309189535f);
    float r = __builtin_fmaf(-k, 6.28125f, a);
    r = __builtin_fmaf(-k, 0.0019353071693331003f, r);
    r = __builtin_fmaf(-k, 1.0253131677018246e-11f, r);
    const float rev = r * 0.15915494309189535f;
    s = __builtin_amdgcn_sinf(rev); c = __builtin_amdgcn_cosf(rev);
}

__device__ __forceinline__ void moba_a_item(Frame& F, int item) {
    const int blk = item >> 2, h = item & 3;
    LAS float* KM = (LAS float*)(F.lds);
    bf16* zb = (bf16*)(F.ws + WS_Z); float* kmean_g = (float*)(F.ws + WS_KMEAN);
    {
        const int ts = F.lane >> 4, g = F.lane & 15;
        const float* gmq_ = IN_g_mq; const float* gmk_ = IN_g_mk; const int* pos_ = IN_pos;
        LAS float* INVT = KM + 32 * 128;
        if (F.tid < 64) INVT[F.tid] = 1.0f / powf(10000.0f, (float)F.tid / 64.0f);
        WG_SYNC();
        float inv[4]; f32x4 gq1 = *(const f32x4*)(gmq_ + 4 * g), gq2 = *(const f32x4*)(gmq_ + 64 + 4 * g), gk1 = *(const f32x4*)(gmk_ + 4 * g), gk2 = *(const f32x4*)(gmk_ + 64 + 4 * g);
#pragma unroll
        for (int c = 0; c < 4; ++c) inv[c] = INVT[4 * g + c];
        float km1[4] = {0.f, 0.f, 0.f, 0.f}, km2[4] = {0.f, 0.f, 0.f, 0.f};
        for (int b4 = 0; b4 < 2; ++b4) {
            u2_t ql[4], qh[4], kl[4], kh[4]; int ps[4];
#pragma unroll
            for (int u = 0; u < 4; ++u) { const int t = blk * 256 + F.wave * 32 + 16 * b4 + 4 * u + ts;
                const bf16* pq = zb + (size_t)t * ZW + Z_MQ + h * 128 + 4 * g; const bf16* pk = zb + (size_t)t * ZW + Z_MK + h * 128 + 4 * g;
                ps[u] = pos_[t]; ql[u] = *(const u2_t*)pq; qh[u] = *(const u2_t*)(pq + 64); kl[u] = *(const u2_t*)pk; kh[u] = *(const u2_t*)(pk + 64); }
#pragma unroll
            for (int u = 0; u < 4; ++u) { const int t = blk * 256 + F.wave * 32 + 16 * b4 + 4 * u + ts;
                float q1[4] = {bf2f(ql[u].x & 0xffffu), bf2f(ql[u].x >> 16), bf2f(ql[u].y & 0xffffu), bf2f(ql[u].y >> 16)}, q2[4] = {bf2f(qh[u].x & 0xffffu), bf2f(qh[u].x >> 16), bf2f(qh[u].y & 0xffffu), bf2f(qh[u].y >> 16)};
                float k1[4] = {bf2f(kl[u].x & 0xffffu), bf2f(kl[u].x >> 16), bf2f(kl[u].y & 0xffffu), bf2f(kl[u].y >> 16)}, k2[4] = {bf2f(kh[u].x & 0xffffu), bf2f(kh[u].x >> 16), bf2f(kh[u].y & 0xffffu), bf2f(kh[u].y >> 16)};
                float sq = 0.f, sk = 0.f;
#pragma unroll
                for (int c = 0; c < 4; ++c) { sq += q1[c] * q1[c] + q2[c] * q2[c]; sk += k1[c] * k1[c] + k2[c] * k2[c]; }
                sq = row16_sum(sq); sk = row16_sum(sk);
                const float rq = __builtin_amdgcn_rsqf(sq * (1.0f / 128.0f) + EPS_), rk = __builtin_amdgcn_rsqf(sk * (1.0f / 128.0f) + EPS_);
                float oq1[4], oq2[4], ok1[4], ok2[4];
#pragma unroll
                for (int c = 0; c < 4; ++c) { float sn, cs; sincos_acc((float)ps[u] * inv[c], sn, cs);
                    const float yq1 = q1[c] * rq * gq1[c], yq2 = q2[c] * rq * gq2[c], yk1 = k1[c] * rk * gk1[c], yk2 = k2[c] * rk * gk2[c];
                    oq1[c] = yq1 * cs - yq2 * sn; oq2[c] = yq2 * cs + yq1 * sn; ok1[c] = yk1 * cs - yk2 * sn; ok2[c] = yk2 * cs + yk1 * sn;
                    km1[c] += ok1[c]; km2[c] += ok2[c]; }
                bf16* pq = zb + (size_t)t * ZW + Z_MQ + h * 128 + 4 * g; bf16* pk = zb + (size_t)t * ZW + Z_MK + h * 128 + 4 * g;
                u2_t w; w.x = pkbf(oq1[0], oq1[1]); w.y = pkbf(oq1[2], oq1[3]); *(u2_t*)pq = w; w.x = pkbf(oq2[0], oq2[1]); w.y = pkbf(oq2[2], oq2[3]); *(u2_t*)(pq + 64) = w;
                w.x = pkbf(ok1[0], ok1[1]); w.y = pkbf(ok1[2], ok1[3]); *(u2_t*)pk = w; w.x = pkbf(ok2[0], ok2[1]); w.y = pkbf(ok2[2], ok2[3]); *(u2_t*)(pk + 64) = w;
            }
        }
#pragma unroll
        for (int c = 0; c < 4; ++c) { KM[(F.wave * 4 + ts) * 128 + 4 * g + c] = km1[c]; KM[(F.wave * 4 + ts) * 128 + 64 + 4 * g + c] = km2[c]; }
    }
    WG_SYNC();
    if (F.tid < 128) { float s = 0.f;
#pragma unroll
        for (int w = 0; w < 32; ++w) s += KM[w * 128 + F.tid];
        kmean_g[(size_t)(h * 64 + blk) * 128 + F.tid] = s * (1.0f / 256.0f); }
    WG_SYNC();
}

__device__ __forceinline__ void top3_insert(float v, int j, float& v0, float& v1, float& v2, int& i0, int& i1, int& i2) {
    const bool b0 = (v > v0) || (v == v0 && j < i0), b1 = (v > v1) || (v == v1 && j < i1), b2 = (v > v2) || (v == v2 && j < i2);
    const float n2 = b1 ? v1 : (b2 ? v : v2); const int m2 = b1 ? i1 : (b2 ? j : i2);
    const float n1 = b0 ? v0 : (b1 ? v : v1); const int m1 = b0 ? i0 : (b1 ? j : i1);
    const float n0 = b0 ? v : v0; const int m0 = b0 ? j : i0;
    v0 = n0; v1 = n1; v2 = n2; i0 = m0; i1 = m1; i2 = m2;
}
__device__ __forceinline__ void moba_b_item(Frame& F, int item) {
    const int kb = item >> 2, h = item & 3;
    if (kb == 0) return;
    LAS bf16* KMH = (LAS bf16*)(F.lds);
    LAS bf16* KML = (LAS bf16*)(F.lds + 64 * KROW * 2);
    LAS unsigned* HIST = (LAS unsigned*)(F.lds + 2 * 64 * KROW * 2);
    LAS unsigned* BASE = HIST + 64;
    const bf16* zb = (const bf16*)(F.ws + WS_Z); const float* kmean_g = (const float*)(F.ws + WS_KMEAN); unsigned* list_g = (unsigned*)(F.ws + WS_LIST);
    const int i = F.lane & 31, kk = F.lane >> 5;
    const int t = kb * 256 + F.wave * 32 + i;
    bf16x8 qf[8];
    { const bf16* qrow = zb + (size_t)t * ZW + Z_MQ + h * 128 + 8 * kk;
#pragma unroll
      for (int s = 0; s < 8; ++s) qf[s] = *(const bf16x8*)(qrow + 16 * s); }
    for (int idx = F.tid; idx < 64 * 128; idx += 512) { const int j = idx >> 7, d = idx & 127; const float v = (j < kb) ? kmean_g[(size_t)(h * 64 + j) * 128 + d] : 0.f;
        const unsigned hi = f2bf(v); const float rem = v - bf2f(hi); KMH[j * KROW + d] = (bf16)hi; KML[j * KROW + d] = (bf16)f2bf(rem); }
    if (F.tid < 64) HIST[F.tid] = 0u;
    WG_SYNC();
    float v0 = -INFINITY, v1 = -INFINITY, v2 = -INFINITY; int i0 = 1 << 20, i1 = 1 << 20, i2 = 1 << 20;
    const int njt = (kb + 31) >> 5;
    for (int jt = 0; jt < njt; ++jt) {
        f32x16 acc;
#pragma unroll
        for (int r = 0; r < 16; ++r) acc[r] = 0.f;
#pragma unroll
        for (int s = 0; s < 8; ++s) {
            const bf16x8 ah = *(const LAS bf16x8*)(KMH + (size_t)(32 * jt + i) * KROW + 16 * s + 8 * kk), al = *(const LAS bf16x8*)(KML + (size_t)(32 * jt + i) * KROW + 16 * s + 8 * kk);
            acc = MFMA32(ah, qf[s], acc); acc = MFMA32(al, qf[s], acc);
        }
#pragma unroll
        for (int r = 0; r < 16; ++r) { const int j = 32 * jt + (r & 3) + 8 * (r >> 2) + 4 * kk; if (j < kb) top3_insert(acc[r], j, v0, v1, v2, i0, i1, i2); }
    }
    {
        const float pv0 = __shfl_xor(v0, 32), pv1 = __shfl_xor(v1, 32), pv2 = __shfl_xor(v2, 32);
        const int pi0 = __shfl_xor(i0, 32), pi1 = __shfl_xor(i1, 32), pi2 = __shfl_xor(i2, 32);
        top3_insert(pv0, pi0, v0, v1, v2, i0, i1, i2); top3_insert(pv1, pi1, v0, v1, v2, i0, i1, i2); top3_insert(pv2, pi2, v0, v1, v2, i0, i1, i2);
    }
    const int nsel = kb < 3 ? kb : 3;
    unsigned lp0 = 0, lp1 = 0, lp2 = 0;
    if (kk == 0) {
        if (nsel > 0) lp0 = atomicAdd((unsigned*)&HIST[i0], 1u);
        if (nsel > 1) lp1 = atomicAdd((unsigned*)&HIST[i1], 1u);
        if (nsel > 2) lp2 = atomicAdd((unsigned*)&HIST[i2], 1u);
    }
    WG_SYNC();
    if (F.tid < 64) { const unsigned n = HIST[F.tid]; BASE[F.tid] = n ? atomicAdd((unsigned*)(F.ctl + CW_CNT + h * 64 + F.tid), n) : 0u; }
    WG_SYNC();
    if (kk == 0) {
        if (nsel > 0) list_g[list_off(h, i0) + BASE[i0] + lp0] = (unsigned)t | (0u << 16);
        if (nsel > 1) list_g[list_off(h, i1) + BASE[i1] + lp1] = (unsigned)t | (1u << 16);
        if (nsel > 2) list_g[list_off(h, i2) + BASE[i2] + lp2] = (unsigned)t | (2u << 16);
    }
    WG_SYNC();
}

__device__ __forceinline__ void moba_load_kv(Frame& F, int h, int j, LAS bf16* KL, LAS unsigned char* VL) {
    const bf16* zb = (const bf16*)(F.ws + WS_Z);
#pragma unroll
    for (int i = 0; i < 8; ++i) { const int idx = F.tid + 512 * i, r = idx >> 4, c16 = idx & 15;
        *(LAS v4u*)(KL + (size_t)r * KROW + 8 * c16) = *(const v4u*)(zb + (size_t)(j * 256 + r) * ZW + Z_MK + h * 128 + 8 * c16); }
#pragma unroll
    for (int i = 0; i < 8; ++i) { const int idx = F.tid + 512 * i, r = idx >> 4, c16 = idx & 15;
        *(LAS v4u*)(VL + voff_b(r, c16)) = *(const v4u*)(zb + (size_t)(j * 256 + r) * ZW + Z_MV + h * 128 + 8 * c16); }
}
__device__ __forceinline__ void moba_wave_attend(const bf16x8 (&qf)[8], const LAS bf16* KL, const LAS unsigned char* VL, int nkt, int diag_kt, int i, int hh, int lane, float c2, float mc2, f32x16 (&acc)[4], float& lsum) {
    for (int kt = 0; kt < nkt; ++kt) {
        f32x16 St;
#pragma unroll
        for (int r = 0; r < 16; ++r) St[r] = 0.f;
#pragma unroll
        for (int s = 0; s < 8; ++s) { const bf16x8 kf = *(const LAS bf16x8*)(KL + (size_t)(32 * kt + i) * KROW + 16 * s + 8 * hh); St = MFMA32(kf, qf[s], St); }
#pragma unroll
        for (int r = 0; r < 16; ++r) St[r] = __builtin_amdgcn_exp2f(St[r] * c2 - mc2);
        if (kt == diag_kt) {
#pragma unroll
            for (int r = 0; r < 16; ++r) { const int kl = (r & 3) + 8 * (r >> 2) + 4 * hh; if (kl > i) St[r] = 0.f; }
        }
#pragma unroll
        for (int r = 0; r < 16; ++r) lsum += St[r];
#pragma unroll
        for (int s2 = 0; s2 < 2; ++s2) {
            const bf16x8 ps = pack8(St, s2);
#pragma unroll
            for (int et = 0; et < 4; ++et) { const bf16x8 vf = v_tr_frag(VL, 32 * kt + 16 * s2, et, lane); acc[et] = MFMA32(vf, ps, acc[et]); }
        }
    }
}
__device__ __forceinline__ void moba_shift(Frame& F, float& c2, float& mc2) {
    const float* gmq_ = IN_g_mq; const float* gmk_ = IN_g_mk;
    float m1 = fmaxf(fabsf(gmq_[F.lane]), fabsf(gmq_[F.lane + 64])), m2 = fmaxf(fabsf(gmk_[F.lane]), fabsf(gmk_[F.lane + 64]));
#pragma unroll
    for (int o = 1; o < 64; o <<= 1) { m1 = fmaxf(m1, __shfl_xor(m1, o)); m2 = fmaxf(m2, __shfl_xor(m2, o)); }
    c2 = 0.08838834764831845f * 1.4426950408889634f;
    mc2 = 11.313708498984761f * m1 * m2 * 1.4426950408889634f;
}

__device__ __forceinline__ void mc_decode(const LAS int* PRE, int it, int& hj, int& chunk) {
    int lo = 0, hi = 255;
    while (lo < hi) { const int mid = (lo + hi + 1) >> 1; if (PRE[mid] <= it) lo = mid; else hi = mid - 1; }
    hj = lo; chunk = it - PRE[lo];
}
__device__ __forceinline__ void mc_fetch(const Frame& F, int hj, int chunk, int n, int i, int hh, bool& active, bool& valid, int& tq, int& slot, bf16x8 (&qf)[8]) {
    const bf16* zb = (const bf16*)(F.ws + WS_Z); const unsigned* list_g = (const unsigned*)(F.ws + WS_LIST);
    const int h = hj >> 6, j = hj & 63, base = chunk * 256 + F.wave * 32;
    active = base < n; valid = false; tq = 0; slot = 0;
    if (active) {
        const int eidx = base + i; valid = eidx < n;
        const unsigned ent = list_g[list_off(h, j) + (valid ? eidx : base)];
        tq = (int)(ent & 0xffffu); slot = (int)(ent >> 16);
        const bf16* qrow = zb + (size_t)tq * ZW + Z_MQ + h * 128 + 8 * hh;
#pragma unroll
        for (int s = 0; s < 8; ++s) qf[s] = *(const bf16x8*)(qrow + 16 * s);
    }
}
__device__ __forceinline__ void moba_c_phase(Frame& F) {
    LAS bf16* KL = (LAS bf16*)(F.lds); LAS unsigned char* VL = F.lds + 256 * KROW * 2;
    LAS int* PRE = (LAS int*)(F.lds + 256 * KROW * 2 + 65536);
    LAS int* WT = PRE + 260;
    bf16* part_g = (bf16*)((unsigned char*)F.out + OUT_PART); float* lpart_g = (float*)(F.ws + WS_LPART);
    int mycnt = 0;
    if (F.tid < 256) {
        mycnt = (int)__hip_atomic_load(F.ctl + CW_CNT + F.tid, RLX_AGENT);
        int v = (mycnt + 255) >> 8, incl = v;
#pragma unroll
        for (int o = 1; o < 64; o <<= 1) { const int u = __shfl_up(incl, o); if (F.lane >= o) incl += u; }
        if (F.lane == 63) WT[F.wave] = incl;
        PRE[F.tid] = incl - v;
    }
    WG_SYNC();
    if (F.tid < 256) { int off = 0; for (int w = 0; w < F.wave; ++w) off += WT[w]; PRE[F.tid] += off; if (F.tid == 255) PRE[256] = PRE[255] + ((mycnt + 255) >> 8); }
    WG_SYNC();
    const int T = PRE[256];
    float c2, mc2; moba_shift(F, c2, mc2);
    const int i = F.lane & 31, hh = F.lane >> 5;
    const int it0 = (int)(((long long)F.vcu * T) / F.G), it1 = (int)(((long long)(F.vcu + 1) * T) / F.G);
    int cur_hj = -1;
    int hj = 0, chunk = 0, tq = 0, slot = 0; bool active = false, valid = false; bf16x8 qf[8];
#pragma unroll
    for (int s = 0; s < 8; ++s) qf[s] = (bf16x8){0, 0, 0, 0, 0, 0, 0, 0};
    if (it0 < it1) { mc_decode(PRE, it0, hj, chunk); const int n = (int)__hip_atomic_load(F.ctl + CW_CNT + hj, RLX_AGENT); mc_fetch(F, hj, chunk, n, i, hh, active, valid, tq, slot, qf); }
    for (int it = it0; it < it1; ++it) {
        const int h = hj >> 6, j = hj & 63;
        if (hj != cur_hj) { if (cur_hj >= 0) WG_SYNC(); moba_load_kv(F, h, j, KL, VL); WG_SYNC(); cur_hj = hj; }
        int hj2 = hj, chunk2 = 0, tq2 = 0, slot2 = 0; bool active2 = false, valid2 = false; bf16x8 qf2[8];
#pragma unroll
        for (int s = 0; s < 8; ++s) qf2[s] = qf[s];
        if (it + 1 < it1) { mc_decode(PRE, it + 1, hj2, chunk2); const int n2 = (int)__hip_atomic_load(F.ctl + CW_CNT + hj2, RLX_AGENT); mc_fetch(F, hj2, chunk2, n2, i, hh, active2, valid2, tq2, slot2, qf2); }
        if (active) {
            f32x16 acc[4]; float lsum = 0.f;
#pragma unroll
            for (int et = 0; et < 4; ++et)
#pragma unroll
                for (int r = 0; r < 16; ++r) acc[et][r] = 0.f;
            moba_wave_attend(qf, KL, VL, 8, -1, i, hh, F.lane, c2, mc2, acc, lsum);
            lsum += __shfl_xor(lsum, 32);
            if (valid) {
                bf16* prow = part_g + ((size_t)(slot * 4 + h) * S_ + tq) * 128;
#pragma unroll
                for (int et = 0; et < 4; ++et)
#pragma unroll
                    for (int g2 = 0; g2 < 2; ++g2) { v4u w; w.x = pkbf(acc[et][8 * g2], acc[et][8 * g2 + 1]); w.y = pkbf(acc[et][8 * g2 + 2], acc[et][8 * g2 + 3]); w.z = pkbf(acc[et][8 * g2 + 4], acc[et][8 * g2 + 5]); w.w = pkbf(acc[et][8 * g2 + 6], acc[et][8 * g2 + 7]);
                        *(v4u*)(prow + 64 * hh + 16 * et + 8 * g2) = w; }
                if (hh == 0) lpart_g[(size_t)(slot * 4 + h) * S_ + tq] = lsum;
            }
        }
        hj = hj2; chunk = chunk2; tq = tq2; slot = slot2; active = active2; valid = valid2;
#pragma unroll
        for (int s = 0; s < 8; ++s) qf[s] = qf2[s];
    }
    WG_SYNC();
}

__device__ __forceinline__ void moba_d_item(Frame& F, int item, float c2, float mc2) {
    const int blk = item >> 2, h = item & 3;
    LAS bf16* KL = (LAS bf16*)(F.lds); LAS unsigned char* VL = F.lds + 256 * KROW * 2;
    const bf16* zb = (const bf16*)(F.ws + WS_Z); const bf16* part_g = (const bf16*)((const unsigned char*)F.out + OUT_PART); const float* lpart_g = (const float*)(F.ws + WS_LPART);
    bf16* mixb = (bf16*)(F.ws + WS_MIX);
    const int i = F.lane & 31, hh = F.lane >> 5;
    const int tq = blk * 256 + F.wave * 32 + i;
    bf16x8 qf[8];
    { const bf16* qrow = zb + (size_t)tq * ZW + Z_MQ + h * 128 + 8 * hh;
#pragma unroll
      for (int s = 0; s < 8; ++s) qf[s] = *(const bf16x8*)(qrow + 16 * s); }
    moba_load_kv(F, h, blk, KL, VL);
    WG_SYNC();
    f32x16 acc[4]; float lsum = 0.f;
#pragma unroll
    for (int et = 0; et < 4; ++et)
#pragma unroll
        for (int r = 0; r < 16; ++r) acc[et][r] = 0.f;
    moba_wave_attend(qf, KL, VL, F.wave + 1, F.wave, i, hh, F.lane, c2, mc2, acc, lsum);
    lsum += __shfl_xor(lsum, 32);
    const int nsel = blk < 3 ? blk : 3;
    {
        v4u pw[3][8]; float lp[3];
#pragma unroll
        for (int s = 0; s < 3; ++s) { if (s < nsel) { const bf16* prow = part_g + ((size_t)(s * 4 + h) * S_ + tq) * 128 + 64 * hh; lp[s] = lpart_g[(size_t)(s * 4 + h) * S_ + tq];
#pragma unroll
                for (int k = 0; k < 8; ++k) pw[s][k] = *(const v4u*)(prow + 8 * k); } }
#pragma unroll
        for (int s = 0; s < 3; ++s) { if (s < nsel) { lsum += lp[s];
#pragma unroll
                for (int et = 0; et < 4; ++et)
#pragma unroll
                    for (int g2 = 0; g2 < 2; ++g2) { const v4u w = pw[s][2 * et + g2];
                        acc[et][8 * g2] += bf2f(w.x & 0xffffu); acc[et][8 * g2 + 1] += bf2f(w.x >> 16); acc[et][8 * g2 + 2] += bf2f(w.y & 0xffffu); acc[et][8 * g2 + 3] += bf2f(w.y >> 16);
                        acc[et][8 * g2 + 4] += bf2f(w.z & 0xffffu); acc[et][8 * g2 + 5] += bf2f(w.z >> 16); acc[et][8 * g2 + 6] += bf2f(w.w & 0xffffu); acc[et][8 * g2 + 7] += bf2f(w.w >> 16); } } }
    }
    const float inv = 1.0f / lsum;
    bf16* orow = mixb + (size_t)tq * D_ + 512 + h * 128;
#pragma unroll
    for (int et = 0; et < 4; ++et)
#pragma unroll
        for (int g = 0; g < 4; ++g) { u2_t w; w.x = pkbf(acc[et][4 * g] * inv, acc[et][4 * g + 1] * inv); w.y = pkbf(acc[et][4 * g + 2] * inv, acc[et][4 * g + 3] * inv); *(u2_t*)(orow + 32 * et + 8 * g + 4 * hh) = w; }
    WG_SYNC();
}

struct Args { const void* in[18]; float* out; unsigned char* ws; int ph_lo, ph_hi, li, pad; };
constexpr int N_PHASES = 10;
__global__ void __launch_bounds__(NWAVES * 64, 2) mk_fwd(Args args) {
    extern __shared__ __attribute__((aligned(16))) unsigned char lds[];
    Frame F;
    F.lds = (LAS unsigned char*)lds;
    F.MISC = (volatile LAS unsigned*)(F.lds + MISC_OFF);
    F.tid = threadIdx.x; F.lane = F.tid & 63; F.wave = __builtin_amdgcn_readfirstlane(F.tid >> 6);
    F.G = gridDim.x; { const int bx = blockIdx.x; F.vcu = (F.G % 8 == 0) ? (bx % 8) * (F.G / 8) + bx / 8 : bx; }
    F.ws = args.ws; F.out = args.out; F.ctl = (gu32*)(args.ws + WS_CTL);
    if (F.tid < 32) F.MISC[F.tid] = 0u;
    if (F.tid == 0) {
#pragma unroll
        for (int k = 0; k < 18; ++k) { const unsigned long long pv = (unsigned long long)args.in[k]; F.MISC[32 + 2 * k] = (unsigned)pv; F.MISC[33 + 2 * k] = (unsigned)(pv >> 32); }
    }
    __syncthreads();
    XcdBarrier bar = xcd_barrier_post((unsigned*)(F.ctl + CW_BAR) + args.li * XCD_BAR_WORDS, F.MISC + 8);
    const int lo = args.ph_lo, hi = args.ph_hi;
#define IN(k) (lo <= (k) && (k) < hi)
#define SEAM(k) do { if (IN(k) && IN((k) + 1)) xcd_barrier(bar); STAMP((k) + 1); } while (0)
    bf16* xb = (bf16*)(F.ws + WS_AB); bf16* zb = (bf16*)(F.ws + WS_Z); bf16* mixb = (bf16*)(F.ws + WS_MIX); bf16* actb = (bf16*)(F.ws + WS_ACT); bf16* erawb = (bf16*)(F.ws + WS_ERAW);

    STAMP(0);
    if (IN(0)) { p0_prologue(F); } SEAM(0);
    if (IN(1)) {
        { pg8::Gemm g{xb, (const bf16*)(F.ws + WS_WIN), S_, ZW, D_}; pg8::StaticOrder S; S.init(S_, ZW, F.G, (int)blockIdx.x);
          pg8::EpiScale<0, 1> E{zb, ZW, (const float*)(F.ws + WS_RSTDX), EPS_};
          pg8::gemm_phase<pg8::EpiScale<0, 1>, pg8::StaticOrder, PG8_ALIGN, PG8_SP2>(F.lds + RING_OFF, g, S, E); }
        { pg8::Gemm g{(const bf16*)(F.ws + WS_PB), (const bf16*)(F.ws + WS_WPP), S_, D_, PLE_}; pg8::StaticOrder S; S.init(S_, D_, F.G, (int)blockIdx.x);
          pg8::EpiRes<0> E{nullptr, erawb, (float*)(F.ws + WS_SSQE), D_};
          pg8::gemm_phase<pg8::EpiRes<0>, pg8::StaticOrder, false, PG8_SP2>(F.lds + RING_OFF, g, S, E); }
    } SEAM(1);
    if (IN(2)) { for (int ch = F.vcu; ch < 256; ch += F.G) gla_a_chunk(F, ch); for (int ch = F.vcu; ch < 256; ch += F.G) moba_a_item(F, ch); } SEAM(2);
    if (IN(3)) { for (int pr = F.vcu; pr < 256; pr += F.G) gla_b_pair(F, pr); for (int pr = F.vcu; pr < 256; pr += F.G) moba_b_item(F, pr); } SEAM(3);
    if (IN(4)) { for (int ch = F.vcu; ch < 256; ch += F.G) gla_c_chunk(F, ch); moba_c_phase(F); } SEAM(4);
    if (IN(5)) { float c2, mc2; moba_shift(F, c2, mc2); for (int it = F.vcu; it < 256; it += F.G) moba_d_item(F, it, c2, mc2); } SEAM(5);
    if (IN(6)) {
        pg8::Gemm g{mixb, (const bf16*)(F.ws + WS_WOUT), S_, D_, D_}; pg8::StaticOrder S; S.init(S_, D_, F.G, (int)blockIdx.x);
        pg8::EpiRes<1> E{IN_x, xb, (float*)(F.ws + WS_SSQH1), D_};
        pg8::gemm_phase<pg8::EpiRes<1>, pg8::StaticOrder, false, PG8_SP2>(F.lds + RING_OFF, g, S, E);
    } SEAM(6);
    if (IN(7)) {
        pg8::Gemm g{xb, (const bf16*)(F.ws + WS_WUP), S_, FF_, D_}; pg8::StaticOrder S; S.init(S_, FF_, F.G, (int)blockIdx.x);
        pg8::EpiScale<1, 2> E{actb, FF_, (const float*)(F.ws + WS_SSQH1), EPS_};
        pg8::gemm_phase<pg8::EpiScale<1, 2>, pg8::StaticOrder, PG8_ALIGN, PG8_SP2>(F.lds + RING_OFF, g, S, E);
    } SEAM(7);
    if (IN(8)) {
        pg8::Gemm g{actb, (const bf16*)(F.ws + WS_WDOWN), S_, D_, FF_}; pg8::StaticOrder S; S.init(S_, D_, F.G, (int)blockIdx.x);
        pg8::EpiRes<2> E{nullptr, xb, (float*)(F.ws + WS_SSQH2), D_};
        pg8::gemm_phase<pg8::EpiRes<2>, pg8::StaticOrder, false, PG8_SP2>(F.lds + RING_OFF, g, S, E);
    } SEAM(8);
    if (IN(9)) {
        pg8::Gemm g{xb, (const bf16*)(F.ws + WS_WPG), S_, D_, D_}; pg8::StaticOrder S; S.init(S_, D_, F.G, (int)blockIdx.x);
        pg8::EpiGate E{F.out, xb, erawb, (const float*)(F.ws + WS_SSQH2), (const float*)(F.ws + WS_SSQE), IN_g_pe, D_, EPS_};
        pg8::gemm_phase<pg8::EpiGate, pg8::StaticOrder, false, PG8_SP2>(F.lds + RING_OFF, g, S, E);
    }
#ifdef PROBE_LO
    STAMP(10);
    if (blockIdx.x == 0 && F.tid == 0) {
        const unsigned long long a_ = ((unsigned long long)F.MISC[81 + 2 * PROBE_LO] << 32) | F.MISC[80 + 2 * PROBE_LO], b_ = ((unsigned long long)F.MISC[81 + 2 * PROBE_HI] << 32) | F.MISC[80 + 2 * PROBE_HI];
        const unsigned long long d_ = (b_ - a_) * PROBE_K, t0_ = rt();
        while (rt() - t0_ < d_) __builtin_amdgcn_s_sleep(8);
    }
#endif
#undef IN
#undef SEAM
}

static void launch_range(const Args& a0, int lo, int hi, int li, int grid, hipStream_t stream) {
    Args a = a0; a.ph_lo = lo; a.ph_hi = hi; a.li = li;
    hipLaunchKernelGGL(mk_fwd, dim3(grid), dim3(NWAVES * 64), LDS_BYTES, stream, a);
    const hipError_t le = hipPeekAtLastError();
    if (le != hipSuccess) fprintf(stderr, "kernel_launch: launch [%d,%d) failed: %s\n", lo, hi, hipGetErrorName(le));
}
extern "C" void kernel_launch(void* const* d_in, const int* in_sizes, int n_in, void* d_out, int out_size, void* d_ws, size_t ws_size, hipStream_t stream) {
    static int grid = 0;
    if (grid == 0) {
        if (n_in != 18 || out_size != S_ * D_ || ws_size < WS_END) { fprintf(stderr, "kernel_launch: unexpected shapes (n_in %d out %d ws %zu)\n", n_in, out_size, ws_size); grid = -1; return; }
        int dev = 0, cus = 0, per_cu = 0;
        if (hipGetDevice(&dev) != hipSuccess || hipDeviceGetAttribute(&cus, hipDeviceAttributeMultiprocessorCount, dev) != hipSuccess) { grid = -1; return; }
        if (hipFuncSetAttribute((const void*)mk_fwd, hipFuncAttributeMaxDynamicSharedMemorySize, LDS_BYTES) != hipSuccess) { fprintf(stderr, "kernel_launch: hipFuncSetAttribute failed\n"); grid = -1; return; }
        if (hipOccupancyMaxActiveBlocksPerMultiprocessor(&per_cu, (const void*)mk_fwd, NWAVES * 64, LDS_BYTES) != hipSuccess || per_cu < 1) { fprintf(stderr, "kernel_launch: occupancy query says %d\n", per_cu); per_cu = 1; }
        (void)hipGetLastError();
        grid = cus;
        if (grid != 256) fprintf(stderr, "kernel_launch: note: %d CUs\n", grid);
    }
    if (grid < 0) return;
    (void)hipMemsetAsync((char*)d_ws + WS_CTL, 0, CTL_ZERO_BYTES, stream);
    Args a{};
    for (int i = 0; i < 18; ++i) a.in[i] = d_in[i];
    a.out = (float*)d_out; a.ws = (unsigned char*)d_ws;
    launch_range(a, 0, N_PHASES, 0, grid, stream);
}
```

```cpp
#include <hip/hip_runtime.h>
#include <cstdio>
#include <cstdint>
#include <math.h>
namespace pg8 {
#define PG8_LAS __attribute__((address_space(3)))
typedef unsigned short bf16_t;
typedef short bf16x8 __attribute__((ext_vector_type(8)));
typedef float f32x4 __attribute__((ext_vector_type(4)));
typedef unsigned u32x4 __attribute__((ext_vector_type(4)));
constexpr int BM = 256, BK = 64, HALF = 128, HTB = HALF * BK * 2  , STAGE_BYTES = 8 * HTB, NXCD = 8, WGM = 8;

__host__ __device__ __forceinline__ int lds_byte(int r, int c) { const int st = (r >> 4) * 2 + (c >> 5), rr = r & 15, cc = c & 31, ob = rr * 64 + cc * 2; return st * 1024 + (ob ^ (((ob >> 9) & 1) << 5)); }
__host__ __device__ __forceinline__ void stage_rc(int b, int& R, int& C) { const int st = b / 1024, sb = b % 1024, swz = sb ^ (((sb >> 9) & 1) << 5); R = (st >> 1) * 16 + swz / 64; C = (st & 1) * 32 + (swz % 64) / 2; }
__host__ __device__ __forceinline__ int perm32(int rho) { const int n = rho >> 4, i = rho & 15; return 8 * (i >> 2) + 4 * n + (i & 3); }

struct Unit { int pm, pn; };
struct Gemm { const bf16_t* A; const bf16_t* Bt; int M, N, K; };

struct StaticOrder {
    int nM, nN, nwg, G, c;
    __host__ __device__ void init(int M, int N, int G_, int c_) { nM = M / BM; nN = N / BM; nwg = nM * nN; G = G_; c = c_; }
    __host__ __device__ bool next(int i, Unit& u) const {
        const long L = (long)i * G + c; if (L >= nwg) return false;
        int wgid = (int)L; { const int q = nwg / NXCD, r = nwg % NXCD, xcd = wgid % NXCD, off = wgid / NXCD; wgid = (xcd < r ? xcd * (q + 1) : r * (q + 1) + (xcd - r) * q) + off; }
        const int nig = WGM * nN, gid = wgid / nig, fm = gid * WGM, gsz = (nM - fm) < WGM ? (nM - fm) : WGM;
        u.pm = fm + ((wgid % nig) % gsz); u.pn = (wgid % nig) / gsz; return true;
    }
    __device__ __forceinline__ void a_ready(const Unit&) const {}
    __device__ __forceinline__ void done(const Unit&) const {}
};

__device__ __forceinline__ unsigned cvt_pk_bf16(float lo, float hi) { unsigned r; asm volatile("v_cvt_pk_bf16_f32 %0, %1, %2" : "=v"(r) : "v"(lo), "v"(hi)); return r; }
typedef float f32x2 __attribute__((ext_vector_type(2)));

__device__ __forceinline__ void st16_wt(void* p, u32x4 v) { asm volatile("global_store_dwordx4 %0, %1, off sc1\n\ts_nop 1" :: "v"(p), "v"(v) : "memory"); }

__device__ __forceinline__ float rstd_from_part(const float* part, int row, float inv_n, float eps) {
    const f32x4 p = *(const f32x4*)(part + (size_t)row * 4);
    return __builtin_amdgcn_rsqf(((p[0] + p[1]) + (p[2] + p[3])) * inv_n + eps);
}
template <int ACT, int RS> struct EpiScale {
    static constexpr bool PERM = true, AFTER_DRAIN = false;
    bf16_t* O; int ldc; const float* rsv; float eps;
    __device__ __forceinline__ void operator()(const f32x4 (&acc)[2][2][4][2], const Unit& u, int wr, int wc, int fr, int fq) const {
        const int row0 = u.pm * BM + wr * 64 + fr, col0 = u.pn * BM + wc * 32 + 8 * fq;
#pragma unroll
        for (int ai = 0; ai < 2; ++ai)
#pragma unroll
            for (int m = 0; m < 4; ++m) {
                const int row = row0 + ai * HALF + m * 16;
                float s = 1.f;
                if (RS == 1) s = rsv[row];
                if (RS == 2) s = rstd_from_part(rsv, row, 1.0f / 1024.0f, eps);
                bf16_t* rowp = O + (size_t)row * ldc + col0;
#pragma unroll
                for (int bj = 0; bj < 2; ++bj) {
                    f32x4 v0 = acc[ai][bj][m][0] * s, v1 = acc[ai][bj][m][1] * s;
                    if (ACT == 1) {
#pragma unroll
                        for (int e = 0; e < 4; ++e) { const float a = fmaxf(v0[e], 0.f), b = fmaxf(v1[e], 0.f); v0[e] = a * a; v1[e] = b * b; }
                    }
                    u32x4 w; w.x = cvt_pk_bf16(v0[0], v0[1]); w.y = cvt_pk_bf16(v0[2], v0[3]); w.z = cvt_pk_bf16(v1[0], v1[1]); w.w = cvt_pk_bf16(v1[2], v1[3]);
                    *(u32x4*)(rowp + bj * HALF) = w;
                }
            }
    }
};
template <int RES> struct EpiRes {
    static constexpr bool PERM = true, AFTER_DRAIN = true;
    const float* base; bf16_t* hb; float* part; int ldc;
    __device__ __forceinline__ void fused(f32x4 (&acc)[2][2][4][2], const Unit& u, int wr, int wc, int fr, int fq, PG8_LAS unsigned char* lds, int wid, int lane) const {
        PG8_LAS float* P = (PG8_LAS float*)lds;
        const int row0 = u.pm * BM + wr * 64 + fr, col0 = u.pn * BM + wc * 32 + 8 * fq;
#pragma unroll
        for (int ai = 0; ai < 2; ++ai) {
            f32x4 pre[4][2][2]; u32x4 preb[4][2];
            if (RES == 1) {
#pragma unroll
                for (int m = 0; m < 4; ++m) { const size_t off = (size_t)(row0 + ai * HALF + m * 16) * ldc + col0;
#pragma unroll
                    for (int bj = 0; bj < 2; ++bj) { pre[m][bj][0] = __builtin_nontemporal_load((const f32x4*)(base + off + bj * HALF)); pre[m][bj][1] = __builtin_nontemporal_load((const f32x4*)(base + off + bj * HALF + 4)); } }
            }
            if (RES == 2) {
#pragma unroll
                for (int m = 0; m < 4; ++m) { const size_t off = (size_t)(row0 + ai * HALF + m * 16) * ldc + col0;
#pragma unroll
                    for (int bj = 0; bj < 2; ++bj) preb[m][bj] = *(const u32x4*)(hb + off + bj * HALF); }
            }
#pragma unroll
            for (int m = 0; m < 4; ++m) {
                const int row = row0 + ai * HALF + m * 16;
                const size_t off = (size_t)row * ldc + col0;
                float q = 0.f;
#pragma unroll
                for (int bj = 0; bj < 2; ++bj) {
                    f32x4 v0 = acc[ai][bj][m][0], v1 = acc[ai][bj][m][1];
                    if (RES == 1) { v0 = v0 + pre[m][bj][0]; v1 = v1 + pre[m][bj][1]; }
                    if (RES == 2) { const u32x4 ew = preb[m][bj];
                        v0[0] += __uint_as_float(ew.x << 16); v0[1] += __uint_as_float(ew.x & 0xffff0000u); v0[2] += __uint_as_float(ew.y << 16); v0[3] += __uint_as_float(ew.y & 0xffff0000u);
                        v1[0] += __uint_as_float(ew.z << 16); v1[1] += __uint_as_float(ew.z & 0xffff0000u); v1[2] += __uint_as_float(ew.w << 16); v1[3] += __uint_as_float(ew.w & 0xffff0000u); }
                    u32x4 w; w.x = cvt_pk_bf16(v0[0], v0[1]); w.y = cvt_pk_bf16(v0[2], v0[3]); w.z = cvt_pk_bf16(v1[0], v1[1]); w.w = cvt_pk_bf16(v1[2], v1[3]);
                    *(u32x4*)(hb + off + bj * HALF) = w;
                    q += (v0[0] * v0[0] + v0[1] * v0[1]) + (v0[2] * v0[2] + v0[3] * v0[3]) + (v1[0] * v1[0] + v1[1] * v1[1]) + (v1[2] * v1[2] + v1[3] * v1[3]);
                }
                q += __shfl_xor(q, 16); q += __shfl_xor(q, 32);
                if (fq == 0) P[(ai * HALF + wr * 64 + m * 16 + fr) * 4 + wc] = q;
            }
        }
        asm volatile("s_waitcnt lgkmcnt(0)" ::: "memory"); __builtin_amdgcn_s_barrier(); asm volatile("" ::: "memory");
        const int tid = wid * 64 + lane;
        if (tid < 256) { const f32x4 p = ((const PG8_LAS f32x4*)lds)[tid]; part[(size_t)(u.pm * BM + tid) * 4 + u.pn] = (p[0] + p[1]) + (p[2] + p[3]); }
        asm volatile("s_waitcnt lgkmcnt(0)" ::: "memory"); __builtin_amdgcn_s_barrier(); asm volatile("" ::: "memory");
    }
};
struct EpiGate {
    static constexpr bool PERM = true, AFTER_DRAIN = false;
    float* out; const bf16_t* hb; const bf16_t* eraw; const float* part_h; const float* part_e; const float* g_emb; int ldc; float eps;
    __device__ __forceinline__ void operator()(const f32x4 (&acc)[2][2][4][2], const Unit& u, int wr, int wc, int fr, int fq) const {
        const int row0 = u.pm * BM + wr * 64 + fr, col0 = u.pn * BM + wc * 32 + 8 * fq;
        f32x4 gv[2][2];
#pragma unroll
        for (int bj = 0; bj < 2; ++bj) { gv[bj][0] = *(const f32x4*)(g_emb + col0 + bj * HALF); gv[bj][1] = *(const f32x4*)(g_emb + col0 + bj * HALF + 4); }
#pragma unroll
        for (int ai = 0; ai < 2; ++ai)
#pragma unroll
            for (int mp = 0; mp < 2; ++mp) {
                u32x4 hv[2][2]; u32x4 ewv[2][2]; float sh[2], se[2];
#pragma unroll
                for (int mm = 0; mm < 2; ++mm) { const int row = row0 + ai * HALF + (2 * mp + mm) * 16; const size_t off = (size_t)row * ldc + col0;
                    sh[mm] = rstd_from_part(part_h, row, 1.0f / 1024.0f, eps); se[mm] = rstd_from_part(part_e, row, 1.0f / 1024.0f, eps);
#pragma unroll
                    for (int bj = 0; bj < 2; ++bj) { ewv[mm][bj] = __builtin_nontemporal_load((const u32x4*)(eraw + off + bj * HALF)); hv[mm][bj] = __builtin_nontemporal_load((const u32x4*)(hb + off + bj * HALF)); } }
#pragma unroll
                for (int mm = 0; mm < 2; ++mm) { const int m = 2 * mp + mm; const int row = row0 + ai * HALF + m * 16; const size_t off = (size_t)row * ldc + col0;
#pragma unroll
                    for (int bj = 0; bj < 2; ++bj) {
                        const u32x4 ew = ewv[mm][bj];
                        f32x4 e0, e1;
                        e0[0] = __uint_as_float(ew.x << 16); e0[1] = __uint_as_float(ew.x & 0xffff0000u); e0[2] = __uint_as_float(ew.y << 16); e0[3] = __uint_as_float(ew.y & 0xffff0000u);
                        e1[0] = __uint_as_float(ew.z << 16); e1[1] = __uint_as_float(ew.z & 0xffff0000u); e1[2] = __uint_as_float(ew.w << 16); e1[3] = __uint_as_float(ew.w & 0xffff0000u);
                        const u32x4 hw = hv[mm][bj];
                        f32x4 h0, h1;
                        h0[0] = __uint_as_float(hw.x << 16); h0[1] = __uint_as_float(hw.x & 0xffff0000u); h0[2] = __uint_as_float(hw.y << 16); h0[3] = __uint_as_float(hw.y & 0xffff0000u);
                        h1[0] = __uint_as_float(hw.z << 16); h1[1] = __uint_as_float(hw.z & 0xffff0000u); h1[2] = __uint_as_float(hw.w << 16); h1[3] = __uint_as_float(hw.w & 0xffff0000u);
                        const f32x4 a0 = acc[ai][bj][m][0] * sh[mm], a1 = acc[ai][bj][m][1] * sh[mm];
#pragma unroll
                        for (int e = 0; e < 4; ++e) {
                            const float g0 = __builtin_amdgcn_rcpf(1.0f + __expf(-a0[e])), g1 = __builtin_amdgcn_rcpf(1.0f + __expf(-a1[e]));
                            h0[e] += g0 * (e0[e] * se[mm] * gv[bj][0][e]); h1[e] += g1 * (e1[e] * se[mm] * gv[bj][1][e]);
                        }
                        __builtin_nontemporal_store(h0, (f32x4*)(out + off + bj * HALF)); __builtin_nontemporal_store(h1, (f32x4*)(out + off + bj * HALF + 4));
                    } }
            }
    }
};
template <class Epi, class Sched, bool ALIGN_EPI = false, bool SP2 = false>
__device__ __forceinline__ void gemm_phase(PG8_LAS unsigned char* lds, const Gemm g, const Sched& S, const Epi& E) {
    const int tid = threadIdx.x, wid = __builtin_amdgcn_readfirstlane(tid >> 6), lane = tid & 63, wr = wid >> 2, wc = wid & 3, fr = lane & 15, fq = lane >> 4;
    const int K = g.K, nt = K / BK;
    unsigned voffA[2], voffB[2];
#pragma unroll
    for (int i = 0; i < 2; ++i) { int R, C; stage_rc(tid * 16 + i * 8192, R, C); const int Rb = Epi::PERM ? ((R & ~31) + perm32(R & 31)) : R;
        voffA[i] = (unsigned)(R * K + C) * 2u; voffB[i] = (unsigned)(Rb * K + C) * 2u; }
    const size_t kstep = (size_t)(BK * 2);
    const size_t hstep = (size_t)HALF * K * 2;
    const size_t tstep = 2 * hstep;
    const unsigned ldsw = (unsigned)wid * 1024u;
    const int aoff = lds_byte(wr * 64 + fr, fq * 8), boff = lds_byte(wc * 32 + fr, fq * 8);
#define PG8_SA(b, h) (((b) * 2 + (h)) * HTB)
#define PG8_SB(b, h) ((4 + (b) * 2 + (h)) * HTB)
#define PG8_STAGE(bufoff, gbase, voff) do { _Pragma("unroll") for (int _i = 0; _i < 2; ++_i) \
        __builtin_amdgcn_global_load_lds((const unsigned*)((const char*)(gbase) + (voff)[_i]), (PG8_LAS unsigned*)(lds + (bufoff) + ldsw + _i * 8192), 16, 0, 0); } while (0)
#define PG8_LDA(dst, b, h) do { _Pragma("unroll") for (int m = 0; m < 4; ++m) _Pragma("unroll") for (int k = 0; k < 2; ++k) dst[m][k] = *(const PG8_LAS bf16x8*)(lds + PG8_SA(b, h) + aoff + m * 2048 + k * 1024); } while (0)
#define PG8_LDB(dst, b, h) do { _Pragma("unroll") for (int n = 0; n < 2; ++n) _Pragma("unroll") for (int k = 0; k < 2; ++k) dst[n][k] = *(const PG8_LAS bf16x8*)(lds + PG8_SB(b, h) + boff + n * 2048 + k * 1024); } while (0)
#define PG8_MMA(ai, bj, At, Bt) do { __builtin_amdgcn_s_setprio(1); _Pragma("unroll") for (int m = 0; m < 4; ++m) _Pragma("unroll") for (int n = 0; n < 2; ++n) _Pragma("unroll") for (int k = 0; k < 2; ++k) \
        acc[ai][bj][m][n] = __builtin_amdgcn_mfma_f32_16x16x32_bf16(Bt[n][k], At[m][k], acc[ai][bj][m][n], 0, 0, 0); __builtin_amdgcn_s_setprio(0); } while (0)
#define PG8_WAIT_V(n) asm volatile("s_waitcnt vmcnt(" #n ")" ::: "memory")
#define PG8_WAIT_L(n) asm volatile("s_waitcnt lgkmcnt(" #n ")" ::: "memory")
#define PG8_BAR __builtin_amdgcn_s_barrier()
#define PG8_SCHED __builtin_amdgcn_sched_barrier(0)
    Unit cur, nxt; int ui = 0;
    if (!S.next(0, cur)) return;
    f32x4 acc[2][2][4][2];
#pragma unroll
    for (int a = 0; a < 2; ++a)
#pragma unroll
        for (int b = 0; b < 2; ++b)
#pragma unroll
            for (int m = 0; m < 4; ++m)
#pragma unroll
                for (int n = 0; n < 2; ++n) acc[a][b][m][n] = (f32x4){0.f, 0.f, 0.f, 0.f};
    bf16x8 At[4][2], B0[2][2], B1[2][2];
    const char* cA = (const char*)g.A + (size_t)cur.pm * tstep; const char* cB = (const char*)g.Bt + (size_t)cur.pn * tstep;
    S.a_ready(cur);
    if constexpr (SP2) {
        PG8_STAGE(PG8_SB(0, 0), cB, voffB); PG8_STAGE(PG8_SB(0, 1), cB + hstep, voffB); PG8_STAGE(PG8_SA(0, 0), cA, voffA); PG8_STAGE(PG8_SA(0, 1), cA + hstep, voffA);
        if (wr == 1) PG8_BAR;
        PG8_WAIT_V(2); PG8_BAR;
        PG8_STAGE(PG8_SB(1, 0), cB + kstep, voffB); PG8_STAGE(PG8_SA(1, 0), cA + kstep, voffA); PG8_STAGE(PG8_SB(1, 1), cB + hstep + kstep, voffB);
        PG8_WAIT_V(6); PG8_BAR;
    } else {
        PG8_STAGE(PG8_SB(0, 0), cB, voffB); PG8_STAGE(PG8_SA(0, 0), cA, voffA); PG8_STAGE(PG8_SB(0, 1), cB + hstep, voffB); PG8_STAGE(PG8_SA(0, 1), cA + hstep, voffA);
        if (wr == 1) PG8_BAR;
        PG8_WAIT_V(4); PG8_BAR;
        PG8_STAGE(PG8_SB(1, 0), cB + kstep, voffB); PG8_STAGE(PG8_SA(1, 0), cA + kstep, voffA); PG8_STAGE(PG8_SB(1, 1), cB + hstep + kstep, voffB);
        PG8_WAIT_V(6); PG8_BAR;
    }
    for (;;) {
        const bool has_next = S.next(ui + 1, nxt);
        const char* nA = has_next ? (const char*)g.A + (size_t)nxt.pm * tstep : cA; const char* nB = has_next ? (const char*)g.Bt + (size_t)nxt.pn * tstep : cB;
        for (int t = 0; t < nt; t += 2) {
            const bool last = (t == nt - 2);
            const char* a1 = cA + (size_t)(t + 1) * kstep;
            const char* a2 = last ? nA : cA + (size_t)(t + 2) * kstep; const char* b2 = last ? nB : cB + (size_t)(t + 2) * kstep;
            const char* a3 = a2 + kstep; const char* b3 = b2 + kstep;
            if (last && has_next) S.a_ready(nxt);
            if constexpr (SP2) {
            PG8_LDB(B0, 0, 0); PG8_LDB(B1, 0, 1); PG8_SCHED; PG8_LDA(At, 0, 0); PG8_STAGE(PG8_SA(1, 1), a1 + hstep, voffA);
            PG8_WAIT_V(8); PG8_WAIT_L(0); PG8_BAR; PG8_MMA(0, 0, At, B0); PG8_MMA(0, 1, At, B1); PG8_BAR; PG8_SCHED;
            PG8_LDA(At, 0, 1); PG8_STAGE(PG8_SB(0, 0), b2, voffB); PG8_STAGE(PG8_SB(0, 1), b2 + hstep, voffB); PG8_STAGE(PG8_SA(0, 0), a2, voffA);
            PG8_WAIT_V(8); PG8_WAIT_L(0); PG8_BAR; PG8_MMA(1, 0, At, B0); PG8_MMA(1, 1, At, B1); PG8_BAR; PG8_SCHED;
            PG8_LDB(B0, 1, 0); PG8_LDB(B1, 1, 1); PG8_SCHED; PG8_LDA(At, 1, 0); PG8_STAGE(PG8_SA(0, 1), a2 + hstep, voffA);
            PG8_WAIT_V(8); PG8_WAIT_L(0); PG8_BAR; PG8_MMA(0, 0, At, B0); PG8_MMA(0, 1, At, B1); PG8_BAR; PG8_SCHED;
            PG8_LDA(At, 1, 1); PG8_STAGE(PG8_SB(1, 0), b3, voffB); PG8_STAGE(PG8_SB(1, 1), b3 + hstep, voffB); PG8_STAGE(PG8_SA(1, 0), a3, voffA);
            PG8_WAIT_V(8); PG8_WAIT_L(0); PG8_BAR; PG8_MMA(1, 0, At, B0); PG8_MMA(1, 1, At, B1); PG8_BAR; PG8_SCHED;
            } else {
            PG8_LDB(B0, 0, 0); PG8_SCHED; PG8_LDA(At, 0, 0); PG8_STAGE(PG8_SA(1, 1), a1 + hstep, voffA);
            PG8_WAIT_L(8); PG8_BAR; PG8_WAIT_L(0); PG8_MMA(0, 0, At, B0); PG8_BAR; PG8_SCHED;
            PG8_LDB(B1, 0, 1); PG8_STAGE(PG8_SB(0, 0), b2, voffB);
            PG8_BAR; PG8_WAIT_L(0); PG8_MMA(0, 1, At, B1); PG8_BAR;
            PG8_LDA(At, 0, 1); PG8_STAGE(PG8_SA(0, 0), a2, voffA);
            PG8_BAR; PG8_WAIT_L(0); PG8_MMA(1, 0, At, B0); PG8_BAR; PG8_SCHED;
            PG8_STAGE(PG8_SB(0, 1), b2 + hstep, voffB);
            PG8_WAIT_V(6); PG8_BAR; PG8_MMA(1, 1, At, B1); PG8_BAR;
            PG8_LDB(B0, 1, 0); PG8_SCHED; PG8_LDA(At, 1, 0); PG8_STAGE(PG8_SA(0, 1), a2 + hstep, voffA);
            PG8_WAIT_L(8); PG8_BAR; PG8_WAIT_L(0); PG8_MMA(0, 0, At, B0); PG8_BAR; PG8_SCHED;
            PG8_LDB(B1, 1, 1); PG8_STAGE(PG8_SB(1, 0), b3, voffB);
            PG8_BAR; PG8_WAIT_L(0); PG8_MMA(0, 1, At, B1); PG8_BAR;
            PG8_LDA(At, 1, 1); PG8_STAGE(PG8_SA(1, 0), a3, voffA);
            PG8_BAR; PG8_WAIT_L(0); PG8_MMA(1, 0, At, B0); PG8_BAR; PG8_SCHED;
            PG8_STAGE(PG8_SB(1, 1), b3 + hstep, voffB);
            PG8_WAIT_V(6); PG8_BAR; PG8_MMA(1, 1, At, B1); PG8_BAR;
            }
        }
        if constexpr (ALIGN_EPI) { if (wr == 0) PG8_BAR; }
        if constexpr (!Epi::AFTER_DRAIN) { E(acc, cur, wr, wc, fr, fq); S.done(cur); }
        if (!has_next) break;
#pragma unroll
        for (int a = 0; a < 2; ++a)
#pragma unroll
            for (int b = 0; b < 2; ++b)
#pragma unroll
                for (int m = 0; m < 4; ++m)
#pragma unroll
                    for (int n = 0; n < 2; ++n) acc[a][b][m][n] = (f32x4){0.f, 0.f, 0.f, 0.f};
        cur = nxt; cA = nA; cB = nB; ++ui;
        if constexpr (ALIGN_EPI) { if (wr == 1) PG8_BAR; }
    }
    PG8_WAIT_V(0);
    if constexpr (!ALIGN_EPI) { if (wr == 0) PG8_BAR; }
    PG8_BAR;
    if constexpr (Epi::AFTER_DRAIN) { E.fused(acc, cur, wr, wc, fr, fq, lds, wid, lane); S.done(cur); }
#undef PG8_SA
#undef PG8_SB
#undef PG8_STAGE
#undef PG8_LDA
#undef PG8_LDB
#undef PG8_MMA
#undef PG8_WAIT_V
#undef PG8_WAIT_L
#undef PG8_BAR
#undef PG8_SCHED
}
}
#ifndef PG8_SP2
#define PG8_SP2 true
#endif
#ifndef PG8_ALIGN
#define PG8_ALIGN true
#endif

constexpr int NWAVES = 8;
constexpr int S_ = 16384, D_ = 1024, FF_ = 4096, PLE_ = 256, INW_ = 3088, ZW = 3072;
constexpr int Z_GQ = 0, Z_GK = 256, Z_GV = 512, Z_GG = 1024, Z_MQ = 1536, Z_MK = 2048, Z_MV = 2560;
constexpr float EPS_ = 1e-6f;

constexpr size_t MiB = 1u << 20, KiB = 1u << 10;
constexpr size_t WS_CTL = 0, CTL_ZERO_BYTES = 64 * KiB;
constexpr size_t WS_WIN = 1 * MiB, WS_WOUT = 7 * MiB, WS_WUP = 9 * MiB, WS_WDOWN = 17 * MiB, WS_WPG = 25 * MiB, WS_WPP = 27 * MiB, WS_WGA = 27 * MiB + 512 * KiB;
constexpr size_t WS_SMALL = 28 * MiB;
constexpr size_t WS_RSTDX = WS_SMALL, WS_GA = WS_SMALL + 64 * KiB, WS_DECAY = WS_SMALL + 1088 * KiB, WS_KMEAN = WS_SMALL + 1344 * KiB,
                 WS_SSQH1 = WS_SMALL + 1472 * KiB, WS_SSQH2 = WS_SMALL + 1728 * KiB, WS_SSQE = WS_SMALL + 1984 * KiB, WS_LPART = WS_SMALL + 2240 * KiB;
constexpr size_t WS_ERAW = 32 * MiB, WS_AB = 64 * MiB, WS_Z = 96 * MiB, WS_MIX = 192 * MiB, WS_PB = 224 * MiB, WS_ACT = 96 * MiB, WS_END = 256 * MiB;
constexpr size_t WS_DS = 224 * MiB  , WS_LIST = 240 * MiB  ;
constexpr size_t OUT_PART = 0  , OUT_SPREV = 48 * MiB  ;
constexpr int CW_TMO = 0, CW_CNT = 1024  , CW_BAR = 4096;

constexpr int RING_OFF = 0, RING_BYTES = 131072;
constexpr int LDS_BYTES = 160 * 1024;
constexpr int MISC_OFF = LDS_BYTES - 512;

#define GAS __attribute__((address_space(1)))
#define LAS __attribute__((address_space(3)))
typedef unsigned short bf16;
typedef unsigned v4u __attribute__((ext_vector_type(4)));
typedef float f32x4 __attribute__((ext_vector_type(4)));
typedef short bf16x8 __attribute__((ext_vector_type(8)));
typedef GAS unsigned gu32;
typedef GAS unsigned long long gu64;
#define RLX_AGENT __ATOMIC_RELAXED, __HIP_MEMORY_SCOPE_AGENT
#define LDS_WAIT() asm volatile("s_waitcnt lgkmcnt(0)" ::: "memory")
#define VM_WAIT() asm volatile("s_waitcnt vmcnt(0)" ::: "memory")
__device__ __forceinline__ unsigned long long rt() { return __builtin_amdgcn_s_memrealtime(); }
__device__ __forceinline__ unsigned f2bf(float f) { unsigned u = __builtin_bit_cast(unsigned, f); return (u + 0x7fffu + ((u >> 16) & 1u)) >> 16; }
__device__ __forceinline__ unsigned pk2(float lo, float hi) { return f2bf(lo) | (f2bf(hi) << 16); }

#define XB_TMO      128
#define XB_XCNT(j)  (256  + 64 * (j))
#define XB_XSUB(j)  (1280 + 64 * (j))
#define XB_XGEN(j)  (2304 + 64 * (j))
#define XB_TOP      3328
#define XB_TOPGEN   3392
#define XCD_BAR_WORDS 3456
#define XB_SPIN_CAP (1u << 18)

__device__ __forceinline__ unsigned xb_ld(unsigned* p)              { return __hip_atomic_load(p, __ATOMIC_RELAXED, __HIP_MEMORY_SCOPE_AGENT); }
__device__ __forceinline__ unsigned xb_add(unsigned* p, unsigned v) { return __hip_atomic_fetch_add(p, v, __ATOMIC_RELAXED, __HIP_MEMORY_SCOPE_AGENT); }
__device__ __forceinline__ unsigned xb_xcc_id() { return (unsigned)__builtin_amdgcn_s_getreg((3 << 11) | 20) & 0xFu; }
#define XB_SPIN(cond, bar) do { unsigned _sp = 0; while (cond) { __builtin_amdgcn_s_sleep(1); \
    if ((++_sp & 255u) == 0u) { if (xb_ld(&(bar)[XB_TMO])) break; if (_sp > XB_SPIN_CAP) { atomicAdd(&(bar)[XB_TMO], 1u); break; } } } } while (0)

struct XcdBarrier {
    unsigned* bar; unsigned x;
    volatile LAS unsigned* st;
};

__device__ __forceinline__ XcdBarrier xcd_barrier_post(unsigned* bar, volatile LAS unsigned* st) {
    XcdBarrier b; b.bar = bar; b.x = xb_xcc_id(); b.st = st;
    if (threadIdx.x == 0) (void)xb_add(&bar[XB_XCNT(b.x)], 1u);
    return b;
}
__device__ __forceinline__ void xcd_barrier_complete(unsigned* bar, unsigned x, unsigned& nloc, unsigned& nx) {
    const unsigned G = gridDim.x * gridDim.y * gridDim.z;
    unsigned sum, cnt, mine, sp = 0u;
    for (;;) {
        sum = 0u; cnt = 0u; mine = 0u;
#pragma unroll
        for (unsigned j = 0; j < 16; ++j) { const unsigned c = xb_ld(&bar[XB_XCNT(j)]); sum += c; cnt += (c > 0u) ? 1u : 0u; mine = (j == x) ? c : mine; }
        if (sum == G) break;
        __builtin_amdgcn_s_sleep(1);
        if ((++sp & 255u) == 0u) { if (xb_ld(&bar[XB_TMO])) break; if (sp > XB_SPIN_CAP) { atomicAdd(&bar[XB_TMO], 1u); break; } }
    }
    nloc = mine > 0u ? mine : 1u; nx = cnt > 0u ? cnt : 1u;
}

__device__ __forceinline__ void xcd_barrier(const XcdBarrier& b) {
    asm volatile("s_waitcnt vmcnt(0)" ::: "memory");
    __syncthreads();
    if (threadIdx.x == 0) {
        unsigned* bar = b.bar;
        __builtin_amdgcn_s_waitcnt(0);
        unsigned nloc = b.st[0], nx = b.st[1];
        if (nloc == 0u) { xcd_barrier_complete(bar, b.x, nloc, nx); b.st[0] = nloc; b.st[1] = nx; }
        const unsigned old = xb_add(&bar[XB_XSUB(b.x)], 1u);
        const unsigned gen = old / nloc;
        if (old + 1u == (gen + 1u) * nloc) {
            __builtin_amdgcn_fence(__ATOMIC_RELEASE, "agent");
            asm volatile("s_waitcnt vmcnt(0)" ::: "memory");
            const unsigned og = xb_add(&bar[XB_TOP], 1u);
            const unsigned tg = og / nx;
            if (og + 1u == (tg + 1u) * nx) xb_add(&bar[XB_TOPGEN], 1u);
            else XB_SPIN(xb_ld(&bar[XB_TOPGEN]) == tg, bar);
            __builtin_amdgcn_fence(__ATOMIC_ACQUIRE, "agent");
            xb_add(&bar[XB_XGEN(b.x)], 1u);
            asm volatile("s_waitcnt vmcnt(0)" ::: "memory");
        } else {
            XB_SPIN(xb_ld(&bar[XB_XGEN(b.x)]) == gen, bar);
            __builtin_amdgcn_fence(__ATOMIC_ACQUIRE, "agent");
            asm volatile("s_waitcnt vmcnt(0)" ::: "memory");
        }
    }
    __syncthreads();
}

struct Frame {
    LAS unsigned char* lds;
    volatile LAS unsigned* MISC;
    gu32* ctl;
    int tid, lane, wave, vcu, G;
    unsigned char* ws; float* out;
};
__device__ __forceinline__ const void* in_ptr(const Frame& F, int k) {
    const unsigned lo = __builtin_amdgcn_readfirstlane(F.MISC[32 + 2 * k]), hi = __builtin_amdgcn_readfirstlane(F.MISC[33 + 2 * k]);
    return (const void*)(((unsigned long long)hi << 32) | lo);
}
#define IN_x ((const float*)in_ptr(F, 0))
#define IN_p ((const float*)in_ptr(F, 1))
#define IN_pos ((const int*)in_ptr(F, 2))
#define IN_g_mix ((const float*)in_ptr(F, 3))
#define IN_w_in ((const float*)in_ptr(F, 4))
#define IN_w_a2 ((const float*)in_ptr(F, 5))
#define IN_b_a ((const float*)in_ptr(F, 6))
#define IN_g_gla ((const float*)in_ptr(F, 7))
#define IN_g_mq ((const float*)in_ptr(F, 8))
#define IN_g_mk ((const float*)in_ptr(F, 9))
#define IN_w_out ((const float*)in_ptr(F, 10))
#define IN_g_ffn ((const float*)in_ptr(F, 11))
#define IN_w_up ((const float*)in_ptr(F, 12))
#define IN_w_down ((const float*)in_ptr(F, 13))
#define IN_g_pg ((const float*)in_ptr(F, 14))
#define IN_w_pg ((const float*)in_ptr(F, 15))
#define IN_w_pp ((const float*)in_ptr(F, 16))
#define IN_g_pe ((const float*)in_ptr(F, 17))
template <int CTRL> __device__ __forceinline__ float dpp_mov(float v) { return __builtin_bit_cast(float, __builtin_amdgcn_update_dpp(0, __builtin_bit_cast(int, v), CTRL, 0xf, 0xf, true)); }
__device__ __forceinline__ float row16_sum(float v) { v += dpp_mov<0xB1>(v); v += dpp_mov<0x4E>(v); v += dpp_mov<0x141>(v); v += dpp_mov<0x140>(v); return v; }
__device__ __forceinline__ float wave_sum(float v) {
    v = row16_sum(v);
    const float s0 = __builtin_bit_cast(float, __builtin_amdgcn_readlane(__builtin_bit_cast(int, v), 0)), s1 = __builtin_bit_cast(float, __builtin_amdgcn_readlane(__builtin_bit_cast(int, v), 16));
    const float s2 = __builtin_bit_cast(float, __builtin_amdgcn_readlane(__builtin_bit_cast(int, v), 32)), s3 = __builtin_bit_cast(float, __builtin_amdgcn_readlane(__builtin_bit_cast(int, v), 48));
    return (s0 + s1) + (s2 + s3);
}
__device__ __forceinline__ float bf2f(unsigned v16) { return __uint_as_float(v16 << 16); }

#ifdef PROBE_LO
#define STAMP(k) do { if (blockIdx.x == 0 && F.tid == 0) { const unsigned long long t_ = rt(); F.MISC[80 + 2 * (k)] = (unsigned)t_; F.MISC[81 + 2 * (k)] = (unsigned)(t_ >> 32); } } while (0)
#else
#define STAMP(k) do { } while (0)
#endif
struct TItem { const float* W; const float* gain; bf16* WT; int ldn, src_col, K, n_dst, k0; };
__device__ __forceinline__ TItem p0_decode(const Frame& F, int it) {
    constexpr int I_IN = (D_ / 64) * (ZW / 32), I_OUT = (D_ / 64) * (D_ / 32), I_UP = (D_ / 64) * (FF_ / 32), I_DN = (FF_ / 64) * (D_ / 32), I_PG = I_OUT;
    TItem t; int r = it;
    if (r < I_IN) { const int nb = r % (ZW / 32), kb = r / (ZW / 32), n0 = 32 * nb; t.W = IN_w_in; t.gain = IN_g_mix; t.WT = (bf16*)(F.ws + WS_WIN); t.ldn = INW_; t.src_col = n0 < 1536 ? n0 : n0 + 16; t.K = D_; t.n_dst = n0; t.k0 = 64 * kb; return t; } r -= I_IN;
    if (r < I_OUT) { const int nb = r % (D_ / 32), kb = r / (D_ / 32); t.W = IN_w_out; t.gain = nullptr; t.WT = (bf16*)(F.ws + WS_WOUT); t.ldn = D_; t.src_col = 32 * nb; t.K = D_; t.n_dst = 32 * nb; t.k0 = 64 * kb; return t; } r -= I_OUT;
    if (r < I_UP) { const int nb = r % (FF_ / 32), kb = r / (FF_ / 32); t.W = IN_w_up; t.gain = IN_g_ffn; t.WT = (bf16*)(F.ws + WS_WUP); t.ldn = FF_; t.src_col = 32 * nb; t.K = D_; t.n_dst = 32 * nb; t.k0 = 64 * kb; return t; } r -= I_UP;
    if (r < I_DN) { const int nb = r % (D_ / 32), kb = r / (D_ / 32); t.W = IN_w_down; t.gain = nullptr; t.WT = (bf16*)(F.ws + WS_WDOWN); t.ldn = D_; t.src_col = 32 * nb; t.K = FF_; t.n_dst = 32 * nb; t.k0 = 64 * kb; return t; } r -= I_DN;
    if (r < I_PG) { const int nb = r % (D_ / 32), kb = r / (D_ / 32); t.W = IN_w_pg; t.gain = IN_g_pg; t.WT = (bf16*)(F.ws + WS_WPG); t.ldn = D_; t.src_col = 32 * nb; t.K = D_; t.n_dst = 32 * nb; t.k0 = 64 * kb; return t; } r -= I_PG;
    { const int nb = r % (D_ / 32), kb = r / (D_ / 32); t.W = IN_w_pp; t.gain = nullptr; t.WT = (bf16*)(F.ws + WS_WPP); t.ldn = D_; t.src_col = 32 * nb; t.K = PLE_; t.n_dst = 32 * nb; t.k0 = 64 * kb; return t; }
}
__device__ __forceinline__ void p0_issue(const TItem& t, int lane, float (&w)[32], f32x4 (&g)[2]) {
    const float* src = t.W + (size_t)(t.k0 + (lane >> 5)) * t.ldn + t.src_col + (lane & 31);
#pragma unroll
    for (int i = 0; i < 32; ++i) w[i] = __builtin_nontemporal_load(src + (size_t)(2 * i) * t.ldn);
    if (t.gain) { g[0] = *(const f32x4*)(t.gain + t.k0 + 8 * (lane & 7)); g[1] = *(const f32x4*)(t.gain + t.k0 + 8 * (lane & 7) + 4); }
    else { g[0] = (f32x4){1.f, 1.f, 1.f, 1.f}; g[1] = g[0]; }
}
__device__ __forceinline__ void p0_prologue(Frame& F) {
    LAS float* scr = (LAS float*)(F.lds + RING_OFF + F.wave * 16384);
    constexpr int P0_ROWW = 5, P0_TRW = NWAVES - P0_ROWW;
    const bool row_role = F.wave < P0_ROWW;
    const int gw = row_role ? F.vcu * P0_ROWW + F.wave : F.vcu * P0_TRW + (F.wave - P0_ROWW), NGW = F.G * (row_role ? P0_ROWW : P0_TRW);
    bf16* Wga_t = (bf16*)(F.ws + WS_WGA);
    constexpr int NITEMS = (D_ / 64) * (ZW / 32) + 2 * (D_ / 64) * (D_ / 32) + (D_ / 64) * (FF_ / 32) + (FF_ / 64) * (D_ / 32) + (PLE_ / 64) * (D_ / 32);
    if (!row_role) {
        int it = gw; bool have = it < NITEMS;
        float w[32]; f32x4 g[2]; TItem cur;
        if (have) { cur = p0_decode(F, it); p0_issue(cur, F.lane, w, g); }
        while (have) {
#pragma unroll
            for (int i = 0; i < 32; ++i) scr[(2 * i + (F.lane >> 5)) * 33 + (F.lane & 31)] = w[i];
            const f32x4 g0 = g[0], g1 = g[1]; const TItem t = cur;
            LDS_WAIT(); asm volatile("" ::: "memory");
            const int nit = it + NGW; const bool nh = nit < NITEMS;
            if (nh) { cur = p0_decode(F, nit); p0_issue(cur, F.lane, w, g); }
            const int c = F.lane & 7;
#pragma unroll
            for (int j = 0; j < 4; ++j) { const int n = (F.lane >> 3) + 8 * j; const LAS float* s = scr + (8 * c) * 33 + n;
                v4u o; o.x = pk2(s[0 * 33] * g0[0], s[1 * 33] * g0[1]); o.y = pk2(s[2 * 33] * g0[2], s[3 * 33] * g0[3]); o.z = pk2(s[4 * 33] * g1[0], s[5 * 33] * g1[1]); o.w = pk2(s[6 * 33] * g1[2], s[7 * 33] * g1[3]);
                *(GAS v4u*)(t.WT + (size_t)(t.n_dst + n) * t.K + t.k0 + 8 * c) = o; }
            LDS_WAIT(); asm volatile("" ::: "memory");
            it = nit; have = nh;
        }
    }
    if (!row_role) { const float* wi_ = IN_w_in; const float* gm_ = IN_g_mix;
      for (int i = gw * 64 + F.lane; i < 16 * D_; i += NGW * 64) { const int r = i >> 10, k = i & 1023; Wga_t[i] = (bf16)f2bf(wi_[(size_t)k * INW_ + 1536 + r] * gm_[k]); } }
    bf16* xb = (bf16*)(F.ws + WS_AB); bf16* pb = (bf16*)(F.ws + WS_PB); float* rstdx = (float*)(F.ws + WS_RSTDX);
    const float* x_ = IN_x; const float* p_ = IN_p;
    if (row_role) {
        f32x4 v[4][4], pv[4], vn[4][4], pvn[4];
        int m0 = gw * 4; bool have = m0 < S_;
        if (have) {
#pragma unroll
            for (int rr = 0; rr < 4; ++rr) { const GAS f32x4* xr = (const GAS f32x4*)(x_ + (size_t)(m0 + rr) * D_) + F.lane;
#pragma unroll
                for (int j = 0; j < 4; ++j) v[rr][j] = __builtin_nontemporal_load(xr + 64 * j);
                pv[rr] = __builtin_nontemporal_load((const GAS f32x4*)(p_ + (size_t)(m0 + rr) * PLE_) + F.lane); }
        }
        while (have) {
            const int m1 = m0 + NGW * 4; const bool nh = m1 < S_;
            if (nh) {
#pragma unroll
                for (int rr = 0; rr < 4; ++rr) { const GAS f32x4* xr = (const GAS f32x4*)(x_ + (size_t)(m1 + rr) * D_) + F.lane;
#pragma unroll
                    for (int j = 0; j < 4; ++j) vn[rr][j] = __builtin_nontemporal_load(xr + 64 * j);
                    pvn[rr] = __builtin_nontemporal_load((const GAS f32x4*)(p_ + (size_t)(m1 + rr) * PLE_) + F.lane); }
            }
#pragma unroll
            for (int rr = 0; rr < 4; ++rr) { const int m = m0 + rr; float s = 0.f;
#pragma unroll
                for (int j = 0; j < 4; ++j) s += (v[rr][j].x * v[rr][j].x + v[rr][j].y * v[rr][j].y) + (v[rr][j].z * v[rr][j].z + v[rr][j].w * v[rr][j].w);
                s = wave_sum(s);
                GAS unsigned long long* o8 = (GAS unsigned long long*)(xb + (size_t)m * D_) + F.lane;
#pragma unroll
                for (int j = 0; j < 4; ++j) o8[64 * j] = (unsigned long long)pk2(v[rr][j].x, v[rr][j].y) | ((unsigned long long)pk2(v[rr][j].z, v[rr][j].w) << 32);
                if (F.lane == 0) rstdx[m] = 1.0f / sqrtf(s * (1.0f / D_) + EPS_);
                *((GAS unsigned long long*)(pb + (size_t)m * PLE_) + F.lane) = (unsigned long long)pk2(pv[rr].x, pv[rr].y) | ((unsigned long long)pk2(pv[rr].z, pv[rr].w) << 32); }
#pragma unroll
            for (int rr = 0; rr < 4; ++rr) { pv[rr] = pvn[rr];
#pragma unroll
                for (int j = 0; j < 4; ++j) v[rr][j] = vn[rr][j]; }
            m0 = m1; have = nh;
        }
    }
}

typedef float f32x16 __attribute__((ext_vector_type(16)));
typedef __bf16 bf2_t __attribute__((ext_vector_type(2)));
typedef float f2_t __attribute__((ext_vector_type(2)));
__device__ __forceinline__ unsigned pkbf(float lo, float hi) { f2_t v = {lo, hi}; bf2_t b = __builtin_convertvector(v, bf2_t); return __builtin_bit_cast(unsigned, b); }
#define MFMA32(a, b, c) __builtin_amdgcn_mfma_f32_32x32x16_bf16((a), (b), (c), 0, 0, 0)
#define WG_SYNC() do { asm volatile("s_waitcnt lgkmcnt(0)" ::: "memory"); __builtin_amdgcn_s_barrier(); asm volatile("" ::: "memory"); } while (0)
__device__ __forceinline__ bf16x8 pack8(const f32x16& x, int s) {
    v4u p; p.x = pkbf(x[8 * s], x[8 * s + 1]); p.y = pkbf(x[8 * s + 2], x[8 * s + 3]); p.z = pkbf(x[8 * s + 4], x[8 * s + 5]); p.w = pkbf(x[8 * s + 6], x[8 * s + 7]);
    return __builtin_bit_cast(bf16x8, p);
}
__device__ __forceinline__ float log_sigmoid(float s) { return fminf(s, 0.f) - __logf(1.0f + __expf(-fabsf(s))); }
constexpr int GROW = 72;
__device__ __forceinline__ int tperm(int tt) { return (tt & ~15) + 8 * ((tt >> 2) & 1) + 4 * ((tt >> 3) & 1) + (tt & 3); }
typedef short s16x4_t __attribute__((ext_vector_type(4)));
__device__ __forceinline__ unsigned voff_b(unsigned row, unsigned ch) { return 256u * row + 16u * (ch ^ (((row & 3u) << 2) | ((row >> 2) & 3u))); }
__device__ __forceinline__ bf16x8 v_tr_frag(const LAS unsigned char* VL, int kb0, int et, int lane) {
    const unsigned hh = lane >> 5, blk = (lane >> 4) & 1, q = (lane & 15) >> 2, p = lane & 3;
    const unsigned r0 = kb0 + 4 * hh + q, ch = 4 * et + 2 * blk + (p >> 1);
    const s16x4_t lo = __builtin_amdgcn_ds_read_tr16_b64_v4i16((LAS s16x4_t*)(VL + voff_b(r0, ch) + 8 * (p & 1)));
    const s16x4_t hi = __builtin_amdgcn_ds_read_tr16_b64_v4i16((LAS s16x4_t*)(VL + voff_b(r0 + 8, ch) + 8 * (p & 1)));
    return __builtin_shufflevector(lo, hi, 0, 1, 2, 3, 4, 5, 6, 7);
}

__device__ __forceinline__ void gla_load_w2(Frame& F, float (&w2)[16], float& bias) {
    const int c = F.tid & 255;
    const float* wa2_ = IN_w_a2;
#pragma unroll
    for (int r = 0; r < 16; ++r) w2[r] = wa2_[r * 256 + c];
    bias = IN_b_a[c];
}
__device__ __forceinline__ void gla_cumsum(Frame& F, const LAS float* GAS_, LAS float* TOT, const float (&w2)[16], float bias, float (&bl)[32], float& blast, float& boff) {
    const int c = F.tid & 255, half = F.tid >> 8;
    float run = 0.f;
#pragma unroll
    for (int i = 0; i < 32; ++i) {
        const LAS f32x4* g4 = (const LAS f32x4*)(GAS_ + (32 * half + i) * 16);
        const f32x4 g0 = g4[0], g1 = g4[1], g2 = g4[2], g3 = g4[3];
        float a = bias;
        a += g0[0] * w2[0]; a += g0[1] * w2[1]; a += g0[2] * w2[2]; a += g0[3] * w2[3];
        a += g1[0] * w2[4]; a += g1[1] * w2[5]; a += g1[2] * w2[6]; a += g1[3] * w2[7];
        a += g2[0] * w2[8]; a += g2[1] * w2[9]; a += g2[2] * w2[10]; a += g2[3] * w2[11];
        a += g3[0] * w2[12]; a += g3[1] * w2[13]; a += g3[2] * w2[14]; a += g3[3] * w2[15];
        run += log_sigmoid(a) * (1.0f / 16.0f);
        bl[i] = run;
    }
    TOT[half * 256 + c] = run;
    WG_SYNC();
    const float t0 = TOT[c], t1 = TOT[256 + c];
    blast = t0 + t1; boff = half ? t0 : 0.f;
}
__device__ __forceinline__ void gla_vt_load(Frame& F, const bf16* zb, int t0, v4u (&vw)[8]) {
#pragma unroll
    for (int i = 0; i < 8; ++i) { const int idx = F.tid + 512 * i, t = idx >> 6, c64 = idx & 63; vw[i] = *(const v4u*)(zb + (size_t)(t0 + t) * ZW + Z_GV + 8 * c64); }
}
__device__ __forceinline__ void gla_vt_write(Frame& F, LAS unsigned char* VL, const v4u (&vw)[8]) {
#pragma unroll
    for (int i = 0; i < 8; ++i) { const int idx = F.tid + 512 * i, t = idx >> 6, c64 = idx & 63; *(LAS v4u*)(VL + (c64 >> 4) * 16384 + voff_b(t, c64 & 15)) = vw[i]; }
}

__device__ __forceinline__ void gla_a_chunk(Frame& F, int ch) {
    LAS float* GA_S = (LAS float*)(F.lds);
    LAS float* TOT = (LAS float*)(F.lds + 8192);
    LAS bf16* KTE = (LAS bf16*)(F.lds + 10240);
    LAS unsigned char* VT = F.lds + 10240 + 4 * 64 * GROW * 2;
    const bf16* xb = (const bf16*)(F.ws + WS_AB); const bf16* zb = (const bf16*)(F.ws + WS_Z); const bf16* wga = (const bf16*)(F.ws + WS_WGA);
    const float* rstdx = (const float*)(F.ws + WS_RSTDX); float* ga_g = (float*)(F.ws + WS_GA); float* decay_g = (float*)(F.ws + WS_DECAY); bf16* dS_g = (bf16*)(F.ws + WS_DS);
    const int t0 = ch * 64;
    float w2[16], bias; gla_load_w2(F, w2, bias);
    v4u vw[8]; gla_vt_load(F, zb, t0, vw);
    LAS bf16* KRAW = (LAS bf16*)(VT + 65536);
    v4u kw[4];
#pragma unroll
    for (int i = 0; i < 4; ++i) { const int idx = F.tid + 512 * i, t = idx >> 5, c32 = idx & 31; kw[i] = *(const v4u*)(zb + (size_t)(t0 + t) * ZW + Z_GK + 8 * c32); }
    {
        const int rg = F.wave & 3, kh = F.wave >> 2, r = F.lane & 15, q = F.lane >> 4;
        const bf16* arow = xb + (size_t)(t0 + 16 * rg + r) * D_ + 8 * q; const bf16* brow = wga + (size_t)r * D_ + 8 * q;
        pg8::f32x4 acc = {0.f, 0.f, 0.f, 0.f};
#pragma unroll
        for (int s = 16 * kh; s < 16 * kh + 16; ++s) { const bf16x8 a = *(const bf16x8*)(arow + 32 * s), b = *(const bf16x8*)(brow + 32 * s); acc = __builtin_amdgcn_mfma_f32_16x16x32_bf16(a, b, acc, 0, 0, 0); }
#pragma unroll
        for (int g = 0; g < 4; ++g) GA_S[kh * 1024 + (16 * rg + 4 * q + g) * 16 + r] = acc[g];
    }
#pragma unroll
    for (int i = 0; i < 4; ++i) { const int idx = F.tid + 512 * i, t = idx >> 5, c32 = idx & 31; *(LAS v4u*)(KRAW + (size_t)((c32 >> 3) * 64 + t) * GROW + 8 * (c32 & 7)) = kw[i]; }
    gla_vt_write(F, VT, vw);
    WG_SYNC();
    for (int idx = F.tid; idx < 1024; idx += 512) { const float v = (GA_S[idx] + GA_S[1024 + idx]) * rstdx[t0 + (idx >> 4)]; GA_S[idx] = v; ga_g[(size_t)t0 * 16 + idx] = v; }
    WG_SYNC();
    float bl[32], blast, boff;
    gla_cumsum(F, GA_S, TOT, w2, bias, bl, blast, boff);
    {
        const int c = F.tid & 255, half = F.tid >> 8, h = c >> 6, d = c & 63;
        if (half == 0) decay_g[ch * 256 + c] = __expf(blast);
#pragma unroll
        for (int g8 = 0; g8 < 4; ++g8) {
            float v[8];
#pragma unroll
            for (int j = 0; j < 8; ++j) v[j] = bf2f(KRAW[(size_t)(h * 64 + 32 * half + 8 * g8 + j) * GROW + d]) * __expf(blast - (boff + bl[8 * g8 + j]));
            const int tt = 32 * half + 8 * g8, hi = (tt >> 3) & 1;
            LAS bf16* row = KTE + (size_t)(h * 64 + d) * GROW + (tt & ~15) + 4 * hi;
            typedef unsigned u2 __attribute__((ext_vector_type(2)));
            u2 lo, hi2; lo.x = pkbf(v[0], v[1]); lo.y = pkbf(v[2], v[3]); hi2.x = pkbf(v[4], v[5]); hi2.y = pkbf(v[6], v[7]);
            *(LAS u2*)(row) = lo; *(LAS u2*)(row + 8) = hi2;
        }
    }
    WG_SYNC();
    {
        const int h = F.wave >> 1, dt = F.wave & 1, i = F.lane & 31, hh = F.lane >> 5;
        f32x16 acc[4];
#pragma unroll
        for (int et = 0; et < 4; ++et)
#pragma unroll
            for (int r = 0; r < 16; ++r) acc[et][r] = 0.f;
#pragma unroll
        for (int s = 0; s < 4; ++s) {
            const bf16x8 a = *(const LAS bf16x8*)(KTE + (size_t)(h * 64 + 32 * dt + i) * GROW + 16 * s + 8 * hh);
#pragma unroll
            for (int et = 0; et < 4; ++et) { const bf16x8 b = v_tr_frag(VT + h * 16384, 16 * s, et, F.lane); acc[et] = MFMA32(a, b, acc[et]); }
        }
#pragma unroll
        for (int et = 0; et < 4; ++et) {
            bf16* dst = dS_g + ((size_t)(ch * 4 + h) * 128 + 32 * et + i) * 64 + 32 * dt + 4 * hh;
            typedef unsigned u2 __attribute__((ext_vector_type(2)));
#pragma unroll
            for (int g = 0; g < 4; ++g) { u2 w; w.x = pkbf(acc[et][4 * g], acc[et][4 * g + 1]); w.y = pkbf(acc[et][4 * g + 2], acc[et][4 * g + 3]); *(u2*)(dst + 8 * g) = w; }
        }
    }
    WG_SYNC();
}

__device__ __forceinline__ void gla_b_pair(Frame& F, int pair) {
    LAS float* DSL = (LAS float*)(F.lds);
    LAS float* DEC = (LAS float*)(F.lds + 65536);
    LAS float* SEGE = (LAS float*)(F.lds + 131072);
    LAS float* SEGP = (LAS float*)(F.lds + 131072 + 2048);
    const float* decay_g = (const float*)(F.ws + WS_DECAY); const bf16* dS_g = (const bf16*)(F.ws + WS_DS); bf16* sp_g = (bf16*)((unsigned char*)F.out + OUT_SPREV);
    const int h = pair >> 6, seg = F.tid >> 6, d = F.tid & 63;
#pragma unroll
    for (int i = 0; i < 8; ++i) { const int idx = F.tid + 512 * i, n = idx >> 4, d4 = idx & 15; *(LAS pg8::f32x4*)(DEC + n * 64 + 4 * d4) = *(const pg8::f32x4*)(decay_g + (size_t)n * 256 + h * 64 + 4 * d4); }
    for (int sub = 0; sub < 2; ++sub) {
        const int e = (pair & 63) * 2 + sub;
#pragma unroll
        for (int i = 0; i < 4; ++i) { const int idx = F.tid + 512 * i, n = idx >> 3, d8 = idx & 7;
            const v4u w = *(const v4u*)(dS_g + ((size_t)(n * 4 + h) * 128 + e) * 64 + 8 * d8);
            LAS pg8::f32x4* dp = (LAS pg8::f32x4*)(DSL + n * 64 + 8 * d8);
            dp[0] = (pg8::f32x4){bf2f(w.x & 0xffffu), bf2f(w.x >> 16), bf2f(w.y & 0xffffu), bf2f(w.y >> 16)}; dp[1] = (pg8::f32x4){bf2f(w.z & 0xffffu), bf2f(w.z >> 16), bf2f(w.w & 0xffffu), bf2f(w.w >> 16)}; }
        WG_SYNC();
        float Sv = 0.f, P = 1.f;
#pragma unroll 8
        for (int i = 0; i < 32; ++i) { const int n = seg * 32 + i; const float x = DSL[n * 64 + d], a = DEC[n * 64 + d]; DSL[n * 64 + d] = Sv; Sv = a * Sv + x; P *= a; }
        SEGE[seg * 64 + d] = Sv; SEGP[seg * 64 + d] = P;
        WG_SYNC();
        float st = 0.f;
        for (int k = 0; k < seg; ++k) st = SEGP[k * 64 + d] * st + SEGE[k * 64 + d];
        float Pq = 1.f;
#pragma unroll 8
        for (int i = 0; i < 32; ++i) { const int n = seg * 32 + i; const float v = DSL[n * 64 + d] + Pq * st; Pq *= DEC[n * 64 + d]; sp_g[((size_t)(n * 4 + h) * 128 + e) * 64 + d] = (bf16)f2bf(v); }
        WG_SYNC();
    }
}

__device__ __forceinline__ void gla_c_chunk(Frame& F, int ch) {
    LAS float* GA2 = (LAS float*)(F.lds);
    LAS float* TOT = (LAS float*)(F.lds + 4096);
    LAS bf16* QD = (LAS bf16*)(F.lds + 6144);
    LAS bf16* KI = (LAS bf16*)(F.lds + 6144 + 36864);
    LAS unsigned char* VT = F.lds + 6144 + 2 * 36864;
    const bf16* zb = (const bf16*)(F.ws + WS_Z); const float* ga_g = (const float*)(F.ws + WS_GA); const bf16* sp_g = (const bf16*)((const unsigned char*)F.out + OUT_SPREV); bf16* mixb = (bf16*)(F.ws + WS_MIX);
    const int t0 = ch * 64;
    float w2[16], bias; gla_load_w2(F, w2, bias);
    v4u vw[8]; gla_vt_load(F, zb, t0, vw);
    v4u qw[4], kw[4];
#pragma unroll
    for (int i = 0; i < 4; ++i) { const int idx = F.tid + 512 * i, t = idx >> 5, c32 = idx & 31; qw[i] = *(const v4u*)(zb + (size_t)(t0 + t) * ZW + Z_GQ + 8 * c32); kw[i] = *(const v4u*)(zb + (size_t)(t0 + t) * ZW + Z_GK + 8 * c32); }
    for (int idx = F.tid; idx < 1024; idx += 512) GA2[idx] = ga_g[(size_t)t0 * 16 + idx];
    bf16x8 sfr[4][4];
    { const int h_ = F.wave >> 1, i_ = F.lane & 31, hh_ = F.lane >> 5;
#pragma unroll
      for (int et = 0; et < 4; ++et) { const bf16* srow = sp_g + ((size_t)(ch * 4 + h_) * 128 + 32 * et + i_) * 64 + 8 * hh_;
#pragma unroll
          for (int s = 0; s < 4; ++s) sfr[et][s] = *(const bf16x8*)(srow + 16 * s); } }
#pragma unroll
    for (int i = 0; i < 4; ++i) { const int idx = F.tid + 512 * i, t = idx >> 5, c32 = idx & 31; const size_t o = (size_t)((c32 >> 3) * 64 + t) * GROW + 8 * (c32 & 7); *(LAS v4u*)(QD + o) = qw[i]; *(LAS v4u*)(KI + o) = kw[i]; }
    gla_vt_write(F, VT, vw);
    WG_SYNC();
    float bl[32], blast, boff;
    gla_cumsum(F, GA2, TOT, w2, bias, bl, blast, boff);
    {
        const int c = F.tid & 255, half = F.tid >> 8, h = c >> 6, d = c & 63;
#pragma unroll
        for (int i = 0; i < 32; ++i) {
            const float b = boff + bl[i];
            const size_t o = (size_t)(h * 64 + 32 * half + i) * GROW + d;
            const float qd = bf2f(QD[o]) * __expf(b) * 0.125f, ki = bf2f(KI[o]) * __expf(-b);
            QD[o] = (bf16)f2bf(qd); KI[o] = (bf16)f2bf(ki);
        }
    }
    v4u ggw[8];
#pragma unroll
    for (int k = 0; k < 8; ++k) { const int idx = F.tid + 512 * k, t = idx >> 6, c64 = idx & 63; ggw[k] = *(const v4u*)(zb + (size_t)(t0 + t) * ZW + Z_GG + 8 * c64); }
    WG_SYNC();
    {
        const int h = F.wave >> 1, ct = F.wave & 1, i = F.lane & 31, hh = F.lane >> 5;
        bf16x8 qf[4];
#pragma unroll
        for (int s = 0; s < 4; ++s) qf[s] = *(const LAS bf16x8*)(QD + (size_t)(h * 64 + 32 * ct + i) * GROW + 16 * s + 8 * hh);
        f32x16 acc[4];
#pragma unroll
        for (int et = 0; et < 4; ++et)
#pragma unroll
            for (int r = 0; r < 16; ++r) acc[et][r] = 0.f;
#pragma unroll
        for (int et = 0; et < 4; ++et) {
#pragma unroll
            for (int s = 0; s < 4; ++s) acc[et] = MFMA32(sfr[et][s], qf[s], acc[et]);
        }
        for (int jt = 0; jt <= ct; ++jt) {
            f32x16 X;
#pragma unroll
            for (int r = 0; r < 16; ++r) X[r] = 0.f;
#pragma unroll
            for (int s = 0; s < 4; ++s) { const bf16x8 kf = *(const LAS bf16x8*)(KI + (size_t)(h * 64 + 32 * jt + i) * GROW + 16 * s + 8 * hh); X = MFMA32(kf, qf[s], X); }
            if (jt == ct) {
#pragma unroll
                for (int r = 0; r < 16; ++r) { const int j = (r & 3) + 8 * (r >> 2) + 4 * hh; if (j > i) X[r] = 0.f; }
            }
#pragma unroll
            for (int s2 = 0; s2 < 2; ++s2) {
                const bf16x8 xs = pack8(X, s2);
#pragma unroll
                for (int et = 0; et < 4; ++et) { const bf16x8 vf = v_tr_frag(VT + h * 16384, 32 * jt + 16 * s2, et, F.lane); acc[et] = MFMA32(vf, xs, acc[et]); }
            }
        }
        float ss = 0.f;
#pragma unroll
        for (int et = 0; et < 4; ++et)
#pragma unroll
            for (int r = 0; r < 16; ++r) ss += acc[et][r] * acc[et][r];
        ss += __shfl_xor(ss, 32);
        const float rn = __builtin_amdgcn_rsqf(ss * (1.0f / 128.0f) + EPS_);
        const float* ggl_ = IN_g_gla;
        WG_SYNC();
        const int t = 32 * ct + i;
#pragma unroll
        for (int et = 0; et < 4; ++et)
#pragma unroll
            for (int g = 0; g < 4; ++g) {
                const int e0 = 32 * et + 8 * g + 4 * hh;
                const pg8::f32x4 gl = *(const pg8::f32x4*)(ggl_ + e0);
                typedef unsigned u2 __attribute__((ext_vector_type(2)));
                u2 w; w.x = pkbf(acc[et][4 * g] * rn * gl[0], acc[et][4 * g + 1] * rn * gl[1]); w.y = pkbf(acc[et][4 * g + 2] * rn * gl[2], acc[et][4 * g + 3] * rn * gl[3]);
                *(LAS u2*)(VT + h * 16384 + voff_b(t, e0 >> 3) + 8 * hh) = w;
            }
    }
    WG_SYNC();
#pragma unroll
    for (int k = 0; k < 8; ++k) { const int idx = F.tid + 512 * k, t = idx >> 6, c64 = idx & 63;
        const v4u on = *(const LAS v4u*)(VT + (c64 >> 4) * 16384 + voff_b(t, c64 & 15)), gw = ggw[k];
        float o[8] = {bf2f(on.x & 0xffffu), bf2f(on.x >> 16), bf2f(on.y & 0xffffu), bf2f(on.y >> 16), bf2f(on.z & 0xffffu), bf2f(on.z >> 16), bf2f(on.w & 0xffffu), bf2f(on.w >> 16)};
        float gv[8] = {bf2f(gw.x & 0xffffu), bf2f(gw.x >> 16), bf2f(gw.y & 0xffffu), bf2f(gw.y >> 16), bf2f(gw.z & 0xffffu), bf2f(gw.z >> 16), bf2f(gw.w & 0xffffu), bf2f(gw.w >> 16)};
#pragma unroll
        for (int j = 0; j < 8; ++j) o[j] *= gv[j] * __builtin_amdgcn_rcpf(1.0f + __expf(-gv[j]));
        v4u w; w.x = pkbf(o[0], o[1]); w.y = pkbf(o[2], o[3]); w.z = pkbf(o[4], o[5]); w.w = pkbf(o[6], o[7]);
        *(v4u*)(mixb + (size_t)(t0 + t) * D_ + 8 * c64) = w; }
    WG_SYNC();
}

constexpr int KROW = 136;
constexpr int LIST_PER_HEAD = 256 * 2016;
__device__ __forceinline__ int list_off(int h, int j) { return h * LIST_PER_HEAD + 256 * (63 * j - (j * (j - 1)) / 2); }
typedef unsigned u2_t __attribute__((ext_vector_type(2)));

__device__ __forceinline__ void sincos_acc(float a, float& s, float& c) {
    const float k = __builtin_rintf(a * 0.15915494309189535f);
    float r = __builtin_fmaf(-k, 6.28125f, a);
    r = __builtin_fmaf(-k, 0.0019353071693331003f, r);
    r = __builtin_fmaf(-k, 1.0253131677018246e-11f, r);
    const float rev = r * 0.15915494309189535f;
    s = __builtin_amdgcn_sinf(rev); c = __builtin_amdgcn_cosf(rev);
}

__device__ __forceinline__ void moba_a_item(Frame& F, int item) {
    const int blk = item >> 2, h = item & 3;
    LAS float* KM = (LAS float*)(F.lds);
    bf16* zb = (bf16*)(F.ws + WS_Z); float* kmean_g = (float*)(F.ws + WS_KMEAN);
    {
        const int ts = F.lane >> 4, g = F.lane & 15;
        const float* gmq_ = IN_g_mq; const float* gmk_ = IN_g_mk; const int* pos_ = IN_pos;
        LAS float* INVT = KM + 32 * 128;
        if (F.tid < 64) INVT[F.tid] = 1.0f / powf(10000.0f, (float)F.tid / 64.0f);
        WG_SYNC();
        float inv[4]; f32x4 gq1 = *(const f32x4*)(gmq_ + 4 * g), gq2 = *(const f32x4*)(gmq_ + 64 + 4 * g), gk1 = *(const f32x4*)(gmk_ + 4 * g), gk2 = *(const f32x4*)(gmk_ + 64 + 4 * g);
#pragma unroll
        for (int c = 0; c < 4; ++c) inv[c] = INVT[4 * g + c];
        float km1[4] = {0.f, 0.f, 0.f, 0.f}, km2[4] = {0.f, 0.f, 0.f, 0.f};
        for (int b4 = 0; b4 < 2; ++b4) {
            u2_t ql[4], qh[4], kl[4], kh[4]; int ps[4];
#pragma unroll
            for (int u = 0; u < 4; ++u) { const int t = blk * 256 + F.wave * 32 + 16 * b4 + 4 * u + ts;
                const bf16* pq = zb + (size_t)t * ZW + Z_MQ + h * 128 + 4 * g; const bf16* pk = zb + (size_t)t * ZW + Z_MK + h * 128 + 4 * g;
                ps[u] = pos_[t]; ql[u] = *(const u2_t*)pq; qh[u] = *(const u2_t*)(pq + 64); kl[u] = *(const u2_t*)pk; kh[u] = *(const u2_t*)(pk + 64); }
#pragma unroll
            for (int u = 0; u < 4; ++u) { const int t = blk * 256 + F.wave * 32 + 16 * b4 + 4 * u + ts;
                float q1[4] = {bf2f(ql[u].x & 0xffffu), bf2f(ql[u].x >> 16), bf2f(ql[u].y & 0xffffu), bf2f(ql[u].y >> 16)}, q2[4] = {bf2f(qh[u].x & 0xffffu), bf2f(qh[u].x >> 16), bf2f(qh[u].y & 0xffffu), bf2f(qh[u].y >> 16)};
                float k1[4] = {bf2f(kl[u].x & 0xffffu), bf2f(kl[u].x >> 16), bf2f(kl[u].y & 0xffffu), bf2f(kl[u].y >> 16)}, k2[4] = {bf2f(kh[u].x & 0xffffu), bf2f(kh[u].x >> 16), bf2f(kh[u].y & 0xffffu), bf2f(kh[u].y >> 16)};
                float sq = 0.f, sk = 0.f;
#pragma unroll
                for (int c = 0; c < 4; ++c) { sq += q1[c] * q1[c] + q2[c] * q2[c]; sk += k1[c] * k1[c] + k2[c] * k2[c]; }
                sq = row16_sum(sq); sk = row16_sum(sk);
                const float rq = __builtin_amdgcn_rsqf(sq * (1.0f / 128.0f) + EPS_), rk = __builtin_amdgcn_rsqf(sk * (1.0f / 128.0f) + EPS_);
                float oq1[4], oq2[4], ok1[4], ok2[4];
#pragma unroll
                for (int c = 0; c < 4; ++c) { float sn, cs; sincos_acc((float)ps[u] * inv[c], sn, cs);
                    const float yq1 = q1[c] * rq * gq1[c], yq2 = q2[c] * rq * gq2[c], yk1 = k1[c] * rk * gk1[c], yk2 = k2[c] * rk * gk2[c];
                    oq1[c] = yq1 * cs - yq2 * sn; oq2[c] = yq2 * cs + yq1 * sn; ok1[c] = yk1 * cs - yk2 * sn; ok2[c] = yk2 * cs + yk1 * sn;
                    km1[c] += ok1[c]; km2[c] += ok2[c]; }
                bf16* pq = zb + (size_t)t * ZW + Z_MQ + h * 128 + 4 * g; bf16* pk = zb + (size_t)t * ZW + Z_MK + h * 128 + 4 * g;
                u2_t w; w.x = pkbf(oq1[0], oq1[1]); w.y = pkbf(oq1[2], oq1[3]); *(u2_t*)pq = w; w.x = pkbf(oq2[0], oq2[1]); w.y = pkbf(oq2[2], oq2[3]); *(u2_t*)(pq + 64) = w;
                w.x = pkbf(ok1[0], ok1[1]); w.y = pkbf(ok1[2], ok1[3]); *(u2_t*)pk = w; w.x = pkbf(ok2[0], ok2[1]); w.y = pkbf(ok2[2], ok2[3]); *(u2_t*)(pk + 64) = w;
            }
        }
#pragma unroll
        for (int c = 0; c < 4; ++c) { KM[(F.wave * 4 + ts) * 128 + 4 * g + c] = km1[c]; KM[(F.wave * 4 + ts) * 128 + 64 + 4 * g + c] = km2[c]; }
    }
    WG_SYNC();
    if (F.tid < 128) { float s = 0.f;
#pragma unroll
        for (int w = 0; w < 32; ++w) s += KM[w * 128 + F.tid];
        kmean_g[(size_t)(h * 64 + blk) * 128 + F.tid] = s * (1.0f / 256.0f); }
    WG_SYNC();
}

__device__ __forceinline__ void top3_insert(float v, int j, float& v0, float& v1, float& v2, int& i0, int& i1, int& i2) {
    const bool b0 = (v > v0) || (v == v0 && j < i0), b1 = (v > v1) || (v == v1 && j < i1), b2 = (v > v2) || (v == v2 && j < i2);
    const float n2 = b1 ? v1 : (b2 ? v : v2); const int m2 = b1 ? i1 : (b2 ? j : i2);
    const float n1 = b0 ? v0 : (b1 ? v : v1); const int m1 = b0 ? i0 : (b1 ? j : i1);
    const float n0 = b0 ? v : v0; const int m0 = b0 ? j : i0;
    v0 = n0; v1 = n1; v2 = n2; i0 = m0; i1 = m1; i2 = m2;
}
__device__ __forceinline__ void moba_b_item(Frame& F, int item) {
    const int kb = item >> 2, h = item & 3;
    if (kb == 0) return;
    LAS bf16* KMH = (LAS bf16*)(F.lds);
    LAS bf16* KML = (LAS bf16*)(F.lds + 64 * KROW * 2);
    LAS unsigned* HIST = (LAS unsigned*)(F.lds + 2 * 64 * KROW * 2);
    LAS unsigned* BASE = HIST + 64;
    const bf16* zb = (const bf16*)(F.ws + WS_Z); const float* kmean_g = (const float*)(F.ws + WS_KMEAN); unsigned* list_g = (unsigned*)(F.ws + WS_LIST);
    const int i = F.lane & 31, kk = F.lane >> 5;
    const int t = kb * 256 + F.wave * 32 + i;
    bf16x8 qf[8];
    { const bf16* qrow = zb + (size_t)t * ZW + Z_MQ + h * 128 + 8 * kk;
#pragma unroll
      for (int s = 0; s < 8; ++s) qf[s] = *(const bf16x8*)(qrow + 16 * s); }
    for (int idx = F.tid; idx < 64 * 128; idx += 512) { const int j = idx >> 7, d = idx & 127; const float v = (j < kb) ? kmean_g[(size_t)(h * 64 + j) * 128 + d] : 0.f;
        const unsigned hi = f2bf(v); const float rem = v - bf2f(hi); KMH[j * KROW + d] = (bf16)hi; KML[j * KROW + d] = (bf16)f2bf(rem); }
    if (F.tid < 64) HIST[F.tid] = 0u;
    WG_SYNC();
    float v0 = -INFINITY, v1 = -INFINITY, v2 = -INFINITY; int i0 = 1 << 20, i1 = 1 << 20, i2 = 1 << 20;
    const int njt = (kb + 31) >> 5;
    for (int jt = 0; jt < njt; ++jt) {
        f32x16 acc;
#pragma unroll
        for (int r = 0; r < 16; ++r) acc[r] = 0.f;
#pragma unroll
        for (int s = 0; s < 8; ++s) {
            const bf16x8 ah = *(const LAS bf16x8*)(KMH + (size_t)(32 * jt + i) * KROW + 16 * s + 8 * kk), al = *(const LAS bf16x8*)(KML + (size_t)(32 * jt + i) * KROW + 16 * s + 8 * kk);
            acc = MFMA32(ah, qf[s], acc); acc = MFMA32(al, qf[s], acc);
        }
#pragma unroll
        for (int r = 0; r < 16; ++r) { const int j = 32 * jt + (r & 3) + 8 * (r >> 2) + 4 * kk; if (j < kb) top3_insert(acc[r], j, v0, v1, v2, i0, i1, i2); }
    }
    {
        const float pv0 = __shfl_xor(v0, 32), pv1 = __shfl_xor(v1, 32), pv2 = __shfl_xor(v2, 32);
        const int pi0 = __shfl_xor(i0, 32), pi1 = __shfl_xor(i1, 32), pi2 = __shfl_xor(i2, 32);
        top3_insert(pv0, pi0, v0, v1, v2, i0, i1, i2); top3_insert(pv1, pi1, v0, v1, v2, i0, i1, i2); top3_insert(pv2, pi2, v0, v1, v2, i0, i1, i2);
    }
    const int nsel = kb < 3 ? kb : 3;
    unsigned lp0 = 0, lp1 = 0, lp2 = 0;
    if (kk == 0) {
        if (nsel > 0) lp0 = atomicAdd((unsigned*)&HIST[i0], 1u);
        if (nsel > 1) lp1 = atomicAdd((unsigned*)&HIST[i1], 1u);
        if (nsel > 2) lp2 = atomicAdd((unsigned*)&HIST[i2], 1u);
    }
    WG_SYNC();
    if (F.tid < 64) { const unsigned n = HIST[F.tid]; BASE[F.tid] = n ? atomicAdd((unsigned*)(F.ctl + CW_CNT + h * 64 + F.tid), n) : 0u; }
    WG_SYNC();
    if (kk == 0) {
        if (nsel > 0) list_g[list_off(h, i0) + BASE[i0] + lp0] = (unsigned)t | (0u << 16);
        if (nsel > 1) list_g[list_off(h, i1) + BASE[i1] + lp1] = (unsigned)t | (1u << 16);
        if (nsel > 2) list_g[list_off(h, i2) + BASE[i2] + lp2] = (unsigned)t | (2u << 16);
    }
    WG_SYNC();
}

__device__ __forceinline__ void moba_load_kv(Frame& F, int h, int j, LAS bf16* KL, LAS unsigned char* VL) {
    const bf16* zb = (const bf16*)(F.ws + WS_Z);
#pragma unroll
    for (int i = 0; i < 8; ++i) { const int idx = F.tid + 512 * i, r = idx >> 4, c16 = idx & 15;
        *(LAS v4u*)(KL + (size_t)r * KROW + 8 * c16) = *(const v4u*)(zb + (size_t)(j * 256 + r) * ZW + Z_MK + h * 128 + 8 * c16); }
#pragma unroll
    for (int i = 0; i < 8; ++i) { const int idx = F.tid + 512 * i, r = idx >> 4, c16 = idx & 15;
        *(LAS v4u*)(VL + voff_b(r, c16)) = *(const v4u*)(zb + (size_t)(j * 256 + r) * ZW + Z_MV + h * 128 + 8 * c16); }
}
__device__ __forceinline__ void moba_wave_attend(const bf16x8 (&qf)[8], const LAS bf16* KL, const LAS unsigned char* VL, int nkt, int diag_kt, int i, int hh, int lane, float c2, float mc2, f32x16 (&acc)[4], float& lsum) {
    for (int kt = 0; kt < nkt; ++kt) {
        f32x16 St;
#pragma unroll
        for (int r = 0; r < 16; ++r) St[r] = 0.f;
#pragma unroll
        for (int s = 0; s < 8; ++s) { const bf16x8 kf = *(const LAS bf16x8*)(KL + (size_t)(32 * kt + i) * KROW + 16 * s + 8 * hh); St = MFMA32(kf, qf[s], St); }
#pragma unroll
        for (int r = 0; r < 16; ++r) St[r] = __builtin_amdgcn_exp2f(St[r] * c2 - mc2);
        if (kt == diag_kt) {
#pragma unroll
            for (int r = 0; r < 16; ++r) { const int kl = (r & 3) + 8 * (r >> 2) + 4 * hh; if (kl > i) St[r] = 0.f; }
        }
#pragma unroll
        for (int r = 0; r < 16; ++r) lsum += St[r];
#pragma unroll
        for (int s2 = 0; s2 < 2; ++s2) {
            const bf16x8 ps = pack8(St, s2);
#pragma unroll
            for (int et = 0; et < 4; ++et) { const bf16x8 vf = v_tr_frag(VL, 32 * kt + 16 * s2, et, lane); acc[et] = MFMA32(vf, ps, acc[et]); }
        }
    }
}
__device__ __forceinline__ void moba_shift(Frame& F, float& c2, float& mc2) {
    const float* gmq_ = IN_g_mq; const float* gmk_ = IN_g_mk;
    float m1 = fmaxf(fabsf(gmq_[F.lane]), fabsf(gmq_[F.lane + 64])), m2 = fmaxf(fabsf(gmk_[F.lane]), fabsf(gmk_[F.lane + 64]));
#pragma unroll
    for (int o = 1; o < 64; o <<= 1) { m1 = fmaxf(m1, __shfl_xor(m1, o)); m2 = fmaxf(m2, __shfl_xor(m2, o)); }
    c2 = 0.08838834764831845f * 1.4426950408889634f;
    mc2 = 11.313708498984761f * m1 * m2 * 1.4426950408889634f;
}

__device__ __forceinline__ void mc_decode(const LAS int* PRE, int it, int& hj, int& chunk) {
    int lo = 0, hi = 255;
    while (lo < hi) { const int mid = (lo + hi + 1) >> 1; if (PRE[mid] <= it) lo = mid; else hi = mid - 1; }
    hj = lo; chunk = it - PRE[lo];
}
__device__ __forceinline__ void mc_fetch(const Frame& F, int hj, int chunk, int n, int i, int hh, bool& active, bool& valid, int& tq, int& slot, bf16x8 (&qf)[8]) {
    const bf16* zb = (const bf16*)(F.ws + WS_Z); const unsigned* list_g = (const unsigned*)(F.ws + WS_LIST);
    const int h = hj >> 6, j = hj & 63, base = chunk * 256 + F.wave * 32;
    active = base < n; valid = false; tq = 0; slot = 0;
    if (active) {
        const int eidx = base + i; valid = eidx < n;
        const unsigned ent = list_g[list_off(h, j) + (valid ? eidx : base)];
        tq = (int)(ent & 0xffffu); slot = (int)(ent >> 16);
        const bf16* qrow = zb + (size_t)tq * ZW + Z_MQ + h * 128 + 8 * hh;
#pragma unroll
        for (int s = 0; s < 8; ++s) qf[s] = *(const bf16x8*)(qrow + 16 * s);
    }
}
__device__ __forceinline__ void moba_c_phase(Frame& F) {
    LAS bf16* KL = (LAS bf16*)(F.lds); LAS unsigned char* VL = F.lds + 256 * KROW * 2;
    LAS int* PRE = (LAS int*)(F.lds + 256 * KROW * 2 + 65536);
    LAS int* WT = PRE + 260;
    bf16* part_g = (bf16*)((unsigned char*)F.out + OUT_PART); float* lpart_g = (float*)(F.ws + WS_LPART);
    int mycnt = 0;
    if (F.tid < 256) {
        mycnt = (int)__hip_atomic_load(F.ctl + CW_CNT + F.tid, RLX_AGENT);
        int v = (mycnt + 255) >> 8, incl = v;
#pragma unroll
        for (int o = 1; o < 64; o <<= 1) { const int u = __shfl_up(incl, o); if (F.lane >= o) incl += u; }
        if (F.lane == 63) WT[F.wave] = incl;
        PRE[F.tid] = incl - v;
    }
    WG_SYNC();
    if (F.tid < 256) { int off = 0; for (int w = 0; w < F.wave; ++w) off += WT[w]; PRE[F.tid] += off; if (F.tid == 255) PRE[256] = PRE[255] + ((mycnt + 255) >> 8); }
    WG_SYNC();
    const int T = PRE[256];
    float c2, mc2; moba_shift(F, c2, mc2);
    const int i = F.lane & 31, hh = F.lane >> 5;
    const int it0 = (int)(((long long)F.vcu * T) / F.G), it1 = (int)(((long long)(F.vcu + 1) * T) / F.G);
    int cur_hj = -1;
    int hj = 0, chunk = 0, tq = 0, slot = 0; bool active = false, valid = false; bf16x8 qf[8];
#pragma unroll
    for (int s = 0; s < 8; ++s) qf[s] = (bf16x8){0, 0, 0, 0, 0, 0, 0, 0};
    if (it0 < it1) { mc_decode(PRE, it0, hj, chunk); const int n = (int)__hip_atomic_load(F.ctl + CW_CNT + hj, RLX_AGENT); mc_fetch(F, hj, chunk, n, i, hh, active, valid, tq, slot, qf); }
    for (int it = it0; it < it1; ++it) {
        const int h = hj >> 6, j = hj & 63;
        if (hj != cur_hj) { if (cur_hj >= 0) WG_SYNC(); moba_load_kv(F, h, j, KL, VL); WG_SYNC(); cur_hj = hj; }
        int hj2 = hj, chunk2 = 0, tq2 = 0, slot2 = 0; bool active2 = false, valid2 = false; bf16x8 qf2[8];
#pragma unroll
        for (int s = 0; s < 8; ++s) qf2[s] = qf[s];
        if (it + 1 < it1) { mc_decode(PRE, it + 1, hj2, chunk2); const int n2 = (int)__hip_atomic_load(F.ctl + CW_CNT + hj2, RLX_AGENT); mc_fetch(F, hj2, chunk2, n2, i, hh, active2, valid2, tq2, slot2, qf2); }
        if (active) {
            f32x16 acc[4]; float lsum = 0.f;
#pragma unroll
            for (int et = 0; et < 4; ++et)
#pragma unroll
                for (int r = 0; r < 16; ++r) acc[et][r] = 0.f;
            moba_wave_attend(qf, KL, VL, 8, -1, i, hh, F.lane, c2, mc2, acc, lsum);
            lsum += __shfl_xor(lsum, 32);
            if (valid) {
                bf16* prow = part_g + ((size_t)(slot * 4 + h) * S_ + tq) * 128;
#pragma unroll
                for (int et = 0; et < 4; ++et)
#pragma unroll
                    for (int g2 = 0; g2 < 2; ++g2) { v4u w; w.x = pkbf(acc[et][8 * g2], acc[et][8 * g2 + 1]); w.y = pkbf(acc[et][8 * g2 + 2], acc[et][8 * g2 + 3]); w.z = pkbf(acc[et][8 * g2 + 4], acc[et][8 * g2 + 5]); w.w = pkbf(acc[et][8 * g2 + 6], acc[et][8 * g2 + 7]);
                        *(v4u*)(prow + 64 * hh + 16 * et + 8 * g2) = w; }
                if (hh == 0) lpart_g[(size_t)(slot * 4 + h) * S_ + tq] = lsum;
            }
        }
        hj = hj2; chunk = chunk2; tq = tq2; slot = slot2; active = active2; valid = valid2;
#pragma unroll
        for (int s = 0; s < 8; ++s) qf[s] = qf2[s];
    }
    WG_SYNC();
}

__device__ __forceinline__ void moba_d_item(Frame& F, int item, float c2, float mc2) {
    const int blk = item >> 2, h = item & 3;
    LAS bf16* KL = (LAS bf16*)(F.lds); LAS unsigned char* VL = F.lds + 256 * KROW * 2;
    const bf16* zb = (const bf16*)(F.ws + WS_Z); const bf16* part_g = (const bf16*)((const unsigned char*)F.out + OUT_PART); const float* lpart_g = (const float*)(F.ws + WS_LPART);
    bf16* mixb = (bf16*)(F.ws + WS_MIX);
    const int i = F.lane & 31, hh = F.lane >> 5;
    const int tq = blk * 256 + F.wave * 32 + i;
    bf16x8 qf[8];
    { const bf16* qrow = zb + (size_t)tq * ZW + Z_MQ + h * 128 + 8 * hh;
#pragma unroll
      for (int s = 0; s < 8; ++s) qf[s] = *(const bf16x8*)(qrow + 16 * s); }
    moba_load_kv(F, h, blk, KL, VL);
    WG_SYNC();
    f32x16 acc[4]; float lsum = 0.f;
#pragma unroll
    for (int et = 0; et < 4; ++et)
#pragma unroll
        for (int r = 0; r < 16; ++r) acc[et][r] = 0.f;
    moba_wave_attend(qf, KL, VL, F.wave + 1, F.wave, i, hh, F.lane, c2, mc2, acc, lsum);
    lsum += __shfl_xor(lsum, 32);
    const int nsel = blk < 3 ? blk : 3;
    {
        v4u pw[3][8]; float lp[3];
#pragma unroll
        for (int s = 0; s < 3; ++s) { if (s < nsel) { const bf16* prow = part_g + ((size_t)(s * 4 + h) * S_ + tq) * 128 + 64 * hh; lp[s] = lpart_g[(size_t)(s * 4 + h) * S_ + tq];
#pragma unroll
                for (int k = 0; k < 8; ++k) pw[s][k] = *(const v4u*)(prow + 8 * k); } }
#pragma unroll
        for (int s = 0; s < 3; ++s) { if (s < nsel) { lsum += lp[s];
#pragma unroll
                for (int et = 0; et < 4; ++et)
#pragma unroll
                    for (int g2 = 0; g2 < 2; ++g2) { const v4u w = pw[s][2 * et + g2];
                        acc[et][8 * g2] += bf2f(w.x & 0xffffu); acc[et][8 * g2 + 1] += bf2f(w.x >> 16); acc[et][8 * g2 + 2] += bf2f(w.y & 0xffffu); acc[et][8 * g2 + 3] += bf2f(w.y >> 16);
                        acc[et][8 * g2 + 4] += bf2f(w.z & 0xffffu); acc[et][8 * g2 + 5] += bf2f(w.z >> 16); acc[et][8 * g2 + 6] += bf2f(w.w & 0xffffu); acc[et][8 * g2 + 7] += bf2f(w.w >> 16); } } }
    }
    const float inv = 1.0f / lsum;
    bf16* orow = mixb + (size_t)tq * D_ + 512 + h * 128;
#pragma unroll
    for (int et = 0; et < 4; ++et)
#pragma unroll
        for (int g = 0; g < 4; ++g) { u2_t w; w.x = pkbf(acc[et][4 * g] * inv, acc[et][4 * g + 1] * inv); w.y = pkbf(acc[et][4 * g + 2] * inv, acc[et][4 * g + 3] * inv); *(u2_t*)(orow + 32 * et + 8 * g + 4 * hh) = w; }
    WG_SYNC();
}

struct Args { const void* in[18]; float* out; unsigned char* ws; int ph_lo, ph_hi, li, pad; };
constexpr int N_PHASES = 10;
__global__ void __launch_bounds__(NWAVES * 64, 2) mk_fwd(Args args) {
    extern __shared__ __attribute__((aligned(16))) unsigned char lds[];
    Frame F;
    F.lds = (LAS unsigned char*)lds;
    F.MISC = (volatile LAS unsigned*)(F.lds + MISC_OFF);
    F.tid = threadIdx.x; F.lane = F.tid & 63; F.wave = __builtin_amdgcn_readfirstlane(F.tid >> 6);
    F.G = gridDim.x; { const int bx = blockIdx.x; F.vcu = (F.G % 8 == 0) ? (bx % 8) * (F.G / 8) + bx / 8 : bx; }
    F.ws = args.ws; F.out = args.out; F.ctl = (gu32*)(args.ws + WS_CTL);
    if (F.tid < 32) F.MISC[F.tid] = 0u;
    if (F.tid == 0) {
#pragma unroll
        for (int k = 0; k < 18; ++k) { const unsigned long long pv = (unsigned long long)args.in[k]; F.MISC[32 + 2 * k] = (unsigned)pv; F.MISC[33 + 2 * k] = (unsigned)(pv >> 32); }
    }
    __syncthreads();
    XcdBarrier bar = xcd_barrier_post((unsigned*)(F.ctl + CW_BAR) + args.li * XCD_BAR_WORDS, F.MISC + 8);
    const int lo = args.ph_lo, hi = args.ph_hi;
#define IN(k) (lo <= (k) && (k) < hi)
#define SEAM(k) do { if (IN(k) && IN((k) + 1)) xcd_barrier(bar); STAMP((k) + 1); } while (0)
    bf16* xb = (bf16*)(F.ws + WS_AB); bf16* zb = (bf16*)(F.ws + WS_Z); bf16* mixb = (bf16*)(F.ws + WS_MIX); bf16* actb = (bf16*)(F.ws + WS_ACT); bf16* erawb = (bf16*)(F.ws + WS_ERAW);

    STAMP(0);
    if (IN(0)) { p0_prologue(F); } SEAM(0);
    if (IN(1)) {
        { pg8::Gemm g{xb, (const bf16*)(F.ws + WS_WIN), S_, ZW, D_}; pg8::StaticOrder S; S.init(S_, ZW, F.G, (int)blockIdx.x);
          pg8::EpiScale<0, 1> E{zb, ZW, (const float*)(F.ws + WS_RSTDX), EPS_};
          pg8::gemm_phase<pg8::EpiScale<0, 1>, pg8::StaticOrder, PG8_ALIGN, PG8_SP2>(F.lds + RING_OFF, g, S, E); }
        { pg8::Gemm g{(const bf16*)(F.ws + WS_PB), (const bf16*)(F.ws + WS_WPP), S_, D_, PLE_}; pg8::StaticOrder S; S.init(S_, D_, F.G, (int)blockIdx.x);
          pg8::EpiRes<0> E{nullptr, erawb, (float*)(F.ws + WS_SSQE), D_};
          pg8::gemm_phase<pg8::EpiRes<0>, pg8::StaticOrder, false, PG8_SP2>(F.lds + RING_OFF, g, S, E); }
    } SEAM(1);
    if (IN(2)) { for (int ch = F.vcu; ch < 256; ch += F.G) gla_a_chunk(F, ch); for (int ch = F.vcu; ch < 256; ch += F.G) moba_a_item(F, ch); } SEAM(2);
    if (IN(3)) { for (int pr = F.vcu; pr < 256; pr += F.G) gla_b_pair(F, pr); for (int pr = F.vcu; pr < 256; pr += F.G) moba_b_item(F, pr); } SEAM(3);
    if (IN(4)) { for (int ch = F.vcu; ch < 256; ch += F.G) gla_c_chunk(F, ch); moba_c_phase(F); } SEAM(4);
    if (IN(5)) { float c2, mc2; moba_shift(F, c2, mc2); for (int it = F.vcu; it < 256; it += F.G) moba_d_item(F, it, c2, mc2); } SEAM(5);
    if (IN(6)) {
        pg8::Gemm g{mixb, (const bf16*)(F.ws + WS_WOUT), S_, D_, D_}; pg8::StaticOrder S; S.init(S_, D_, F.G, (int)blockIdx.x);
        pg8::EpiRes<2> E{nullptr, xb, (float*)(F.ws + WS_SSQH1), D_};
        pg8::gemm_phase<pg8::EpiRes<2>, pg8::StaticOrder, false, PG8_SP2>(F.lds + RING_OFF, g, S, E);
    } SEAM(6);
    if (IN(7)) {
        pg8::Gemm g{xb, (const bf16*)(F.ws + WS_WUP), S_, FF_, D_}; pg8::StaticOrder S; S.init(S_, FF_, F.G, (int)blockIdx.x);
        pg8::EpiScale<1, 2> E{actb, FF_, (const float*)(F.ws + WS_SSQH1), EPS_};
        pg8::gemm_phase<pg8::EpiScale<1, 2>, pg8::StaticOrder, PG8_ALIGN, PG8_SP2>(F.lds + RING_OFF, g, S, E);
    } SEAM(7);
    if (IN(8)) {
        pg8::Gemm g{actb, (const bf16*)(F.ws + WS_WDOWN), S_, D_, FF_}; pg8::StaticOrder S; S.init(S_, D_, F.G, (int)blockIdx.x);
        pg8::EpiRes<2> E{nullptr, xb, (float*)(F.ws + WS_SSQH2), D_};
        pg8::gemm_phase<pg8::EpiRes<2>, pg8::StaticOrder, false, PG8_SP2>(F.lds + RING_OFF, g, S, E);
    } SEAM(8);
    if (IN(9)) {
        pg8::Gemm g{xb, (const bf16*)(F.ws + WS_WPG), S_, D_, D_}; pg8::StaticOrder S; S.init(S_, D_, F.G, (int)blockIdx.x);
        pg8::EpiGate E{F.out, xb, erawb, (const float*)(F.ws + WS_SSQH2), (const float*)(F.ws + WS_SSQE), IN_g_pe, D_, EPS_};
        pg8::gemm_phase<pg8::EpiGate, pg8::StaticOrder, false, PG8_SP2>(F.lds + RING_OFF, g, S, E);
    }
#ifdef PROBE_LO
    STAMP(10);
    if (blockIdx.x == 0 && F.tid == 0) {
        const unsigned long long a_ = ((unsigned long long)F.MISC[81 + 2 * PROBE_LO] << 32) | F.MISC[80 + 2 * PROBE_LO], b_ = ((unsigned long long)F.MISC[81 + 2 * PROBE_HI] << 32) | F.MISC[80 + 2 * PROBE_HI];
        const unsigned long long d_ = (b_ - a_) * PROBE_K, t0_ = rt();
        while (rt() - t0_ < d_) __builtin_amdgcn_s_sleep(8);
    }
#endif
#undef IN
#undef SEAM
}

static void launch_range(const Args& a0, int lo, int hi, int li, int grid, hipStream_t stream) {
    Args a = a0; a.ph_lo = lo; a.ph_hi = hi; a.li = li;
    hipLaunchKernelGGL(mk_fwd, dim3(grid), dim3(NWAVES * 64), LDS_BYTES, stream, a);
    const hipError_t le = hipPeekAtLastError();
    if (le != hipSuccess) fprintf(stderr, "kernel_launch: launch [%d,%d) failed: %s\n", lo, hi, hipGetErrorName(le));
}
extern "C" void kernel_launch(void* const* d_in, const int* in_sizes, int n_in, void* d_out, int out_size, void* d_ws, size_t ws_size, hipStream_t stream) {
    static int grid = 0;
    if (grid == 0) {
        if (n_in != 18 || out_size != S_ * D_ || ws_size < WS_END) { fprintf(stderr, "kernel_launch: unexpected shapes (n_in %d out %d ws %zu)\n", n_in, out_size, ws_size); grid = -1; return; }
        int dev = 0, cus = 0, per_cu = 0;
        if (hipGetDevice(&dev) != hipSuccess || hipDeviceGetAttribute(&cus, hipDeviceAttributeMultiprocessorCount, dev) != hipSuccess) { grid = -1; return; }
        if (hipFuncSetAttribute((const void*)mk_fwd, hipFuncAttributeMaxDynamicSharedMemorySize, LDS_BYTES) != hipSuccess) { fprintf(stderr, "kernel_launch: hipFuncSetAttribute failed\n"); grid = -1; return; }
        if (hipOccupancyMaxActiveBlocksPerMultiprocessor(&per_cu, (const void*)mk_fwd, NWAVES * 64, LDS_BYTES) != hipSuccess || per_cu < 1) { fprintf(stderr, "kernel_launch: occupancy query says %d\n", per_cu); per_cu = 1; }
        (void)hipGetLastError();
        grid = cus;
        if (grid != 256) fprintf(stderr, "kernel_launch: note: %d CUs\n", grid);
    }
    if (grid < 0) return;
    (void)hipMemsetAsync((char*)d_ws + WS_CTL, 0, CTL_ZERO_BYTES, stream);
    Args a{};
    for (int i = 0; i < 18; ++i) a.in[i] = d_in[i];
    a.out = (float*)d_out; a.ws = (unsigned char*)d_ws;
    launch_range(a, 0, N_PHASES, 0, grid, stream);
}
```

```cpp
#include <hip/hip_runtime.h>
#include <cstdio>
#include <cstdint>
#include <math.h>
namespace pg8 {
#define PG8_LAS __attribute__((address_space(3)))
typedef unsigned short bf16_t;
typedef short bf16x8 __attribute__((ext_vector_type(8)));
typedef float f32x4 __attribute__((ext_vector_type(4)));
typedef unsigned u32x4 __attribute__((ext_vector_type(4)));
constexpr int BM = 256, BK = 64, HALF = 128, HTB = HALF * BK * 2  , STAGE_BYTES = 8 * HTB, NXCD = 8, WGM = 8;

__host__ __device__ __forceinline__ int lds_byte(int r, int c) { const int st = (r >> 4) * 2 + (c >> 5), rr = r & 15, cc = c & 31, ob = rr * 64 + cc * 2; return st * 1024 + (ob ^ (((ob >> 9) & 1) << 5)); }
__host__ __device__ __forceinline__ void stage_rc(int b, int& R, int& C) { const int st = b / 1024, sb = b % 1024, swz = sb ^ (((sb >> 9) & 1) << 5); R = (st >> 1) * 16 + swz / 64; C = (st & 1) * 32 + (swz % 64) / 2; }
__host__ __device__ __forceinline__ int perm32(int rho) { const int n = rho >> 4, i = rho & 15; return 8 * (i >> 2) + 4 * n + (i & 3); }

struct Unit { int pm, pn; };
struct Gemm { const bf16_t* A; const bf16_t* Bt; int M, N, K; };

struct StaticOrder {
    int nM, nN, nwg, G, c;
    __host__ __device__ void init(int M, int N, int G_, int c_) { nM = M / BM; nN = N / BM; nwg = nM * nN; G = G_; c = c_; }
    __host__ __device__ bool next(int i, Unit& u) const {
        const long L = (long)i * G + c; if (L >= nwg) return false;
        int wgid = (int)L; { const int q = nwg / NXCD, r = nwg % NXCD, xcd = wgid % NXCD, off = wgid / NXCD; wgid = (xcd < r ? xcd * (q + 1) : r * (q + 1) + (xcd - r) * q) + off; }
        const int nig = WGM * nN, gid = wgid / nig, fm = gid * WGM, gsz = (nM - fm) < WGM ? (nM - fm) : WGM;
        u.pm = fm + ((wgid % nig) % gsz); u.pn = (wgid % nig) / gsz; return true;
    }
    __device__ __forceinline__ void a_ready(const Unit&) const {}
    __device__ __forceinline__ void done(const Unit&) const {}
};

__device__ __forceinline__ unsigned cvt_pk_bf16(float lo, float hi) { unsigned r; asm volatile("v_cvt_pk_bf16_f32 %0, %1, %2" : "=v"(r) : "v"(lo), "v"(hi)); return r; }
typedef float f32x2 __attribute__((ext_vector_type(2)));

__device__ __forceinline__ void st16_wt(void* p, u32x4 v) { asm volatile("global_store_dwordx4 %0, %1, off sc1\n\ts_nop 1" :: "v"(p), "v"(v) : "memory"); }

__device__ __forceinline__ float rstd_from_part(const float* part, int row, float inv_n, float eps) {
    const f32x4 p = *(const f32x4*)(part + (size_t)row * 4);
    return __builtin_amdgcn_rsqf(((p[0] + p[1]) + (p[2] + p[3])) * inv_n + eps);
}
template <int ACT, int RS> struct EpiScale {
    static constexpr bool PERM = true, AFTER_DRAIN = false;
    bf16_t* O; int ldc; const float* rsv; float eps;
    __device__ __forceinline__ void operator()(const f32x4 (&acc)[2][2][4][2], const Unit& u, int wr, int wc, int fr, int fq) const {
        const int row0 = u.pm * BM + wr * 64 + fr, col0 = u.pn * BM + wc * 32 + 8 * fq;
#pragma unroll
        for (int ai = 0; ai < 2; ++ai)
#pragma unroll
            for (int m = 0; m < 4; ++m) {
                const int row = row0 + ai * HALF + m * 16;
                float s = 1.f;
                if (RS == 1) s = rsv[row];
                if (RS == 2) s = rstd_from_part(rsv, row, 1.0f / 1024.0f, eps);
                bf16_t* rowp = O + (size_t)row * ldc + col0;
#pragma unroll
                for (int bj = 0; bj < 2; ++bj) {
                    f32x4 v0 = acc[ai][bj][m][0] * s, v1 = acc[ai][bj][m][1] * s;
                    if (ACT == 1) {
#pragma unroll
                        for (int e = 0; e < 4; ++e) { const float a = fmaxf(v0[e], 0.f), b = fmaxf(v1[e], 0.f); v0[e] = a * a; v1[e] = b * b; }
                    }
                    u32x4 w; w.x = cvt_pk_bf16(v0[0], v0[1]); w.y = cvt_pk_bf16(v0[2], v0[3]); w.z = cvt_pk_bf16(v1[0], v1[1]); w.w = cvt_pk_bf16(v1[2], v1[3]);
                    *(u32x4*)(rowp + bj * HALF) = w;
                }
            }
    }
};
template <int RES> struct EpiRes {
    static constexpr bool PERM = true, AFTER_DRAIN = true;
    const float* base; bf16_t* hb; float* part; int ldc; const float* rsc; const float* accpart; float eps;
    __device__ __forceinline__ void fused(f32x4 (&acc)[2][2][4][2], const Unit& u, int wr, int wc, int fr, int fq, PG8_LAS unsigned char* lds, int wid, int lane) const {
        PG8_LAS float* P = (PG8_LAS float*)lds;
        const int row0 = u.pm * BM + wr * 64 + fr, col0 = u.pn * BM + wc * 32 + 8 * fq;
#pragma unroll
        for (int ai = 0; ai < 2; ++ai) {
            f32x4 pre[4][2][2]; u32x4 preb[4][2];
            if (RES == 1) {
#pragma unroll
                for (int m = 0; m < 4; ++m) { const size_t off = (size_t)(row0 + ai * HALF + m * 16) * ldc + col0;
#pragma unroll
                    for (int bj = 0; bj < 2; ++bj) { pre[m][bj][0] = __builtin_nontemporal_load((const f32x4*)(base + off + bj * HALF)); pre[m][bj][1] = __builtin_nontemporal_load((const f32x4*)(base + off + bj * HALF + 4)); } }
            }
            if (RES == 2) {
#pragma unroll
                for (int m = 0; m < 4; ++m) { const size_t off = (size_t)(row0 + ai * HALF + m * 16) * ldc + col0;
#pragma unroll
                    for (int bj = 0; bj < 2; ++bj) preb[m][bj] = *(const u32x4*)(hb + off + bj * HALF); }
            }
            float rsv4[4], asv4[4];
#pragma unroll
            for (int m = 0; m < 4; ++m) { const int row = row0 + ai * HALF + m * 16; rsv4[m] = rsc ? rsc[row] : 1.f;
                float a2 = 1.f; if (accpart) { const f32x4 p = *(const f32x4*)(accpart + (size_t)row * 4); a2 = __builtin_amdgcn_rcpf(((p[0] + p[1]) + (p[2] + p[3])) * (1.0f / 1024.0f) + eps); } asv4[m] = a2; }
#pragma unroll
            for (int m = 0; m < 4; ++m) {
                const int row = row0 + ai * HALF + m * 16;
                const size_t off = (size_t)row * ldc + col0;
                float q = 0.f;
                const float rs = rsv4[m], as2 = asv4[m];
#pragma unroll
                for (int bj = 0; bj < 2; ++bj) {
                    f32x4 v0 = acc[ai][bj][m][0] * as2, v1 = acc[ai][bj][m][1] * as2;
                    if (RES == 1) { v0 = v0 + pre[m][bj][0]; v1 = v1 + pre[m][bj][1]; }
                    if (RES == 2) { const u32x4 ew = preb[m][bj];
                        v0[0] += rs * __uint_as_float(ew.x << 16); v0[1] += rs * __uint_as_float(ew.x & 0xffff0000u); v0[2] += rs * __uint_as_float(ew.y << 16); v0[3] += rs * __uint_as_float(ew.y & 0xffff0000u);
                        v1[0] += rs * __uint_as_float(ew.z << 16); v1[1] += rs * __uint_as_float(ew.z & 0xffff0000u); v1[2] += rs * __uint_as_float(ew.w << 16); v1[3] += rs * __uint_as_float(ew.w & 0xffff0000u); }
                    u32x4 w; w.x = cvt_pk_bf16(v0[0], v0[1]); w.y = cvt_pk_bf16(v0[2], v0[3]); w.z = cvt_pk_bf16(v1[0], v1[1]); w.w = cvt_pk_bf16(v1[2], v1[3]);
                    *(u32x4*)(hb + off + bj * HALF) = w;
                    q += (v0[0] * v0[0] + v0[1] * v0[1]) + (v0[2] * v0[2] + v0[3] * v0[3]) + (v1[0] * v1[0] + v1[1] * v1[1]) + (v1[2] * v1[2] + v1[3] * v1[3]);
                }
                q += __shfl_xor(q, 16); q += __shfl_xor(q, 32);
                if (fq == 0) P[(ai * HALF + wr * 64 + m * 16 + fr) * 4 + wc] = q;
            }
        }
        asm volatile("s_waitcnt lgkmcnt(0)" ::: "memory"); __builtin_amdgcn_s_barrier(); asm volatile("" ::: "memory");
        const int tid = wid * 64 + lane;
        if (tid < 256) { const f32x4 p = ((const PG8_LAS f32x4*)lds)[tid]; part[(size_t)(u.pm * BM + tid) * 4 + u.pn] = (p[0] + p[1]) + (p[2] + p[3]); }
        asm volatile("s_waitcnt lgkmcnt(0)" ::: "memory"); __builtin_amdgcn_s_barrier(); asm volatile("" ::: "memory");
    }
};
__device__ __forceinline__ void sincos_rope(float a, float& s, float& c) {
    const float k = __builtin_rintf(a * 0.15915494309189535f);
    float r = __builtin_fmaf(-k, 6.28125f, a);
    r = __builtin_fmaf(-k, 0.0019353071693331003f, r);
    r = __builtin_fmaf(-k, 1.0253131677018246e-11f, r);
    const float rev = r * 0.15915494309189535f;
    s = __builtin_amdgcn_sinf(rev); c = __builtin_amdgcn_cosf(rev);
}
template <int CTRL> __device__ __forceinline__ float dpp_mov_pg(float v) { return __builtin_bit_cast(float, __builtin_amdgcn_update_dpp(0, __builtin_bit_cast(int, v), CTRL, 0xf, 0xf, true)); }
__device__ __forceinline__ float row16_sum_pg(float v) { v += dpp_mov_pg<0xB1>(v); v += dpp_mov_pg<0x4E>(v); v += dpp_mov_pg<0x141>(v); v += dpp_mov_pg<0x140>(v); return v; }
struct EpiZ {
    static constexpr bool PERM = true, AFTER_DRAIN = false;
    bf16_t* O; int ldc; size_t hm_base, hm_head; const float* rstdx; const int* pos; const float* gq; const float* gk; PG8_LAS unsigned char* xr; float eps; float inv0, inv1, inv2, inv3;
    __device__ __forceinline__ void operator()(const f32x4 (&acc)[2][2][4][2], const Unit& u, int wr, int wc, int fr, int fq) const {
        const int row0 = u.pm * BM + wr * 64 + fr, col0 = u.pn * BM + wc * 32 + 8 * fq;
        const int type = (u.pn >= 6 && u.pn < 8) ? 1 : ((u.pn >= 8 && u.pn < 10) ? 2 : 0);
        const size_t hm0 = hm_base + (size_t)((u.pn >= 6 ? ((u.pn - 6) >> 1) * 4 + 2 * (u.pn & 1) : 0)) * hm_head; const size_t bjstep = (u.pn < 6) ? (size_t)HALF : hm_head;
        if (type == 0) {
#pragma unroll
            for (int ai = 0; ai < 2; ++ai)
#pragma unroll
                for (int m = 0; m < 4; ++m) {
                    const int row = row0 + ai * HALF + m * 16; const float s = 1.f;
                    bf16_t* rowp = (u.pn < 6) ? O + (size_t)row * ldc + col0 : O + hm0 + (size_t)row * 128 + wc * 32 + 8 * fq;
#pragma unroll
                    for (int bj = 0; bj < 2; ++bj) { const f32x4 v0 = acc[ai][bj][m][0] * s, v1 = acc[ai][bj][m][1] * s;
                        u32x4 w; w.x = cvt_pk_bf16(v0[0], v0[1]); w.y = cvt_pk_bf16(v0[2], v0[3]); w.z = cvt_pk_bf16(v1[0], v1[1]); w.w = cvt_pk_bf16(v1[2], v1[3]);
                        *(u32x4*)(rowp + (size_t)bj * bjstep) = w; }
                }
            return;
        }
        PG8_LAS float* P = (PG8_LAS float*)xr;
        const float* g = type == 1 ? gq : gk;
        const int m8 = 4 * wc + fq;
        const f32x4 g1 = *(const f32x4*)(g + 4 * m8), g2 = *(const f32x4*)(g + 64 + 4 * m8);
        float rsx[8], pfx[8];
#pragma unroll
        for (int ai = 0; ai < 2; ++ai)
#pragma unroll
            for (int m = 0; m < 4; ++m) { const int row = u.pm * BM + ai * HALF + wr * 64 + m * 16 + fr; rsx[ai * 4 + m] = 1.f; pfx[ai * 4 + m] = (float)pos[row]; }
#pragma unroll
        for (int ai = 0; ai < 2; ++ai)
#pragma unroll
            for (int m = 0; m < 4; ++m) {
                const int rl = ai * HALF + wr * 64 + m * 16 + fr; const float s = rsx[ai * 4 + m];
#pragma unroll
                for (int bj = 0; bj < 2; ++bj) { const f32x4 v0 = acc[ai][bj][m][0] * s, v1 = acc[ai][bj][m][1] * s;
                    float q = (v0[0] * v0[0] + v0[1] * v0[1]) + (v0[2] * v0[2] + v0[3] * v0[3]) + (v1[0] * v1[0] + v1[1] * v1[1]) + (v1[2] * v1[2] + v1[3] * v1[3]);
                    q += __shfl_xor(q, 16); q += __shfl_xor(q, 32);
                    if (fq == 0) P[(rl * 2 + bj) * 4 + wc] = q; }
            }
        asm volatile("s_waitcnt lgkmcnt(0)" ::: "memory"); __builtin_amdgcn_s_barrier(); asm volatile("" ::: "memory");
#pragma unroll
        for (int ai = 0; ai < 2; ++ai)
#pragma unroll
            for (int m = 0; m < 4; ++m) {
                const int rl = ai * HALF + wr * 64 + m * 16 + fr, row = u.pm * BM + rl; const float s = rsx[ai * 4 + m]; const float pf = pfx[ai * 4 + m];
                f32x4 sn, cs;
                { float a, b; sincos_rope(pf * inv0, a, b); sn[0] = a; cs[0] = b; sincos_rope(pf * inv1, a, b); sn[1] = a; cs[1] = b; sincos_rope(pf * inv2, a, b); sn[2] = a; cs[2] = b; sincos_rope(pf * inv3, a, b); sn[3] = a; cs[3] = b; }
                bf16_t* rowp = O + hm0 + (size_t)row * 128 + wc * 32 + 8 * fq;
#pragma unroll
                for (int bj = 0; bj < 2; ++bj) {
                    const f32x4 pr = *(const PG8_LAS f32x4*)(P + (rl * 2 + bj) * 4);
                    const float sc = s * __builtin_amdgcn_rsqf(((pr[0] + pr[1]) + (pr[2] + pr[3])) * (1.0f / 128.0f) + eps);
                    const f32x4 y1 = acc[ai][bj][m][0] * sc * g1, y2 = acc[ai][bj][m][1] * sc * g2;
                    const f32x4 o1 = y1 * cs - y2 * sn, o2 = y2 * cs + y1 * sn;
                    u32x4 w; w.x = cvt_pk_bf16(o1[0], o1[1]); w.y = cvt_pk_bf16(o1[2], o1[3]); w.z = cvt_pk_bf16(o2[0], o2[1]); w.w = cvt_pk_bf16(o2[2], o2[3]);
                    *(u32x4*)(rowp + (size_t)bj * hm_head) = w;
                }
            }
    }
};
struct EpiGate {
    static constexpr bool PERM = true, AFTER_DRAIN = false;
    float* out; const bf16_t* hb; const bf16_t* eraw; const float* part_h; const float* part_e; const float* g_emb; int ldc; float eps;
    __device__ __forceinline__ void operator()(const f32x4 (&acc)[2][2][4][2], const Unit& u, int wr, int wc, int fr, int fq) const {
        const int row0 = u.pm * BM + wr * 64 + fr, col0 = u.pn * BM + wc * 32 + 8 * fq;
        f32x4 gv[2][2];
#pragma unroll
        for (int bj = 0; bj < 2; ++bj) { gv[bj][0] = *(const f32x4*)(g_emb + col0 + bj * HALF); gv[bj][1] = *(const f32x4*)(g_emb + col0 + bj * HALF + 4); }
#pragma unroll
        for (int ai = 0; ai < 2; ++ai)
#pragma unroll
            for (int mp = 0; mp < 2; ++mp) {
                u32x4 hv[2][2]; u32x4 ewv[2][2]; float sh[2], se[2];
#pragma unroll
                for (int mm = 0; mm < 2; ++mm) { const int row = row0 + ai * HALF + (2 * mp + mm) * 16; const size_t off = (size_t)row * ldc + col0;
                    sh[mm] = rstd_from_part(part_h, row, 1.0f / 1024.0f, eps); se[mm] = rstd_from_part(part_e, row, 1.0f / 1024.0f, eps);
#pragma unroll
                    for (int bj = 0; bj < 2; ++bj) { ewv[mm][bj] = __builtin_nontemporal_load((const u32x4*)(eraw + off + bj * HALF)); hv[mm][bj] = __builtin_nontemporal_load((const u32x4*)(hb + off + bj * HALF)); } }
#pragma unroll
                for (int mm = 0; mm < 2; ++mm) { const int m = 2 * mp + mm; const int row = row0 + ai * HALF + m * 16; const size_t off = (size_t)row * ldc + col0;
#pragma unroll
                    for (int bj = 0; bj < 2; ++bj) {
                        const u32x4 ew = ewv[mm][bj];
                        f32x4 e0, e1;
                        e0[0] = __uint_as_float(ew.x << 16); e0[1] = __uint_as_float(ew.x & 0xffff0000u); e0[2] = __uint_as_float(ew.y << 16); e0[3] = __uint_as_float(ew.y & 0xffff0000u);
                        e1[0] = __uint_as_float(ew.z << 16); e1[1] = __uint_as_float(ew.z & 0xffff0000u); e1[2] = __uint_as_float(ew.w << 16); e1[3] = __uint_as_float(ew.w & 0xffff0000u);
                        const u32x4 hw = hv[mm][bj];
                        f32x4 h0, h1;
                        h0[0] = __uint_as_float(hw.x << 16); h0[1] = __uint_as_float(hw.x & 0xffff0000u); h0[2] = __uint_as_float(hw.y << 16); h0[3] = __uint_as_float(hw.y & 0xffff0000u);
                        h1[0] = __uint_as_float(hw.z << 16); h1[1] = __uint_as_float(hw.z & 0xffff0000u); h1[2] = __uint_as_float(hw.w << 16); h1[3] = __uint_as_float(hw.w & 0xffff0000u);
                        const f32x4 a0 = acc[ai][bj][m][0] * sh[mm], a1 = acc[ai][bj][m][1] * sh[mm];
#pragma unroll
                        for (int e = 0; e < 4; ++e) {
                            const float g0 = __builtin_amdgcn_rcpf(1.0f + __expf(-a0[e])), g1 = __builtin_amdgcn_rcpf(1.0f + __expf(-a1[e]));
                            h0[e] += g0 * (e0[e] * se[mm] * gv[bj][0][e]); h1[e] += g1 * (e1[e] * se[mm] * gv[bj][1][e]);
                        }
                        __builtin_nontemporal_store(h0, (f32x4*)(out + off + bj * HALF)); __builtin_nontemporal_store(h1, (f32x4*)(out + off + bj * HALF + 4));
                    } }
            }
    }
};
template <class Epi, class Sched, bool ALIGN_EPI = false, bool SP2 = false>
__device__ __forceinline__ void gemm_phase(PG8_LAS unsigned char* lds, const Gemm g, const Sched& S, const Epi& E) {
    const int tid = threadIdx.x, wid = __builtin_amdgcn_readfirstlane(tid >> 6), lane = tid & 63, wr = wid >> 2, wc = wid & 3, fr = lane & 15, fq = lane >> 4;
    const int K = g.K, nt = K / BK;
    unsigned voffA[2], voffB[2];
#pragma unroll
    for (int i = 0; i < 2; ++i) { int R, C; stage_rc(tid * 16 + i * 8192, R, C); const int Rb = Epi::PERM ? ((R & ~31) + perm32(R & 31)) : R;
        voffA[i] = (unsigned)(R * K + C) * 2u; voffB[i] = (unsigned)(Rb * K + C) * 2u; }
    const size_t kstep = (size_t)(BK * 2);
    const size_t hstep = (size_t)HALF * K * 2;
    const size_t tstep = 2 * hstep;
    const unsigned ldsw = (unsigned)wid * 1024u;
    const int aoff = lds_byte(wr * 64 + fr, fq * 8), boff = lds_byte(wc * 32 + fr, fq * 8);
#define PG8_SA(b, h) (((b) * 2 + (h)) * HTB)
#define PG8_SB(b, h) ((4 + (b) * 2 + (h)) * HTB)
#define PG8_STAGE(bufoff, gbase, voff) do { _Pragma("unroll") for (int _i = 0; _i < 2; ++_i) \
        __builtin_amdgcn_global_load_lds((const unsigned*)((const char*)(gbase) + (voff)[_i]), (PG8_LAS unsigned*)(lds + (bufoff) + ldsw + _i * 8192), 16, 0, 0); } while (0)
#define PG8_LDA(dst, b, h) do { _Pragma("unroll") for (int m = 0; m < 4; ++m) _Pragma("unroll") for (int k = 0; k < 2; ++k) dst[m][k] = *(const PG8_LAS bf16x8*)(lds + PG8_SA(b, h) + aoff + m * 2048 + k * 1024); } while (0)
#define PG8_LDB(dst, b, h) do { _Pragma("unroll") for (int n = 0; n < 2; ++n) _Pragma("unroll") for (int k = 0; k < 2; ++k) dst[n][k] = *(const PG8_LAS bf16x8*)(lds + PG8_SB(b, h) + boff + n * 2048 + k * 1024); } while (0)
#define PG8_MMA(ai, bj, At, Bt) do { __builtin_amdgcn_s_setprio(1); _Pragma("unroll") for (int m = 0; m < 4; ++m) _Pragma("unroll") for (int n = 0; n < 2; ++n) _Pragma("unroll") for (int k = 0; k < 2; ++k) \
        acc[ai][bj][m][n] = __builtin_amdgcn_mfma_f32_16x16x32_bf16(Bt[n][k], At[m][k], acc[ai][bj][m][n], 0, 0, 0); __builtin_amdgcn_s_setprio(0); } while (0)
#define PG8_WAIT_V(n) asm volatile("s_waitcnt vmcnt(" #n ")" ::: "memory")
#define PG8_WAIT_L(n) asm volatile("s_waitcnt lgkmcnt(" #n ")" ::: "memory")
#define PG8_BAR __builtin_amdgcn_s_barrier()
#define PG8_SCHED __builtin_amdgcn_sched_barrier(0)
    Unit cur, nxt; int ui = 0;
    if (!S.next(0, cur)) return;
    f32x4 acc[2][2][4][2];
#pragma unroll
    for (int a = 0; a < 2; ++a)
#pragma unroll
        for (int b = 0; b < 2; ++b)
#pragma unroll
            for (int m = 0; m < 4; ++m)
#pragma unroll
                for (int n = 0; n < 2; ++n) acc[a][b][m][n] = (f32x4){0.f, 0.f, 0.f, 0.f};
    bf16x8 At[4][2], B0[2][2], B1[2][2];
    const char* cA = (const char*)g.A + (size_t)cur.pm * tstep; const char* cB = (const char*)g.Bt + (size_t)cur.pn * tstep;
    S.a_ready(cur);
    if constexpr (SP2) {
        PG8_STAGE(PG8_SB(0, 0), cB, voffB); PG8_STAGE(PG8_SB(0, 1), cB + hstep, voffB); PG8_STAGE(PG8_SA(0, 0), cA, voffA); PG8_STAGE(PG8_SA(0, 1), cA + hstep, voffA);
        if (wr == 1) PG8_BAR;
        PG8_WAIT_V(2); PG8_BAR;
        PG8_STAGE(PG8_SB(1, 0), cB + kstep, voffB); PG8_STAGE(PG8_SA(1, 0), cA + kstep, voffA); PG8_STAGE(PG8_SB(1, 1), cB + hstep + kstep, voffB);
        PG8_WAIT_V(6); PG8_BAR;
    } else {
        PG8_STAGE(PG8_SB(0, 0), cB, voffB); PG8_STAGE(PG8_SA(0, 0), cA, voffA); PG8_STAGE(PG8_SB(0, 1), cB + hstep, voffB); PG8_STAGE(PG8_SA(0, 1), cA + hstep, voffA);
        if (wr == 1) PG8_BAR;
        PG8_WAIT_V(4); PG8_BAR;
        PG8_STAGE(PG8_SB(1, 0), cB + kstep, voffB); PG8_STAGE(PG8_SA(1, 0), cA + kstep, voffA); PG8_STAGE(PG8_SB(1, 1), cB + hstep + kstep, voffB);
        PG8_WAIT_V(6); PG8_BAR;
    }
    for (;;) {
        const bool has_next = S.next(ui + 1, nxt);
        const char* nA = has_next ? (const char*)g.A + (size_t)nxt.pm * tstep : cA; const char* nB = has_next ? (const char*)g.Bt + (size_t)nxt.pn * tstep : cB;
        for (int t = 0; t < nt; t += 2) {
            const bool last = (t == nt - 2);
            const char* a1 = cA + (size_t)(t + 1) * kstep;
            const char* a2 = last ? nA : cA + (size_t)(t + 2) * kstep; const char* b2 = last ? nB : cB + (size_t)(t + 2) * kstep;
            const char* a3 = a2 + kstep; const char* b3 = b2 + kstep;
            if (last && has_next) S.a_ready(nxt);
            if constexpr (SP2) {
            PG8_LDB(B0, 0, 0); PG8_LDB(B1, 0, 1); PG8_SCHED; PG8_LDA(At, 0, 0); PG8_STAGE(PG8_SA(1, 1), a1 + hstep, voffA);
            PG8_WAIT_V(8); PG8_WAIT_L(0); PG8_BAR; PG8_MMA(0, 0, At, B0); PG8_MMA(0, 1, At, B1); PG8_BAR; PG8_SCHED;
            PG8_LDA(At, 0, 1); PG8_STAGE(PG8_SB(0, 0), b2, voffB); PG8_STAGE(PG8_SB(0, 1), b2 + hstep, voffB); PG8_STAGE(PG8_SA(0, 0), a2, voffA);
            PG8_WAIT_V(8); PG8_WAIT_L(0); PG8_BAR; PG8_MMA(1, 0, At, B0); PG8_MMA(1, 1, At, B1); PG8_BAR; PG8_SCHED;
            PG8_LDB(B0, 1, 0); PG8_LDB(B1, 1, 1); PG8_SCHED; PG8_LDA(At, 1, 0); PG8_STAGE(PG8_SA(0, 1), a2 + hstep, voffA);
            PG8_WAIT_V(8); PG8_WAIT_L(0); PG8_BAR; PG8_MMA(0, 0, At, B0); PG8_MMA(0, 1, At, B1); PG8_BAR; PG8_SCHED;
            PG8_LDA(At, 1, 1); PG8_STAGE(PG8_SB(1, 0), b3, voffB); PG8_STAGE(PG8_SB(1, 1), b3 + hstep, voffB); PG8_STAGE(PG8_SA(1, 0), a3, voffA);
            PG8_WAIT_V(8); PG8_WAIT_L(0); PG8_BAR; PG8_MMA(1, 0, At, B0); PG8_MMA(1, 1, At, B1); PG8_BAR; PG8_SCHED;
            } else {
            PG8_LDB(B0, 0, 0); PG8_SCHED; PG8_LDA(At, 0, 0); PG8_STAGE(PG8_SA(1, 1), a1 + hstep, voffA);
            PG8_WAIT_L(8); PG8_BAR; PG8_WAIT_L(0); PG8_MMA(0, 0, At, B0); PG8_BAR; PG8_SCHED;
            PG8_LDB(B1, 0, 1); PG8_STAGE(PG8_SB(0, 0), b2, voffB);
            PG8_BAR; PG8_WAIT_L(0); PG8_MMA(0, 1, At, B1); PG8_BAR;
            PG8_LDA(At, 0, 1); PG8_STAGE(PG8_SA(0, 0), a2, voffA);
            PG8_BAR; PG8_WAIT_L(0); PG8_MMA(1, 0, At, B0); PG8_BAR; PG8_SCHED;
            PG8_STAGE(PG8_SB(0, 1), b2 + hstep, voffB);
            PG8_WAIT_V(6); PG8_BAR; PG8_MMA(1, 1, At, B1); PG8_BAR;
            PG8_LDB(B0, 1, 0); PG8_SCHED; PG8_LDA(At, 1, 0); PG8_STAGE(PG8_SA(0, 1), a2 + hstep, voffA);
            PG8_WAIT_L(8); PG8_BAR; PG8_WAIT_L(0); PG8_MMA(0, 0, At, B0); PG8_BAR; PG8_SCHED;
            PG8_LDB(B1, 1, 1); PG8_STAGE(PG8_SB(1, 0), b3, voffB);
            PG8_BAR; PG8_WAIT_L(0); PG8_MMA(0, 1, At, B1); PG8_BAR;
            PG8_LDA(At, 1, 1); PG8_STAGE(PG8_SA(1, 0), a3, voffA);
            PG8_BAR; PG8_WAIT_L(0); PG8_MMA(1, 0, At, B0); PG8_BAR; PG8_SCHED;
            PG8_STAGE(PG8_SB(1, 1), b3 + hstep, voffB);
            PG8_WAIT_V(6); PG8_BAR; PG8_MMA(1, 1, At, B1); PG8_BAR;
            }
        }
        if constexpr (ALIGN_EPI) { if (wr == 0) PG8_BAR; }
        if constexpr (!Epi::AFTER_DRAIN) { E(acc, cur, wr, wc, fr, fq); S.done(cur); }
        if (!has_next) break;
#pragma unroll
        for (int a = 0; a < 2; ++a)
#pragma unroll
            for (int b = 0; b < 2; ++b)
#pragma unroll
                for (int m = 0; m < 4; ++m)
#pragma unroll
                    for (int n = 0; n < 2; ++n) acc[a][b][m][n] = (f32x4){0.f, 0.f, 0.f, 0.f};
        cur = nxt; cA = nA; cB = nB; ++ui;
        if constexpr (ALIGN_EPI) { if (wr == 1) PG8_BAR; }
    }
    PG8_WAIT_V(0);
    if constexpr (!ALIGN_EPI) { if (wr == 0) PG8_BAR; }
    PG8_BAR;
    if constexpr (Epi::AFTER_DRAIN) { E.fused(acc, cur, wr, wc, fr, fq, lds, wid, lane); S.done(cur); }
#undef PG8_SA
#undef PG8_SB
#undef PG8_STAGE
#undef PG8_LDA
#undef PG8_LDB
#undef PG8_MMA
#undef PG8_WAIT_V
#undef PG8_WAIT_L
#undef PG8_BAR
#undef PG8_SCHED
}
}
#ifndef PG8_SP2
#define PG8_SP2 true
#endif
#ifndef PG8_ALIGN
#define PG8_ALIGN true
#endif

constexpr int NWAVES = 8;
constexpr int S_ = 16384, D_ = 1024, FF_ = 4096, PLE_ = 256, INW_ = 3088, ZW = 3072;
constexpr int Z_GQ = 0, Z_GK = 256, Z_GV = 512, Z_GG = 1024, Z_MQ = 1536, Z_MK = 2048, Z_MV = 2560;
constexpr int ZG = 1536;
__device__ __forceinline__ size_t zm_off(int which, int h) { return (size_t)48 * 1024 * 1024 / 2 + (size_t)(which * 4 + h) * S_ * 128; }
constexpr float EPS_ = 1e-6f;

constexpr size_t MiB = 1u << 20, KiB = 1u << 10;
constexpr size_t WS_CTL = 0, CTL_ZERO_BYTES = 64 * KiB;
constexpr size_t WS_WIN = 1 * MiB, WS_WOUT = 7 * MiB, WS_WUP = 9 * MiB, WS_WDOWN = 17 * MiB, WS_WPG = 25 * MiB, WS_WPP = 27 * MiB, WS_WGA = 27 * MiB + 512 * KiB;
constexpr size_t WS_SMALL = 28 * MiB;
constexpr size_t WS_RSTDX = WS_SMALL, WS_GA = WS_SMALL + 64 * KiB, WS_DECAY = WS_SMALL + 1088 * KiB, WS_KMEAN = WS_SMALL + 1344 * KiB,
                 WS_SSQH1 = WS_SMALL + 1472 * KiB, WS_SSQH2 = WS_SMALL + 1728 * KiB, WS_SSQE = WS_SMALL + 1984 * KiB, WS_LPART = WS_SMALL + 2240 * KiB;
constexpr size_t WS_ERAW = 32 * MiB, WS_AB = 64 * MiB, WS_Z = 96 * MiB, WS_MIX = 192 * MiB, WS_PB = 224 * MiB, WS_ACT = 96 * MiB, WS_END = 256 * MiB;
constexpr size_t WS_DS = 224 * MiB  , WS_LIST = 240 * MiB  ;
constexpr size_t OUT_PART = 0  , OUT_SPREV = 48 * MiB  ;
constexpr int CW_TMO = 0, CW_CNT = 1024  , CW_BAR = 4096;

constexpr int RING_OFF = 0, RING_BYTES = 131072;
constexpr int LDS_BYTES = 160 * 1024;
constexpr int MISC_OFF = LDS_BYTES - 512;

#define GAS __attribute__((address_space(1)))
#define LAS __attribute__((address_space(3)))
typedef unsigned short bf16;
typedef unsigned v4u __attribute__((ext_vector_type(4)));
typedef float f32x4 __attribute__((ext_vector_type(4)));
typedef short bf16x8 __attribute__((ext_vector_type(8)));
typedef GAS unsigned gu32;
typedef GAS unsigned long long gu64;
#define RLX_AGENT __ATOMIC_RELAXED, __HIP_MEMORY_SCOPE_AGENT
#define LDS_WAIT() asm volatile("s_waitcnt lgkmcnt(0)" ::: "memory")
#define VM_WAIT() asm volatile("s_waitcnt vmcnt(0)" ::: "memory")
__device__ __forceinline__ unsigned long long rt() { return __builtin_amdgcn_s_memrealtime(); }
__device__ __forceinline__ unsigned f2bf(float f) { unsigned u = __builtin_bit_cast(unsigned, f); return (u + 0x7fffu + ((u >> 16) & 1u)) >> 16; }
__device__ __forceinline__ unsigned pk2(float lo, float hi) { return f2bf(lo) | (f2bf(hi) << 16); }

#define XB_TMO      128
#define XB_XCNT(j)  (256  + 64 * (j))
#define XB_XSUB(j)  (1280 + 64 * (j))
#define XB_XGEN(j)  (2304 + 64 * (j))
#define XB_TOP      3328
#define XB_TOPGEN   3392
#define XCD_BAR_WORDS 3456
#define XB_SPIN_CAP (1u << 18)

__device__ __forceinline__ unsigned xb_ld(unsigned* p)              { return __hip_atomic_load(p, __ATOMIC_RELAXED, __HIP_MEMORY_SCOPE_AGENT); }
__device__ __forceinline__ unsigned xb_add(unsigned* p, unsigned v) { return __hip_atomic_fetch_add(p, v, __ATOMIC_RELAXED, __HIP_MEMORY_SCOPE_AGENT); }
__device__ __forceinline__ unsigned xb_xcc_id() { return (unsigned)__builtin_amdgcn_s_getreg((3 << 11) | 20) & 0xFu; }
#define XB_SPIN(cond, bar) do { unsigned _sp = 0; while (cond) { __builtin_amdgcn_s_sleep(1); \
    if ((++_sp & 255u) == 0u) { if (xb_ld(&(bar)[XB_TMO])) break; if (_sp > XB_SPIN_CAP) { atomicAdd(&(bar)[XB_TMO], 1u); break; } } } } while (0)

struct XcdBarrier {
    unsigned* bar; unsigned x;
    volatile LAS unsigned* st;
};

__device__ __forceinline__ XcdBarrier xcd_barrier_post(unsigned* bar, volatile LAS unsigned* st) {
    XcdBarrier b; b.bar = bar; b.x = xb_xcc_id(); b.st = st;
    if (threadIdx.x == 0) (void)xb_add(&bar[XB_XCNT(b.x)], 1u);
    return b;
}
__device__ __forceinline__ void xcd_barrier_complete(unsigned* bar, unsigned x, unsigned& nloc, unsigned& nx) {
    const unsigned G = gridDim.x * gridDim.y * gridDim.z;
    unsigned sum, cnt, mine, sp = 0u;
    for (;;) {
        sum = 0u; cnt = 0u; mine = 0u;
#pragma unroll
        for (unsigned j = 0; j < 16; ++j) { const unsigned c = xb_ld(&bar[XB_XCNT(j)]); sum += c; cnt += (c > 0u) ? 1u : 0u; mine = (j == x) ? c : mine; }
        if (sum == G) break;
        __builtin_amdgcn_s_sleep(1);
        if ((++sp & 255u) == 0u) { if (xb_ld(&bar[XB_TMO])) break; if (sp > XB_SPIN_CAP) { atomicAdd(&bar[XB_TMO], 1u); break; } }
    }
    nloc = mine > 0u ? mine : 1u; nx = cnt > 0u ? cnt : 1u;
}

__device__ __forceinline__ void xcd_barrier(const XcdBarrier& b) {
    asm volatile("s_waitcnt vmcnt(0)" ::: "memory");
    __syncthreads();
    if (threadIdx.x == 0) {
        unsigned* bar = b.bar;
        __builtin_amdgcn_s_waitcnt(0);
        unsigned nloc = b.st[0], nx = b.st[1];
        if (nloc == 0u) { xcd_barrier_complete(bar, b.x, nloc, nx); b.st[0] = nloc; b.st[1] = nx; }
        const unsigned old = xb_add(&bar[XB_XSUB(b.x)], 1u);
        const unsigned gen = old / nloc;
        if (old + 1u == (gen + 1u) * nloc) {
            __builtin_amdgcn_fence(__ATOMIC_RELEASE, "agent");
            asm volatile("s_waitcnt vmcnt(0)" ::: "memory");
            const unsigned og = xb_add(&bar[XB_TOP], 1u);
            const unsigned tg = og / nx;
            if (og + 1u == (tg + 1u) * nx) xb_add(&bar[XB_TOPGEN], 1u);
            else XB_SPIN(xb_ld(&bar[XB_TOPGEN]) == tg, bar);
            __builtin_amdgcn_fence(__ATOMIC_ACQUIRE, "agent");
            xb_add(&bar[XB_XGEN(b.x)], 1u);
            asm volatile("s_waitcnt vmcnt(0)" ::: "memory");
        } else {
            XB_SPIN(xb_ld(&bar[XB_XGEN(b.x)]) == gen, bar);
            __builtin_amdgcn_fence(__ATOMIC_ACQUIRE, "agent");
            asm volatile("s_waitcnt vmcnt(0)" ::: "memory");
        }
    }
    __syncthreads();
}

struct Frame {
    LAS unsigned char* lds;
    volatile LAS unsigned* MISC;
    gu32* ctl;
    int tid, lane, wave, vcu, G;
    unsigned char* ws; float* out;
};
__device__ __forceinline__ const void* in_ptr(const Frame& F, int k) {
    const unsigned lo = __builtin_amdgcn_readfirstlane(F.MISC[32 + 2 * k]), hi = __builtin_amdgcn_readfirstlane(F.MISC[33 + 2 * k]);
    return (const void*)(((unsigned long long)hi << 32) | lo);
}
#define IN_x ((const float*)in_ptr(F, 0))
#define IN_p ((const float*)in_ptr(F, 1))
#define IN_pos ((const int*)in_ptr(F, 2))
#define IN_g_mix ((const float*)in_ptr(F, 3))
#define IN_w_in ((const float*)in_ptr(F, 4))
#define IN_w_a2 ((const float*)in_ptr(F, 5))
#define IN_b_a ((const float*)in_ptr(F, 6))
#define IN_g_gla ((const float*)in_ptr(F, 7))
#define IN_g_mq ((const float*)in_ptr(F, 8))
#define IN_g_mk ((const float*)in_ptr(F, 9))
#define IN_w_out ((const float*)in_ptr(F, 10))
#define IN_g_ffn ((const float*)in_ptr(F, 11))
#define IN_w_up ((const float*)in_ptr(F, 12))
#define IN_w_down ((const float*)in_ptr(F, 13))
#define IN_g_pg ((const float*)in_ptr(F, 14))
#define IN_w_pg ((const float*)in_ptr(F, 15))
#define IN_w_pp ((const float*)in_ptr(F, 16))
#define IN_g_pe ((const float*)in_ptr(F, 17))
template <int CTRL> __device__ __forceinline__ float dpp_mov(float v) { return __builtin_bit_cast(float, __builtin_amdgcn_update_dpp(0, __builtin_bit_cast(int, v), CTRL, 0xf, 0xf, true)); }
__device__ __forceinline__ float row16_sum(float v) { v += dpp_mov<0xB1>(v); v += dpp_mov<0x4E>(v); v += dpp_mov<0x141>(v); v += dpp_mov<0x140>(v); return v; }
__device__ __forceinline__ float wave_sum(float v) {
    v = row16_sum(v);
    const float s0 = __builtin_bit_cast(float, __builtin_amdgcn_readlane(__builtin_bit_cast(int, v), 0)), s1 = __builtin_bit_cast(float, __builtin_amdgcn_readlane(__builtin_bit_cast(int, v), 16));
    const float s2 = __builtin_bit_cast(float, __builtin_amdgcn_readlane(__builtin_bit_cast(int, v), 32)), s3 = __builtin_bit_cast(float, __builtin_amdgcn_readlane(__builtin_bit_cast(int, v), 48));
    return (s0 + s1) + (s2 + s3);
}
__device__ __forceinline__ float bf2f(unsigned v16) { return __uint_as_float(v16 << 16); }

#ifdef PROBE_LO
#define STAMP(k) do { if (blockIdx.x == 0 && F.tid == 0) { const unsigned long long t_ = rt(); F.MISC[80 + 2 * (k)] = (unsigned)t_; F.MISC[81 + 2 * (k)] = (unsigned)(t_ >> 32); } } while (0)
#else
#define STAMP(k) do { } while (0)
#endif
struct TItem { const float* W; const float* gain; bf16* WT; int ldn, src_col, K, n_dst, k0, perm; };
__device__ __forceinline__ TItem p0_decode(const Frame& F, int it) {
    constexpr int I_IN = (D_ / 64) * (ZW / 32), I_OUT = (D_ / 64) * (D_ / 32), I_UP = (D_ / 64) * (FF_ / 32), I_DN = (FF_ / 64) * (D_ / 32), I_PG = I_OUT;
    TItem t; int r = it;
    t.perm = -1;
    if (r < I_IN) { const int nb = r % (ZW / 32), kb = r / (ZW / 32), n0 = 32 * nb; t.W = IN_w_in; t.gain = IN_g_mix; t.WT = (bf16*)(F.ws + WS_WIN); t.ldn = INW_; t.K = D_; t.n_dst = n0; t.k0 = 64 * kb;
        if (n0 >= Z_MQ && n0 < Z_MV) { t.perm = (n0 & 127) >> 5; t.src_col = (n0 & ~127) + 16; }
        else t.src_col = n0 < 1536 ? n0 : n0 + 16;
        return t; } r -= I_IN;
    if (r < I_OUT) { const int nb = r % (D_ / 32), kb = r / (D_ / 32); t.W = IN_w_out; t.gain = nullptr; t.WT = (bf16*)(F.ws + WS_WOUT); t.ldn = D_; t.src_col = 32 * nb; t.K = D_; t.n_dst = 32 * nb; t.k0 = 64 * kb; return t; } r -= I_OUT;
    if (r < I_UP) { const int nb = r % (FF_ / 32), kb = r / (FF_ / 32); t.W = IN_w_up; t.gain = IN_g_ffn; t.WT = (bf16*)(F.ws + WS_WUP); t.ldn = FF_; t.src_col = 32 * nb; t.K = D_; t.n_dst = 32 * nb; t.k0 = 64 * kb; return t; } r -= I_UP;
    if (r < I_DN) { const int nb = r % (D_ / 32), kb = r / (D_ / 32); t.W = IN_w_down; t.gain = nullptr; t.WT = (bf16*)(F.ws + WS_WDOWN); t.ldn = D_; t.src_col = 32 * nb; t.K = FF_; t.n_dst = 32 * nb; t.k0 = 64 * kb; return t; } r -= I_DN;
    if (r < I_PG) { const int nb = r % (D_ / 32), kb = r / (D_ / 32); t.W = IN_w_pg; t.gain = IN_g_pg; t.WT = (bf16*)(F.ws + WS_WPG); t.ldn = D_; t.src_col = 32 * nb; t.K = D_; t.n_dst = 32 * nb; t.k0 = 64 * kb; return t; } r -= I_PG;
    { const int nb = r % (D_ / 32), kb = r / (D_ / 32); t.W = IN_w_pp; t.gain = nullptr; t.WT = (bf16*)(F.ws + WS_WPP); t.ldn = D_; t.src_col = 32 * nb; t.K = PLE_; t.n_dst = 32 * nb; t.k0 = 64 * kb; return t; }
}
__device__ __forceinline__ void p0_issue(const TItem& t, int lane, float (&w)[32], f32x4 (&g)[2]) {
    const int lam = lane & 31;
    const int cm = t.perm < 0 ? lam : (((lam & 7) < 4) ? 16 * t.perm + 4 * (lam >> 3) + (lam & 7) : 64 + 16 * t.perm + 4 * (lam >> 3) + (lam & 7) - 4);
    const float* src = t.W + (size_t)(t.k0 + (lane >> 5)) * t.ldn + t.src_col + cm;
#pragma unroll
    for (int i = 0; i < 32; ++i) w[i] = __builtin_nontemporal_load(src + (size_t)(2 * i) * t.ldn);
    if (t.gain) { g[0] = *(const f32x4*)(t.gain + t.k0 + 8 * (lane & 7)); g[1] = *(const f32x4*)(t.gain + t.k0 + 8 * (lane & 7) + 4); }
    else { g[0] = (f32x4){1.f, 1.f, 1.f, 1.f}; g[1] = g[0]; }
}
__device__ __forceinline__ void p0_prologue(Frame& F) {
    LAS float* scr = (LAS float*)(F.lds + RING_OFF + F.wave * 16384);
    constexpr int P0_ROWW = 5, P0_TRW = NWAVES - P0_ROWW;
    const bool row_role = F.wave < P0_ROWW;
    const int gw = row_role ? F.vcu * P0_ROWW + F.wave : F.vcu * P0_TRW + (F.wave - P0_ROWW), NGW = F.G * (row_role ? P0_ROWW : P0_TRW);
    bf16* Wga_t = (bf16*)(F.ws + WS_WGA);
    constexpr int NITEMS = (D_ / 64) * (ZW / 32) + 2 * (D_ / 64) * (D_ / 32) + (D_ / 64) * (FF_ / 32) + (FF_ / 64) * (D_ / 32) + (PLE_ / 64) * (D_ / 32);
    if (!row_role) {
        int it = gw; bool have = it < NITEMS;
        float w[32]; f32x4 g[2]; TItem cur;
        if (have) { cur = p0_decode(F, it); p0_issue(cur, F.lane, w, g); }
        while (have) {
#pragma unroll
            for (int i = 0; i < 32; ++i) scr[(2 * i + (F.lane >> 5)) * 33 + (F.lane & 31)] = w[i];
            const f32x4 g0 = g[0], g1 = g[1]; const TItem t = cur;
            LDS_WAIT(); asm volatile("" ::: "memory");
            const int nit = it + NGW; const bool nh = nit < NITEMS;
            if (nh) { cur = p0_decode(F, nit); p0_issue(cur, F.lane, w, g); }
            const int c = F.lane & 7;
#pragma unroll
            for (int j = 0; j < 4; ++j) { const int n = (F.lane >> 3) + 8 * j; const LAS float* s = scr + (8 * c) * 33 + n;
                v4u o; o.x = pk2(s[0 * 33] * g0[0], s[1 * 33] * g0[1]); o.y = pk2(s[2 * 33] * g0[2], s[3 * 33] * g0[3]); o.z = pk2(s[4 * 33] * g1[0], s[5 * 33] * g1[1]); o.w = pk2(s[6 * 33] * g1[2], s[7 * 33] * g1[3]);
                *(GAS v4u*)(t.WT + (size_t)(t.n_dst + n) * t.K + t.k0 + 8 * c) = o; }
            LDS_WAIT(); asm volatile("" ::: "memory");
            it = nit; have = nh;
        }
    }
    if (!row_role) { const float* wi_ = IN_w_in; const float* gm_ = IN_g_mix;
      for (int i = gw * 64 + F.lane; i < 16 * D_; i += NGW * 64) { const int r = i >> 10, k = i & 1023; Wga_t[i] = (bf16)f2bf(wi_[(size_t)k * INW_ + 1536 + r] * gm_[k]); } }
    bf16* xb = (bf16*)(F.ws + WS_AB); bf16* pb = (bf16*)(F.ws + WS_PB); float* rstdx = (float*)(F.ws + WS_RSTDX);
    const float* x_ = IN_x; const float* p_ = IN_p;
    if (row_role) {
        f32x4 v[4][4], pv[4], vn[4][4], pvn[4];
        int m0 = gw * 4; bool have = m0 < S_;
        if (have) {
#pragma unroll
            for (int rr = 0; rr < 4; ++rr) { const GAS f32x4* xr = (const GAS f32x4*)(x_ + (size_t)(m0 + rr) * D_) + F.lane;
#pragma unroll
                for (int j = 0; j < 4; ++j) v[rr][j] = __builtin_nontemporal_load(xr + 64 * j);
                pv[rr] = __builtin_nontemporal_load((const GAS f32x4*)(p_ + (size_t)(m0 + rr) * PLE_) + F.lane); }
        }
        while (have) {
            const int m1 = m0 + NGW * 4; const bool nh = m1 < S_;
            if (nh) {
#pragma unroll
                for (int rr = 0; rr < 4; ++rr) { const GAS f32x4* xr = (const GAS f32x4*)(x_ + (size_t)(m1 + rr) * D_) + F.lane;
#pragma unroll
                    for (int j = 0; j < 4; ++j) vn[rr][j] = __builtin_nontemporal_load(xr + 64 * j);
                    pvn[rr] = __builtin_nontemporal_load((const GAS f32x4*)(p_ + (size_t)(m1 + rr) * PLE_) + F.lane); }
            }
#pragma unroll
            for (int rr = 0; rr < 4; ++rr) { const int m = m0 + rr; float s = 0.f;
#pragma unroll
                for (int j = 0; j < 4; ++j) s += (v[rr][j].x * v[rr][j].x + v[rr][j].y * v[rr][j].y) + (v[rr][j].z * v[rr][j].z + v[rr][j].w * v[rr][j].w);
                s = wave_sum(s);
                const float nrm = sqrtf(s * (1.0f / D_) + EPS_), rsd = 1.0f / nrm;
                GAS unsigned long long* o8 = (GAS unsigned long long*)(xb + (size_t)m * D_) + F.lane;
#pragma unroll
                for (int j = 0; j < 4; ++j) o8[64 * j] = (unsigned long long)pk2(v[rr][j].x * rsd, v[rr][j].y * rsd) | ((unsigned long long)pk2(v[rr][j].z * rsd, v[rr][j].w * rsd) << 32);
                if (F.lane == 0) rstdx[m] = nrm;
                *((GAS unsigned long long*)(pb + (size_t)m * PLE_) + F.lane) = (unsigned long long)pk2(pv[rr].x, pv[rr].y) | ((unsigned long long)pk2(pv[rr].z, pv[rr].w) << 32); }
#pragma unroll
            for (int rr = 0; rr < 4; ++rr) { pv[rr] = pvn[rr];
#pragma unroll
                for (int j = 0; j < 4; ++j) v[rr][j] = vn[rr][j]; }
            m0 = m1; have = nh;
        }
    }
}

typedef float f32x16 __attribute__((ext_vector_type(16)));
typedef __bf16 bf2_t __attribute__((ext_vector_type(2)));
typedef float f2_t __attribute__((ext_vector_type(2)));
__device__ __forceinline__ unsigned pkbf(float lo, float hi) { f2_t v = {lo, hi}; bf2_t b = __builtin_convertvector(v, bf2_t); return __builtin_bit_cast(unsigned, b); }
#define MFMA32(a, b, c) __builtin_amdgcn_mfma_f32_32x32x16_bf16((a), (b), (c), 0, 0, 0)
#define WG_SYNC() do { asm volatile("s_waitcnt lgkmcnt(0)" ::: "memory"); __builtin_amdgcn_s_barrier(); asm volatile("" ::: "memory"); } while (0)
__device__ __forceinline__ bf16x8 pack8(const f32x16& x, int s) {
    v4u p; p.x = pkbf(x[8 * s], x[8 * s + 1]); p.y = pkbf(x[8 * s + 2], x[8 * s + 3]); p.z = pkbf(x[8 * s + 4], x[8 * s + 5]); p.w = pkbf(x[8 * s + 6], x[8 * s + 7]);
    return __builtin_bit_cast(bf16x8, p);
}
__device__ __forceinline__ float log_sigmoid(float s) { return fminf(s, 0.f) - __logf(1.0f + __expf(-fabsf(s))); }
constexpr int GROW = 72;
__device__ __forceinline__ int tperm(int tt) { return (tt & ~15) + 8 * ((tt >> 2) & 1) + 4 * ((tt >> 3) & 1) + (tt & 3); }
typedef short s16x4_t __attribute__((ext_vector_type(4)));
__device__ __forceinline__ unsigned voff_b(unsigned row, unsigned ch) { return 256u * row + 16u * (ch ^ (((row & 3u) << 2) | ((row >> 2) & 3u))); }
__device__ __forceinline__ bf16x8 v_tr_frag(const LAS unsigned char* VL, int kb0, int et, int lane) {
    const unsigned hh = lane >> 5, blk = (lane >> 4) & 1, q = (lane & 15) >> 2, p = lane & 3;
    const unsigned r0 = kb0 + 4 * hh + q, ch = 4 * et + 2 * blk + (p >> 1);
    const s16x4_t lo = __builtin_amdgcn_ds_read_tr16_b64_v4i16((LAS s16x4_t*)(VL + voff_b(r0, ch) + 8 * (p & 1)));
    const s16x4_t hi = __builtin_amdgcn_ds_read_tr16_b64_v4i16((LAS s16x4_t*)(VL + voff_b(r0 + 8, ch) + 8 * (p & 1)));
    return __builtin_shufflevector(lo, hi, 0, 1, 2, 3, 4, 5, 6, 7);
}
__device__ __forceinline__ void v_tr_offsets(int lane, unsigned (&o)[8]) {
    const unsigned hh = lane >> 5, blk = (lane >> 4) & 1, q = (lane & 15) >> 2, p = lane & 3;
#pragma unroll
    for (int et = 0; et < 4; ++et) { const unsigned ch = 4 * et + 2 * blk + (p >> 1); o[et] = voff_b(4 * hh + q, ch) + 8 * (p & 1); o[4 + et] = voff_b(8 + 4 * hh + q, ch) + 8 * (p & 1); }
}
__device__ __forceinline__ bf16x8 v_tr_frag_o(const LAS unsigned char* VL, int kb0, unsigned o_lo, unsigned o_hi) {
    const s16x4_t lo = __builtin_amdgcn_ds_read_tr16_b64_v4i16((LAS s16x4_t*)(VL + 256 * kb0 + o_lo));
    const s16x4_t hi = __builtin_amdgcn_ds_read_tr16_b64_v4i16((LAS s16x4_t*)(VL + 256 * kb0 + o_hi));
    return __builtin_shufflevector(lo, hi, 0, 1, 2, 3, 4, 5, 6, 7);
}

__device__ __forceinline__ void split_bf16x8(const float (&v)[8], bf16x8& hi, bf16x8& lo) {
    unsigned h[4], l[4];
#pragma unroll
    for (int k = 0; k < 4; ++k) { const unsigned p = pkbf(v[2 * k], v[2 * k + 1]); h[k] = p; l[k] = pkbf(v[2 * k] - bf2f(p & 0xffffu), v[2 * k + 1] - bf2f(p >> 16)); }
    hi = __builtin_bit_cast(bf16x8, (v4u){h[0], h[1], h[2], h[3]}); lo = __builtin_bit_cast(bf16x8, (v4u){l[0], l[1], l[2], l[3]});
}
__device__ __forceinline__ void gla_load_w2(Frame& F, bf16x8& whi, bf16x8& wlo, float& bias) {
    const int c = 32 * F.wave + (F.lane & 31), hh = F.lane >> 5;
    const float* wa2_ = IN_w_a2;
    float w[8];
#pragma unroll
    for (int j = 0; j < 8; ++j) w[j] = wa2_[(8 * hh + j) * 256 + c];
    split_bf16x8(w, whi, wlo);
    bias = IN_b_a[c];
}
__device__ __forceinline__ void gla_cumsum(Frame& F, const LAS float* GAS_, const bf16x8 whi, const bf16x8 wlo, float bias, float (&bv)[2][16], float& blast) {
    const int i = F.lane & 31, hh = F.lane >> 5;
    float gs[2][4];
#pragma unroll
    for (int tt = 0; tt < 2; ++tt) {
        const LAS f32x4* g4 = (const LAS f32x4*)(GAS_ + (32 * tt + i) * 16 + 8 * hh);
        const f32x4 g0 = g4[0], g1 = g4[1];
        const float gv[8] = {g0[0], g0[1], g0[2], g0[3], g1[0], g1[1], g1[2], g1[3]};
        bf16x8 ghi, glo; split_bf16x8(gv, ghi, glo);
        f32x16 acc;
#pragma unroll
        for (int r = 0; r < 16; ++r) acc[r] = 0.f;
        acc = MFMA32(ghi, whi, acc); acc = MFMA32(ghi, wlo, acc); acc = MFMA32(glo, whi, acc);
#pragma unroll
        for (int r = 0; r < 16; ++r) bv[tt][r] = log_sigmoid(acc[r] + bias) * (1.0f / 16.0f);
#pragma unroll
        for (int g = 0; g < 4; ++g) gs[tt][g] = (bv[tt][4 * g] + bv[tt][4 * g + 1]) + (bv[tt][4 * g + 2] + bv[tt][4 * g + 3]);
    }
    float run = 0.f;
#pragma unroll
    for (int tt = 0; tt < 2; ++tt)
#pragma unroll
        for (int g = 0; g < 4; ++g) {
            const float mine = gs[tt][g], other = __shfl_xor(mine, 32);
            float off = run + (hh ? other : 0.f);
#pragma unroll
            for (int j = 0; j < 4; ++j) { off += bv[tt][4 * g + j]; bv[tt][4 * g + j] = off; }
            run += mine + other;
        }
    blast = run;
}
__device__ __forceinline__ void gla_vt_load(Frame& F, const bf16* zb, int t0, v4u (&vw)[8]) {
#pragma unroll
    for (int i = 0; i < 8; ++i) { const int idx = F.tid + 512 * i, t = idx >> 6, c64 = idx & 63; vw[i] = *(const v4u*)(zb + (size_t)(t0 + t) * ZG + Z_GV + 8 * c64); }
}
__device__ __forceinline__ void gla_vt_write(Frame& F, LAS unsigned char* VL, const v4u (&vw)[8]) {
#pragma unroll
    for (int i = 0; i < 8; ++i) { const int idx = F.tid + 512 * i, t = idx >> 6, c64 = idx & 63; *(LAS v4u*)(VL + (c64 >> 4) * 16384 + voff_b(t, c64 & 15)) = vw[i]; }
}

__device__ __forceinline__ void gla_a_chunk(Frame& F, int ch) {
    LAS float* GA_S = (LAS float*)(F.lds);
    LAS float* TOT = (LAS float*)(F.lds + 8192);
    LAS bf16* KTE = (LAS bf16*)(F.lds + 10240);
    LAS unsigned char* VT = F.lds + 10240 + 4 * 64 * GROW * 2;
    const bf16* xb = (const bf16*)(F.ws + WS_AB); const bf16* zb = (const bf16*)(F.ws + WS_Z); const bf16* wga = (const bf16*)(F.ws + WS_WGA);
    const float* rstdx = (const float*)(F.ws + WS_RSTDX); float* ga_g = (float*)(F.ws + WS_GA); float* decay_g = (float*)(F.ws + WS_DECAY); bf16* dS_g = (bf16*)(F.ws + WS_DS);
    const int t0 = ch * 64;
    bf16x8 whi, wlo; float bias; gla_load_w2(F, whi, wlo, bias);
    v4u vw[8]; gla_vt_load(F, zb, t0, vw);
    LAS bf16* KRAW = (LAS bf16*)(VT + 65536);
    v4u kw[4];
#pragma unroll
    for (int i = 0; i < 4; ++i) { const int idx = F.tid + 512 * i, t = idx >> 5, c32 = idx & 31; kw[i] = *(const v4u*)(zb + (size_t)(t0 + t) * ZG + Z_GK + 8 * c32); }
    {
        const int rg = F.wave & 3, kh = F.wave >> 2, r = F.lane & 15, q = F.lane >> 4;
        const bf16* arow = xb + (size_t)(t0 + 16 * rg + r) * D_ + 8 * q; const bf16* brow = wga + (size_t)r * D_ + 8 * q;
        pg8::f32x4 acc = {0.f, 0.f, 0.f, 0.f};
#pragma unroll
        for (int s = 16 * kh; s < 16 * kh + 16; ++s) { const bf16x8 a = *(const bf16x8*)(arow + 32 * s), b = *(const bf16x8*)(brow + 32 * s); acc = __builtin_amdgcn_mfma_f32_16x16x32_bf16(a, b, acc, 0, 0, 0); }
#pragma unroll
        for (int g = 0; g < 4; ++g) GA_S[kh * 1024 + (16 * rg + 4 * q + g) * 16 + r] = acc[g];
    }
#pragma unroll
    for (int i = 0; i < 4; ++i) { const int idx = F.tid + 512 * i, t = idx >> 5, c32 = idx & 31; *(LAS v4u*)(KRAW + (size_t)((c32 >> 3) * 64 + t) * GROW + 8 * (c32 & 7)) = kw[i]; }
    gla_vt_write(F, VT, vw);
    WG_SYNC();
    for (int idx = F.tid; idx < 1024; idx += 512) { const float v = GA_S[idx] + GA_S[1024 + idx]; GA_S[idx] = v; ga_g[(size_t)t0 * 16 + idx] = v; }
    WG_SYNC();
    float bv[2][16], blast;
    gla_cumsum(F, GA_S, whi, wlo, bias, bv, blast);
    {
        const int i = F.lane & 31, hh = F.lane >> 5, c = 32 * F.wave + i, h = c >> 6, d = c & 63;
        if (hh == 0) decay_g[ch * 256 + c] = __expf(blast);
#pragma unroll
        for (int tt = 0; tt < 2; ++tt)
#pragma unroll
            for (int g = 0; g < 4; ++g) {
                float v[4];
#pragma unroll
                for (int j = 0; j < 4; ++j) { const int t = 32 * tt + 8 * g + 4 * hh + j; v[j] = bf2f(KRAW[(size_t)(h * 64 + t) * GROW + d]) * __expf(blast - bv[tt][4 * g + j]); }
                typedef unsigned u2 __attribute__((ext_vector_type(2)));
                u2 w; w.x = pkbf(v[0], v[1]); w.y = pkbf(v[2], v[3]);
                *(LAS u2*)(KTE + (size_t)(h * 64 + d) * GROW + 32 * tt + 16 * (g >> 1) + 8 * hh + 4 * (g & 1)) = w;
            }
    }
    WG_SYNC();
    {
        const int h = F.wave >> 1, dt = F.wave & 1, i = F.lane & 31, hh = F.lane >> 5;
        f32x16 acc[4];
#pragma unroll
        for (int et = 0; et < 4; ++et)
#pragma unroll
            for (int r = 0; r < 16; ++r) acc[et][r] = 0.f;
#pragma unroll
        for (int s = 0; s < 4; ++s) {
            const bf16x8 a = *(const LAS bf16x8*)(KTE + (size_t)(h * 64 + 32 * dt + i) * GROW + 16 * s + 8 * hh);
#pragma unroll
            for (int et = 0; et < 4; ++et) { const bf16x8 b = v_tr_frag(VT + h * 16384, 16 * s, et, F.lane); acc[et] = MFMA32(a, b, acc[et]); }
        }
#pragma unroll
        for (int et = 0; et < 4; ++et) {
            bf16* dst = dS_g + ((size_t)(ch * 4 + h) * 128 + 32 * et + i) * 64 + 32 * dt + 4 * hh;
            typedef unsigned u2 __attribute__((ext_vector_type(2)));
#pragma unroll
            for (int g = 0; g < 4; ++g) { u2 w; w.x = pkbf(acc[et][4 * g], acc[et][4 * g + 1]); w.y = pkbf(acc[et][4 * g + 2], acc[et][4 * g + 3]); *(u2*)(dst + 8 * g) = w; }
        }
    }
    WG_SYNC();
}

__device__ __forceinline__ void gla_b_pair(Frame& F, int pair) {
    LAS float* DSL = (LAS float*)(F.lds);
    LAS float* DEC = (LAS float*)(F.lds + 65536);
    LAS float* SEGE = (LAS float*)(F.lds + 131072);
    LAS float* SEGP = (LAS float*)(F.lds + 131072 + 2048);
    const float* decay_g = (const float*)(F.ws + WS_DECAY); const bf16* dS_g = (const bf16*)(F.ws + WS_DS); bf16* sp_g = (bf16*)((unsigned char*)F.out + OUT_SPREV);
    const int h = pair >> 6, seg = F.tid >> 6, d = F.tid & 63;
#pragma unroll
    for (int i = 0; i < 8; ++i) { const int idx = F.tid + 512 * i, n = idx >> 4, d4 = idx & 15; *(LAS pg8::f32x4*)(DEC + n * 64 + 4 * d4) = *(const pg8::f32x4*)(decay_g + (size_t)n * 256 + h * 64 + 4 * d4); }
    for (int sub = 0; sub < 2; ++sub) {
        const int e = (pair & 63) * 2 + sub;
#pragma unroll
        for (int i = 0; i < 4; ++i) { const int idx = F.tid + 512 * i, n = idx >> 3, d8 = idx & 7;
            const v4u w = *(const v4u*)(dS_g + ((size_t)(n * 4 + h) * 128 + e) * 64 + 8 * d8);
            LAS pg8::f32x4* dp = (LAS pg8::f32x4*)(DSL + n * 64 + 8 * d8);
            dp[0] = (pg8::f32x4){bf2f(w.x & 0xffffu), bf2f(w.x >> 16), bf2f(w.y & 0xffffu), bf2f(w.y >> 16)}; dp[1] = (pg8::f32x4){bf2f(w.z & 0xffffu), bf2f(w.z >> 16), bf2f(w.w & 0xffffu), bf2f(w.w >> 16)}; }
        WG_SYNC();
        float Sv = 0.f, P = 1.f;
#pragma unroll 8
        for (int i = 0; i < 32; ++i) { const int n = seg * 32 + i; const float x = DSL[n * 64 + d], a = DEC[n * 64 + d]; DSL[n * 64 + d] = Sv; Sv = a * Sv + x; P *= a; }
        SEGE[seg * 64 + d] = Sv; SEGP[seg * 64 + d] = P;
        WG_SYNC();
        float st = 0.f;
        for (int k = 0; k < seg; ++k) st = SEGP[k * 64 + d] * st + SEGE[k * 64 + d];
        float Pq = 1.f;
#pragma unroll 8
        for (int i = 0; i < 32; ++i) { const int n = seg * 32 + i; const float v = DSL[n * 64 + d] + Pq * st; Pq *= DEC[n * 64 + d]; sp_g[((size_t)(n * 4 + h) * 128 + e) * 64 + d] = (bf16)f2bf(v); }
        WG_SYNC();
    }
}

__device__ __forceinline__ void gla_c_chunk(Frame& F, int ch) {
    LAS float* GA2 = (LAS float*)(F.lds);
    LAS float* TOT = (LAS float*)(F.lds + 4096);
    LAS bf16* QD = (LAS bf16*)(F.lds + 6144);
    LAS bf16* KI = (LAS bf16*)(F.lds + 6144 + 36864);
    LAS unsigned char* VT = F.lds + 6144 + 2 * 36864;
    const bf16* zb = (const bf16*)(F.ws + WS_Z); const float* ga_g = (const float*)(F.ws + WS_GA); const bf16* sp_g = (const bf16*)((const unsigned char*)F.out + OUT_SPREV); bf16* mixb = (bf16*)(F.ws + WS_MIX);
    const int t0 = ch * 64;
    bf16x8 whi, wlo; float bias; gla_load_w2(F, whi, wlo, bias);
    v4u vw[8]; gla_vt_load(F, zb, t0, vw);
    v4u qw[4], kw[4];
#pragma unroll
    for (int i = 0; i < 4; ++i) { const int idx = F.tid + 512 * i, t = idx >> 5, c32 = idx & 31; qw[i] = *(const v4u*)(zb + (size_t)(t0 + t) * ZG + Z_GQ + 8 * c32); kw[i] = *(const v4u*)(zb + (size_t)(t0 + t) * ZG + Z_GK + 8 * c32); }
    for (int idx = F.tid; idx < 1024; idx += 512) GA2[idx] = ga_g[(size_t)t0 * 16 + idx];
#pragma unroll
    for (int i = 0; i < 4; ++i) { const int idx = F.tid + 512 * i, t = idx >> 5, c32 = idx & 31; const size_t o = (size_t)((c32 >> 3) * 64 + t) * GROW + 8 * (c32 & 7); *(LAS v4u*)(QD + o) = qw[i]; *(LAS v4u*)(KI + o) = kw[i]; }
    gla_vt_write(F, VT, vw);
    WG_SYNC();
    float bv[2][16], blast;
    gla_cumsum(F, GA2, whi, wlo, bias, bv, blast);
    {
        const int i = F.lane & 31, hh = F.lane >> 5, c = 32 * F.wave + i, h = c >> 6, d = c & 63;
#pragma unroll
        for (int tt = 0; tt < 2; ++tt)
#pragma unroll
            for (int r = 0; r < 16; ++r) {
                const int t = 32 * tt + (r & 3) + 8 * (r >> 2) + 4 * hh; const float b = bv[tt][r];
                const size_t o = (size_t)(h * 64 + t) * GROW + d;
                const float qd = bf2f(QD[o]) * __expf(b) * 0.125f, ki = bf2f(KI[o]) * __expf(-b);
                QD[o] = (bf16)f2bf(qd); KI[o] = (bf16)f2bf(ki);
            }
    }
    bf16x8 sfr[4][4];
    { const int h_ = F.wave >> 1, i_ = F.lane & 31, hh_ = F.lane >> 5;
#pragma unroll
      for (int et = 0; et < 4; ++et) { const bf16* srow = sp_g + ((size_t)(ch * 4 + h_) * 128 + 32 * et + i_) * 64 + 8 * hh_;
#pragma unroll
          for (int s = 0; s < 4; ++s) sfr[et][s] = *(const bf16x8*)(srow + 16 * s); } }
    v4u ggw[8];
#pragma unroll
    for (int k = 0; k < 8; ++k) { const int idx = F.tid + 512 * k, t = idx >> 6, c64 = idx & 63; ggw[k] = *(const v4u*)(zb + (size_t)(t0 + t) * ZG + Z_GG + 8 * c64); }
    WG_SYNC();
    {
        const int h = F.wave >> 1, ct = F.wave & 1, i = F.lane & 31, hh = F.lane >> 5;
        bf16x8 qf[4];
#pragma unroll
        for (int s = 0; s < 4; ++s) qf[s] = *(const LAS bf16x8*)(QD + (size_t)(h * 64 + 32 * ct + i) * GROW + 16 * s + 8 * hh);
        f32x16 acc[4];
#pragma unroll
        for (int et = 0; et < 4; ++et)
#pragma unroll
            for (int r = 0; r < 16; ++r) acc[et][r] = 0.f;
#pragma unroll
        for (int et = 0; et < 4; ++et) {
#pragma unroll
            for (int s = 0; s < 4; ++s) acc[et] = MFMA32(sfr[et][s], qf[s], acc[et]);
        }
        for (int jt = 0; jt <= ct; ++jt) {
            f32x16 X;
#pragma unroll
            for (int r = 0; r < 16; ++r) X[r] = 0.f;
#pragma unroll
            for (int s = 0; s < 4; ++s) { const bf16x8 kf = *(const LAS bf16x8*)(KI + (size_t)(h * 64 + 32 * jt + i) * GROW + 16 * s + 8 * hh); X = MFMA32(kf, qf[s], X); }
            if (jt == ct) {
#pragma unroll
                for (int r = 0; r < 16; ++r) { const int j = (r & 3) + 8 * (r >> 2) + 4 * hh; if (j > i) X[r] = 0.f; }
            }
#pragma unroll
            for (int s2 = 0; s2 < 2; ++s2) {
                const bf16x8 xs = pack8(X, s2);
#pragma unroll
                for (int et = 0; et < 4; ++et) { const bf16x8 vf = v_tr_frag(VT + h * 16384, 32 * jt + 16 * s2, et, F.lane); acc[et] = MFMA32(vf, xs, acc[et]); }
            }
        }
        float ss = 0.f;
#pragma unroll
        for (int et = 0; et < 4; ++et)
#pragma unroll
            for (int r = 0; r < 16; ++r) ss += acc[et][r] * acc[et][r];
        ss += __shfl_xor(ss, 32);
        const float rn = __builtin_amdgcn_rsqf(ss * (1.0f / 128.0f) + EPS_);
        const float* ggl_ = IN_g_gla;
        WG_SYNC();
        const int t = 32 * ct + i;
#pragma unroll
        for (int et = 0; et < 4; ++et)
#pragma unroll
            for (int g = 0; g < 4; ++g) {
                const int e0 = 32 * et + 8 * g + 4 * hh;
                const pg8::f32x4 gl = *(const pg8::f32x4*)(ggl_ + e0);
                typedef unsigned u2 __attribute__((ext_vector_type(2)));
                u2 w; w.x = pkbf(acc[et][4 * g] * rn * gl[0], acc[et][4 * g + 1] * rn * gl[1]); w.y = pkbf(acc[et][4 * g + 2] * rn * gl[2], acc[et][4 * g + 3] * rn * gl[3]);
                *(LAS u2*)(VT + h * 16384 + voff_b(t, e0 >> 3) + 8 * hh) = w;
            }
    }
    WG_SYNC();
#pragma unroll
    for (int k = 0; k < 8; ++k) { const int idx = F.tid + 512 * k, t = idx >> 6, c64 = idx & 63;
        const v4u on = *(const LAS v4u*)(VT + (c64 >> 4) * 16384 + voff_b(t, c64 & 15)), gw = ggw[k];
        float o[8] = {bf2f(on.x & 0xffffu), bf2f(on.x >> 16), bf2f(on.y & 0xffffu), bf2f(on.y >> 16), bf2f(on.z & 0xffffu), bf2f(on.z >> 16), bf2f(on.w & 0xffffu), bf2f(on.w >> 16)};
        float gv[8] = {bf2f(gw.x & 0xffffu), bf2f(gw.x >> 16), bf2f(gw.y & 0xffffu), bf2f(gw.y >> 16), bf2f(gw.z & 0xffffu), bf2f(gw.z >> 16), bf2f(gw.w & 0xffffu), bf2f(gw.w >> 16)};
#pragma unroll
        for (int j = 0; j < 8; ++j) o[j] *= gv[j] * __builtin_amdgcn_rcpf(1.0f + __expf(-gv[j]));
        v4u w; w.x = pkbf(o[0], o[1]); w.y = pkbf(o[2], o[3]); w.z = pkbf(o[4], o[5]); w.w = pkbf(o[6], o[7]);
        *(v4u*)(mixb + (size_t)(t0 + t) * D_ + 8 * c64) = w; }
    WG_SYNC();
}

constexpr int KROW = 136;
constexpr int LIST_PER_HEAD = 256 * 2016;
__device__ __forceinline__ int list_off(int h, int j) { return h * LIST_PER_HEAD + 256 * (63 * j - (j * (j - 1)) / 2); }
typedef unsigned u2_t __attribute__((ext_vector_type(2)));

__device__ __forceinline__ void sincos_acc(float a, float& s, float& c) {
    const float k = __builtin_rintf(a * 0.15915494309189535f);
    float r = __builtin_fmaf(-k, 6.28125f, a);
    r = __builtin_fmaf(-k, 0.0019353071693331003f, r);
    r = __builtin_fmaf(-k, 1.0253131677018246e-11f, r);
    const float rev = r * 0.15915494309189535f;
    s = __builtin_amdgcn_sinf(rev); c = __builtin_amdgcn_cosf(rev);
}

__device__ __forceinline__ void moba_a_item(Frame& F, int item) {
    const int blk = item >> 2, h = item & 3;
    LAS float* KM = (LAS float*)(F.lds);
    const bf16* zb = (const bf16*)(F.ws + WS_Z); float* kmean_g = (float*)(F.ws + WS_KMEAN);
    const int c16 = F.tid & 15, rg = F.tid >> 4;
    float acc8[8] = {0.f, 0.f, 0.f, 0.f, 0.f, 0.f, 0.f, 0.f};
    v4u w[8];
#pragma unroll
    for (int i = 0; i < 8; ++i) w[i] = *(const v4u*)(zb + zm_off(1, h) + (size_t)(blk * 256 + rg + 32 * i) * 128 + 8 * c16);
#pragma unroll
    for (int i = 0; i < 8; ++i) { acc8[0] += bf2f(w[i].x & 0xffffu); acc8[1] += bf2f(w[i].x >> 16); acc8[2] += bf2f(w[i].y & 0xffffu); acc8[3] += bf2f(w[i].y >> 16);
                                  acc8[4] += bf2f(w[i].z & 0xffffu); acc8[5] += bf2f(w[i].z >> 16); acc8[6] += bf2f(w[i].w & 0xffffu); acc8[7] += bf2f(w[i].w >> 16); }
#pragma unroll
    for (int j = 0; j < 8; ++j) KM[rg * 128 + 8 * c16 + j] = acc8[j];
    WG_SYNC();
    if (F.tid < 128) { float sm = 0.f;
#pragma unroll
        for (int r = 0; r < 32; ++r) sm += KM[r * 128 + F.tid];
        kmean_g[(size_t)(h * 64 + blk) * 128 + F.tid] = sm * (1.0f / 256.0f); }
    WG_SYNC();
}

__device__ __forceinline__ void top3_insert(float v, int j, float& v0, float& v1, float& v2, int& i0, int& i1, int& i2) {
    const bool b0 = (v > v0) || (v == v0 && j < i0), b1 = (v > v1) || (v == v1 && j < i1), b2 = (v > v2) || (v == v2 && j < i2);
    const float n2 = b1 ? v1 : (b2 ? v : v2); const int m2 = b1 ? i1 : (b2 ? j : i2);
    const float n1 = b0 ? v0 : (b1 ? v : v1); const int m1 = b0 ? i0 : (b1 ? j : i1);
    const float n0 = b0 ? v : v0; const int m0 = b0 ? j : i0;
    v0 = n0; v1 = n1; v2 = n2; i0 = m0; i1 = m1; i2 = m2;
}
__device__ __forceinline__ void moba_b_item(Frame& F, int item) {
    const int kb = item >> 2, h = item & 3;
    if (kb == 0) return;
    LAS bf16* KMH = (LAS bf16*)(F.lds);
    LAS bf16* KML = (LAS bf16*)(F.lds + 64 * KROW * 2);
    LAS unsigned* HIST = (LAS unsigned*)(F.lds + 2 * 64 * KROW * 2);
    LAS unsigned* BASE = HIST + 64;
    const bf16* zb = (const bf16*)(F.ws + WS_Z); const float* kmean_g = (const float*)(F.ws + WS_KMEAN); unsigned* list_g = (unsigned*)(F.ws + WS_LIST);
    const int i = F.lane & 31, kk = F.lane >> 5;
    const int t = kb * 256 + F.wave * 32 + i;
    bf16x8 qf[8];
    { const bf16* qrow = zb + zm_off(0, h) + (size_t)t * 128 + 8 * kk;
#pragma unroll
      for (int s = 0; s < 8; ++s) qf[s] = *(const bf16x8*)(qrow + 16 * s); }
    for (int idx = F.tid; idx < 64 * 128; idx += 512) { const int j = idx >> 7, d = idx & 127; const float v = (j < kb) ? kmean_g[(size_t)(h * 64 + j) * 128 + d] : 0.f;
        const unsigned hi = f2bf(v); const float rem = v - bf2f(hi); KMH[j * KROW + d] = (bf16)hi; KML[j * KROW + d] = (bf16)f2bf(rem); }
    if (F.tid < 64) HIST[F.tid] = 0u;
    WG_SYNC();
    float v0 = -INFINITY, v1 = -INFINITY, v2 = -INFINITY; int i0 = 1 << 20, i1 = 1 << 20, i2 = 1 << 20;
    const int njt = (kb + 31) >> 5;
    for (int jt = 0; jt < njt; ++jt) {
        f32x16 acc;
#pragma unroll
        for (int r = 0; r < 16; ++r) acc[r] = 0.f;
#pragma unroll
        for (int s = 0; s < 8; ++s) {
            const bf16x8 ah = *(const LAS bf16x8*)(KMH + (size_t)(32 * jt + i) * KROW + 16 * s + 8 * kk), al = *(const LAS bf16x8*)(KML + (size_t)(32 * jt + i) * KROW + 16 * s + 8 * kk);
            acc = MFMA32(ah, qf[s], acc); acc = MFMA32(al, qf[s], acc);
        }
#pragma unroll
        for (int r = 0; r < 16; ++r) { const int j = 32 * jt + (r & 3) + 8 * (r >> 2) + 4 * kk; if (j < kb) top3_insert(acc[r], j, v0, v1, v2, i0, i1, i2); }
    }
    {
        const float pv0 = __shfl_xor(v0, 32), pv1 = __shfl_xor(v1, 32), pv2 = __shfl_xor(v2, 32);
        const int pi0 = __shfl_xor(i0, 32), pi1 = __shfl_xor(i1, 32), pi2 = __shfl_xor(i2, 32);
        top3_insert(pv0, pi0, v0, v1, v2, i0, i1, i2); top3_insert(pv1, pi1, v0, v1, v2, i0, i1, i2); top3_insert(pv2, pi2, v0, v1, v2, i0, i1, i2);
    }
    const int nsel = kb < 3 ? kb : 3;
    unsigned lp0 = 0, lp1 = 0, lp2 = 0;
    if (kk == 0) {
        if (nsel > 0) lp0 = atomicAdd((unsigned*)&HIST[i0], 1u);
        if (nsel > 1) lp1 = atomicAdd((unsigned*)&HIST[i1], 1u);
        if (nsel > 2) lp2 = atomicAdd((unsigned*)&HIST[i2], 1u);
    }
    WG_SYNC();
    if (F.tid < 64) { const unsigned n = HIST[F.tid]; BASE[F.tid] = n ? atomicAdd((unsigned*)(F.ctl + CW_CNT + h * 64 + F.tid), n) : 0u; }
    WG_SYNC();
    if (kk == 0) {
        if (nsel > 0) list_g[list_off(h, i0) + BASE[i0] + lp0] = (unsigned)t | (0u << 16);
        if (nsel > 1) list_g[list_off(h, i1) + BASE[i1] + lp1] = (unsigned)t | (1u << 16);
        if (nsel > 2) list_g[list_off(h, i2) + BASE[i2] + lp2] = (unsigned)t | (2u << 16);
    }
    WG_SYNC();
}

__device__ __forceinline__ void moba_load_kv(Frame& F, int h, int j, LAS bf16* KL, LAS unsigned char* VL) {
    const bf16* zb = (const bf16*)(F.ws + WS_Z);
#pragma unroll
    for (int i = 0; i < 8; ++i) { const int idx = F.tid + 512 * i, r = idx >> 4, c16 = idx & 15;
        *(LAS v4u*)(KL + (size_t)r * KROW + 8 * c16) = *(const v4u*)(zb + zm_off(1, h) + (size_t)(j * 256 + r) * 128 + 8 * c16); }
#pragma unroll
    for (int i = 0; i < 8; ++i) { const int idx = F.tid + 512 * i, r = idx >> 4, c16 = idx & 15;
        *(LAS v4u*)(VL + voff_b(r, c16)) = *(const v4u*)(zb + zm_off(2, h) + (size_t)(j * 256 + r) * 128 + 8 * c16); }
}
__device__ __forceinline__ void moba_wave_attend(const bf16x8 (&qf)[8], const LAS bf16* KL, const LAS unsigned char* VL, int nkt, int diag_kt, int i, int hh, int lane, float c2, float mc2, f32x16 (&acc)[4], float& lsum) {
    unsigned vo[8]; v_tr_offsets(lane, vo);
    for (int kt = 0; kt < nkt; ++kt) {
        f32x16 St;
#pragma unroll
        for (int r = 0; r < 16; ++r) St[r] = 0.f;
#pragma unroll
        for (int s = 0; s < 8; ++s) { const bf16x8 kf = *(const LAS bf16x8*)(KL + (size_t)(32 * kt + i) * KROW + 16 * s + 8 * hh); St = MFMA32(kf, qf[s], St); }
#pragma unroll
        for (int r = 0; r < 16; ++r) St[r] = __builtin_amdgcn_exp2f(St[r] * c2 - mc2);
        if (kt == diag_kt) {
#pragma unroll
            for (int r = 0; r < 16; ++r) { const int kl = (r & 3) + 8 * (r >> 2) + 4 * hh; if (kl > i) St[r] = 0.f; }
        }
#pragma unroll
        for (int r = 0; r < 16; ++r) lsum += St[r];
#pragma unroll
        for (int s2 = 0; s2 < 2; ++s2) {
            const bf16x8 ps = pack8(St, s2);
#pragma unroll
            for (int et = 0; et < 4; ++et) { const bf16x8 vf = v_tr_frag_o(VL, 32 * kt + 16 * s2, vo[et], vo[4 + et]); acc[et] = MFMA32(vf, ps, acc[et]); }
        }
    }
}
__device__ __forceinline__ void moba_shift(Frame& F, float& c2, float& mc2) {
    const float* gmq_ = IN_g_mq; const float* gmk_ = IN_g_mk;
    float m1 = fmaxf(fabsf(gmq_[F.lane]), fabsf(gmq_[F.lane + 64])), m2 = fmaxf(fabsf(gmk_[F.lane]), fabsf(gmk_[F.lane + 64]));
#pragma unroll
    for (int o = 1; o < 64; o <<= 1) { m1 = fmaxf(m1, __shfl_xor(m1, o)); m2 = fmaxf(m2, __shfl_xor(m2, o)); }
    c2 = 0.08838834764831845f * 1.4426950408889634f;
    mc2 = 11.313708498984761f * m1 * m2 * 1.4426950408889634f;
}

__device__ __forceinline__ void mc_decode(const LAS int* PRE, int it, int& hj, int& chunk) {
    int lo = 0, hi = 255;
    while (lo < hi) { const int mid = (lo + hi + 1) >> 1; if (PRE[mid] <= it) lo = mid; else hi = mid - 1; }
    hj = lo; chunk = it - PRE[lo];
}
__device__ __forceinline__ void mc_fetch(const Frame& F, int hj, int chunk, int n, int i, int hh, bool& active, bool& valid, int& tq, int& slot, bf16x8 (&qf)[8]) {
    const bf16* zb = (const bf16*)(F.ws + WS_Z); const unsigned* list_g = (const unsigned*)(F.ws + WS_LIST);
    const int h = hj >> 6, j = hj & 63, base = chunk * 256 + F.wave * 32;
    active = base < n; valid = false; tq = 0; slot = 0;
    if (active) {
        const int eidx = base + i; valid = eidx < n;
        const unsigned ent = list_g[list_off(h, j) + (valid ? eidx : base)];
        tq = (int)(ent & 0xffffu); slot = (int)(ent >> 16);
        const bf16* qrow = zb + zm_off(0, h) + (size_t)tq * 128 + 8 * hh;
#pragma unroll
        for (int s = 0; s < 8; ++s) qf[s] = *(const bf16x8*)(qrow + 16 * s);
    }
}
__device__ __forceinline__ void moba_c_phase(Frame& F) {
    LAS bf16* KL = (LAS bf16*)(F.lds); LAS unsigned char* VL = F.lds + 256 * KROW * 2;
    LAS int* PRE = (LAS int*)(F.lds + 256 * KROW * 2 + 65536);
    LAS int* WT = PRE + 260;
    bf16* part_g = (bf16*)((unsigned char*)F.out + OUT_PART); float* lpart_g = (float*)(F.ws + WS_LPART);
    int mycnt = 0;
    if (F.tid < 256) {
        mycnt = (int)__hip_atomic_load(F.ctl + CW_CNT + F.tid, RLX_AGENT);
        int v = (mycnt + 255) >> 8, incl = v;
#pragma unroll
        for (int o = 1; o < 64; o <<= 1) { const int u = __shfl_up(incl, o); if (F.lane >= o) incl += u; }
        if (F.lane == 63) WT[F.wave] = incl;
        PRE[F.tid] = incl - v;
    }
    WG_SYNC();
    if (F.tid < 256) { int off = 0; for (int w = 0; w < F.wave; ++w) off += WT[w]; PRE[F.tid] += off; if (F.tid == 255) PRE[256] = PRE[255] + ((mycnt + 255) >> 8); }
    WG_SYNC();
    const int T = PRE[256];
    float c2, mc2; moba_shift(F, c2, mc2);
    const int i = F.lane & 31, hh = F.lane >> 5;
    const int it0 = (int)(((long long)F.vcu * T) / F.G), it1 = (int)(((long long)(F.vcu + 1) * T) / F.G);
    int cur_hj = -1;
    int hj = 0, chunk = 0, tq = 0, slot = 0; bool active = false, valid = false; bf16x8 qf[8];
#pragma unroll
    for (int s = 0; s < 8; ++s) qf[s] = (bf16x8){0, 0, 0, 0, 0, 0, 0, 0};
    if (it0 < it1) { mc_decode(PRE, it0, hj, chunk); const int n = (int)__hip_atomic_load(F.ctl + CW_CNT + hj, RLX_AGENT); mc_fetch(F, hj, chunk, n, i, hh, active, valid, tq, slot, qf); }
    for (int it = it0; it < it1; ++it) {
        const int h = hj >> 6, j = hj & 63;
        if (hj != cur_hj) { if (cur_hj >= 0) WG_SYNC(); moba_load_kv(F, h, j, KL, VL); WG_SYNC(); cur_hj = hj; }
        int hj2 = hj, chunk2 = 0, tq2 = 0, slot2 = 0; bool active2 = false, valid2 = false; bf16x8 qf2[8];
#pragma unroll
        for (int s = 0; s < 8; ++s) qf2[s] = qf[s];
        if (it + 1 < it1) { mc_decode(PRE, it + 1, hj2, chunk2); const int n2 = (int)__hip_atomic_load(F.ctl + CW_CNT + hj2, RLX_AGENT); mc_fetch(F, hj2, chunk2, n2, i, hh, active2, valid2, tq2, slot2, qf2); }
        if (active) {
            f32x16 acc[4]; float lsum = 0.f;
#pragma unroll
            for (int et = 0; et < 4; ++et)
#pragma unroll
                for (int r = 0; r < 16; ++r) acc[et][r] = 0.f;
            moba_wave_attend(qf, KL, VL, 8, -1, i, hh, F.lane, c2, mc2, acc, lsum);
            lsum += __shfl_xor(lsum, 32);
            if (valid) {
                bf16* prow = part_g + ((size_t)(slot * 4 + h) * S_ + tq) * 128;
#pragma unroll
                for (int et = 0; et < 4; ++et)
#pragma unroll
                    for (int g2 = 0; g2 < 2; ++g2) { v4u w; w.x = pkbf(acc[et][8 * g2], acc[et][8 * g2 + 1]); w.y = pkbf(acc[et][8 * g2 + 2], acc[et][8 * g2 + 3]); w.z = pkbf(acc[et][8 * g2 + 4], acc[et][8 * g2 + 5]); w.w = pkbf(acc[et][8 * g2 + 6], acc[et][8 * g2 + 7]);
                        *(v4u*)(prow + 64 * hh + 16 * et + 8 * g2) = w; }
                if (hh == 0) lpart_g[(size_t)(slot * 4 + h) * S_ + tq] = lsum;
            }
        }
        hj = hj2; chunk = chunk2; tq = tq2; slot = slot2; active = active2; valid = valid2;
#pragma unroll
        for (int s = 0; s < 8; ++s) qf[s] = qf2[s];
    }
    WG_SYNC();
}

__device__ __forceinline__ void moba_d_item(Frame& F, int item, float c2, float mc2) {
    const int blk = item >> 2, h = item & 3;
    LAS bf16* KL = (LAS bf16*)(F.lds); LAS unsigned char* VL = F.lds + 256 * KROW * 2;
    const bf16* zb = (const bf16*)(F.ws + WS_Z); const bf16* part_g = (const bf16*)((const unsigned char*)F.out + OUT_PART); const float* lpart_g = (const float*)(F.ws + WS_LPART);
    bf16* mixb = (bf16*)(F.ws + WS_MIX);
    const int i = F.lane & 31, hh = F.lane >> 5;
    const int tq = blk * 256 + F.wave * 32 + i;
    bf16x8 qf[8];
    { const bf16* qrow = zb + zm_off(0, h) + (size_t)tq * 128 + 8 * hh;
#pragma unroll
      for (int s = 0; s < 8; ++s) qf[s] = *(const bf16x8*)(qrow + 16 * s); }
    moba_load_kv(F, h, blk, KL, VL);
    WG_SYNC();
    f32x16 acc[4]; float lsum = 0.f;
#pragma unroll
    for (int et = 0; et < 4; ++et)
#pragma unroll
        for (int r = 0; r < 16; ++r) acc[et][r] = 0.f;
    moba_wave_attend(qf, KL, VL, F.wave + 1, F.wave, i, hh, F.lane, c2, mc2, acc, lsum);
    lsum += __shfl_xor(lsum, 32);
    const int nsel = blk < 3 ? blk : 3;
    {
        v4u pw[3][8]; float lp[3];
#pragma unroll
        for (int s = 0; s < 3; ++s) { if (s < nsel) { const bf16* prow = part_g + ((size_t)(s * 4 + h) * S_ + tq) * 128 + 64 * hh; lp[s] = lpart_g[(size_t)(s * 4 + h) * S_ + tq];
#pragma unroll
                for (int k = 0; k < 8; ++k) pw[s][k] = *(const v4u*)(prow + 8 * k); } }
#pragma unroll
        for (int s = 0; s < 3; ++s) { if (s < nsel) { lsum += lp[s];
#pragma unroll
                for (int et = 0; et < 4; ++et)
#pragma unroll
                    for (int g2 = 0; g2 < 2; ++g2) { const v4u w = pw[s][2 * et + g2];
                        acc[et][8 * g2] += bf2f(w.x & 0xffffu); acc[et][8 * g2 + 1] += bf2f(w.x >> 16); acc[et][8 * g2 + 2] += bf2f(w.y & 0xffffu); acc[et][8 * g2 + 3] += bf2f(w.y >> 16);
                        acc[et][8 * g2 + 4] += bf2f(w.z & 0xffffu); acc[et][8 * g2 + 5] += bf2f(w.z >> 16); acc[et][8 * g2 + 6] += bf2f(w.w & 0xffffu); acc[et][8 * g2 + 7] += bf2f(w.w >> 16); } } }
    }
    const float inv = 1.0f / lsum;
    bf16* orow = mixb + (size_t)tq * D_ + 512 + h * 128;
#pragma unroll
    for (int et = 0; et < 4; ++et)
#pragma unroll
        for (int g = 0; g < 4; ++g) { u2_t w; w.x = pkbf(acc[et][4 * g] * inv, acc[et][4 * g + 1] * inv); w.y = pkbf(acc[et][4 * g + 2] * inv, acc[et][4 * g + 3] * inv); *(u2_t*)(orow + 32 * et + 8 * g + 4 * hh) = w; }
    WG_SYNC();
}

struct Args { const void* in[18]; float* out; unsigned char* ws; int ph_lo, ph_hi, li, pad; };
constexpr int N_PHASES = 10;
__global__ void __launch_bounds__(NWAVES * 64, 2) mk_fwd(Args args) {
    extern __shared__ __attribute__((aligned(16))) unsigned char lds[];
    Frame F;
    F.lds = (LAS unsigned char*)lds;
    F.MISC = (volatile LAS unsigned*)(F.lds + MISC_OFF);
    F.tid = threadIdx.x; F.lane = F.tid & 63; F.wave = __builtin_amdgcn_readfirstlane(F.tid >> 6);
    F.G = gridDim.x; { const int bx = blockIdx.x; F.vcu = (F.G % 8 == 0) ? (bx % 8) * (F.G / 8) + bx / 8 : bx; }
    F.ws = args.ws; F.out = args.out; F.ctl = (gu32*)(args.ws + WS_CTL);
    if (F.tid < 32) F.MISC[F.tid] = 0u;
    if (F.tid == 0) {
#pragma unroll
        for (int k = 0; k < 18; ++k) { const unsigned long long pv = (unsigned long long)args.in[k]; F.MISC[32 + 2 * k] = (unsigned)pv; F.MISC[33 + 2 * k] = (unsigned)(pv >> 32); }
    }
    __syncthreads();
    XcdBarrier bar = xcd_barrier_post((unsigned*)(F.ctl + CW_BAR) + args.li * XCD_BAR_WORDS, F.MISC + 8);
    const int lo = args.ph_lo, hi = args.ph_hi;
#define IN(k) (lo <= (k) && (k) < hi)
#define SEAM(k) do { if (IN(k) && IN((k) + 1)) xcd_barrier(bar); STAMP((k) + 1); } while (0)
    bf16* xb = (bf16*)(F.ws + WS_AB); bf16* zb = (bf16*)(F.ws + WS_Z); bf16* mixb = (bf16*)(F.ws + WS_MIX); bf16* actb = (bf16*)(F.ws + WS_ACT); bf16* erawb = (bf16*)(F.ws + WS_ERAW);

    STAMP(0);
    if (IN(0)) { p0_prologue(F); } SEAM(0);
    if (IN(1)) {
        { pg8::Gemm g{xb, (const bf16*)(F.ws + WS_WIN), S_, ZW, D_}; pg8::StaticOrder S; S.init(S_, ZW, F.G, (int)blockIdx.x);
          const int m8_ = 4 * (F.wave & 3) + (F.lane >> 4);
          pg8::EpiZ E{zb, ZG, zm_off(0, 0), (size_t)S_ * 128, (const float*)(F.ws + WS_RSTDX), IN_pos, IN_g_mq, IN_g_mk, (PG8_LAS unsigned char*)(F.lds + RING_OFF + RING_BYTES), EPS_,
                      1.0f / powf(10000.0f, (float)(4 * m8_ + 0) / 64.0f), 1.0f / powf(10000.0f, (float)(4 * m8_ + 1) / 64.0f), 1.0f / powf(10000.0f, (float)(4 * m8_ + 2) / 64.0f), 1.0f / powf(10000.0f, (float)(4 * m8_ + 3) / 64.0f)};
          static_assert(PG8_ALIGN, "EpiZ has workgroup barriers inside: it needs ALIGN_EPI");
          pg8::gemm_phase<pg8::EpiZ, pg8::StaticOrder, true, PG8_SP2>(F.lds + RING_OFF, g, S, E); }
        { pg8::Gemm g{(const bf16*)(F.ws + WS_PB), (const bf16*)(F.ws + WS_WPP), S_, D_, PLE_}; pg8::StaticOrder S; S.init(S_, D_, F.G, (int)blockIdx.x);
          pg8::EpiRes<0> E{nullptr, erawb, (float*)(F.ws + WS_SSQE), D_, nullptr, nullptr, EPS_};
          pg8::gemm_phase<pg8::EpiRes<0>, pg8::StaticOrder, false, PG8_SP2>(F.lds + RING_OFF, g, S, E); }
    } SEAM(1);
    if (IN(2)) { for (int ch = F.vcu; ch < 256; ch += F.G) gla_a_chunk(F, ch); for (int ch = F.vcu; ch < 256; ch += F.G) moba_a_item(F, ch); } SEAM(2);
    if (IN(3)) { for (int pr = F.vcu; pr < 256; pr += F.G) gla_b_pair(F, pr); for (int pr = F.vcu; pr < 256; pr += F.G) moba_b_item(F, pr); } SEAM(3);
    if (IN(4)) { for (int ch = F.vcu; ch < 256; ch += F.G) gla_c_chunk(F, ch); moba_c_phase(F); } SEAM(4);
    if (IN(5)) { float c2, mc2; moba_shift(F, c2, mc2); for (int it = F.vcu; it < 256; it += F.G) moba_d_item(F, it, c2, mc2); } SEAM(5);
    if (IN(6)) {
        pg8::Gemm g{mixb, (const bf16*)(F.ws + WS_WOUT), S_, D_, D_}; pg8::StaticOrder S; S.init(S_, D_, F.G, (int)blockIdx.x);
        pg8::EpiRes<2> E{nullptr, xb, (float*)(F.ws + WS_SSQH1), D_, (const float*)(F.ws + WS_RSTDX), nullptr, EPS_};
        pg8::gemm_phase<pg8::EpiRes<2>, pg8::StaticOrder, false, PG8_SP2>(F.lds + RING_OFF, g, S, E);
    } SEAM(6);
    if (IN(7)) {
        pg8::Gemm g{xb, (const bf16*)(F.ws + WS_WUP), S_, FF_, D_}; pg8::StaticOrder S; S.init(S_, FF_, F.G, (int)blockIdx.x);
        pg8::EpiScale<1, 0> E{actb, FF_, nullptr, EPS_};
        pg8::gemm_phase<pg8::EpiScale<1, 0>, pg8::StaticOrder, PG8_ALIGN, PG8_SP2>(F.lds + RING_OFF, g, S, E);
    } SEAM(7);
    if (IN(8)) {
        pg8::Gemm g{actb, (const bf16*)(F.ws + WS_WDOWN), S_, D_, FF_}; pg8::StaticOrder S; S.init(S_, D_, F.G, (int)blockIdx.x);
        pg8::EpiRes<2> E{nullptr, xb, (float*)(F.ws + WS_SSQH2), D_, nullptr, (const float*)(F.ws + WS_SSQH1), EPS_};
        pg8::gemm_phase<pg8::EpiRes<2>, pg8::StaticOrder, false, PG8_SP2>(F.lds + RING_OFF, g, S, E);
    } SEAM(8);
    if (IN(9)) {
        pg8::Gemm g{xb, (const bf16*)(F.ws + WS_WPG), S_, D_, D_}; pg8::StaticOrder S; S.init(S_, D_, F.G, (int)blockIdx.x);
        pg8::EpiGate E{F.out, xb, erawb, (const float*)(F.ws + WS_SSQH2), (const float*)(F.ws + WS_SSQE), IN_g_pe, D_, EPS_};
        pg8::gemm_phase<pg8::EpiGate, pg8::StaticOrder, false, PG8_SP2>(F.lds + RING_OFF, g, S, E);
    }
#ifdef PROBE_LO
    STAMP(10);
    if (blockIdx.x == 0 && F.tid == 0) {
        const unsigned long long a_ = ((unsigned long long)F.MISC[81 + 2 * PROBE_LO] << 32) | F.MISC[80 + 2 * PROBE_LO], b_ = ((unsigned long long)F.MISC[81 + 2 * PROBE_HI] << 32) | F.MISC[80 + 2 * PROBE_HI];
        const unsigned long long d_ = (b_ - a_) * PROBE_K, t0_ = rt();
        while (rt() - t0_ < d_) __builtin_amdgcn_s_sleep(8);
    }
#endif
#undef IN
#undef SEAM
}

static void launch_range(const Args& a0, int lo, int hi, int li, int grid, hipStream_t stream) {
    Args a = a0; a.ph_lo = lo; a.ph_hi = hi; a.li = li;
    hipLaunchKernelGGL(mk_fwd, dim3(grid), dim3(NWAVES * 64), LDS_BYTES, stream, a);
    const hipError_t le = hipPeekAtLastError();
    if (le != hipSuccess) fprintf(stderr, "kernel_launch: launch [%d,%d) failed: %s\n", lo, hi, hipGetErrorName(le));
}
extern "C" void kernel_launch(void* const* d_in, const int* in_sizes, int n_in, void* d_out, int out_size, void* d_ws, size_t ws_size, hipStream_t stream) {
    static int grid = 0;
    if (grid == 0) {
        if (n_in != 18 || out_size != S_ * D_ || ws_size < WS_END) { fprintf(stderr, "kernel_launch: unexpected shapes (n_in %d out %d ws %zu)\n", n_in, out_size, ws_size); grid = -1; return; }
        int dev = 0, cus = 0, per_cu = 0;
        if (hipGetDevice(&dev) != hipSuccess || hipDeviceGetAttribute(&cus, hipDeviceAttributeMultiprocessorCount, dev) != hipSuccess) { grid = -1; return; }
        if (hipFuncSetAttribute((const void*)mk_fwd, hipFuncAttributeMaxDynamicSharedMemorySize, LDS_BYTES) != hipSuccess) { fprintf(stderr, "kernel_launch: hipFuncSetAttribute failed\n"); grid = -1; return; }
        if (hipOccupancyMaxActiveBlocksPerMultiprocessor(&per_cu, (const void*)mk_fwd, NWAVES * 64, LDS_BYTES) != hipSuccess || per_cu < 1) { fprintf(stderr, "kernel_launch: occupancy query says %d\n", per_cu); per_cu = 1; }
        (void)hipGetLastError();
        grid = cus;
        if (grid != 256) fprintf(stderr, "kernel_launch: note: %d CUs\n", grid);
    }
    if (grid < 0) return;
    (void)hipMemsetAsync((char*)d_ws + WS_CTL, 0, CTL_ZERO_BYTES, stream);
    Args a{};
    for (int i = 0; i < 18; ++i) a.in[i] = d_in[i];
    a.out = (float*)d_out; a.ws = (unsigned char*)d_ws;
    launch_range(a, 0, N_PHASES, 0, grid, stream);
}
```

```cpp
#include <hip/hip_runtime.h>
#include <cstdio>
#include <cstdint>
#include <math.h>
namespace pg8 {
#define PG8_LAS __attribute__((address_space(3)))
typedef unsigned short bf16_t;
typedef short bf16x8 __attribute__((ext_vector_type(8)));
typedef float f32x4 __attribute__((ext_vector_type(4)));
typedef unsigned u32x4 __attribute__((ext_vector_type(4)));
constexpr int BM = 256, BK = 64, HALF = 128, HTB = HALF * BK * 2  , STAGE_BYTES = 8 * HTB, NXCD = 8, WGM = 8;

__host__ __device__ __forceinline__ int lds_byte(int r, int c) { const int st = (r >> 4) * 2 + (c >> 5), rr = r & 15, cc = c & 31, ob = rr * 64 + cc * 2; return st * 1024 + (ob ^ (((ob >> 9) & 1) << 5)); }
__host__ __device__ __forceinline__ void stage_rc(int b, int& R, int& C) { const int st = b / 1024, sb = b % 1024, swz = sb ^ (((sb >> 9) & 1) << 5); R = (st >> 1) * 16 + swz / 64; C = (st & 1) * 32 + (swz % 64) / 2; }
__host__ __device__ __forceinline__ int perm32(int rho) { const int n = rho >> 4, i = rho & 15; return 8 * (i >> 2) + 4 * n + (i & 3); }

struct Unit { int pm, pn; };
struct Gemm { const bf16_t* A; const bf16_t* Bt; int M, N, K; };

struct StaticOrder {
    int nM, nN, nwg, G, c;
    __host__ __device__ void init(int M, int N, int G_, int c_) { nM = M / BM; nN = N / BM; nwg = nM * nN; G = G_; c = c_; }
    __host__ __device__ bool next(int i, Unit& u) const {
        const long L = (long)i * G + c; if (L >= nwg) return false;
        int wgid = (int)L; { const int q = nwg / NXCD, r = nwg % NXCD, xcd = wgid % NXCD, off = wgid / NXCD; wgid = (xcd < r ? xcd * (q + 1) : r * (q + 1) + (xcd - r) * q) + off; }
        const int nig = WGM * nN, gid = wgid / nig, fm = gid * WGM, gsz = (nM - fm) < WGM ? (nM - fm) : WGM;
        u.pm = fm + ((wgid % nig) % gsz); u.pn = (wgid % nig) / gsz; return true;
    }
    __device__ __forceinline__ void a_ready(const Unit&) const {}
    __device__ __forceinline__ void done(const Unit&) const {}
};

__device__ __forceinline__ unsigned cvt_pk_bf16(float lo, float hi) { unsigned r; asm volatile("v_cvt_pk_bf16_f32 %0, %1, %2" : "=v"(r) : "v"(lo), "v"(hi)); return r; }
typedef float f32x2 __attribute__((ext_vector_type(2)));

__device__ __forceinline__ void st16_wt(void* p, u32x4 v) { asm volatile("global_store_dwordx4 %0, %1, off sc1\n\ts_nop 1" :: "v"(p), "v"(v) : "memory"); }

__device__ __forceinline__ float rstd_from_part(const float* part, int row, float inv_n, float eps) {
    const f32x4 p = *(const f32x4*)(part + (size_t)row * 4);
    return __builtin_amdgcn_rsqf(((p[0] + p[1]) + (p[2] + p[3])) * inv_n + eps);
}
template <int ACT, int RS> struct EpiScale {
    static constexpr bool PERM = true, AFTER_DRAIN = false;
    bf16_t* O; int ldc; const float* rsv; float eps;
    __device__ __forceinline__ void operator()(const f32x4 (&acc)[2][2][4][2], const Unit& u, int wr, int wc, int fr, int fq) const {
        const int row0 = u.pm * BM + wr * 64 + fr, col0 = u.pn * BM + wc * 32 + 8 * fq;
#pragma unroll
        for (int ai = 0; ai < 2; ++ai)
#pragma unroll
            for (int m = 0; m < 4; ++m) {
                const int row = row0 + ai * HALF + m * 16;
                float s = 1.f;
                if (RS == 1) s = rsv[row];
                if (RS == 2) s = rstd_from_part(rsv, row, 1.0f / 1024.0f, eps);
                bf16_t* rowp = O + (size_t)row * ldc + col0;
#pragma unroll
                for (int bj = 0; bj < 2; ++bj) {
                    f32x4 v0 = acc[ai][bj][m][0] * s, v1 = acc[ai][bj][m][1] * s;
                    if (ACT == 1) {
#pragma unroll
                        for (int e = 0; e < 4; ++e) { const float a = fmaxf(v0[e], 0.f), b = fmaxf(v1[e], 0.f); v0[e] = a * a; v1[e] = b * b; }
                    }
                    u32x4 w; w.x = cvt_pk_bf16(v0[0], v0[1]); w.y = cvt_pk_bf16(v0[2], v0[3]); w.z = cvt_pk_bf16(v1[0], v1[1]); w.w = cvt_pk_bf16(v1[2], v1[3]);
                    *(u32x4*)(rowp + bj * HALF) = w;
                }
            }
    }
};
template <int RES> struct EpiRes {
    static constexpr bool PERM = true, AFTER_DRAIN = true;
    const float* base; bf16_t* hb; float* part; int ldc; const float* rsc; const float* accpart; float eps;
    __device__ __forceinline__ void fused(f32x4 (&acc)[2][2][4][2], const Unit& u, int wr, int wc, int fr, int fq, PG8_LAS unsigned char* lds, int wid, int lane) const {
        PG8_LAS float* P = (PG8_LAS float*)lds;
        const int row0 = u.pm * BM + wr * 64 + fr, col0 = u.pn * BM + wc * 32 + 8 * fq;
#pragma unroll
        for (int ai = 0; ai < 2; ++ai) {
            f32x4 pre[4][2][2]; u32x4 preb[4][2];
            if (RES == 1) {
#pragma unroll
                for (int m = 0; m < 4; ++m) { const size_t off = (size_t)(row0 + ai * HALF + m * 16) * ldc + col0;
#pragma unroll
                    for (int bj = 0; bj < 2; ++bj) { pre[m][bj][0] = __builtin_nontemporal_load((const f32x4*)(base + off + bj * HALF)); pre[m][bj][1] = __builtin_nontemporal_load((const f32x4*)(base + off + bj * HALF + 4)); } }
            }
            if (RES == 2) {
#pragma unroll
                for (int m = 0; m < 4; ++m) { const size_t off = (size_t)(row0 + ai * HALF + m * 16) * ldc + col0;
#pragma unroll
                    for (int bj = 0; bj < 2; ++bj) preb[m][bj] = *(const u32x4*)(hb + off + bj * HALF); }
            }
            float rsv4[4], asv4[4];
#pragma unroll
            for (int m = 0; m < 4; ++m) { const int row = row0 + ai * HALF + m * 16; rsv4[m] = rsc ? rsc[row] : 1.f;
                float a2 = 1.f; if (accpart) { const f32x4 p = *(const f32x4*)(accpart + (size_t)row * 4); a2 = __builtin_amdgcn_rcpf(((p[0] + p[1]) + (p[2] + p[3])) * (1.0f / 1024.0f) + eps); } asv4[m] = a2; }
#pragma unroll
            for (int m = 0; m < 4; ++m) {
                const int row = row0 + ai * HALF + m * 16;
                const size_t off = (size_t)row * ldc + col0;
                float q = 0.f;
                const float rs = rsv4[m], as2 = asv4[m];
#pragma unroll
                for (int bj = 0; bj < 2; ++bj) {
                    f32x4 v0 = acc[ai][bj][m][0] * as2, v1 = acc[ai][bj][m][1] * as2;
                    if (RES == 1) { v0 = v0 + pre[m][bj][0]; v1 = v1 + pre[m][bj][1]; }
                    if (RES == 2) { const u32x4 ew = preb[m][bj];
                        v0[0] += rs * __uint_as_float(ew.x << 16); v0[1] += rs * __uint_as_float(ew.x & 0xffff0000u); v0[2] += rs * __uint_as_float(ew.y << 16); v0[3] += rs * __uint_as_float(ew.y & 0xffff0000u);
                        v1[0] += rs * __uint_as_float(ew.z << 16); v1[1] += rs * __uint_as_float(ew.z & 0xffff0000u); v1[2] += rs * __uint_as_float(ew.w << 16); v1[3] += rs * __uint_as_float(ew.w & 0xffff0000u); }
                    u32x4 w; w.x = cvt_pk_bf16(v0[0], v0[1]); w.y = cvt_pk_bf16(v0[2], v0[3]); w.z = cvt_pk_bf16(v1[0], v1[1]); w.w = cvt_pk_bf16(v1[2], v1[3]);
                    *(u32x4*)(hb + off + bj * HALF) = w;
                    q += (v0[0] * v0[0] + v0[1] * v0[1]) + (v0[2] * v0[2] + v0[3] * v0[3]) + (v1[0] * v1[0] + v1[1] * v1[1]) + (v1[2] * v1[2] + v1[3] * v1[3]);
                }
                q += __shfl_xor(q, 16); q += __shfl_xor(q, 32);
                if (fq == 0) P[(ai * HALF + wr * 64 + m * 16 + fr) * 4 + wc] = q;
            }
        }
        asm volatile("s_waitcnt lgkmcnt(0)" ::: "memory"); __builtin_amdgcn_s_barrier(); asm volatile("" ::: "memory");
        const int tid = wid * 64 + lane;
        if (tid < 256) { const f32x4 p = ((const PG8_LAS f32x4*)lds)[tid]; part[(size_t)(u.pm * BM + tid) * 4 + u.pn] = (p[0] + p[1]) + (p[2] + p[3]); }
        asm volatile("s_waitcnt lgkmcnt(0)" ::: "memory"); __builtin_amdgcn_s_barrier(); asm volatile("" ::: "memory");
    }
};
__device__ __forceinline__ void sincos_rope(float a, float& s, float& c) {
    const float k = __builtin_rintf(a * 0.15915494309189535f);
    float r = __builtin_fmaf(-k, 6.28125f, a);
    r = __builtin_fmaf(-k, 0.0019353071693331003f, r);
    r = __builtin_fmaf(-k, 1.0253131677018246e-11f, r);
    const float rev = r * 0.15915494309189535f;
    s = __builtin_amdgcn_sinf(rev); c = __builtin_amdgcn_cosf(rev);
}
template <int CTRL> __device__ __forceinline__ float dpp_mov_pg(float v) { return __builtin_bit_cast(float, __builtin_amdgcn_update_dpp(0, __builtin_bit_cast(int, v), CTRL, 0xf, 0xf, true)); }
__device__ __forceinline__ float row16_sum_pg(float v) { v += dpp_mov_pg<0xB1>(v); v += dpp_mov_pg<0x4E>(v); v += dpp_mov_pg<0x141>(v); v += dpp_mov_pg<0x140>(v); return v; }
struct EpiZ {
    static constexpr bool PERM = true, AFTER_DRAIN = false;
    bf16_t* O; int ldc; size_t hm_base, hm_head; const float* rstdx; const int* pos; const float* gq; const float* gk; PG8_LAS unsigned char* xr; float eps; float inv0, inv1, inv2, inv3;
    __device__ __forceinline__ void operator()(const f32x4 (&acc)[2][2][4][2], const Unit& u, int wr, int wc, int fr, int fq) const {
        const int row0 = u.pm * BM + wr * 64 + fr, col0 = u.pn * BM + wc * 32 + 8 * fq;
        const int type = (u.pn >= 6 && u.pn < 8) ? 1 : ((u.pn >= 8 && u.pn < 10) ? 2 : 0);
        const size_t hm0 = hm_base + (size_t)((u.pn >= 6 ? ((u.pn - 6) >> 1) * 4 + 2 * (u.pn & 1) : 0)) * hm_head; const size_t bjstep = (u.pn < 6) ? (size_t)HALF : hm_head;
        if (type == 0) {
#pragma unroll
            for (int ai = 0; ai < 2; ++ai)
#pragma unroll
                for (int m = 0; m < 4; ++m) {
                    const int row = row0 + ai * HALF + m * 16; const float s = 1.f;
                    bf16_t* rowp = (u.pn < 6) ? O + (size_t)row * ldc + col0 : O + hm0 + (size_t)row * 128 + wc * 32 + 8 * fq;
#pragma unroll
                    for (int bj = 0; bj < 2; ++bj) { const f32x4 v0 = acc[ai][bj][m][0] * s, v1 = acc[ai][bj][m][1] * s;
                        u32x4 w; w.x = cvt_pk_bf16(v0[0], v0[1]); w.y = cvt_pk_bf16(v0[2], v0[3]); w.z = cvt_pk_bf16(v1[0], v1[1]); w.w = cvt_pk_bf16(v1[2], v1[3]);
                        *(u32x4*)(rowp + (size_t)bj * bjstep) = w; }
                }
            return;
        }
        PG8_LAS float* P = (PG8_LAS float*)xr;
        const float* g = type == 1 ? gq : gk;
        const int m8 = 4 * wc + fq;
        const f32x4 g1 = *(const f32x4*)(g + 4 * m8), g2 = *(const f32x4*)(g + 64 + 4 * m8);
        float rsx[8], pfx[8];
#pragma unroll
        for (int ai = 0; ai < 2; ++ai)
#pragma unroll
            for (int m = 0; m < 4; ++m) { const int row = u.pm * BM + ai * HALF + wr * 64 + m * 16 + fr; rsx[ai * 4 + m] = 1.f; pfx[ai * 4 + m] = (float)pos[row]; }
#pragma unroll
        for (int ai = 0; ai < 2; ++ai)
#pragma unroll
            for (int m = 0; m < 4; ++m) {
                const int rl = ai * HALF + wr * 64 + m * 16 + fr; const float s = rsx[ai * 4 + m];
#pragma unroll
                for (int bj = 0; bj < 2; ++bj) { const f32x4 v0 = acc[ai][bj][m][0] * s, v1 = acc[ai][bj][m][1] * s;
                    float q = (v0[0] * v0[0] + v0[1] * v0[1]) + (v0[2] * v0[2] + v0[3] * v0[3]) + (v1[0] * v1[0] + v1[1] * v1[1]) + (v1[2] * v1[2] + v1[3] * v1[3]);
                    q += __shfl_xor(q, 16); q += __shfl_xor(q, 32);
                    if (fq == 0) P[(rl * 2 + bj) * 4 + wc] = q; }
            }
        asm volatile("s_waitcnt lgkmcnt(0)" ::: "memory"); __builtin_amdgcn_s_barrier(); asm volatile("" ::: "memory");
#pragma unroll
        for (int ai = 0; ai < 2; ++ai)
#pragma unroll
            for (int m = 0; m < 4; ++m) {
                const int rl = ai * HALF + wr * 64 + m * 16 + fr, row = u.pm * BM + rl; const float s = rsx[ai * 4 + m]; const float pf = pfx[ai * 4 + m];
                f32x4 sn, cs;
                { float a, b; sincos_rope(pf * inv0, a, b); sn[0] = a; cs[0] = b; sincos_rope(pf * inv1, a, b); sn[1] = a; cs[1] = b; sincos_rope(pf * inv2, a, b); sn[2] = a; cs[2] = b; sincos_rope(pf * inv3, a, b); sn[3] = a; cs[3] = b; }
                bf16_t* rowp = O + hm0 + (size_t)row * 128 + wc * 32 + 8 * fq;
#pragma unroll
                for (int bj = 0; bj < 2; ++bj) {
                    const f32x4 pr = *(const PG8_LAS f32x4*)(P + (rl * 2 + bj) * 4);
                    const float sc = s * __builtin_amdgcn_rsqf(((pr[0] + pr[1]) + (pr[2] + pr[3])) * (1.0f / 128.0f) + eps);
                    const f32x4 y1 = acc[ai][bj][m][0] * sc * g1, y2 = acc[ai][bj][m][1] * sc * g2;
                    const f32x4 o1 = y1 * cs - y2 * sn, o2 = y2 * cs + y1 * sn;
                    u32x4 w; w.x = cvt_pk_bf16(o1[0], o1[1]); w.y = cvt_pk_bf16(o1[2], o1[3]); w.z = cvt_pk_bf16(o2[0], o2[1]); w.w = cvt_pk_bf16(o2[2], o2[3]);
                    *(u32x4*)(rowp + (size_t)bj * hm_head) = w;
                }
            }
    }
};
struct EpiGate {
    static constexpr bool PERM = true, AFTER_DRAIN = false;
    float* out; const bf16_t* hb; const bf16_t* eraw; const float* part_h; const float* part_e; const float* g_emb; int ldc; float eps;
    __device__ __forceinline__ void operator()(const f32x4 (&acc)[2][2][4][2], const Unit& u, int wr, int wc, int fr, int fq) const {
        const int row0 = u.pm * BM + wr * 64 + fr, col0 = u.pn * BM + wc * 32 + 8 * fq;
        f32x4 gv[2][2];
#pragma unroll
        for (int bj = 0; bj < 2; ++bj) { gv[bj][0] = *(const f32x4*)(g_emb + col0 + bj * HALF); gv[bj][1] = *(const f32x4*)(g_emb + col0 + bj * HALF + 4); }
#pragma unroll
        for (int ai = 0; ai < 2; ++ai)
#pragma unroll
            for (int mp = 0; mp < 2; ++mp) {
                u32x4 hv[2][2]; u32x4 ewv[2][2]; float sh[2], se[2];
#pragma unroll
                for (int mm = 0; mm < 2; ++mm) { const int row = row0 + ai * HALF + (2 * mp + mm) * 16; const size_t off = (size_t)row * ldc + col0;
                    sh[mm] = rstd_from_part(part_h, row, 1.0f / 1024.0f, eps); se[mm] = rstd_from_part(part_e, row, 1.0f / 1024.0f, eps);
#pragma unroll
                    for (int bj = 0; bj < 2; ++bj) { ewv[mm][bj] = __builtin_nontemporal_load((const u32x4*)(eraw + off + bj * HALF)); hv[mm][bj] = __builtin_nontemporal_load((const u32x4*)(hb + off + bj * HALF)); } }
#pragma unroll
                for (int mm = 0; mm < 2; ++mm) { const int m = 2 * mp + mm; const int row = row0 + ai * HALF + m * 16; const size_t off = (size_t)row * ldc + col0;
#pragma unroll
                    for (int bj = 0; bj < 2; ++bj) {
                        const u32x4 ew = ewv[mm][bj];
                        f32x4 e0, e1;
                        e0[0] = __uint_as_float(ew.x << 16); e0[1] = __uint_as_float(ew.x & 0xffff0000u); e0[2] = __uint_as_float(ew.y << 16); e0[3] = __uint_as_float(ew.y & 0xffff0000u);
                        e1[0] = __uint_as_float(ew.z << 16); e1[1] = __uint_as_float(ew.z & 0xffff0000u); e1[2] = __uint_as_float(ew.w << 16); e1[3] = __uint_as_float(ew.w & 0xffff0000u);
                        const u32x4 hw = hv[mm][bj];
                        f32x4 h0, h1;
                        h0[0] = __uint_as_float(hw.x << 16); h0[1] = __uint_as_float(hw.x & 0xffff0000u); h0[2] = __uint_as_float(hw.y << 16); h0[3] = __uint_as_float(hw.y & 0xffff0000u);
                        h1[0] = __uint_as_float(hw.z << 16); h1[1] = __uint_as_float(hw.z & 0xffff0000u); h1[2] = __uint_as_float(hw.w << 16); h1[3] = __uint_as_float(hw.w & 0xffff0000u);
                        const f32x4 a0 = acc[ai][bj][m][0] * sh[mm], a1 = acc[ai][bj][m][1] * sh[mm];
#pragma unroll
                        for (int e = 0; e < 4; ++e) {
                            const float g0 = __builtin_amdgcn_rcpf(1.0f + __expf(-a0[e])), g1 = __builtin_amdgcn_rcpf(1.0f + __expf(-a1[e]));
                            h0[e] += g0 * (e0[e] * se[mm] * gv[bj][0][e]); h1[e] += g1 * (e1[e] * se[mm] * gv[bj][1][e]);
                        }
                        __builtin_nontemporal_store(h0, (f32x4*)(out + off + bj * HALF)); __builtin_nontemporal_store(h1, (f32x4*)(out + off + bj * HALF + 4));
                    } }
            }
    }
};
template <class Epi, class Sched, bool ALIGN_EPI = false, bool SP2 = false>
__device__ __forceinline__ void gemm_phase(PG8_LAS unsigned char* lds, const Gemm g, const Sched& S, const Epi& E) {
    const int tid = threadIdx.x, wid = __builtin_amdgcn_readfirstlane(tid >> 6), lane = tid & 63, wr = wid >> 2, wc = wid & 3, fr = lane & 15, fq = lane >> 4;
    const int K = g.K, nt = K / BK;
    unsigned voffA[2], voffB[2];
#pragma unroll
    for (int i = 0; i < 2; ++i) { int R, C; stage_rc(tid * 16 + i * 8192, R, C); const int Rb = Epi::PERM ? ((R & ~31) + perm32(R & 31)) : R;
        voffA[i] = (unsigned)(R * K + C) * 2u; voffB[i] = (unsigned)(Rb * K + C) * 2u; }
    const size_t kstep = (size_t)(BK * 2);
    const size_t hstep = (size_t)HALF * K * 2;
    const size_t tstep = 2 * hstep;
    const unsigned ldsw = (unsigned)wid * 1024u;
    const int aoff = lds_byte(wr * 64 + fr, fq * 8), boff = lds_byte(wc * 32 + fr, fq * 8);
#define PG8_SA(b, h) (((b) * 2 + (h)) * HTB)
#define PG8_SB(b, h) ((4 + (b) * 2 + (h)) * HTB)
#define PG8_STAGE(bufoff, gbase, voff) do { _Pragma("unroll") for (int _i = 0; _i < 2; ++_i) \
        __builtin_amdgcn_global_load_lds((const unsigned*)((const char*)(gbase) + (voff)[_i]), (PG8_LAS unsigned*)(lds + (bufoff) + ldsw + _i * 8192), 16, 0, 0); } while (0)
#define PG8_LDA(dst, b, h) do { _Pragma("unroll") for (int m = 0; m < 4; ++m) _Pragma("unroll") for (int k = 0; k < 2; ++k) dst[m][k] = *(const PG8_LAS bf16x8*)(lds + PG8_SA(b, h) + aoff + m * 2048 + k * 1024); } while (0)
#define PG8_LDB(dst, b, h) do { _Pragma("unroll") for (int n = 0; n < 2; ++n) _Pragma("unroll") for (int k = 0; k < 2; ++k) dst[n][k] = *(const PG8_LAS bf16x8*)(lds + PG8_SB(b, h) + boff + n * 2048 + k * 1024); } while (0)
#define PG8_MMA(ai, bj, At, Bt) do { __builtin_amdgcn_s_setprio(1); _Pragma("unroll") for (int m = 0; m < 4; ++m) _Pragma("unroll") for (int n = 0; n < 2; ++n) _Pragma("unroll") for (int k = 0; k < 2; ++k) \
        acc[ai][bj][m][n] = __builtin_amdgcn_mfma_f32_16x16x32_bf16(Bt[n][k], At[m][k], acc[ai][bj][m][n], 0, 0, 0); __builtin_amdgcn_s_setprio(0); } while (0)
#define PG8_WAIT_V(n) asm volatile("s_waitcnt vmcnt(" #n ")" ::: "memory")
#define PG8_WAIT_L(n) asm volatile("s_waitcnt lgkmcnt(" #n ")" ::: "memory")
#define PG8_BAR __builtin_amdgcn_s_barrier()
#define PG8_SCHED __builtin_amdgcn_sched_barrier(0)
    Unit cur, nxt; int ui = 0;
    if (!S.next(0, cur)) return;
    f32x4 acc[2][2][4][2];
#pragma unroll
    for (int a = 0; a < 2; ++a)
#pragma unroll
        for (int b = 0; b < 2; ++b)
#pragma unroll
            for (int m = 0; m < 4; ++m)
#pragma unroll
                for (int n = 0; n < 2; ++n) acc[a][b][m][n] = (f32x4){0.f, 0.f, 0.f, 0.f};
    bf16x8 At[4][2], B0[2][2], B1[2][2];
    const char* cA = (const char*)g.A + (size_t)cur.pm * tstep; const char* cB = (const char*)g.Bt + (size_t)cur.pn * tstep;
    S.a_ready(cur);
    if constexpr (SP2) {
        PG8_STAGE(PG8_SB(0, 0), cB, voffB); PG8_STAGE(PG8_SB(0, 1), cB + hstep, voffB); PG8_STAGE(PG8_SA(0, 0), cA, voffA); PG8_STAGE(PG8_SA(0, 1), cA + hstep, voffA);
        if (wr == 1) PG8_BAR;
        PG8_WAIT_V(2); PG8_BAR;
        PG8_STAGE(PG8_SB(1, 0), cB + kstep, voffB); PG8_STAGE(PG8_SA(1, 0), cA + kstep, voffA); PG8_STAGE(PG8_SB(1, 1), cB + hstep + kstep, voffB);
        PG8_WAIT_V(6); PG8_BAR;
    } else {
        PG8_STAGE(PG8_SB(0, 0), cB, voffB); PG8_STAGE(PG8_SA(0, 0), cA, voffA); PG8_STAGE(PG8_SB(0, 1), cB + hstep, voffB); PG8_STAGE(PG8_SA(0, 1), cA + hstep, voffA);
        if (wr == 1) PG8_BAR;
        PG8_WAIT_V(4); PG8_BAR;
        PG8_STAGE(PG8_SB(1, 0), cB + kstep, voffB); PG8_STAGE(PG8_SA(1, 0), cA + kstep, voffA); PG8_STAGE(PG8_SB(1, 1), cB + hstep + kstep, voffB);
        PG8_WAIT_V(6); PG8_BAR;
    }
    for (;;) {
        const bool has_next = S.next(ui + 1, nxt);
        const char* nA = has_next ? (const char*)g.A + (size_t)nxt.pm * tstep : cA; const char* nB = has_next ? (const char*)g.Bt + (size_t)nxt.pn * tstep : cB;
        for (int t = 0; t < nt; t += 2) {
            const bool last = (t == nt - 2);
            const char* a1 = cA + (size_t)(t + 1) * kstep;
            const char* a2 = last ? nA : cA + (size_t)(t + 2) * kstep; const char* b2 = last ? nB : cB + (size_t)(t + 2) * kstep;
            const char* a3 = a2 + kstep; const char* b3 = b2 + kstep;
            if (last && has_next) S.a_ready(nxt);
            if constexpr (SP2) {
            PG8_LDB(B0, 0, 0); PG8_LDB(B1, 0, 1); PG8_SCHED; PG8_LDA(At, 0, 0); PG8_STAGE(PG8_SA(1, 1), a1 + hstep, voffA);
            PG8_WAIT_V(8); PG8_WAIT_L(0); PG8_BAR; PG8_MMA(0, 0, At, B0); PG8_MMA(0, 1, At, B1); PG8_BAR; PG8_SCHED;
            PG8_LDA(At, 0, 1); PG8_STAGE(PG8_SB(0, 0), b2, voffB); PG8_STAGE(PG8_SB(0, 1), b2 + hstep, voffB); PG8_STAGE(PG8_SA(0, 0), a2, voffA);
            PG8_WAIT_V(8); PG8_WAIT_L(0); PG8_BAR; PG8_MMA(1, 0, At, B0); PG8_MMA(1, 1, At, B1); PG8_BAR; PG8_SCHED;
            PG8_LDB(B0, 1, 0); PG8_LDB(B1, 1, 1); PG8_SCHED; PG8_LDA(At, 1, 0); PG8_STAGE(PG8_SA(0, 1), a2 + hstep, voffA);
            PG8_WAIT_V(8); PG8_WAIT_L(0); PG8_BAR; PG8_MMA(0, 0, At, B0); PG8_MMA(0, 1, At, B1); PG8_BAR; PG8_SCHED;
            PG8_LDA(At, 1, 1); PG8_STAGE(PG8_SB(1, 0), b3, voffB); PG8_STAGE(PG8_SB(1, 1), b3 + hstep, voffB); PG8_STAGE(PG8_SA(1, 0), a3, voffA);
            PG8_WAIT_V(8); PG8_WAIT_L(0); PG8_BAR; PG8_MMA(1, 0, At, B0); PG8_MMA(1, 1, At, B1); PG8_BAR; PG8_SCHED;
            } else {
            PG8_LDB(B0, 0, 0); PG8_SCHED; PG8_LDA(At, 0, 0); PG8_STAGE(PG8_SA(1, 1), a1 + hstep, voffA);
            PG8_WAIT_L(8); PG8_BAR; PG8_WAIT_L(0); PG8_MMA(0, 0, At, B0); PG8_BAR; PG8_SCHED;
            PG8_LDB(B1, 0, 1); PG8_STAGE(PG8_SB(0, 0), b2, voffB);
            PG8_BAR; PG8_WAIT_L(0); PG8_MMA(0, 1, At, B1); PG8_BAR;
            PG8_LDA(At, 0, 1); PG8_STAGE(PG8_SA(0, 0), a2, voffA);
            PG8_BAR; PG8_WAIT_L(0); PG8_MMA(1, 0, At, B0); PG8_BAR; PG8_SCHED;
            PG8_STAGE(PG8_SB(0, 1), b2 + hstep, voffB);
            PG8_WAIT_V(6); PG8_BAR; PG8_MMA(1, 1, At, B1); PG8_BAR;
            PG8_LDB(B0, 1, 0); PG8_SCHED; PG8_LDA(At, 1, 0); PG8_STAGE(PG8_SA(0, 1), a2 + hstep, voffA);
            PG8_WAIT_L(8); PG8_BAR; PG8_WAIT_L(0); PG8_MMA(0, 0, At, B0); PG8_BAR; PG8_SCHED;
            PG8_LDB(B1, 1, 1); PG8_STAGE(PG8_SB(1, 0), b3, voffB);
            PG8_BAR; PG8_WAIT_L(0); PG8_MMA(0, 1, At, B1); PG8_BAR;
            PG8_LDA(At, 1, 1); PG8_STAGE(PG8_SA(1, 0), a3, voffA);
            PG8_BAR; PG8_WAIT_L(0); PG8_MMA(1, 0, At, B0); PG8_BAR; PG8_SCHED;
            PG8_STAGE(PG8_SB(1, 1), b3 + hstep, voffB);
            PG8_WAIT_V(6); PG8_BAR; PG8_MMA(1, 1, At, B1); PG8_BAR;
            }
        }
        if constexpr (ALIGN_EPI) { if (wr == 0) PG8_BAR; }
        if constexpr (!Epi::AFTER_DRAIN) { E(acc, cur, wr, wc, fr, fq); S.done(cur); }
        if (!has_next) break;
#pragma unroll
        for (int a = 0; a < 2; ++a)
#pragma unroll
            for (int b = 0; b < 2; ++b)
#pragma unroll
                for (int m = 0; m < 4; ++m)
#pragma unroll
                    for (int n = 0; n < 2; ++n) acc[a][b][m][n] = (f32x4){0.f, 0.f, 0.f, 0.f};
        cur = nxt; cA = nA; cB = nB; ++ui;
        if constexpr (ALIGN_EPI) { if (wr == 1) PG8_BAR; }
    }
    PG8_WAIT_V(0);
    if constexpr (!ALIGN_EPI) { if (wr == 0) PG8_BAR; }
    PG8_BAR;
    if constexpr (Epi::AFTER_DRAIN) { E.fused(acc, cur, wr, wc, fr, fq, lds, wid, lane); S.done(cur); }
#undef PG8_SA
#undef PG8_SB
#undef PG8_STAGE
#undef PG8_LDA
#undef PG8_LDB
#undef PG8_MMA
#undef PG8_WAIT_V
#undef PG8_WAIT_L
#undef PG8_BAR
#undef PG8_SCHED
}
}
#ifndef PG8_SP2
#define PG8_SP2 true
#endif
#ifndef PG8_ALIGN
#define PG8_ALIGN true
#endif

constexpr int NWAVES = 8;
constexpr int S_ = 16384, D_ = 1024, FF_ = 4096, PLE_ = 256, INW_ = 3088, ZW = 3072;
constexpr int Z_GQ = 0, Z_GK = 256, Z_GV = 512, Z_GG = 1024, Z_MQ = 1536, Z_MK = 2048, Z_MV = 2560;
constexpr int ZG = 1536;
__device__ __forceinline__ size_t zm_off(int which, int h) { return (size_t)48 * 1024 * 1024 / 2 + (size_t)(which * 4 + h) * S_ * 128; }
constexpr float EPS_ = 1e-6f;

constexpr size_t MiB = 1u << 20, KiB = 1u << 10;
constexpr size_t WS_CTL = 0, CTL_ZERO_BYTES = 64 * KiB;
constexpr size_t WS_WIN = 1 * MiB, WS_WOUT = 7 * MiB, WS_WUP = 9 * MiB, WS_WDOWN = 17 * MiB, WS_WPG = 25 * MiB, WS_WPP = 27 * MiB, WS_WGA = 27 * MiB + 512 * KiB;
constexpr size_t WS_SMALL = 28 * MiB;
constexpr size_t WS_RSTDX = WS_SMALL, WS_GA = WS_SMALL + 64 * KiB, WS_DECAY = WS_SMALL + 1088 * KiB, WS_KMEAN = WS_SMALL + 1344 * KiB,
                 WS_SSQH1 = WS_SMALL + 1472 * KiB, WS_SSQH2 = WS_SMALL + 1728 * KiB, WS_SSQE = WS_SMALL + 1984 * KiB, WS_LPART = WS_SMALL + 2240 * KiB;
constexpr size_t WS_ERAW = 32 * MiB, WS_AB = 64 * MiB, WS_Z = 96 * MiB, WS_MIX = 192 * MiB, WS_PB = 224 * MiB, WS_ACT = 96 * MiB, WS_END = 256 * MiB;
constexpr size_t WS_DS = 224 * MiB  , WS_LIST = 240 * MiB  ;
constexpr size_t OUT_PART = 0  , OUT_SPREV = 48 * MiB  ;
constexpr int CW_TMO = 0, CW_CNT = 1024  , CW_BAR = 4096;

constexpr int RING_OFF = 0, RING_BYTES = 131072;
constexpr int LDS_BYTES = 160 * 1024;
constexpr int MISC_OFF = LDS_BYTES - 512;

#define GAS __attribute__((address_space(1)))
#define LAS __attribute__((address_space(3)))
typedef unsigned short bf16;
typedef unsigned v4u __attribute__((ext_vector_type(4)));
typedef float f32x4 __attribute__((ext_vector_type(4)));
typedef short bf16x8 __attribute__((ext_vector_type(8)));
typedef GAS unsigned gu32;
typedef GAS unsigned long long gu64;
#define RLX_AGENT __ATOMIC_RELAXED, __HIP_MEMORY_SCOPE_AGENT
#define LDS_WAIT() asm volatile("s_waitcnt lgkmcnt(0)" ::: "memory")
#define VM_WAIT() asm volatile("s_waitcnt vmcnt(0)" ::: "memory")
__device__ __forceinline__ unsigned long long rt() { return __builtin_amdgcn_s_memrealtime(); }
__device__ __forceinline__ unsigned f2bf(float f) { unsigned u = __builtin_bit_cast(unsigned, f); return (u + 0x7fffu + ((u >> 16) & 1u)) >> 16; }
__device__ __forceinline__ unsigned pk2(float lo, float hi) { return f2bf(lo) | (f2bf(hi) << 16); }

#define XB_TMO      128
#define XB_XCNT(j)  (256  + 64 * (j))
#define XB_XSUB(j)  (1280 + 64 * (j))
#define XB_XGEN(j)  (2304 + 64 * (j))
#define XB_TOP      3328
#define XB_TOPGEN   3392
#define XCD_BAR_WORDS 3456
#define XB_SPIN_CAP (1u << 18)

__device__ __forceinline__ unsigned xb_ld(unsigned* p)              { return __hip_atomic_load(p, __ATOMIC_RELAXED, __HIP_MEMORY_SCOPE_AGENT); }
__device__ __forceinline__ unsigned xb_add(unsigned* p, unsigned v) { return __hip_atomic_fetch_add(p, v, __ATOMIC_RELAXED, __HIP_MEMORY_SCOPE_AGENT); }
__device__ __forceinline__ unsigned xb_xcc_id() { return (unsigned)__builtin_amdgcn_s_getreg((3 << 11) | 20) & 0xFu; }
#define XB_SPIN(cond, bar) do { unsigned _sp = 0; while (cond) { __builtin_amdgcn_s_sleep(1); \
    if ((++_sp & 255u) == 0u) { if (xb_ld(&(bar)[XB_TMO])) break; if (_sp > XB_SPIN_CAP) { atomicAdd(&(bar)[XB_TMO], 1u); break; } } } } while (0)

struct XcdBarrier {
    unsigned* bar; unsigned x;
    volatile LAS unsigned* st;
};

__device__ __forceinline__ XcdBarrier xcd_barrier_post(unsigned* bar, volatile LAS unsigned* st) {
    XcdBarrier b; b.bar = bar; b.x = xb_xcc_id(); b.st = st;
    if (threadIdx.x == 0) (void)xb_add(&bar[XB_XCNT(b.x)], 1u);
    return b;
}
__device__ __forceinline__ void xcd_barrier_complete(unsigned* bar, unsigned x, unsigned& nloc, unsigned& nx) {
    const unsigned G = gridDim.x * gridDim.y * gridDim.z;
    unsigned sum, cnt, mine, sp = 0u;
    for (;;) {
        sum = 0u; cnt = 0u; mine = 0u;
#pragma unroll
        for (unsigned j = 0; j < 16; ++j) { const unsigned c = xb_ld(&bar[XB_XCNT(j)]); sum += c; cnt += (c > 0u) ? 1u : 0u; mine = (j == x) ? c : mine; }
        if (sum == G) break;
        __builtin_amdgcn_s_sleep(1);
        if ((++sp & 255u) == 0u) { if (xb_ld(&bar[XB_TMO])) break; if (sp > XB_SPIN_CAP) { atomicAdd(&bar[XB_TMO], 1u); break; } }
    }
    nloc = mine > 0u ? mine : 1u; nx = cnt > 0u ? cnt : 1u;
}

__device__ __forceinline__ void xcd_barrier(const XcdBarrier& b) {
    asm volatile("s_waitcnt vmcnt(0)" ::: "memory");
    __syncthreads();
    if (threadIdx.x == 0) {
        unsigned* bar = b.bar;
        __builtin_amdgcn_s_waitcnt(0);
        unsigned nloc = b.st[0], nx = b.st[1];
        if (nloc == 0u) { xcd_barrier_complete(bar, b.x, nloc, nx); b.st[0] = nloc; b.st[1] = nx; }
        const unsigned old = xb_add(&bar[XB_XSUB(b.x)], 1u);
        const unsigned gen = old / nloc;
        if (old + 1u == (gen + 1u) * nloc) {
            __builtin_amdgcn_fence(__ATOMIC_RELEASE, "agent");
            asm volatile("s_waitcnt vmcnt(0)" ::: "memory");
            const unsigned og = xb_add(&bar[XB_TOP], 1u);
            const unsigned tg = og / nx;
            if (og + 1u == (tg + 1u) * nx) xb_add(&bar[XB_TOPGEN], 1u);
            else XB_SPIN(xb_ld(&bar[XB_TOPGEN]) == tg, bar);
            __builtin_amdgcn_fence(__ATOMIC_ACQUIRE, "agent");
            xb_add(&bar[XB_XGEN(b.x)], 1u);
            asm volatile("s_waitcnt vmcnt(0)" ::: "memory");
        } else {
            XB_SPIN(xb_ld(&bar[XB_XGEN(b.x)]) == gen, bar);
            __builtin_amdgcn_fence(__ATOMIC_ACQUIRE, "agent");
            asm volatile("s_waitcnt vmcnt(0)" ::: "memory");
        }
    }
    __syncthreads();
}

struct Frame {
    LAS unsigned char* lds;
    volatile LAS unsigned* MISC;
    gu32* ctl;
    int tid, lane, wave, vcu, G;
    unsigned char* ws; float* out;
};
__device__ __forceinline__ const void* in_ptr(const Frame& F, int k) {
    const unsigned lo = __builtin_amdgcn_readfirstlane(F.MISC[32 + 2 * k]), hi = __builtin_amdgcn_readfirstlane(F.MISC[33 + 2 * k]);
    return (const void*)(((unsigned long long)hi << 32) | lo);
}
#define IN_x ((const float*)in_ptr(F, 0))
#define IN_p ((const float*)in_ptr(F, 1))
#define IN_pos ((const int*)in_ptr(F, 2))
#define IN_g_mix ((const float*)in_ptr(F, 3))
#define IN_w_in ((const float*)in_ptr(F, 4))
#define IN_w_a2 ((const float*)in_ptr(F, 5))
#define IN_b_a ((const float*)in_ptr(F, 6))
#define IN_g_gla ((const float*)in_ptr(F, 7))
#define IN_g_mq ((const float*)in_ptr(F, 8))
#define IN_g_mk ((const float*)in_ptr(F, 9))
#define IN_w_out ((const float*)in_ptr(F, 10))
#define IN_g_ffn ((const float*)in_ptr(F, 11))
#define IN_w_up ((const float*)in_ptr(F, 12))
#define IN_w_down ((const float*)in_ptr(F, 13))
#define IN_g_pg ((const float*)in_ptr(F, 14))
#define IN_w_pg ((const float*)in_ptr(F, 15))
#define IN_w_pp ((const float*)in_ptr(F, 16))
#define IN_g_pe ((const float*)in_ptr(F, 17))
template <int CTRL> __device__ __forceinline__ float dpp_mov(float v) { return __builtin_bit_cast(float, __builtin_amdgcn_update_dpp(0, __builtin_bit_cast(int, v), CTRL, 0xf, 0xf, true)); }
__device__ __forceinline__ float row16_sum(float v) { v += dpp_mov<0xB1>(v); v += dpp_mov<0x4E>(v); v += dpp_mov<0x141>(v); v += dpp_mov<0x140>(v); return v; }
__device__ __forceinline__ float wave_sum(float v) {
    v = row16_sum(v);
    const float s0 = __builtin_bit_cast(float, __builtin_amdgcn_readlane(__builtin_bit_cast(int, v), 0)), s1 = __builtin_bit_cast(float, __builtin_amdgcn_readlane(__builtin_bit_cast(int, v), 16));
    const float s2 = __builtin_bit_cast(float, __builtin_amdgcn_readlane(__builtin_bit_cast(int, v), 32)), s3 = __builtin_bit_cast(float, __builtin_amdgcn_readlane(__builtin_bit_cast(int, v), 48));
    return (s0 + s1) + (s2 + s3);
}
__device__ __forceinline__ float bf2f(unsigned v16) { return __uint_as_float(v16 << 16); }

#ifdef PROBE_LO
#define STAMP(k) do { if (blockIdx.x == 0 && F.tid == 0) { const unsigned long long t_ = rt(); F.MISC[80 + 2 * (k)] = (unsigned)t_; F.MISC[81 + 2 * (k)] = (unsigned)(t_ >> 32); } } while (0)
#else
#define STAMP(k) do { } while (0)
#endif
struct TItem { const float* W; const float* gain; bf16* WT; int ldn, src_col, K, n_dst, k0, perm; };
__device__ __forceinline__ TItem p0_decode(const Frame& F, int it) {
    constexpr int I_IN = (D_ / 64) * (ZW / 32), I_OUT = (D_ / 64) * (D_ / 32), I_UP = (D_ / 64) * (FF_ / 32), I_DN = (FF_ / 64) * (D_ / 32), I_PG = I_OUT;
    TItem t; int r = it;
    t.perm = -1;
    if (r < I_IN) { const int nb = r % (ZW / 32), kb = r / (ZW / 32), n0 = 32 * nb; t.W = IN_w_in; t.gain = IN_g_mix; t.WT = (bf16*)(F.ws + WS_WIN); t.ldn = INW_; t.K = D_; t.n_dst = n0; t.k0 = 64 * kb;
        if (n0 >= Z_MQ && n0 < Z_MV) { t.perm = (n0 & 127) >> 5; t.src_col = (n0 & ~127) + 16; }
        else t.src_col = n0 < 1536 ? n0 : n0 + 16;
        return t; } r -= I_IN;
    if (r < I_OUT) { const int nb = r % (D_ / 32), kb = r / (D_ / 32); t.W = IN_w_out; t.gain = nullptr; t.WT = (bf16*)(F.ws + WS_WOUT); t.ldn = D_; t.src_col = 32 * nb; t.K = D_; t.n_dst = 32 * nb; t.k0 = 64 * kb; return t; } r -= I_OUT;
    if (r < I_UP) { const int nb = r % (FF_ / 32), kb = r / (FF_ / 32); t.W = IN_w_up; t.gain = IN_g_ffn; t.WT = (bf16*)(F.ws + WS_WUP); t.ldn = FF_; t.src_col = 32 * nb; t.K = D_; t.n_dst = 32 * nb; t.k0 = 64 * kb; return t; } r -= I_UP;
    if (r < I_DN) { const int nb = r % (D_ / 32), kb = r / (D_ / 32); t.W = IN_w_down; t.gain = nullptr; t.WT = (bf16*)(F.ws + WS_WDOWN); t.ldn = D_; t.src_col = 32 * nb; t.K = FF_; t.n_dst = 32 * nb; t.k0 = 64 * kb; return t; } r -= I_DN;
    if (r < I_PG) { const int nb = r % (D_ / 32), kb = r / (D_ / 32); t.W = IN_w_pg; t.gain = IN_g_pg; t.WT = (bf16*)(F.ws + WS_WPG); t.ldn = D_; t.src_col = 32 * nb; t.K = D_; t.n_dst = 32 * nb; t.k0 = 64 * kb; return t; } r -= I_PG;
    { const int nb = r % (D_ / 32), kb = r / (D_ / 32); t.W = IN_w_pp; t.gain = nullptr; t.WT = (bf16*)(F.ws + WS_WPP); t.ldn = D_; t.src_col = 32 * nb; t.K = PLE_; t.n_dst = 32 * nb; t.k0 = 64 * kb; return t; }
}
__device__ __forceinline__ void p0_issue(const TItem& t, int lane, float (&w)[32], f32x4 (&g)[2]) {
    const int lam = lane & 31;
    const int cm = t.perm < 0 ? lam : (((lam & 7) < 4) ? 16 * t.perm + 4 * (lam >> 3) + (lam & 7) : 64 + 16 * t.perm + 4 * (lam >> 3) + (lam & 7) - 4);
    const float* src = t.W + (size_t)(t.k0 + (lane >> 5)) * t.ldn + t.src_col + cm;
#pragma unroll
    for (int i = 0; i < 32; ++i) w[i] = __builtin_nontemporal_load(src + (size_t)(2 * i) * t.ldn);
    if (t.gain) { g[0] = *(const f32x4*)(t.gain + t.k0 + 8 * (lane & 7)); g[1] = *(const f32x4*)(t.gain + t.k0 + 8 * (lane & 7) + 4); }
    else { g[0] = (f32x4){1.f, 1.f, 1.f, 1.f}; g[1] = g[0]; }
}
__device__ __forceinline__ void p0_prologue(Frame& F) {
    LAS float* scr = (LAS float*)(F.lds + RING_OFF + F.wave * 16384);
    constexpr int P0_ROWW = 4, P0_TRW = NWAVES - P0_ROWW;
    const bool row_role = F.wave < P0_ROWW;
    const int gw = row_role ? F.vcu * P0_ROWW + F.wave : F.vcu * P0_TRW + (F.wave - P0_ROWW), NGW = F.G * (row_role ? P0_ROWW : P0_TRW);
    bf16* Wga_t = (bf16*)(F.ws + WS_WGA);
    constexpr int NITEMS = (D_ / 64) * (ZW / 32) + 2 * (D_ / 64) * (D_ / 32) + (D_ / 64) * (FF_ / 32) + (FF_ / 64) * (D_ / 32) + (PLE_ / 64) * (D_ / 32);
    if (!row_role) {
        int it = gw; bool have = it < NITEMS;
        float w[32]; f32x4 g[2]; TItem cur;
        if (have) { cur = p0_decode(F, it); p0_issue(cur, F.lane, w, g); }
        while (have) {
#pragma unroll
            for (int i = 0; i < 32; ++i) scr[(2 * i + (F.lane >> 5)) * 33 + (F.lane & 31)] = w[i];
            const f32x4 g0 = g[0], g1 = g[1]; const TItem t = cur;
            LDS_WAIT(); asm volatile("" ::: "memory");
            const int nit = it + NGW; const bool nh = nit < NITEMS;
            if (nh) { cur = p0_decode(F, nit); p0_issue(cur, F.lane, w, g); }
            const int c = F.lane & 7;
#pragma unroll
            for (int j = 0; j < 4; ++j) { const int n = (F.lane >> 3) + 8 * j; const LAS float* s = scr + (8 * c) * 33 + n;
                v4u o; o.x = pk2(s[0 * 33] * g0[0], s[1 * 33] * g0[1]); o.y = pk2(s[2 * 33] * g0[2], s[3 * 33] * g0[3]); o.z = pk2(s[4 * 33] * g1[0], s[5 * 33] * g1[1]); o.w = pk2(s[6 * 33] * g1[2], s[7 * 33] * g1[3]);
                *(GAS v4u*)(t.WT + (size_t)(t.n_dst + n) * t.K + t.k0 + 8 * c) = o; }
            LDS_WAIT(); asm volatile("" ::: "memory");
            it = nit; have = nh;
        }
    }
    if (!row_role) { const float* wi_ = IN_w_in; const float* gm_ = IN_g_mix;
      for (int i = gw * 64 + F.lane; i < 16 * D_; i += NGW * 64) { const int r = i >> 10, k = i & 1023; Wga_t[i] = (bf16)f2bf(wi_[(size_t)k * INW_ + 1536 + r] * gm_[k]); } }
    bf16* xb = (bf16*)(F.ws + WS_AB); bf16* pb = (bf16*)(F.ws + WS_PB); float* rstdx = (float*)(F.ws + WS_RSTDX);
    const float* x_ = IN_x; const float* p_ = IN_p;
    if (row_role) {
        f32x4 v[4][4], pv[4], vn[4][4], pvn[4];
        int m0 = gw * 4; bool have = m0 < S_;
        if (have) {
#pragma unroll
            for (int rr = 0; rr < 4; ++rr) { const GAS f32x4* xr = (const GAS f32x4*)(x_ + (size_t)(m0 + rr) * D_) + F.lane;
#pragma unroll
                for (int j = 0; j < 4; ++j) v[rr][j] = __builtin_nontemporal_load(xr + 64 * j);
                pv[rr] = __builtin_nontemporal_load((const GAS f32x4*)(p_ + (size_t)(m0 + rr) * PLE_) + F.lane); }
        }
        while (have) {
            const int m1 = m0 + NGW * 4; const bool nh = m1 < S_;
            if (nh) {
#pragma unroll
                for (int rr = 0; rr < 4; ++rr) { const GAS f32x4* xr = (const GAS f32x4*)(x_ + (size_t)(m1 + rr) * D_) + F.lane;
#pragma unroll
                    for (int j = 0; j < 4; ++j) vn[rr][j] = __builtin_nontemporal_load(xr + 64 * j);
                    pvn[rr] = __builtin_nontemporal_load((const GAS f32x4*)(p_ + (size_t)(m1 + rr) * PLE_) + F.lane); }
            }
#pragma unroll
            for (int rr = 0; rr < 4; ++rr) { const int m = m0 + rr; float s = 0.f;
#pragma unroll
                for (int j = 0; j < 4; ++j) s += (v[rr][j].x * v[rr][j].x + v[rr][j].y * v[rr][j].y) + (v[rr][j].z * v[rr][j].z + v[rr][j].w * v[rr][j].w);
                s = wave_sum(s);
                const float nrm = sqrtf(s * (1.0f / D_) + EPS_), rsd = 1.0f / nrm;
                GAS unsigned long long* o8 = (GAS unsigned long long*)(xb + (size_t)m * D_) + F.lane;
#pragma unroll
                for (int j = 0; j < 4; ++j) o8[64 * j] = (unsigned long long)pk2(v[rr][j].x * rsd, v[rr][j].y * rsd) | ((unsigned long long)pk2(v[rr][j].z * rsd, v[rr][j].w * rsd) << 32);
                if (F.lane == 0) rstdx[m] = nrm;
                *((GAS unsigned long long*)(pb + (size_t)m * PLE_) + F.lane) = (unsigned long long)pk2(pv[rr].x, pv[rr].y) | ((unsigned long long)pk2(pv[rr].z, pv[rr].w) << 32); }
#pragma unroll
            for (int rr = 0; rr < 4; ++rr) { pv[rr] = pvn[rr];
#pragma unroll
                for (int j = 0; j < 4; ++j) v[rr][j] = vn[rr][j]; }
            m0 = m1; have = nh;
        }
    }
}

typedef float f32x16 __attribute__((ext_vector_type(16)));
typedef __bf16 bf2_t __attribute__((ext_vector_type(2)));
typedef float f2_t __attribute__((ext_vector_type(2)));
__device__ __forceinline__ unsigned pkbf(float lo, float hi) { f2_t v = {lo, hi}; bf2_t b = __builtin_convertvector(v, bf2_t); return __builtin_bit_cast(unsigned, b); }
#define MFMA32(a, b, c) __builtin_amdgcn_mfma_f32_32x32x16_bf16((a), (b), (c), 0, 0, 0)
#define WG_SYNC() do { asm volatile("s_waitcnt lgkmcnt(0)" ::: "memory"); __builtin_amdgcn_s_barrier(); asm volatile("" ::: "memory"); } while (0)
__device__ __forceinline__ bf16x8 pack8(const f32x16& x, int s) {
    v4u p; p.x = pkbf(x[8 * s], x[8 * s + 1]); p.y = pkbf(x[8 * s + 2], x[8 * s + 3]); p.z = pkbf(x[8 * s + 4], x[8 * s + 5]); p.w = pkbf(x[8 * s + 6], x[8 * s + 7]);
    return __builtin_bit_cast(bf16x8, p);
}
__device__ __forceinline__ float log_sigmoid(float s) { return fminf(s, 0.f) - __logf(1.0f + __expf(-fabsf(s))); }
constexpr int GROW = 72;
__device__ __forceinline__ int tperm(int tt) { return (tt & ~15) + 8 * ((tt >> 2) & 1) + 4 * ((tt >> 3) & 1) + (tt & 3); }
typedef short s16x4_t __attribute__((ext_vector_type(4)));
__device__ __forceinline__ unsigned voff_b(unsigned row, unsigned ch) { return 256u * row + 16u * (ch ^ (((row & 3u) << 2) | ((row >> 2) & 3u))); }
__device__ __forceinline__ bf16x8 v_tr_frag(const LAS unsigned char* VL, int kb0, int et, int lane) {
    const unsigned hh = lane >> 5, blk = (lane >> 4) & 1, q = (lane & 15) >> 2, p = lane & 3;
    const unsigned r0 = kb0 + 4 * hh + q, ch = 4 * et + 2 * blk + (p >> 1);
    const s16x4_t lo = __builtin_amdgcn_ds_read_tr16_b64_v4i16((LAS s16x4_t*)(VL + voff_b(r0, ch) + 8 * (p & 1)));
    const s16x4_t hi = __builtin_amdgcn_ds_read_tr16_b64_v4i16((LAS s16x4_t*)(VL + voff_b(r0 + 8, ch) + 8 * (p & 1)));
    return __builtin_shufflevector(lo, hi, 0, 1, 2, 3, 4, 5, 6, 7);
}
__device__ __forceinline__ void v_tr_offsets(int lane, unsigned (&o)[8]) {
    const unsigned hh = lane >> 5, blk = (lane >> 4) & 1, q = (lane & 15) >> 2, p = lane & 3;
#pragma unroll
    for (int et = 0; et < 4; ++et) { const unsigned ch = 4 * et + 2 * blk + (p >> 1); o[et] = voff_b(4 * hh + q, ch) + 8 * (p & 1); o[4 + et] = voff_b(8 + 4 * hh + q, ch) + 8 * (p & 1); }
}
__device__ __forceinline__ bf16x8 v_tr_frag_o(const LAS unsigned char* VL, int kb0, unsigned o_lo, unsigned o_hi) {
    const s16x4_t lo = __builtin_amdgcn_ds_read_tr16_b64_v4i16((LAS s16x4_t*)(VL + 256 * kb0 + o_lo));
    const s16x4_t hi = __builtin_amdgcn_ds_read_tr16_b64_v4i16((LAS s16x4_t*)(VL + 256 * kb0 + o_hi));
    return __builtin_shufflevector(lo, hi, 0, 1, 2, 3, 4, 5, 6, 7);
}

__device__ __forceinline__ void split_bf16x8(const float (&v)[8], bf16x8& hi, bf16x8& lo) {
    unsigned h[4], l[4];
#pragma unroll
    for (int k = 0; k < 4; ++k) { const unsigned p = pkbf(v[2 * k], v[2 * k + 1]); h[k] = p; l[k] = pkbf(v[2 * k] - bf2f(p & 0xffffu), v[2 * k + 1] - bf2f(p >> 16)); }
    hi = __builtin_bit_cast(bf16x8, (v4u){h[0], h[1], h[2], h[3]}); lo = __builtin_bit_cast(bf16x8, (v4u){l[0], l[1], l[2], l[3]});
}
__device__ __forceinline__ void gla_load_w2(Frame& F, bf16x8& whi, bf16x8& wlo, float& bias) {
    const int c = 32 * F.wave + (F.lane & 31), hh = F.lane >> 5;
    const float* wa2_ = IN_w_a2;
    float w[8];
#pragma unroll
    for (int j = 0; j < 8; ++j) w[j] = wa2_[(8 * hh + j) * 256 + c];
    split_bf16x8(w, whi, wlo);
    bias = IN_b_a[c];
}
__device__ __forceinline__ void gla_cumsum(Frame& F, const LAS float* GAS_, const bf16x8 whi, const bf16x8 wlo, float bias, float (&bv)[2][16], float& blast) {
    const int i = F.lane & 31, hh = F.lane >> 5;
    float gs[2][4];
#pragma unroll
    for (int tt = 0; tt < 2; ++tt) {
        const LAS f32x4* g4 = (const LAS f32x4*)(GAS_ + (32 * tt + i) * 16 + 8 * hh);
        const f32x4 g0 = g4[0], g1 = g4[1];
        const float gv[8] = {g0[0], g0[1], g0[2], g0[3], g1[0], g1[1], g1[2], g1[3]};
        bf16x8 ghi, glo; split_bf16x8(gv, ghi, glo);
        f32x16 acc;
#pragma unroll
        for (int r = 0; r < 16; ++r) acc[r] = 0.f;
        acc = MFMA32(ghi, whi, acc); acc = MFMA32(ghi, wlo, acc); acc = MFMA32(glo, whi, acc);
#pragma unroll
        for (int r = 0; r < 16; ++r) bv[tt][r] = log_sigmoid(acc[r] + bias) * (1.0f / 16.0f);
#pragma unroll
        for (int g = 0; g < 4; ++g) gs[tt][g] = (bv[tt][4 * g] + bv[tt][4 * g + 1]) + (bv[tt][4 * g + 2] + bv[tt][4 * g + 3]);
    }
    float run = 0.f;
#pragma unroll
    for (int tt = 0; tt < 2; ++tt)
#pragma unroll
        for (int g = 0; g < 4; ++g) {
            const float mine = gs[tt][g], other = __shfl_xor(mine, 32);
            float off = run + (hh ? other : 0.f);
#pragma unroll
            for (int j = 0; j < 4; ++j) { off += bv[tt][4 * g + j]; bv[tt][4 * g + j] = off; }
            run += mine + other;
        }
    blast = run;
}
__device__ __forceinline__ void gla_vt_load(Frame& F, const bf16* zb, int t0, v4u (&vw)[8]) {
#pragma unroll
    for (int i = 0; i < 8; ++i) { const int idx = F.tid + 512 * i, t = idx >> 6, c64 = idx & 63; vw[i] = *(const v4u*)(zb + (size_t)(t0 + t) * ZG + Z_GV + 8 * c64); }
}
__device__ __forceinline__ void gla_vt_write(Frame& F, LAS unsigned char* VL, const v4u (&vw)[8]) {
#pragma unroll
    for (int i = 0; i < 8; ++i) { const int idx = F.tid + 512 * i, t = idx >> 6, c64 = idx & 63; *(LAS v4u*)(VL + (c64 >> 4) * 16384 + voff_b(t, c64 & 15)) = vw[i]; }
}

__device__ __forceinline__ void gla_a_chunk(Frame& F, int ch) {
    LAS float* GA_S = (LAS float*)(F.lds);
    LAS float* TOT = (LAS float*)(F.lds + 8192);
    LAS bf16* KTE = (LAS bf16*)(F.lds + 10240);
    LAS unsigned char* VT = F.lds + 10240 + 4 * 64 * GROW * 2;
    const bf16* xb = (const bf16*)(F.ws + WS_AB); const bf16* zb = (const bf16*)(F.ws + WS_Z); const bf16* wga = (const bf16*)(F.ws + WS_WGA);
    const float* rstdx = (const float*)(F.ws + WS_RSTDX); float* ga_g = (float*)(F.ws + WS_GA); float* decay_g = (float*)(F.ws + WS_DECAY); bf16* dS_g = (bf16*)(F.ws + WS_DS);
    const int t0 = ch * 64;
    bf16x8 whi, wlo; float bias; gla_load_w2(F, whi, wlo, bias);
    v4u vw[8]; gla_vt_load(F, zb, t0, vw);
    LAS bf16* KRAW = (LAS bf16*)(VT + 65536);
    v4u kw[4];
#pragma unroll
    for (int i = 0; i < 4; ++i) { const int idx = F.tid + 512 * i, t = idx >> 5, c32 = idx & 31; kw[i] = *(const v4u*)(zb + (size_t)(t0 + t) * ZG + Z_GK + 8 * c32); }
    {
        const int rg = F.wave & 3, kh = F.wave >> 2, r = F.lane & 15, q = F.lane >> 4;
        const bf16* arow = xb + (size_t)(t0 + 16 * rg + r) * D_ + 8 * q; const bf16* brow = wga + (size_t)r * D_ + 8 * q;
        pg8::f32x4 acc = {0.f, 0.f, 0.f, 0.f};
#pragma unroll
        for (int s = 16 * kh; s < 16 * kh + 16; ++s) { const bf16x8 a = *(const bf16x8*)(arow + 32 * s), b = *(const bf16x8*)(brow + 32 * s); acc = __builtin_amdgcn_mfma_f32_16x16x32_bf16(a, b, acc, 0, 0, 0); }
#pragma unroll
        for (int g = 0; g < 4; ++g) GA_S[kh * 1024 + (16 * rg + 4 * q + g) * 16 + r] = acc[g];
    }
#pragma unroll
    for (int i = 0; i < 4; ++i) { const int idx = F.tid + 512 * i, t = idx >> 5, c32 = idx & 31; *(LAS v4u*)(KRAW + (size_t)((c32 >> 3) * 64 + t) * GROW + 8 * (c32 & 7)) = kw[i]; }
    gla_vt_write(F, VT, vw);
    WG_SYNC();
    for (int idx = F.tid; idx < 1024; idx += 512) { const float v = GA_S[idx] + GA_S[1024 + idx]; GA_S[idx] = v; ga_g[(size_t)t0 * 16 + idx] = v; }
    WG_SYNC();
    float bv[2][16], blast;
    gla_cumsum(F, GA_S, whi, wlo, bias, bv, blast);
    {
        const int i = F.lane & 31, hh = F.lane >> 5, c = 32 * F.wave + i, h = c >> 6, d = c & 63;
        if (hh == 0) decay_g[ch * 256 + c] = __expf(blast);
#pragma unroll
        for (int tt = 0; tt < 2; ++tt)
#pragma unroll
            for (int g = 0; g < 4; ++g) {
                float v[4];
#pragma unroll
                for (int j = 0; j < 4; ++j) { const int t = 32 * tt + 8 * g + 4 * hh + j; v[j] = bf2f(KRAW[(size_t)(h * 64 + t) * GROW + d]) * __expf(blast - bv[tt][4 * g + j]); }
                typedef unsigned u2 __attribute__((ext_vector_type(2)));
                u2 w; w.x = pkbf(v[0], v[1]); w.y = pkbf(v[2], v[3]);
                *(LAS u2*)(KTE + (size_t)(h * 64 + d) * GROW + 32 * tt + 16 * (g >> 1) + 8 * hh + 4 * (g & 1)) = w;
            }
    }
    WG_SYNC();
    {
        const int h = F.wave >> 1, dt = F.wave & 1, i = F.lane & 31, hh = F.lane >> 5;
        f32x16 acc[4];
#pragma unroll
        for (int et = 0; et < 4; ++et)
#pragma unroll
            for (int r = 0; r < 16; ++r) acc[et][r] = 0.f;
#pragma unroll
        for (int s = 0; s < 4; ++s) {
            const bf16x8 a = *(const LAS bf16x8*)(KTE + (size_t)(h * 64 + 32 * dt + i) * GROW + 16 * s + 8 * hh);
#pragma unroll
            for (int et = 0; et < 4; ++et) { const bf16x8 b = v_tr_frag(VT + h * 16384, 16 * s, et, F.lane); acc[et] = MFMA32(a, b, acc[et]); }
        }
#pragma unroll
        for (int et = 0; et < 4; ++et) {
            bf16* dst = dS_g + ((size_t)(ch * 4 + h) * 128 + 32 * et + i) * 64 + 32 * dt + 4 * hh;
            typedef unsigned u2 __attribute__((ext_vector_type(2)));
#pragma unroll
            for (int g = 0; g < 4; ++g) { u2 w; w.x = pkbf(acc[et][4 * g], acc[et][4 * g + 1]); w.y = pkbf(acc[et][4 * g + 2], acc[et][4 * g + 3]); *(u2*)(dst + 8 * g) = w; }
        }
    }
    WG_SYNC();
}

__device__ __forceinline__ void gla_b_pair(Frame& F, int pair) {
    LAS float* DSL = (LAS float*)(F.lds);
    LAS float* DEC = (LAS float*)(F.lds + 65536);
    LAS float* SEGE = (LAS float*)(F.lds + 131072);
    LAS float* SEGP = (LAS float*)(F.lds + 131072 + 2048);
    const float* decay_g = (const float*)(F.ws + WS_DECAY); const bf16* dS_g = (const bf16*)(F.ws + WS_DS); bf16* sp_g = (bf16*)((unsigned char*)F.out + OUT_SPREV);
    const int h = pair >> 6, seg = F.tid >> 6, d = F.tid & 63;
#pragma unroll
    for (int i = 0; i < 8; ++i) { const int idx = F.tid + 512 * i, n = idx >> 4, d4 = idx & 15; *(LAS pg8::f32x4*)(DEC + n * 64 + 4 * d4) = *(const pg8::f32x4*)(decay_g + (size_t)n * 256 + h * 64 + 4 * d4); }
    for (int sub = 0; sub < 2; ++sub) {
        const int e = (pair & 63) * 2 + sub;
#pragma unroll
        for (int i = 0; i < 4; ++i) { const int idx = F.tid + 512 * i, n = idx >> 3, d8 = idx & 7;
            const v4u w = *(const v4u*)(dS_g + ((size_t)(n * 4 + h) * 128 + e) * 64 + 8 * d8);
            LAS pg8::f32x4* dp = (LAS pg8::f32x4*)(DSL + n * 64 + 8 * d8);
            dp[0] = (pg8::f32x4){bf2f(w.x & 0xffffu), bf2f(w.x >> 16), bf2f(w.y & 0xffffu), bf2f(w.y >> 16)}; dp[1] = (pg8::f32x4){bf2f(w.z & 0xffffu), bf2f(w.z >> 16), bf2f(w.w & 0xffffu), bf2f(w.w >> 16)}; }
        WG_SYNC();
        float Sv = 0.f, P = 1.f;
#pragma unroll 8
        for (int i = 0; i < 32; ++i) { const int n = seg * 32 + i; const float x = DSL[n * 64 + d], a = DEC[n * 64 + d]; DSL[n * 64 + d] = Sv; Sv = a * Sv + x; P *= a; }
        SEGE[seg * 64 + d] = Sv; SEGP[seg * 64 + d] = P;
        WG_SYNC();
        float st = 0.f;
        for (int k = 0; k < seg; ++k) st = SEGP[k * 64 + d] * st + SEGE[k * 64 + d];
        float Pq = 1.f;
#pragma unroll 8
        for (int i = 0; i < 32; ++i) { const int n = seg * 32 + i; const float v = DSL[n * 64 + d] + Pq * st; Pq *= DEC[n * 64 + d]; sp_g[((size_t)(n * 4 + h) * 128 + e) * 64 + d] = (bf16)f2bf(v); }
        WG_SYNC();
    }
}

__device__ __forceinline__ void gla_c_chunk(Frame& F, int ch) {
    LAS float* GA2 = (LAS float*)(F.lds);
    LAS float* TOT = (LAS float*)(F.lds + 4096);
    LAS bf16* QD = (LAS bf16*)(F.lds + 6144);
    LAS bf16* KI = (LAS bf16*)(F.lds + 6144 + 36864);
    LAS unsigned char* VT = F.lds + 6144 + 2 * 36864;
    const bf16* zb = (const bf16*)(F.ws + WS_Z); const float* ga_g = (const float*)(F.ws + WS_GA); const bf16* sp_g = (const bf16*)((const unsigned char*)F.out + OUT_SPREV); bf16* mixb = (bf16*)(F.ws + WS_MIX);
    const int t0 = ch * 64;
    bf16x8 whi, wlo; float bias; gla_load_w2(F, whi, wlo, bias);
    v4u vw[8]; gla_vt_load(F, zb, t0, vw);
    v4u qw[4], kw[4];
#pragma unroll
    for (int i = 0; i < 4; ++i) { const int idx = F.tid + 512 * i, t = idx >> 5, c32 = idx & 31; qw[i] = *(const v4u*)(zb + (size_t)(t0 + t) * ZG + Z_GQ + 8 * c32); kw[i] = *(const v4u*)(zb + (size_t)(t0 + t) * ZG + Z_GK + 8 * c32); }
    for (int idx = F.tid; idx < 1024; idx += 512) GA2[idx] = ga_g[(size_t)t0 * 16 + idx];
#pragma unroll
    for (int i = 0; i < 4; ++i) { const int idx = F.tid + 512 * i, t = idx >> 5, c32 = idx & 31; const size_t o = (size_t)((c32 >> 3) * 64 + t) * GROW + 8 * (c32 & 7); *(LAS v4u*)(QD + o) = qw[i]; *(LAS v4u*)(KI + o) = kw[i]; }
    gla_vt_write(F, VT, vw);
    WG_SYNC();
    float bv[2][16], blast;
    gla_cumsum(F, GA2, whi, wlo, bias, bv, blast);
    {
        const int i = F.lane & 31, hh = F.lane >> 5, c = 32 * F.wave + i, h = c >> 6, d = c & 63;
#pragma unroll
        for (int tt = 0; tt < 2; ++tt)
#pragma unroll
            for (int r = 0; r < 16; ++r) {
                const int t = 32 * tt + (r & 3) + 8 * (r >> 2) + 4 * hh; const float b = bv[tt][r];
                const size_t o = (size_t)(h * 64 + t) * GROW + d;
                const float qd = bf2f(QD[o]) * __expf(b) * 0.125f, ki = bf2f(KI[o]) * __expf(-b);
                QD[o] = (bf16)f2bf(qd); KI[o] = (bf16)f2bf(ki);
            }
    }
    bf16x8 sfr[4][4];
    { const int h_ = F.wave >> 1, i_ = F.lane & 31, hh_ = F.lane >> 5;
#pragma unroll
      for (int et = 0; et < 4; ++et) { const bf16* srow = sp_g + ((size_t)(ch * 4 + h_) * 128 + 32 * et + i_) * 64 + 8 * hh_;
#pragma unroll
          for (int s = 0; s < 4; ++s) sfr[et][s] = *(const bf16x8*)(srow + 16 * s); } }
    v4u ggw[8];
#pragma unroll
    for (int k = 0; k < 8; ++k) { const int idx = F.tid + 512 * k, t = idx >> 6, c64 = idx & 63; ggw[k] = *(const v4u*)(zb + (size_t)(t0 + t) * ZG + Z_GG + 8 * c64); }
    WG_SYNC();
    {
        const int h = F.wave >> 1, ct = F.wave & 1, i = F.lane & 31, hh = F.lane >> 5;
        bf16x8 qf[4];
#pragma unroll
        for (int s = 0; s < 4; ++s) qf[s] = *(const LAS bf16x8*)(QD + (size_t)(h * 64 + 32 * ct + i) * GROW + 16 * s + 8 * hh);
        f32x16 acc[4];
#pragma unroll
        for (int et = 0; et < 4; ++et)
#pragma unroll
            for (int r = 0; r < 16; ++r) acc[et][r] = 0.f;
#pragma unroll
        for (int et = 0; et < 4; ++et) {
#pragma unroll
            for (int s = 0; s < 4; ++s) acc[et] = MFMA32(sfr[et][s], qf[s], acc[et]);
        }
        for (int jt = 0; jt <= ct; ++jt) {
            f32x16 X;
#pragma unroll
            for (int r = 0; r < 16; ++r) X[r] = 0.f;
#pragma unroll
            for (int s = 0; s < 4; ++s) { const bf16x8 kf = *(const LAS bf16x8*)(KI + (size_t)(h * 64 + 32 * jt + i) * GROW + 16 * s + 8 * hh); X = MFMA32(kf, qf[s], X); }
            if (jt == ct) {
#pragma unroll
                for (int r = 0; r < 16; ++r) { const int j = (r & 3) + 8 * (r >> 2) + 4 * hh; if (j > i) X[r] = 0.f; }
            }
#pragma unroll
            for (int s2 = 0; s2 < 2; ++s2) {
                const bf16x8 xs = pack8(X, s2);
#pragma unroll
                for (int et = 0; et < 4; ++et) { const bf16x8 vf = v_tr_frag(VT + h * 16384, 32 * jt + 16 * s2, et, F.lane); acc[et] = MFMA32(vf, xs, acc[et]); }
            }
        }
        float ss = 0.f;
#pragma unroll
        for (int et = 0; et < 4; ++et)
#pragma unroll
            for (int r = 0; r < 16; ++r) ss += acc[et][r] * acc[et][r];
        ss += __shfl_xor(ss, 32);
        const float rn = __builtin_amdgcn_rsqf(ss * (1.0f / 128.0f) + EPS_);
        const float* ggl_ = IN_g_gla;
        WG_SYNC();
        const int t = 32 * ct + i;
#pragma unroll
        for (int et = 0; et < 4; ++et)
#pragma unroll
            for (int g = 0; g < 4; ++g) {
                const int e0 = 32 * et + 8 * g + 4 * hh;
                const pg8::f32x4 gl = *(const pg8::f32x4*)(ggl_ + e0);
                typedef unsigned u2 __attribute__((ext_vector_type(2)));
                u2 w; w.x = pkbf(acc[et][4 * g] * rn * gl[0], acc[et][4 * g + 1] * rn * gl[1]); w.y = pkbf(acc[et][4 * g + 2] * rn * gl[2], acc[et][4 * g + 3] * rn * gl[3]);
                *(LAS u2*)(VT + h * 16384 + voff_b(t, e0 >> 3) + 8 * hh) = w;
            }
    }
    WG_SYNC();
#pragma unroll
    for (int k = 0; k < 8; ++k) { const int idx = F.tid + 512 * k, t = idx >> 6, c64 = idx & 63;
        const v4u on = *(const LAS v4u*)(VT + (c64 >> 4) * 16384 + voff_b(t, c64 & 15)), gw = ggw[k];
        float o[8] = {bf2f(on.x & 0xffffu), bf2f(on.x >> 16), bf2f(on.y & 0xffffu), bf2f(on.y >> 16), bf2f(on.z & 0xffffu), bf2f(on.z >> 16), bf2f(on.w & 0xffffu), bf2f(on.w >> 16)};
        float gv[8] = {bf2f(gw.x & 0xffffu), bf2f(gw.x >> 16), bf2f(gw.y & 0xffffu), bf2f(gw.y >> 16), bf2f(gw.z & 0xffffu), bf2f(gw.z >> 16), bf2f(gw.w & 0xffffu), bf2f(gw.w >> 16)};
#pragma unroll
        for (int j = 0; j < 8; ++j) o[j] *= gv[j] * __builtin_amdgcn_rcpf(1.0f + __expf(-gv[j]));
        v4u w; w.x = pkbf(o[0], o[1]); w.y = pkbf(o[2], o[3]); w.z = pkbf(o[4], o[5]); w.w = pkbf(o[6], o[7]);
        *(v4u*)(mixb + (size_t)(t0 + t) * D_ + 8 * c64) = w; }
    WG_SYNC();
}

constexpr int KROW = 136;
constexpr int LIST_PER_HEAD = 256 * 2016;
__device__ __forceinline__ int list_off(int h, int j) { return h * LIST_PER_HEAD + 256 * (63 * j - (j * (j - 1)) / 2); }
typedef unsigned u2_t __attribute__((ext_vector_type(2)));

__device__ __forceinline__ void sincos_acc(float a, float& s, float& c) {
    const float k = __builtin_rintf(a * 0.15915494309189535f);
    float r = __builtin_fmaf(-k, 6.28125f, a);
    r = __builtin_fmaf(-k, 0.0019353071693331003f, r);
    r = __builtin_fmaf(-k, 1.0253131677018246e-11f, r);
    const float rev = r * 0.15915494309189535f;
    s = __builtin_amdgcn_sinf(rev); c = __builtin_amdgcn_cosf(rev);
}

__device__ __forceinline__ void moba_a_item(Frame& F, int item) {
    const int blk = item >> 2, h = item & 3;
    LAS float* KM = (LAS float*)(F.lds);
    const bf16* zb = (const bf16*)(F.ws + WS_Z); float* kmean_g = (float*)(F.ws + WS_KMEAN);
    const int c16 = F.tid & 15, rg = F.tid >> 4;
    float acc8[8] = {0.f, 0.f, 0.f, 0.f, 0.f, 0.f, 0.f, 0.f};
    v4u w[8];
#pragma unroll
    for (int i = 0; i < 8; ++i) w[i] = *(const v4u*)(zb + zm_off(1, h) + (size_t)(blk * 256 + rg + 32 * i) * 128 + 8 * c16);
#pragma unroll
    for (int i = 0; i < 8; ++i) { acc8[0] += bf2f(w[i].x & 0xffffu); acc8[1] += bf2f(w[i].x >> 16); acc8[2] += bf2f(w[i].y & 0xffffu); acc8[3] += bf2f(w[i].y >> 16);
                                  acc8[4] += bf2f(w[i].z & 0xffffu); acc8[5] += bf2f(w[i].z >> 16); acc8[6] += bf2f(w[i].w & 0xffffu); acc8[7] += bf2f(w[i].w >> 16); }
#pragma unroll
    for (int j = 0; j < 8; ++j) KM[rg * 128 + 8 * c16 + j] = acc8[j];
    WG_SYNC();
    if (F.tid < 128) { float sm = 0.f;
#pragma unroll
        for (int r = 0; r < 32; ++r) sm += KM[r * 128 + F.tid];
        kmean_g[(size_t)(h * 64 + blk) * 128 + F.tid] = sm * (1.0f / 256.0f); }
    WG_SYNC();
}

__device__ __forceinline__ void top3_insert(float v, int j, float& v0, float& v1, float& v2, int& i0, int& i1, int& i2) {
    const bool b0 = (v > v0) || (v == v0 && j < i0), b1 = (v > v1) || (v == v1 && j < i1), b2 = (v > v2) || (v == v2 && j < i2);
    const float n2 = b1 ? v1 : (b2 ? v : v2); const int m2 = b1 ? i1 : (b2 ? j : i2);
    const float n1 = b0 ? v0 : (b1 ? v : v1); const int m1 = b0 ? i0 : (b1 ? j : i1);
    const float n0 = b0 ? v : v0; const int m0 = b0 ? j : i0;
    v0 = n0; v1 = n1; v2 = n2; i0 = m0; i1 = m1; i2 = m2;
}
__device__ __forceinline__ void moba_b_item(Frame& F, int item) {
    const int kb = item >> 2, h = item & 3;
    if (kb == 0) return;
    LAS bf16* KMH = (LAS bf16*)(F.lds);
    LAS bf16* KML = (LAS bf16*)(F.lds + 64 * KROW * 2);
    LAS unsigned* HIST = (LAS unsigned*)(F.lds + 2 * 64 * KROW * 2);
    LAS unsigned* BASE = HIST + 64;
    const bf16* zb = (const bf16*)(F.ws + WS_Z); const float* kmean_g = (const float*)(F.ws + WS_KMEAN); unsigned* list_g = (unsigned*)(F.ws + WS_LIST);
    const int i = F.lane & 31, kk = F.lane >> 5;
    const int t = kb * 256 + F.wave * 32 + i;
    bf16x8 qf[8];
    { const bf16* qrow = zb + zm_off(0, h) + (size_t)t * 128 + 8 * kk;
#pragma unroll
      for (int s = 0; s < 8; ++s) qf[s] = *(const bf16x8*)(qrow + 16 * s); }
    for (int idx = F.tid; idx < 64 * 128; idx += 512) { const int j = idx >> 7, d = idx & 127; const float v = (j < kb) ? kmean_g[(size_t)(h * 64 + j) * 128 + d] : 0.f;
        const unsigned hi = f2bf(v); const float rem = v - bf2f(hi); KMH[j * KROW + d] = (bf16)hi; KML[j * KROW + d] = (bf16)f2bf(rem); }
    if (F.tid < 64) HIST[F.tid] = 0u;
    WG_SYNC();
    float v0 = -INFINITY, v1 = -INFINITY, v2 = -INFINITY; int i0 = 1 << 20, i1 = 1 << 20, i2 = 1 << 20;
    const int njt = (kb + 31) >> 5;
    for (int jt = 0; jt < njt; ++jt) {
        f32x16 acc;
#pragma unroll
        for (int r = 0; r < 16; ++r) acc[r] = 0.f;
#pragma unroll
        for (int s = 0; s < 8; ++s) {
            const bf16x8 ah = *(const LAS bf16x8*)(KMH + (size_t)(32 * jt + i) * KROW + 16 * s + 8 * kk), al = *(const LAS bf16x8*)(KML + (size_t)(32 * jt + i) * KROW + 16 * s + 8 * kk);
            acc = MFMA32(ah, qf[s], acc); acc = MFMA32(al, qf[s], acc);
        }
#pragma unroll
        for (int r = 0; r < 16; ++r) { const int j = 32 * jt + (r & 3) + 8 * (r >> 2) + 4 * kk; if (j < kb) top3_insert(acc[r], j, v0, v1, v2, i0, i1, i2); }
    }
    {
        const float pv0 = __shfl_xor(v0, 32), pv1 = __shfl_xor(v1, 32), pv2 = __shfl_xor(v2, 32);
        const int pi0 = __shfl_xor(i0, 32), pi1 = __shfl_xor(i1, 32), pi2 = __shfl_xor(i2, 32);
        top3_insert(pv0, pi0, v0, v1, v2, i0, i1, i2); top3_insert(pv1, pi1, v0, v1, v2, i0, i1, i2); top3_insert(pv2, pi2, v0, v1, v2, i0, i1, i2);
    }
    const int nsel = kb < 3 ? kb : 3;
    unsigned lp0 = 0, lp1 = 0, lp2 = 0;
    if (kk == 0) {
        if (nsel > 0) lp0 = atomicAdd((unsigned*)&HIST[i0], 1u);
        if (nsel > 1) lp1 = atomicAdd((unsigned*)&HIST[i1], 1u);
        if (nsel > 2) lp2 = atomicAdd((unsigned*)&HIST[i2], 1u);
    }
    WG_SYNC();
    if (F.tid < 64) { const unsigned n = HIST[F.tid]; BASE[F.tid] = n ? atomicAdd((unsigned*)(F.ctl + CW_CNT + h * 64 + F.tid), n) : 0u; }
    WG_SYNC();
    if (kk == 0) {
        if (nsel > 0) list_g[list_off(h, i0) + BASE[i0] + lp0] = (unsigned)t | (0u << 16);
        if (nsel > 1) list_g[list_off(h, i1) + BASE[i1] + lp1] = (unsigned)t | (1u << 16);
        if (nsel > 2) list_g[list_off(h, i2) + BASE[i2] + lp2] = (unsigned)t | (2u << 16);
    }
    WG_SYNC();
}

__device__ __forceinline__ void moba_load_kv(Frame& F, int h, int j, LAS bf16* KL, LAS unsigned char* VL) {
    const bf16* zb = (const bf16*)(F.ws + WS_Z);
#pragma unroll
    for (int i = 0; i < 8; ++i) { const int idx = F.tid + 512 * i, r = idx >> 4, c16 = idx & 15;
        *(LAS v4u*)(KL + (size_t)r * KROW + 8 * c16) = *(const v4u*)(zb + zm_off(1, h) + (size_t)(j * 256 + r) * 128 + 8 * c16); }
#pragma unroll
    for (int i = 0; i < 8; ++i) { const int idx = F.tid + 512 * i, r = idx >> 4, c16 = idx & 15;
        *(LAS v4u*)(VL + voff_b(r, c16)) = *(const v4u*)(zb + zm_off(2, h) + (size_t)(j * 256 + r) * 128 + 8 * c16); }
}
__device__ __forceinline__ void moba_wave_attend(const bf16x8 (&qf)[8], const LAS bf16* KL, const LAS unsigned char* VL, int nkt, int diag_kt, int i, int hh, int lane, float c2, float mc2, f32x16 (&acc)[4], float& lsum) {
    unsigned vo[8]; v_tr_offsets(lane, vo);
    for (int kt = 0; kt < nkt; ++kt) {
        f32x16 St;
#pragma unroll
        for (int r = 0; r < 16; ++r) St[r] = 0.f;
#pragma unroll
        for (int s = 0; s < 8; ++s) { const bf16x8 kf = *(const LAS bf16x8*)(KL + (size_t)(32 * kt + i) * KROW + 16 * s + 8 * hh); St = MFMA32(kf, qf[s], St); }
#pragma unroll
        for (int r = 0; r < 16; ++r) St[r] = __builtin_amdgcn_exp2f(St[r] * c2 - mc2);
        if (kt == diag_kt) {
#pragma unroll
            for (int r = 0; r < 16; ++r) { const int kl = (r & 3) + 8 * (r >> 2) + 4 * hh; if (kl > i) St[r] = 0.f; }
        }
#pragma unroll
        for (int r = 0; r < 16; ++r) lsum += St[r];
#pragma unroll
        for (int s2 = 0; s2 < 2; ++s2) {
            const bf16x8 ps = pack8(St, s2);
#pragma unroll
            for (int et = 0; et < 4; ++et) { const bf16x8 vf = v_tr_frag_o(VL, 32 * kt + 16 * s2, vo[et], vo[4 + et]); acc[et] = MFMA32(vf, ps, acc[et]); }
        }
    }
}
__device__ __forceinline__ void moba_shift(Frame& F, float& c2, float& mc2) {
    const float* gmq_ = IN_g_mq; const float* gmk_ = IN_g_mk;
    float m1 = fmaxf(fabsf(gmq_[F.lane]), fabsf(gmq_[F.lane + 64])), m2 = fmaxf(fabsf(gmk_[F.lane]), fabsf(gmk_[F.lane + 64]));
#pragma unroll
    for (int o = 1; o < 64; o <<= 1) { m1 = fmaxf(m1, __shfl_xor(m1, o)); m2 = fmaxf(m2, __shfl_xor(m2, o)); }
    c2 = 0.08838834764831845f * 1.4426950408889634f;
    mc2 = 11.313708498984761f * m1 * m2 * 1.4426950408889634f;
}

__device__ __forceinline__ void mc_decode(const LAS int* PRE, int it, int& hj, int& chunk) {
    int lo = 0, hi = 255;
    while (lo < hi) { const int mid = (lo + hi + 1) >> 1; if (PRE[mid] <= it) lo = mid; else hi = mid - 1; }
    hj = lo; chunk = it - PRE[lo];
}
__device__ __forceinline__ void mc_fetch(const Frame& F, int hj, int chunk, int n, int i, int hh, bool& active, bool& valid, int& tq, int& slot, bf16x8 (&qf)[8]) {
    const bf16* zb = (const bf16*)(F.ws + WS_Z); const unsigned* list_g = (const unsigned*)(F.ws + WS_LIST);
    const int h = hj >> 6, j = hj & 63, base = chunk * 256 + F.wave * 32;
    active = base < n; valid = false; tq = 0; slot = 0;
    if (active) {
        const int eidx = base + i; valid = eidx < n;
        const unsigned ent = list_g[list_off(h, j) + (valid ? eidx : base)];
        tq = (int)(ent & 0xffffu); slot = (int)(ent >> 16);
        const bf16* qrow = zb + zm_off(0, h) + (size_t)tq * 128 + 8 * hh;
#pragma unroll
        for (int s = 0; s < 8; ++s) qf[s] = *(const bf16x8*)(qrow + 16 * s);
    }
}
__device__ __forceinline__ void moba_c_phase(Frame& F) {
    LAS bf16* KL = (LAS bf16*)(F.lds); LAS unsigned char* VL = F.lds + 256 * KROW * 2;
    LAS int* PRE = (LAS int*)(F.lds + 256 * KROW * 2 + 65536);
    LAS int* WT = PRE + 260;
    bf16* part_g = (bf16*)((unsigned char*)F.out + OUT_PART); float* lpart_g = (float*)(F.ws + WS_LPART);
    int mycnt = 0;
    if (F.tid < 256) {
        mycnt = (int)__hip_atomic_load(F.ctl + CW_CNT + F.tid, RLX_AGENT);
        int v = (mycnt + 255) >> 8, incl = v;
#pragma unroll
        for (int o = 1; o < 64; o <<= 1) { const int u = __shfl_up(incl, o); if (F.lane >= o) incl += u; }
        if (F.lane == 63) WT[F.wave] = incl;
        PRE[F.tid] = incl - v;
    }
    WG_SYNC();
    if (F.tid < 256) { int off = 0; for (int w = 0; w < F.wave; ++w) off += WT[w]; PRE[F.tid] += off; if (F.tid == 255) PRE[256] = PRE[255] + ((mycnt + 255) >> 8); }
    WG_SYNC();
    const int T = PRE[256];
    float c2, mc2; moba_shift(F, c2, mc2);
    const int i = F.lane & 31, hh = F.lane >> 5;
    const int it0 = (int)(((long long)F.vcu * T) / F.G), it1 = (int)(((long long)(F.vcu + 1) * T) / F.G);
    int cur_hj = -1;
    int hj = 0, chunk = 0, tq = 0, slot = 0; bool active = false, valid = false; bf16x8 qf[8];
#pragma unroll
    for (int s = 0; s < 8; ++s) qf[s] = (bf16x8){0, 0, 0, 0, 0, 0, 0, 0};
    if (it0 < it1) { mc_decode(PRE, it0, hj, chunk); const int n = (int)__hip_atomic_load(F.ctl + CW_CNT + hj, RLX_AGENT); mc_fetch(F, hj, chunk, n, i, hh, active, valid, tq, slot, qf); }
    for (int it = it0; it < it1; ++it) {
        const int h = hj >> 6, j = hj & 63;
        if (hj != cur_hj) { if (cur_hj >= 0) WG_SYNC(); moba_load_kv(F, h, j, KL, VL); WG_SYNC(); cur_hj = hj; }
        int hj2 = hj, chunk2 = 0, tq2 = 0, slot2 = 0; bool active2 = false, valid2 = false; bf16x8 qf2[8];
#pragma unroll
        for (int s = 0; s < 8; ++s) qf2[s] = qf[s];
        if (it + 1 < it1) { mc_decode(PRE, it + 1, hj2, chunk2); const int n2 = (int)__hip_atomic_load(F.ctl + CW_CNT + hj2, RLX_AGENT); mc_fetch(F, hj2, chunk2, n2, i, hh, active2, valid2, tq2, slot2, qf2); }
        if (active) {
            f32x16 acc[4]; float lsum = 0.f;
#pragma unroll
            for (int et = 0; et < 4; ++et)
#pragma unroll
                for (int r = 0; r < 16; ++r) acc[et][r] = 0.f;
            moba_wave_attend(qf, KL, VL, 8, -1, i, hh, F.lane, c2, mc2, acc, lsum);
            lsum += __shfl_xor(lsum, 32);
            if (valid) {
                bf16* prow = part_g + ((size_t)(slot * 4 + h) * S_ + tq) * 128;
#pragma unroll
                for (int et = 0; et < 4; ++et)
#pragma unroll
                    for (int g2 = 0; g2 < 2; ++g2) { v4u w; w.x = pkbf(acc[et][8 * g2], acc[et][8 * g2 + 1]); w.y = pkbf(acc[et][8 * g2 + 2], acc[et][8 * g2 + 3]); w.z = pkbf(acc[et][8 * g2 + 4], acc[et][8 * g2 + 5]); w.w = pkbf(acc[et][8 * g2 + 6], acc[et][8 * g2 + 7]);
                        *(v4u*)(prow + 64 * hh + 16 * et + 8 * g2) = w; }
                if (hh == 0) lpart_g[(size_t)(slot * 4 + h) * S_ + tq] = lsum;
            }
        }
        hj = hj2; chunk = chunk2; tq = tq2; slot = slot2; active = active2; valid = valid2;
#pragma unroll
        for (int s = 0; s < 8; ++s) qf[s] = qf2[s];
    }
    WG_SYNC();
}

__device__ __forceinline__ void moba_d_item(Frame& F, int item, float c2, float mc2) {
    const int blk = item >> 2, h = item & 3;
    LAS bf16* KL = (LAS bf16*)(F.lds); LAS unsigned char* VL = F.lds + 256 * KROW * 2;
    const bf16* zb = (const bf16*)(F.ws + WS_Z); const bf16* part_g = (const bf16*)((const unsigned char*)F.out + OUT_PART); const float* lpart_g = (const float*)(F.ws + WS_LPART);
    bf16* mixb = (bf16*)(F.ws + WS_MIX);
    const int i = F.lane & 31, hh = F.lane >> 5;
    const int tq = blk * 256 + F.wave * 32 + i;
    bf16x8 qf[8];
    { const bf16* qrow = zb + zm_off(0, h) + (size_t)tq * 128 + 8 * hh;
#pragma unroll
      for (int s = 0; s < 8; ++s) qf[s] = *(const bf16x8*)(qrow + 16 * s); }
    moba_load_kv(F, h, blk, KL, VL);
    WG_SYNC();
    f32x16 acc[4]; float lsum = 0.f;
#pragma unroll
    for (int et = 0; et < 4; ++et)
#pragma unroll
        for (int r = 0; r < 16; ++r) acc[et][r] = 0.f;
    moba_wave_attend(qf, KL, VL, F.wave + 1, F.wave, i, hh, F.lane, c2, mc2, acc, lsum);
    lsum += __shfl_xor(lsum, 32);
    const int nsel = blk < 3 ? blk : 3;
    {
        v4u pw[3][8]; float lp[3];
#pragma unroll
        for (int s = 0; s < 3; ++s) { if (s < nsel) { const bf16* prow = part_g + ((size_t)(s * 4 + h) * S_ + tq) * 128 + 64 * hh; lp[s] = lpart_g[(size_t)(s * 4 + h) * S_ + tq];
#pragma unroll
                for (int k = 0; k < 8; ++k) pw[s][k] = *(const v4u*)(prow + 8 * k); } }
#pragma unroll
        for (int s = 0; s < 3; ++s) { if (s < nsel) { lsum += lp[s];
#pragma unroll
                for (int et = 0; et < 4; ++et)
#pragma unroll
                    for (int g2 = 0; g2 < 2; ++g2) { const v4u w = pw[s][2 * et + g2];
                        acc[et][8 * g2] += bf2f(w.x & 0xffffu); acc[et][8 * g2 + 1] += bf2f(w.x >> 16); acc[et][8 * g2 + 2] += bf2f(w.y & 0xffffu); acc[et][8 * g2 + 3] += bf2f(w.y >> 16);
                        acc[et][8 * g2 + 4] += bf2f(w.z & 0xffffu); acc[et][8 * g2 + 5] += bf2f(w.z >> 16); acc[et][8 * g2 + 6] += bf2f(w.w & 0xffffu); acc[et][8 * g2 + 7] += bf2f(w.w >> 16); } } }
    }
    const float inv = 1.0f / lsum;
    bf16* orow = mixb + (size_t)tq * D_ + 512 + h * 128;
#pragma unroll
    for (int et = 0; et < 4; ++et)
#pragma unroll
        for (int g = 0; g < 4; ++g) { u2_t w; w.x = pkbf(acc[et][4 * g] * inv, acc[et][4 * g + 1] * inv); w.y = pkbf(acc[et][4 * g + 2] * inv, acc[et][4 * g + 3] * inv); *(u2_t*)(orow + 32 * et + 8 * g + 4 * hh) = w; }
    WG_SYNC();
}

struct Args { const void* in[18]; float* out; unsigned char* ws; int ph_lo, ph_hi, li, pad; };
constexpr int N_PHASES = 10;
__global__ void __launch_bounds__(NWAVES * 64, 2) mk_fwd(Args args) {
    extern __shared__ __attribute__((aligned(16))) unsigned char lds[];
    Frame F;
    F.lds = (LAS unsigned char*)lds;
    F.MISC = (volatile LAS unsigned*)(F.lds + MISC_OFF);
    F.tid = threadIdx.x; F.lane = F.tid & 63; F.wave = __builtin_amdgcn_readfirstlane(F.tid >> 6);
    F.G = gridDim.x; { const int bx = blockIdx.x; F.vcu = (F.G % 8 == 0) ? (bx % 8) * (F.G / 8) + bx / 8 : bx; }
    F.ws = args.ws; F.out = args.out; F.ctl = (gu32*)(args.ws + WS_CTL);
    if (F.tid < 32) F.MISC[F.tid] = 0u;
    if (F.tid == 0) {
#pragma unroll
        for (int k = 0; k < 18; ++k) { const unsigned long long pv = (unsigned long long)args.in[k]; F.MISC[32 + 2 * k] = (unsigned)pv; F.MISC[33 + 2 * k] = (unsigned)(pv >> 32); }
    }
    __syncthreads();
    XcdBarrier bar = xcd_barrier_post((unsigned*)(F.ctl + CW_BAR) + args.li * XCD_BAR_WORDS, F.MISC + 8);
    const int lo = args.ph_lo, hi = args.ph_hi;
#define IN(k) (lo <= (k) && (k) < hi)
#define SEAM(k) do { if (IN(k) && IN((k) + 1)) xcd_barrier(bar); STAMP((k) + 1); } while (0)
    bf16* xb = (bf16*)(F.ws + WS_AB); bf16* zb = (bf16*)(F.ws + WS_Z); bf16* mixb = (bf16*)(F.ws + WS_MIX); bf16* actb = (bf16*)(F.ws + WS_ACT); bf16* erawb = (bf16*)(F.ws + WS_ERAW);

    STAMP(0);
    if (IN(0)) { p0_prologue(F); } SEAM(0);
    if (IN(1)) {
        { pg8::Gemm g{xb, (const bf16*)(F.ws + WS_WIN), S_, ZW, D_}; pg8::StaticOrder S; S.init(S_, ZW, F.G, (int)blockIdx.x);
          const int m8_ = 4 * (F.wave & 3) + (F.lane >> 4);
          pg8::EpiZ E{zb, ZG, zm_off(0, 0), (size_t)S_ * 128, (const float*)(F.ws + WS_RSTDX), IN_pos, IN_g_mq, IN_g_mk, (PG8_LAS unsigned char*)(F.lds + RING_OFF + RING_BYTES), EPS_,
                      1.0f / powf(10000.0f, (float)(4 * m8_ + 0) / 64.0f), 1.0f / powf(10000.0f, (float)(4 * m8_ + 1) / 64.0f), 1.0f / powf(10000.0f, (float)(4 * m8_ + 2) / 64.0f), 1.0f / powf(10000.0f, (float)(4 * m8_ + 3) / 64.0f)};
          static_assert(PG8_ALIGN, "EpiZ has workgroup barriers inside: it needs ALIGN_EPI");
          pg8::gemm_phase<pg8::EpiZ, pg8::StaticOrder, true, PG8_SP2>(F.lds + RING_OFF, g, S, E); }
        { pg8::Gemm g{(const bf16*)(F.ws + WS_PB), (const bf16*)(F.ws + WS_WPP), S_, D_, PLE_}; pg8::StaticOrder S; S.init(S_, D_, F.G, (int)blockIdx.x);
          pg8::EpiRes<0> E{nullptr, erawb, (float*)(F.ws + WS_SSQE), D_, nullptr, nullptr, EPS_};
          pg8::gemm_phase<pg8::EpiRes<0>, pg8::StaticOrder, false, PG8_SP2>(F.lds + RING_OFF, g, S, E); }
    } SEAM(1);
    if (IN(2)) { for (int ch = F.vcu; ch < 256; ch += F.G) gla_a_chunk(F, ch); for (int ch = F.vcu; ch < 256; ch += F.G) moba_a_item(F, ch); } SEAM(2);
    if (IN(3)) { for (int pr = F.vcu; pr < 256; pr += F.G) gla_b_pair(F, pr); for (int pr = F.vcu; pr < 256; pr += F.G) moba_b_item(F, pr); } SEAM(3);
    if (IN(4)) { for (int ch = F.vcu; ch < 256; ch += F.G) gla_c_chunk(F, ch); moba_c_phase(F); } SEAM(4);
    if (IN(5)) { float c2, mc2; moba_shift(F, c2, mc2); for (int it = F.vcu; it < 256; it += F.G) moba_d_item(F, it, c2, mc2); } SEAM(5);
    if (IN(6)) {
        pg8::Gemm g{mixb, (const bf16*)(F.ws + WS_WOUT), S_, D_, D_}; pg8::StaticOrder S; S.init(S_, D_, F.G, (int)blockIdx.x);
        pg8::EpiRes<2> E{nullptr, xb, (float*)(F.ws + WS_SSQH1), D_, (const float*)(F.ws + WS_RSTDX), nullptr, EPS_};
        pg8::gemm_phase<pg8::EpiRes<2>, pg8::StaticOrder, false, PG8_SP2>(F.lds + RING_OFF, g, S, E);
    } SEAM(6);
    if (IN(7)) {
        pg8::Gemm g{xb, (const bf16*)(F.ws + WS_WUP), S_, FF_, D_}; pg8::StaticOrder S; S.init(S_, FF_, F.G, (int)blockIdx.x);
        pg8::EpiScale<1, 0> E{actb, FF_, nullptr, EPS_};
        pg8::gemm_phase<pg8::EpiScale<1, 0>, pg8::StaticOrder, PG8_ALIGN, PG8_SP2>(F.lds + RING_OFF, g, S, E);
    } SEAM(7);
    if (IN(8)) {
        pg8::Gemm g{actb, (const bf16*)(F.ws + WS_WDOWN), S_, D_, FF_}; pg8::StaticOrder S; S.init(S_, D_, F.G, (int)blockIdx.x);
        pg8::EpiRes<2> E{nullptr, xb, (float*)(F.ws + WS_SSQH2), D_, nullptr, (const float*)(F.ws + WS_SSQH1), EPS_};
        pg8::gemm_phase<pg8::EpiRes<2>, pg8::StaticOrder, false, PG8_SP2>(F.lds + RING_OFF, g, S, E);
    } SEAM(8);
    if (IN(9)) {
        pg8::Gemm g{xb, (const bf16*)(F.ws + WS_WPG), S_, D_, D_}; pg8::StaticOrder S; S.init(S_, D_, F.G, (int)blockIdx.x);
        pg8::EpiGate E{F.out, xb, erawb, (const float*)(F.ws + WS_SSQH2), (const float*)(F.ws + WS_SSQE), IN_g_pe, D_, EPS_};
        pg8::gemm_phase<pg8::EpiGate, pg8::StaticOrder, false, PG8_SP2>(F.lds + RING_OFF, g, S, E);
    }
#ifdef PROBE_LO
    STAMP(10);
    if (blockIdx.x == 0 && F.tid == 0) {
        const unsigned long long a_ = ((unsigned long long)F.MISC[81 + 2 * PROBE_LO] << 32) | F.MISC[80 + 2 * PROBE_LO], b_ = ((unsigned long long)F.MISC[81 + 2 * PROBE_HI] << 32) | F.MISC[80 + 2 * PROBE_HI];
        const unsigned long long d_ = (b_ - a_) * PROBE_K, t0_ = rt();
        while (rt() - t0_ < d_) __builtin_amdgcn_s_sleep(8);
    }
#endif
#undef IN
#undef SEAM
}

static void launch_range(const Args& a0, int lo, int hi, int li, int grid, hipStream_t stream) {
    Args a = a0; a.ph_lo = lo; a.ph_hi = hi; a.li = li;
    hipLaunchKernelGGL(mk_fwd, dim3(grid), dim3(NWAVES * 64), LDS_BYTES, stream, a);
    const hipError_t le = hipPeekAtLastError();
    if (le != hipSuccess) fprintf(stderr, "kernel_launch: launch [%d,%d) failed: %s\n", lo, hi, hipGetErrorName(le));
}
extern "C" void kernel_launch(void* const* d_in, const int* in_sizes, int n_in, void* d_out, int out_size, void* d_ws, size_t ws_size, hipStream_t stream) {
    static int grid = 0;
    if (grid == 0) {
        if (n_in != 18 || out_size != S_ * D_ || ws_size < WS_END) { fprintf(stderr, "kernel_launch: unexpected shapes (n_in %d out %d ws %zu)\n", n_in, out_size, ws_size); grid = -1; return; }
        int dev = 0, cus = 0, per_cu = 0;
        if (hipGetDevice(&dev) != hipSuccess || hipDeviceGetAttribute(&cus, hipDeviceAttributeMultiprocessorCount, dev) != hipSuccess) { grid = -1; return; }
        if (hipFuncSetAttribute((const void*)mk_fwd, hipFuncAttributeMaxDynamicSharedMemorySize, LDS_BYTES) != hipSuccess) { fprintf(stderr, "kernel_launch: hipFuncSetAttribute failed\n"); grid = -1; return; }
        if (hipOccupancyMaxActiveBlocksPerMultiprocessor(&per_cu, (const void*)mk_fwd, NWAVES * 64, LDS_BYTES) != hipSuccess || per_cu < 1) { fprintf(stderr, "kernel_launch: occupancy query says %d\n", per_cu); per_cu = 1; }
        (void)hipGetLastError();
        grid = cus;
        if (grid != 256) fprintf(stderr, "kernel_launch: note: %d CUs\n", grid);
    }
    if (grid < 0) return;
    (void)hipMemsetAsync((char*)d_ws + WS_CTL, 0, CTL_ZERO_BYTES, stream);
    Args a{};
    for (int i = 0; i < 18; ++i) a.in[i] = d_in[i];
    a.out = (float*)d_out; a.ws = (unsigned char*)d_ws;
    launch_range(a, 0, N_PHASES, 0, grid, stream);
}
```

```cpp
#include <hip/hip_runtime.h>
#include <cstdio>
#include <cstdint>
#include <math.h>
namespace pg8 {
#define PG8_LAS __attribute__((address_space(3)))
typedef unsigned short bf16_t;
typedef short bf16x8 __attribute__((ext_vector_type(8)));
typedef float f32x4 __attribute__((ext_vector_type(4)));
typedef unsigned u32x4 __attribute__((ext_vector_type(4)));
constexpr int BM = 256, BK = 64, HALF = 128, HTB = HALF * BK * 2  , STAGE_BYTES = 8 * HTB, NXCD = 8, WGM = 8;

__host__ __device__ __forceinline__ int lds_byte(int r, int c) { const int st = (r >> 4) * 2 + (c >> 5), rr = r & 15, cc = c & 31, ob = rr * 64 + cc * 2; return st * 1024 + (ob ^ (((ob >> 9) & 1) << 5)); }
__host__ __device__ __forceinline__ void stage_rc(int b, int& R, int& C) { const int st = b / 1024, sb = b % 1024, swz = sb ^ (((sb >> 9) & 1) << 5); R = (st >> 1) * 16 + swz / 64; C = (st & 1) * 32 + (swz % 64) / 2; }
__host__ __device__ __forceinline__ int perm32(int rho) { const int n = rho >> 4, i = rho & 15; return 8 * (i >> 2) + 4 * n + (i & 3); }

struct Unit { int pm, pn; };
struct Gemm { const bf16_t* A; const bf16_t* Bt; int M, N, K; };

struct StaticOrder {
    int nM, nN, nwg, G, c;
    __host__ __device__ void init(int M, int N, int G_, int c_) { nM = M / BM; nN = N / BM; nwg = nM * nN; G = G_; c = c_; }
    __host__ __device__ bool next(int i, Unit& u) const {
        const long L = (long)i * G + c; if (L >= nwg) return false;
        int wgid = (int)L; { const int q = nwg / NXCD, r = nwg % NXCD, xcd = wgid % NXCD, off = wgid / NXCD; wgid = (xcd < r ? xcd * (q + 1) : r * (q + 1) + (xcd - r) * q) + off; }
        const int nig = WGM * nN, gid = wgid / nig, fm = gid * WGM, gsz = (nM - fm) < WGM ? (nM - fm) : WGM;
        u.pm = fm + ((wgid % nig) % gsz); u.pn = (wgid % nig) / gsz; return true;
    }
    __device__ __forceinline__ void a_ready(const Unit&) const {}
    __device__ __forceinline__ void done(const Unit&) const {}
};

__device__ __forceinline__ unsigned cvt_pk_bf16(float lo, float hi) { unsigned r; asm volatile("v_cvt_pk_bf16_f32 %0, %1, %2" : "=v"(r) : "v"(lo), "v"(hi)); return r; }
typedef float f32x2 __attribute__((ext_vector_type(2)));

__device__ __forceinline__ void st16_wt(void* p, u32x4 v) { asm volatile("global_store_dwordx4 %0, %1, off sc1\n\ts_nop 1" :: "v"(p), "v"(v) : "memory"); }

__device__ __forceinline__ float rstd_from_part(const float* part, int row, float inv_n, float eps) {
    const f32x4 p = *(const f32x4*)(part + (size_t)row * 4);
    return __builtin_amdgcn_rsqf(((p[0] + p[1]) + (p[2] + p[3])) * inv_n + eps);
}
template <int ACT, int RS> struct EpiScale {
    static constexpr bool PERM = true, AFTER_DRAIN = false;
    bf16_t* O; int ldc; const float* rsv; float eps; const unsigned* gate_word; unsigned gate_target;
    __device__ __forceinline__ void operator()(const f32x4 (&acc)[2][2][4][2], const Unit& u, int wr, int wc, int fr, int fq) const {
        if (gate_target != 0u && u.pn < 4) {
            unsigned sp_ = 0u;
            while (__hip_atomic_load(gate_word, __ATOMIC_RELAXED, __HIP_MEMORY_SCOPE_AGENT) < gate_target) { __builtin_amdgcn_s_sleep(1); if (++sp_ > (1u << 22)) break; }
            asm volatile("" ::: "memory");
        }
        const int row0 = u.pm * BM + wr * 64 + fr, col0 = u.pn * BM + wc * 32 + 8 * fq;
#pragma unroll
        for (int ai = 0; ai < 2; ++ai)
#pragma unroll
            for (int m = 0; m < 4; ++m) {
                const int row = row0 + ai * HALF + m * 16;
                float s = 1.f;
                if (RS == 1) s = rsv[row];
                if (RS == 2) s = rstd_from_part(rsv, row, 1.0f / 1024.0f, eps);
                bf16_t* rowp = O + (size_t)row * ldc + col0;
#pragma unroll
                for (int bj = 0; bj < 2; ++bj) {
                    f32x4 v0 = acc[ai][bj][m][0] * s, v1 = acc[ai][bj][m][1] * s;
                    if (ACT == 1) {
#pragma unroll
                        for (int e = 0; e < 4; ++e) { const float a = fmaxf(v0[e], 0.f), b = fmaxf(v1[e], 0.f); v0[e] = a * a; v1[e] = b * b; }
                    }
                    u32x4 w; w.x = cvt_pk_bf16(v0[0], v0[1]); w.y = cvt_pk_bf16(v0[2], v0[3]); w.z = cvt_pk_bf16(v1[0], v1[1]); w.w = cvt_pk_bf16(v1[2], v1[3]);
                    *(u32x4*)(rowp + bj * HALF) = w;
                }
            }
    }
};
template <int RES> struct EpiRes {
    static constexpr bool PERM = true, AFTER_DRAIN = true;
    const float* base; bf16_t* hb; float* part; int ldc; const float* rsc; const float* accpart; float eps;
    __device__ __forceinline__ void fused(f32x4 (&acc)[2][2][4][2], const Unit& u, int wr, int wc, int fr, int fq, PG8_LAS unsigned char* lds, int wid, int lane) const {
        PG8_LAS float* P = (PG8_LAS float*)lds;
        const int row0 = u.pm * BM + wr * 64 + fr, col0 = u.pn * BM + wc * 32 + 8 * fq;
#pragma unroll
        for (int ai = 0; ai < 2; ++ai) {
            f32x4 pre[4][2][2]; u32x4 preb[4][2];
            if (RES == 1) {
#pragma unroll
                for (int m = 0; m < 4; ++m) { const size_t off = (size_t)(row0 + ai * HALF + m * 16) * ldc + col0;
#pragma unroll
                    for (int bj = 0; bj < 2; ++bj) { pre[m][bj][0] = __builtin_nontemporal_load((const f32x4*)(base + off + bj * HALF)); pre[m][bj][1] = __builtin_nontemporal_load((const f32x4*)(base + off + bj * HALF + 4)); } }
            }
            if (RES == 2) {
#pragma unroll
                for (int m = 0; m < 4; ++m) { const size_t off = (size_t)(row0 + ai * HALF + m * 16) * ldc + col0;
#pragma unroll
                    for (int bj = 0; bj < 2; ++bj) preb[m][bj] = *(const u32x4*)(hb + off + bj * HALF); }
            }
            float rsv4[4], asv4[4];
#pragma unroll
            for (int m = 0; m < 4; ++m) { const int row = row0 + ai * HALF + m * 16; rsv4[m] = rsc ? rsc[row] : 1.f;
                float a2 = 1.f; if (accpart) { const f32x4 p = *(const f32x4*)(accpart + (size_t)row * 4); a2 = __builtin_amdgcn_rcpf(((p[0] + p[1]) + (p[2] + p[3])) * (1.0f / 1024.0f) + eps); } asv4[m] = a2; }
#pragma unroll
            for (int m = 0; m < 4; ++m) {
                const int row = row0 + ai * HALF + m * 16;
                const size_t off = (size_t)row * ldc + col0;
                float q = 0.f;
                const float rs = rsv4[m], as2 = asv4[m];
#pragma unroll
                for (int bj = 0; bj < 2; ++bj) {
                    f32x4 v0 = acc[ai][bj][m][0] * as2, v1 = acc[ai][bj][m][1] * as2;
                    if (RES == 1) { v0 = v0 + pre[m][bj][0]; v1 = v1 + pre[m][bj][1]; }
                    if (RES == 2) { const u32x4 ew = preb[m][bj];
                        v0[0] += rs * __uint_as_float(ew.x << 16); v0[1] += rs * __uint_as_float(ew.x & 0xffff0000u); v0[2] += rs * __uint_as_float(ew.y << 16); v0[3] += rs * __uint_as_float(ew.y & 0xffff0000u);
                        v1[0] += rs * __uint_as_float(ew.z << 16); v1[1] += rs * __uint_as_float(ew.z & 0xffff0000u); v1[2] += rs * __uint_as_float(ew.w << 16); v1[3] += rs * __uint_as_float(ew.w & 0xffff0000u); }
                    u32x4 w; w.x = cvt_pk_bf16(v0[0], v0[1]); w.y = cvt_pk_bf16(v0[2], v0[3]); w.z = cvt_pk_bf16(v1[0], v1[1]); w.w = cvt_pk_bf16(v1[2], v1[3]);
                    *(u32x4*)(hb + off + bj * HALF) = w;
                    q += (v0[0] * v0[0] + v0[1] * v0[1]) + (v0[2] * v0[2] + v0[3] * v0[3]) + (v1[0] * v1[0] + v1[1] * v1[1]) + (v1[2] * v1[2] + v1[3] * v1[3]);
                }
                q += __shfl_xor(q, 16); q += __shfl_xor(q, 32);
                if (fq == 0) P[(ai * HALF + wr * 64 + m * 16 + fr) * 4 + wc] = q;
            }
        }
        asm volatile("s_waitcnt lgkmcnt(0)" ::: "memory"); __builtin_amdgcn_s_barrier(); asm volatile("" ::: "memory");
        const int tid = wid * 64 + lane;
        if (tid < 256) { const f32x4 p = ((const PG8_LAS f32x4*)lds)[tid]; part[(size_t)(u.pm * BM + tid) * 4 + u.pn] = (p[0] + p[1]) + (p[2] + p[3]); }
        asm volatile("s_waitcnt lgkmcnt(0)" ::: "memory"); __builtin_amdgcn_s_barrier(); asm volatile("" ::: "memory");
    }
};
__device__ __forceinline__ void sincos_rope(float a, float& s, float& c) {
    const float k = __builtin_rintf(a * 0.15915494309189535f);
    float r = __builtin_fmaf(-k, 6.28125f, a);
    r = __builtin_fmaf(-k, 0.0019353071693331003f, r);
    r = __builtin_fmaf(-k, 1.0253131677018246e-11f, r);
    const float rev = r * 0.15915494309189535f;
    s = __builtin_amdgcn_sinf(rev); c = __builtin_amdgcn_cosf(rev);
}
template <int CTRL> __device__ __forceinline__ float dpp_mov_pg(float v) { return __builtin_bit_cast(float, __builtin_amdgcn_update_dpp(0, __builtin_bit_cast(int, v), CTRL, 0xf, 0xf, true)); }
__device__ __forceinline__ float row16_sum_pg(float v) { v += dpp_mov_pg<0xB1>(v); v += dpp_mov_pg<0x4E>(v); v += dpp_mov_pg<0x141>(v); v += dpp_mov_pg<0x140>(v); return v; }
struct EpiZ {
    static constexpr bool PERM = true, AFTER_DRAIN = false;
    bf16_t* O; int ldc; size_t hm_base, hm_head; const float* rstdx; const int* pos; const float* gq; const float* gk; PG8_LAS unsigned char* xr; float eps; float inv0, inv1, inv2, inv3;
    __device__ __forceinline__ void operator()(const f32x4 (&acc)[2][2][4][2], const Unit& u, int wr, int wc, int fr, int fq) const {
        const int row0 = u.pm * BM + wr * 64 + fr, col0 = u.pn * BM + wc * 32 + 8 * fq;
        const int type = (u.pn >= 6 && u.pn < 8) ? 1 : ((u.pn >= 8 && u.pn < 10) ? 2 : 0);
        const size_t hm0 = hm_base + (size_t)((u.pn >= 6 ? ((u.pn - 6) >> 1) * 4 + 2 * (u.pn & 1) : 0)) * hm_head; const size_t bjstep = (u.pn < 6) ? (size_t)HALF : hm_head;
        if (type == 0) {
#pragma unroll
            for (int ai = 0; ai < 2; ++ai)
#pragma unroll
                for (int m = 0; m < 4; ++m) {
                    const int row = row0 + ai * HALF + m * 16; const float s = 1.f;
                    bf16_t* rowp = (u.pn < 6) ? O + (size_t)row * ldc + col0 : O + hm0 + (size_t)row * 128 + wc * 32 + 8 * fq;
#pragma unroll
                    for (int bj = 0; bj < 2; ++bj) { const f32x4 v0 = acc[ai][bj][m][0] * s, v1 = acc[ai][bj][m][1] * s;
                        u32x4 w; w.x = cvt_pk_bf16(v0[0], v0[1]); w.y = cvt_pk_bf16(v0[2], v0[3]); w.z = cvt_pk_bf16(v1[0], v1[1]); w.w = cvt_pk_bf16(v1[2], v1[3]);
                        *(u32x4*)(rowp + (size_t)bj * bjstep) = w; }
                }
            return;
        }
        PG8_LAS float* P = (PG8_LAS float*)xr;
        const float* g = type == 1 ? gq : gk;
        const int m8 = 4 * wc + fq;
        const f32x4 g1 = *(const f32x4*)(g + 4 * m8), g2 = *(const f32x4*)(g + 64 + 4 * m8);
        float rsx[8], pfx[8];
#pragma unroll
        for (int ai = 0; ai < 2; ++ai)
#pragma unroll
            for (int m = 0; m < 4; ++m) { const int row = u.pm * BM + ai * HALF + wr * 64 + m * 16 + fr; rsx[ai * 4 + m] = 1.f; pfx[ai * 4 + m] = (float)pos[row]; }
#pragma unroll
        for (int ai = 0; ai < 2; ++ai)
#pragma unroll
            for (int m = 0; m < 4; ++m) {
                const int rl = ai * HALF + wr * 64 + m * 16 + fr; const float s = rsx[ai * 4 + m];
#pragma unroll
                for (int bj = 0; bj < 2; ++bj) { const f32x4 v0 = acc[ai][bj][m][0] * s, v1 = acc[ai][bj][m][1] * s;
                    float q = (v0[0] * v0[0] + v0[1] * v0[1]) + (v0[2] * v0[2] + v0[3] * v0[3]) + (v1[0] * v1[0] + v1[1] * v1[1]) + (v1[2] * v1[2] + v1[3] * v1[3]);
                    q += __shfl_xor(q, 16); q += __shfl_xor(q, 32);
                    if (fq == 0) P[(rl * 2 + bj) * 4 + wc] = q; }
            }
        asm volatile("s_waitcnt lgkmcnt(0)" ::: "memory"); __builtin_amdgcn_s_barrier(); asm volatile("" ::: "memory");
#pragma unroll
        for (int ai = 0; ai < 2; ++ai)
#pragma unroll
            for (int m = 0; m < 4; ++m) {
                const int rl = ai * HALF + wr * 64 + m * 16 + fr, row = u.pm * BM + rl; const float s = rsx[ai * 4 + m]; const float pf = pfx[ai * 4 + m];
                f32x4 sn, cs;
                { float a, b; sincos_rope(pf * inv0, a, b); sn[0] = a; cs[0] = b; sincos_rope(pf * inv1, a, b); sn[1] = a; cs[1] = b; sincos_rope(pf * inv2, a, b); sn[2] = a; cs[2] = b; sincos_rope(pf * inv3, a, b); sn[3] = a; cs[3] = b; }
                bf16_t* rowp = O + hm0 + (size_t)row * 128 + wc * 32 + 8 * fq;
#pragma unroll
                for (int bj = 0; bj < 2; ++bj) {
                    const f32x4 pr = *(const PG8_LAS f32x4*)(P + (rl * 2 + bj) * 4);
                    const float sc = s * __builtin_amdgcn_rsqf(((pr[0] + pr[1]) + (pr[2] + pr[3])) * (1.0f / 128.0f) + eps);
                    const f32x4 y1 = acc[ai][bj][m][0] * sc * g1, y2 = acc[ai][bj][m][1] * sc * g2;
                    const f32x4 o1 = y1 * cs - y2 * sn, o2 = y2 * cs + y1 * sn;
                    u32x4 w; w.x = cvt_pk_bf16(o1[0], o1[1]); w.y = cvt_pk_bf16(o1[2], o1[3]); w.z = cvt_pk_bf16(o2[0], o2[1]); w.w = cvt_pk_bf16(o2[2], o2[3]);
                    *(u32x4*)(rowp + (size_t)bj * hm_head) = w;
                }
            }
    }
};
struct EpiGate {
    static constexpr bool PERM = true, AFTER_DRAIN = false;
    float* out; const bf16_t* hb; const bf16_t* eraw; const float* part_h; const float* part_e; const float* g_emb; int ldc; float eps;
    __device__ __forceinline__ void operator()(const f32x4 (&acc)[2][2][4][2], const Unit& u, int wr, int wc, int fr, int fq) const {
        const int row0 = u.pm * BM + wr * 64 + fr, col0 = u.pn * BM + wc * 32 + 8 * fq;
        f32x4 gv[2][2];
#pragma unroll
        for (int bj = 0; bj < 2; ++bj) { gv[bj][0] = *(const f32x4*)(g_emb + col0 + bj * HALF); gv[bj][1] = *(const f32x4*)(g_emb + col0 + bj * HALF + 4); }
#pragma unroll
        for (int ai = 0; ai < 2; ++ai)
#pragma unroll
            for (int mp = 0; mp < 2; ++mp) {
                u32x4 hv[2][2]; u32x4 ewv[2][2]; float sh[2], se[2];
#pragma unroll
                for (int mm = 0; mm < 2; ++mm) { const int row = row0 + ai * HALF + (2 * mp + mm) * 16; const size_t off = (size_t)row * ldc + col0;
                    sh[mm] = rstd_from_part(part_h, row, 1.0f / 1024.0f, eps); se[mm] = rstd_from_part(part_e, row, 1.0f / 1024.0f, eps);
#pragma unroll
                    for (int bj = 0; bj < 2; ++bj) { ewv[mm][bj] = *(const u32x4*)(eraw + off + bj * HALF); hv[mm][bj] = *(const u32x4*)(hb + off + bj * HALF);     } }
#pragma unroll
                for (int mm = 0; mm < 2; ++mm) { const int m = 2 * mp + mm; const int row = row0 + ai * HALF + m * 16; const size_t off = (size_t)row * ldc + col0;
#pragma unroll
                    for (int bj = 0; bj < 2; ++bj) {
                        const u32x4 ew = ewv[mm][bj];
                        f32x4 e0, e1;
                        e0[0] = __uint_as_float(ew.x << 16); e0[1] = __uint_as_float(ew.x & 0xffff0000u); e0[2] = __uint_as_float(ew.y << 16); e0[3] = __uint_as_float(ew.y & 0xffff0000u);
                        e1[0] = __uint_as_float(ew.z << 16); e1[1] = __uint_as_float(ew.z & 0xffff0000u); e1[2] = __uint_as_float(ew.w << 16); e1[3] = __uint_as_float(ew.w & 0xffff0000u);
                        const u32x4 hw = hv[mm][bj];
                        f32x4 h0, h1;
                        h0[0] = __uint_as_float(hw.x << 16); h0[1] = __uint_as_float(hw.x & 0xffff0000u); h0[2] = __uint_as_float(hw.y << 16); h0[3] = __uint_as_float(hw.y & 0xffff0000u);
                        h1[0] = __uint_as_float(hw.z << 16); h1[1] = __uint_as_float(hw.z & 0xffff0000u); h1[2] = __uint_as_float(hw.w << 16); h1[3] = __uint_as_float(hw.w & 0xffff0000u);
                        const f32x4 a0 = acc[ai][bj][m][0] * sh[mm], a1 = acc[ai][bj][m][1] * sh[mm];
#pragma unroll
                        for (int e = 0; e < 4; ++e) {
                            const float g0 = __builtin_amdgcn_rcpf(1.0f + __expf(-a0[e])), g1 = __builtin_amdgcn_rcpf(1.0f + __expf(-a1[e]));
                            h0[e] += g0 * (e0[e] * se[mm] * gv[bj][0][e]); h1[e] += g1 * (e1[e] * se[mm] * gv[bj][1][e]);
                        }
                        *(f32x4*)(out + off + bj * HALF) = h0; *(f32x4*)(out + off + bj * HALF + 4) = h1;
                    } }
            }
    }
};
template <class Epi, class Sched, bool ALIGN_EPI = false, bool SP2 = false>
__device__ __forceinline__ void gemm_phase(PG8_LAS unsigned char* lds, const Gemm g, const Sched& S, const Epi& E) {
    const int tid = threadIdx.x, wid = __builtin_amdgcn_readfirstlane(tid >> 6), lane = tid & 63, wr = wid >> 2, wc = wid & 3, fr = lane & 15, fq = lane >> 4;
    const int K = g.K, nt = K / BK;
    unsigned voffA[2], voffB[2];
#pragma unroll
    for (int i = 0; i < 2; ++i) { int R, C; stage_rc(tid * 16 + i * 8192, R, C); const int Rb = Epi::PERM ? ((R & ~31) + perm32(R & 31)) : R;
        voffA[i] = (unsigned)(R * K + C) * 2u; voffB[i] = (unsigned)(Rb * K + C) * 2u; }
    const size_t kstep = (size_t)(BK * 2);
    const size_t hstep = (size_t)HALF * K * 2;
    const size_t tstep = 2 * hstep;
    const unsigned ldsw = (unsigned)wid * 1024u;
    const int aoff = lds_byte(wr * 64 + fr, fq * 8), boff = lds_byte(wc * 32 + fr, fq * 8);
#define PG8_SA(b, h) (((b) * 2 + (h)) * HTB)
#define PG8_SB(b, h) ((4 + (b) * 2 + (h)) * HTB)
#define PG8_STAGE(bufoff, gbase, voff) do { _Pragma("unroll") for (int _i = 0; _i < 2; ++_i) \
        __builtin_amdgcn_global_load_lds((const unsigned*)((const char*)(gbase) + (voff)[_i]), (PG8_LAS unsigned*)(lds + (bufoff) + ldsw + _i * 8192), 16, 0, 0); } while (0)
#define PG8_LDA(dst, b, h) do { _Pragma("unroll") for (int m = 0; m < 4; ++m) _Pragma("unroll") for (int k = 0; k < 2; ++k) dst[m][k] = *(const PG8_LAS bf16x8*)(lds + PG8_SA(b, h) + aoff + m * 2048 + k * 1024); } while (0)
#define PG8_LDB(dst, b, h) do { _Pragma("unroll") for (int n = 0; n < 2; ++n) _Pragma("unroll") for (int k = 0; k < 2; ++k) dst[n][k] = *(const PG8_LAS bf16x8*)(lds + PG8_SB(b, h) + boff + n * 2048 + k * 1024); } while (0)
#define PG8_MMA(ai, bj, At, Bt) do { __builtin_amdgcn_s_setprio(1); _Pragma("unroll") for (int m = 0; m < 4; ++m) _Pragma("unroll") for (int n = 0; n < 2; ++n) _Pragma("unroll") for (int k = 0; k < 2; ++k) \
        acc[ai][bj][m][n] = __builtin_amdgcn_mfma_f32_16x16x32_bf16(Bt[n][k], At[m][k], acc[ai][bj][m][n], 0, 0, 0); __builtin_amdgcn_s_setprio(0); } while (0)
#define PG8_WAIT_V(n) asm volatile("s_waitcnt vmcnt(" #n ")" ::: "memory")
#define PG8_WAIT_L(n) asm volatile("s_waitcnt lgkmcnt(" #n ")" ::: "memory")
#define PG8_BAR __builtin_amdgcn_s_barrier()
#define PG8_SCHED __builtin_amdgcn_sched_barrier(0)
    Unit cur, nxt; int ui = 0;
    if (!S.next(0, cur)) return;
    f32x4 acc[2][2][4][2];
#pragma unroll
    for (int a = 0; a < 2; ++a)
#pragma unroll
        for (int b = 0; b < 2; ++b)
#pragma unroll
            for (int m = 0; m < 4; ++m)
#pragma unroll
                for (int n = 0; n < 2; ++n) acc[a][b][m][n] = (f32x4){0.f, 0.f, 0.f, 0.f};
    bf16x8 At[4][2], B0[2][2], B1[2][2];
    const char* cA = (const char*)g.A + (size_t)cur.pm * tstep; const char* cB = (const char*)g.Bt + (size_t)cur.pn * tstep;
    if constexpr (!SP2) S.a_ready(cur);
    if constexpr (SP2) {
        PG8_STAGE(PG8_SB(0, 0), cB, voffB); PG8_STAGE(PG8_SB(0, 1), cB + hstep, voffB);
        S.a_ready(cur);
        PG8_STAGE(PG8_SA(0, 0), cA, voffA); PG8_STAGE(PG8_SA(0, 1), cA + hstep, voffA);
        if (wr == 1) PG8_BAR;
        PG8_WAIT_V(2); PG8_BAR;
        PG8_STAGE(PG8_SB(1, 0), cB + kstep, voffB); PG8_STAGE(PG8_SA(1, 0), cA + kstep, voffA); PG8_STAGE(PG8_SB(1, 1), cB + hstep + kstep, voffB);
        PG8_WAIT_V(6); PG8_BAR;
    } else {
        PG8_STAGE(PG8_SB(0, 0), cB, voffB); PG8_STAGE(PG8_SA(0, 0), cA, voffA); PG8_STAGE(PG8_SB(0, 1), cB + hstep, voffB); PG8_STAGE(PG8_SA(0, 1), cA + hstep, voffA);
        if (wr == 1) PG8_BAR;
        PG8_WAIT_V(4); PG8_BAR;
        PG8_STAGE(PG8_SB(1, 0), cB + kstep, voffB); PG8_STAGE(PG8_SA(1, 0), cA + kstep, voffA); PG8_STAGE(PG8_SB(1, 1), cB + hstep + kstep, voffB);
        PG8_WAIT_V(6); PG8_BAR;
    }
    for (;;) {
        const bool has_next = S.next(ui + 1, nxt);
        const char* nA = has_next ? (const char*)g.A + (size_t)nxt.pm * tstep : cA; const char* nB = has_next ? (const char*)g.Bt + (size_t)nxt.pn * tstep : cB;
        for (int t = 0; t < nt; t += 2) {
            const bool last = (t == nt - 2);
            const char* a1 = cA + (size_t)(t + 1) * kstep;
            const char* a2 = last ? nA : cA + (size_t)(t + 2) * kstep; const char* b2 = last ? nB : cB + (size_t)(t + 2) * kstep;
            const char* a3 = a2 + kstep; const char* b3 = b2 + kstep;
            if (last && has_next) S.a_ready(nxt);
            if constexpr (SP2) {
            PG8_LDB(B0, 0, 0); PG8_LDB(B1, 0, 1); PG8_SCHED; PG8_LDA(At, 0, 0); PG8_STAGE(PG8_SA(1, 1), a1 + hstep, voffA);
            PG8_WAIT_V(8); PG8_WAIT_L(0); PG8_BAR; PG8_MMA(0, 0, At, B0); PG8_MMA(0, 1, At, B1); PG8_BAR; PG8_SCHED;
            PG8_LDA(At, 0, 1); PG8_STAGE(PG8_SB(0, 0), b2, voffB); PG8_STAGE(PG8_SB(0, 1), b2 + hstep, voffB); PG8_STAGE(PG8_SA(0, 0), a2, voffA);
            PG8_WAIT_V(8); PG8_WAIT_L(0); PG8_BAR; PG8_MMA(1, 0, At, B0); PG8_MMA(1, 1, At, B1); PG8_BAR; PG8_SCHED;
            PG8_LDB(B0, 1, 0); PG8_LDB(B1, 1, 1); PG8_SCHED; PG8_LDA(At, 1, 0); PG8_STAGE(PG8_SA(0, 1), a2 + hstep, voffA);
            PG8_WAIT_V(8); PG8_WAIT_L(0); PG8_BAR; PG8_MMA(0, 0, At, B0); PG8_MMA(0, 1, At, B1); PG8_BAR; PG8_SCHED;
            PG8_LDA(At, 1, 1); PG8_STAGE(PG8_SB(1, 0), b3, voffB); PG8_STAGE(PG8_SB(1, 1), b3 + hstep, voffB); PG8_STAGE(PG8_SA(1, 0), a3, voffA);
            PG8_WAIT_V(8); PG8_WAIT_L(0); PG8_BAR; PG8_MMA(1, 0, At, B0); PG8_MMA(1, 1, At, B1); PG8_BAR; PG8_SCHED;
            } else {
            PG8_LDB(B0, 0, 0); PG8_SCHED; PG8_LDA(At, 0, 0); PG8_STAGE(PG8_SA(1, 1), a1 + hstep, voffA);
            PG8_WAIT_L(8); PG8_BAR; PG8_WAIT_L(0); PG8_MMA(0, 0, At, B0); PG8_BAR; PG8_SCHED;
            PG8_LDB(B1, 0, 1); PG8_STAGE(PG8_SB(0, 0), b2, voffB);
            PG8_BAR; PG8_WAIT_L(0); PG8_MMA(0, 1, At, B1); PG8_BAR;
            PG8_LDA(At, 0, 1); PG8_STAGE(PG8_SA(0, 0), a2, voffA);
            PG8_BAR; PG8_WAIT_L(0); PG8_MMA(1, 0, At, B0); PG8_BAR; PG8_SCHED;
            PG8_STAGE(PG8_SB(0, 1), b2 + hstep, voffB);
            PG8_WAIT_V(6); PG8_BAR; PG8_MMA(1, 1, At, B1); PG8_BAR;
            PG8_LDB(B0, 1, 0); PG8_SCHED; PG8_LDA(At, 1, 0); PG8_STAGE(PG8_SA(0, 1), a2 + hstep, voffA);
            PG8_WAIT_L(8); PG8_BAR; PG8_WAIT_L(0); PG8_MMA(0, 0, At, B0); PG8_BAR; PG8_SCHED;
            PG8_LDB(B1, 1, 1); PG8_STAGE(PG8_SB(1, 0), b3, voffB);
            PG8_BAR; PG8_WAIT_L(0); PG8_MMA(0, 1, At, B1); PG8_BAR;
            PG8_LDA(At, 1, 1); PG8_STAGE(PG8_SA(1, 0), a3, voffA);
            PG8_BAR; PG8_WAIT_L(0); PG8_MMA(1, 0, At, B0); PG8_BAR; PG8_SCHED;
            PG8_STAGE(PG8_SB(1, 1), b3 + hstep, voffB);
            PG8_WAIT_V(6); PG8_BAR; PG8_MMA(1, 1, At, B1); PG8_BAR;
            }
        }
        if constexpr (ALIGN_EPI) { if (wr == 0) PG8_BAR; }
        if constexpr (!Epi::AFTER_DRAIN) { E(acc, cur, wr, wc, fr, fq); S.done(cur); }
        if (!has_next) break;
#pragma unroll
        for (int a = 0; a < 2; ++a)
#pragma unroll
            for (int b = 0; b < 2; ++b)
#pragma unroll
                for (int m = 0; m < 4; ++m)
#pragma unroll
                    for (int n = 0; n < 2; ++n) acc[a][b][m][n] = (f32x4){0.f, 0.f, 0.f, 0.f};
        cur = nxt; cA = nA; cB = nB; ++ui;
        if constexpr (ALIGN_EPI) { if (wr == 1) PG8_BAR; }
    }
    PG8_WAIT_V(0);
    if constexpr (!ALIGN_EPI) { if (wr == 0) PG8_BAR; }
    PG8_BAR;
    if constexpr (Epi::AFTER_DRAIN) { E.fused(acc, cur, wr, wc, fr, fq, lds, wid, lane); S.done(cur); }
#undef PG8_SA
#undef PG8_SB
#undef PG8_STAGE
#undef PG8_LDA
#undef PG8_LDB
#undef PG8_MMA
#undef PG8_WAIT_V
#undef PG8_WAIT_L
#undef PG8_BAR
#undef PG8_SCHED
}
}
#ifndef PG8_SP2
#define PG8_SP2 true
#endif
#ifndef PG8_ALIGN
#define PG8_ALIGN true
#endif

constexpr int NWAVES = 8;
constexpr int S_ = 16384, D_ = 1024, FF_ = 4096, PLE_ = 256, INW_ = 3088, ZW = 3072;
constexpr int Z_GQ = 0, Z_GK = 256, Z_GV = 512, Z_GG = 1024, Z_MQ = 1536, Z_MK = 2048, Z_MV = 2560;
constexpr int ZG = 1536;
__device__ __forceinline__ size_t zm_off(int which, int h) { return (size_t)48 * 1024 * 1024 / 2 + (size_t)(which * 4 + h) * S_ * 128; }
constexpr float EPS_ = 1e-6f;

constexpr size_t MiB = 1u << 20, KiB = 1u << 10;
constexpr size_t WS_CTL = 0, CTL_ZERO_BYTES = 64 * KiB;
constexpr size_t WS_WIN = 1 * MiB, WS_WOUT = 7 * MiB, WS_WUP = 9 * MiB, WS_WDOWN = 17 * MiB, WS_WPG = 25 * MiB, WS_WPP = 27 * MiB, WS_WGA = 27 * MiB + 512 * KiB;
constexpr size_t WS_SMALL = 28 * MiB;
constexpr size_t WS_RSTDX = WS_SMALL, WS_GA = WS_SMALL + 64 * KiB, WS_DECAY = WS_SMALL + 1088 * KiB, WS_KMEAN = WS_SMALL + 1344 * KiB,
                 WS_SSQH1 = WS_SMALL + 1472 * KiB, WS_SSQH2 = WS_SMALL + 1728 * KiB, WS_SSQE = WS_SMALL + 1984 * KiB, WS_LPART = WS_SMALL + 2240 * KiB;
constexpr size_t WS_ERAW = 32 * MiB, WS_AB = 64 * MiB, WS_Z = 96 * MiB, WS_MIX = 192 * MiB, WS_PB = 248 * MiB, WS_ACT = 96 * MiB, WS_END = 256 * MiB;
constexpr size_t WS_DS = 224 * MiB  , WS_LIST = 240 * MiB  ;
constexpr size_t OUT_PART = 0  , OUT_SPREV = 48 * MiB  ;
constexpr int CW_TMO = 0, CW_GLAQ = 64  , CW_TRQ = 96  , CW_CNT = 1024  , CW_SIB = 2048  , CW_XCC = 3072  , CW_SPL = 8192  , CW_BAR = 4096;

constexpr int RING_OFF = 0, RING_BYTES = 131072;
constexpr int LDS_BYTES = 160 * 1024;
constexpr int MISC_OFF = LDS_BYTES - 512;

#define GAS __attribute__((address_space(1)))
#define LAS __attribute__((address_space(3)))
typedef unsigned short bf16;
typedef unsigned v4u __attribute__((ext_vector_type(4)));
typedef float f32x4 __attribute__((ext_vector_type(4)));
typedef short bf16x8 __attribute__((ext_vector_type(8)));
typedef GAS unsigned gu32;
typedef GAS unsigned long long gu64;
#define RLX_AGENT __ATOMIC_RELAXED, __HIP_MEMORY_SCOPE_AGENT
#define LDS_WAIT() asm volatile("s_waitcnt lgkmcnt(0)" ::: "memory")
#define VM_WAIT() asm volatile("s_waitcnt vmcnt(0)" ::: "memory")
__device__ __forceinline__ unsigned long long rt() { return __builtin_amdgcn_s_memrealtime(); }
__device__ __forceinline__ unsigned f2bf(float f) { unsigned u = __builtin_bit_cast(unsigned, f); return (u + 0x7fffu + ((u >> 16) & 1u)) >> 16; }
__device__ __forceinline__ unsigned pk2(float lo, float hi) { return f2bf(lo) | (f2bf(hi) << 16); }

#define XB_TMO      128
#define XB_XCNT(j)  (256  + 64 * (j))
#define XB_XSUB(j)  (1280 + 64 * (j))
#define XB_XGEN(j)  (2304 + 64 * (j))
#define XB_TOP      3328
#define XB_TOPGEN   3392
#define XCD_BAR_WORDS 3456
#define XB_SPIN_CAP (1u << 18)

__device__ __forceinline__ unsigned xb_ld(unsigned* p)              { return __hip_atomic_load(p, __ATOMIC_RELAXED, __HIP_MEMORY_SCOPE_AGENT); }
__device__ __forceinline__ unsigned xb_add(unsigned* p, unsigned v) { return __hip_atomic_fetch_add(p, v, __ATOMIC_RELAXED, __HIP_MEMORY_SCOPE_AGENT); }
__device__ __forceinline__ unsigned xb_xcc_id() { return (unsigned)__builtin_amdgcn_s_getreg((3 << 11) | 20) & 0xFu; }
#define XB_SPIN(cond, bar) do { unsigned _sp = 0; while (cond) { __builtin_amdgcn_s_sleep(6); \
    if ((++_sp & 255u) == 0u) { if (xb_ld(&(bar)[XB_TMO])) break; if (_sp > XB_SPIN_CAP) { atomicAdd(&(bar)[XB_TMO], 1u); break; } } } } while (0)

struct XcdBarrier {
    unsigned* bar; unsigned x;
    volatile LAS unsigned* st;
};

__device__ __forceinline__ XcdBarrier xcd_barrier_post(unsigned* bar, volatile LAS unsigned* st) {
    XcdBarrier b; b.bar = bar; b.x = xb_xcc_id(); b.st = st;
    if (threadIdx.x == 0) (void)xb_add(&bar[XB_XCNT(b.x)], 1u);
    return b;
}
__device__ __forceinline__ void xcd_barrier_complete(unsigned* bar, unsigned x, unsigned& nloc, unsigned& nx) {
    const unsigned G = gridDim.x * gridDim.y * gridDim.z;
    unsigned sum, cnt, mine, sp = 0u;
    for (;;) {
        sum = 0u; cnt = 0u; mine = 0u;
#pragma unroll
        for (unsigned j = 0; j < 16; ++j) { const unsigned c = xb_ld(&bar[XB_XCNT(j)]); sum += c; cnt += (c > 0u) ? 1u : 0u; mine = (j == x) ? c : mine; }
        if (sum == G) break;
        __builtin_amdgcn_s_sleep(1);
        if ((++sp & 255u) == 0u) { if (xb_ld(&bar[XB_TMO])) break; if (sp > XB_SPIN_CAP) { atomicAdd(&bar[XB_TMO], 1u); break; } }
    }
    nloc = mine > 0u ? mine : 1u; nx = cnt > 0u ? cnt : 1u;
}

__device__ __forceinline__ void xcd_barrier(const XcdBarrier& b) {
    asm volatile("s_waitcnt vmcnt(0)" ::: "memory");
    __syncthreads();
    if (threadIdx.x == 0) {
        unsigned* bar = b.bar;
        __builtin_amdgcn_s_waitcnt(0);
        unsigned nloc = b.st[0], nx = b.st[1];
        if (nloc == 0u) { xcd_barrier_complete(bar, b.x, nloc, nx); b.st[0] = nloc; b.st[1] = nx; }
        const unsigned old = xb_add(&bar[XB_XSUB(b.x)], 1u);
        const unsigned gen = old / nloc;
        if (old + 1u == (gen + 1u) * nloc) {
            __builtin_amdgcn_fence(__ATOMIC_RELEASE, "agent");
            asm volatile("s_waitcnt vmcnt(0)" ::: "memory");
            const unsigned og = xb_add(&bar[XB_TOP], 1u);
            const unsigned tg = og / nx;
            if (og + 1u == (tg + 1u) * nx) xb_add(&bar[XB_TOPGEN], 1u);
            else XB_SPIN(xb_ld(&bar[XB_TOPGEN]) == tg, bar);
            __builtin_amdgcn_fence(__ATOMIC_ACQUIRE, "agent");
            xb_add(&bar[XB_XGEN(b.x)], 1u);
            asm volatile("s_waitcnt vmcnt(0)" ::: "memory");
        } else {
            XB_SPIN(xb_ld(&bar[XB_XGEN(b.x)]) == gen, bar);
            __builtin_amdgcn_fence(__ATOMIC_ACQUIRE, "agent");
            asm volatile("s_waitcnt vmcnt(0)" ::: "memory");
        }
    }
    __syncthreads();
}

__device__ __forceinline__ void sib_barrier(unsigned* bar, unsigned* cnt, unsigned target, bool acq) {
    asm volatile("s_waitcnt vmcnt(0)" ::: "memory");
    __syncthreads();
    if (threadIdx.x == 0) {
        __builtin_amdgcn_s_waitcnt(0);
        (void)xb_add(cnt, 1u);
        XB_SPIN(xb_ld(cnt) < target, bar);
        if (acq) { __builtin_amdgcn_fence(__ATOMIC_ACQUIRE, "agent"); asm volatile("s_waitcnt vmcnt(0)" ::: "memory"); }
    }
    __syncthreads();
    asm volatile("" ::: "memory");
}

__device__ __forceinline__ void sib_arrive(unsigned* cnt) {
    asm volatile("s_waitcnt vmcnt(0)" ::: "memory");
    __syncthreads();
    if (threadIdx.x == 0) { __builtin_amdgcn_s_waitcnt(0); (void)xb_add(cnt, 1u); }
}
__device__ __forceinline__ void sib_wait(unsigned* bar, unsigned* cnt, unsigned target, bool acq) {
    if (threadIdx.x == 0) {
        XB_SPIN(xb_ld(cnt) < target, bar);
        if (acq) { __builtin_amdgcn_fence(__ATOMIC_ACQUIRE, "agent"); asm volatile("s_waitcnt vmcnt(0)" ::: "memory"); }
    }
    __syncthreads();
    asm volatile("" ::: "memory");
}
struct SibOrder : pg8::StaticOrder {
    unsigned* tmo_bar; unsigned* cnt; unsigned target; bool acq;
    __device__ __forceinline__ void a_ready(const pg8::Unit& u) const {
        if (target != 0u && u.pn < 4) {
            if (threadIdx.x == 0) {
                XB_SPIN(xb_ld(cnt) < target, tmo_bar);
                if (acq) { __builtin_amdgcn_fence(__ATOMIC_ACQUIRE, "agent"); asm volatile("s_waitcnt vmcnt(0)" ::: "memory"); }
            }
            asm volatile("" ::: "memory"); __builtin_amdgcn_s_barrier(); asm volatile("" ::: "memory");
        }
    }
};

constexpr int SPL_USE_WORDS = 1024, SPL_TOP = 512, SPL_DONE = 576;
__device__ __forceinline__ void split_arrive(unsigned* use, unsigned x, unsigned nloc, unsigned nx) {
    asm volatile("s_waitcnt vmcnt(0)" ::: "memory");
    __syncthreads();
    if (threadIdx.x == 0) {
        __builtin_amdgcn_s_waitcnt(0);
        const unsigned old = xb_add(&use[32 * x], 1u);
        if (old + 1u == nloc) { __builtin_amdgcn_fence(__ATOMIC_RELEASE, "agent"); asm volatile("s_waitcnt vmcnt(0)" ::: "memory");
            const unsigned og = xb_add(&use[SPL_TOP], 1u);
            if (og + 1u == nx) {
#pragma unroll
                for (int j = 0; j < 16; ++j) (void)xb_add(&use[SPL_DONE + 16 * j], 1u); } }
    }
}
__device__ __forceinline__ void split_wait(unsigned* bar, unsigned* use, unsigned x, bool acq) {
    if (threadIdx.x == 0) {
        XB_SPIN(xb_ld(&use[SPL_DONE + 16 * x]) == 0u, bar);
        if (acq) { __builtin_amdgcn_fence(__ATOMIC_ACQUIRE, "agent"); asm volatile("s_waitcnt vmcnt(0)" ::: "memory"); }
    }
    asm volatile("s_waitcnt lgkmcnt(0)" ::: "memory"); __builtin_amdgcn_s_barrier(); asm volatile("" ::: "memory");
}
#define SPLU(k) ((unsigned*)(F.ctl + CW_SPL) + SPL_USE_WORDS * ((k) - 1))

struct Frame {
    LAS unsigned char* lds;
    volatile LAS unsigned* MISC;
    gu32* ctl;
    int tid, lane, wave, vcu, G;
    unsigned char* ws; float* out;
};
__device__ __forceinline__ const void* in_ptr(const Frame& F, int k) {
    const unsigned lo = __builtin_amdgcn_readfirstlane(F.MISC[32 + 2 * k]), hi = __builtin_amdgcn_readfirstlane(F.MISC[33 + 2 * k]);
    return (const void*)(((unsigned long long)hi << 32) | lo);
}
#define IN_x ((const float*)in_ptr(F, 0))
#define IN_p ((const float*)in_ptr(F, 1))
#define IN_pos ((const int*)in_ptr(F, 2))
#define IN_g_mix ((const float*)in_ptr(F, 3))
#define IN_w_in ((const float*)in_ptr(F, 4))
#define IN_w_a2 ((const float*)in_ptr(F, 5))
#define IN_b_a ((const float*)in_ptr(F, 6))
#define IN_g_gla ((const float*)in_ptr(F, 7))
#define IN_g_mq ((const float*)in_ptr(F, 8))
#define IN_g_mk ((const float*)in_ptr(F, 9))
#define IN_w_out ((const float*)in_ptr(F, 10))
#define IN_g_ffn ((const float*)in_ptr(F, 11))
#define IN_w_up ((const float*)in_ptr(F, 12))
#define IN_w_down ((const float*)in_ptr(F, 13))
#define IN_g_pg ((const float*)in_ptr(F, 14))
#define IN_w_pg ((const float*)in_ptr(F, 15))
#define IN_w_pp ((const float*)in_ptr(F, 16))
#define IN_g_pe ((const float*)in_ptr(F, 17))
template <int CTRL> __device__ __forceinline__ float dpp_mov(float v) { return __builtin_bit_cast(float, __builtin_amdgcn_update_dpp(0, __builtin_bit_cast(int, v), CTRL, 0xf, 0xf, true)); }
__device__ __forceinline__ float row16_sum(float v) { v += dpp_mov<0xB1>(v); v += dpp_mov<0x4E>(v); v += dpp_mov<0x141>(v); v += dpp_mov<0x140>(v); return v; }
__device__ __forceinline__ float wave_sum(float v) {
    v = row16_sum(v);
    const float s0 = __builtin_bit_cast(float, __builtin_amdgcn_readlane(__builtin_bit_cast(int, v), 0)), s1 = __builtin_bit_cast(float, __builtin_amdgcn_readlane(__builtin_bit_cast(int, v), 16));
    const float s2 = __builtin_bit_cast(float, __builtin_amdgcn_readlane(__builtin_bit_cast(int, v), 32)), s3 = __builtin_bit_cast(float, __builtin_amdgcn_readlane(__builtin_bit_cast(int, v), 48));
    return (s0 + s1) + (s2 + s3);
}
__device__ __forceinline__ float bf2f(unsigned v16) { return __uint_as_float(v16 << 16); }

#ifdef PROBE_LO
#define STAMP(k) do { if (blockIdx.x == 0 && F.tid == 0) { const unsigned long long t_ = rt(); F.MISC[80 + 2 * (k)] = (unsigned)t_; F.MISC[81 + 2 * (k)] = (unsigned)(t_ >> 32); } } while (0)
#else
#define STAMP(k) do { } while (0)
#endif
struct TItem { const float* W; const float* gain; bf16* WT; int ldn, src_col, K, n_dst, k0, perm; };
constexpr int TI_IN = (D_ / 64) * (ZW / 32), TI_PP = (PLE_ / 64) * (D_ / 32), TI_OUT = (D_ / 64) * (D_ / 32), TI_UP = (D_ / 64) * (FF_ / 32), TI_DN = (FF_ / 64) * (D_ / 32), TI_PG = TI_OUT;
constexpr int TI_EARLY = TI_IN + TI_PP, TI_ALL = TI_EARLY + TI_OUT + TI_UP + TI_DN + TI_PG;
constexpr int TQ_BATCH = 2 * NWAVES, TQ_N = (TI_ALL - TI_EARLY) / TQ_BATCH;
static_assert((TI_ALL - TI_EARLY) % TQ_BATCH == 0, "deferred transposes: whole batches");
__device__ __forceinline__ TItem p0_decode(const Frame& F, int it) {
    TItem t; int r = it;
    t.perm = -1;
    if (r < TI_IN) { const int nb = r % (ZW / 32), kb = r / (ZW / 32), n0 = 32 * nb; t.W = IN_w_in; t.gain = IN_g_mix; t.WT = (bf16*)(F.ws + WS_WIN); t.ldn = INW_; t.K = D_; t.n_dst = n0; t.k0 = 64 * kb;
        if (n0 >= Z_MQ && n0 < Z_MV) { t.perm = (n0 & 127) >> 5; t.src_col = (n0 & ~127) + 16; }
        else t.src_col = n0 < 1536 ? n0 : n0 + 16;
        return t; } r -= TI_IN;
    if (r < TI_PP) { const int nb = r % (D_ / 32), kb = r / (D_ / 32); t.W = IN_w_pp; t.gain = nullptr; t.WT = (bf16*)(F.ws + WS_WPP); t.ldn = D_; t.src_col = 32 * nb; t.K = PLE_; t.n_dst = 32 * nb; t.k0 = 64 * kb; return t; } r -= TI_PP;
    if (r < TI_OUT) { const int nb = r % (D_ / 32), kb = r / (D_ / 32); t.W = IN_w_out; t.gain = nullptr; t.WT = (bf16*)(F.ws + WS_WOUT); t.ldn = D_; t.src_col = 32 * nb; t.K = D_; t.n_dst = 32 * nb; t.k0 = 64 * kb; return t; } r -= TI_OUT;
    if (r < TI_UP) { const int nb = r % (FF_ / 32), kb = r / (FF_ / 32); t.W = IN_w_up; t.gain = IN_g_ffn; t.WT = (bf16*)(F.ws + WS_WUP); t.ldn = FF_; t.src_col = 32 * nb; t.K = D_; t.n_dst = 32 * nb; t.k0 = 64 * kb; return t; } r -= TI_UP;
    if (r < TI_DN) { const int nb = r % (D_ / 32), kb = r / (D_ / 32); t.W = IN_w_down; t.gain = nullptr; t.WT = (bf16*)(F.ws + WS_WDOWN); t.ldn = D_; t.src_col = 32 * nb; t.K = FF_; t.n_dst = 32 * nb; t.k0 = 64 * kb; return t; } r -= TI_DN;
    { const int nb = r % (D_ / 32), kb = r / (D_ / 32); t.W = IN_w_pg; t.gain = IN_g_pg; t.WT = (bf16*)(F.ws + WS_WPG); t.ldn = D_; t.src_col = 32 * nb; t.K = D_; t.n_dst = 32 * nb; t.k0 = 64 * kb; return t; }
}
__device__ __forceinline__ void p0_issue(const TItem& t, int lane, float (&w)[32], f32x4 (&g)[2]) {
    const int lam = lane & 31;
    const int cm = t.perm < 0 ? lam : (((lam & 7) < 4) ? 16 * t.perm + 4 * (lam >> 3) + (lam & 7) : 64 + 16 * t.perm + 4 * (lam >> 3) + (lam & 7) - 4);
    const float* src = t.W + (size_t)(t.k0 + (lane >> 5)) * t.ldn + t.src_col + cm;
#pragma unroll
    for (int i = 0; i < 32; ++i) w[i] = __builtin_nontemporal_load(src + (size_t)(2 * i) * t.ldn);
    if (t.gain) { g[0] = *(const f32x4*)(t.gain + t.k0 + 8 * (lane & 7)); g[1] = *(const f32x4*)(t.gain + t.k0 + 8 * (lane & 7) + 4); }
    else { g[0] = (f32x4){1.f, 1.f, 1.f, 1.f}; g[1] = g[0]; }
}
__device__ __forceinline__ void tr_items(const Frame& F, int lane, LAS float* scr, int first, int stride, int end) {
    int it = first; bool have = it < end;
    float w[32]; f32x4 g[2]; TItem cur;
    if (have) { cur = p0_decode(F, it); p0_issue(cur, lane, w, g); }
    while (have) {
#pragma unroll
        for (int i = 0; i < 32; ++i) scr[(2 * i + (lane >> 5)) * 33 + (lane & 31)] = w[i];
        const f32x4 g0 = g[0], g1 = g[1]; const TItem t = cur;
        LDS_WAIT(); asm volatile("" ::: "memory");
        const int nit = it + stride; const bool nh = nit < end;
        if (nh) { cur = p0_decode(F, nit); p0_issue(cur, lane, w, g); }
        const int c = lane & 7;
#pragma unroll
        for (int j = 0; j < 4; ++j) { const int n = (lane >> 3) + 8 * j; const LAS float* s = scr + (8 * c) * 33 + n;
            v4u o; o.x = pk2(s[0 * 33] * g0[0], s[1 * 33] * g0[1]); o.y = pk2(s[2 * 33] * g0[2], s[3 * 33] * g0[3]); o.z = pk2(s[4 * 33] * g1[0], s[5 * 33] * g1[1]); o.w = pk2(s[6 * 33] * g1[2], s[7 * 33] * g1[3]);
            *(GAS v4u*)(t.WT + (size_t)(t.n_dst + n) * t.K + t.k0 + 8 * c) = o; }
        LDS_WAIT(); asm volatile("" ::: "memory");
        it = nit; have = nh;
    }
}
__device__ __forceinline__ void tr_store(const TItem& t, int lane, LAS float* scr, const float (&w)[32], const f32x4 (&g)[2]) {
#pragma unroll
    for (int i = 0; i < 32; ++i) scr[(2 * i + (lane >> 5)) * 33 + (lane & 31)] = w[i];
    LDS_WAIT(); asm volatile("" ::: "memory");
    const int c = lane & 7;
#pragma unroll
    for (int j = 0; j < 4; ++j) { const int n = (lane >> 3) + 8 * j; const LAS float* s = scr + (8 * c) * 33 + n;
        v4u o; o.x = pk2(s[0 * 33] * g[0][0], s[1 * 33] * g[0][1]); o.y = pk2(s[2 * 33] * g[0][2], s[3 * 33] * g[0][3]); o.z = pk2(s[4 * 33] * g[1][0], s[5 * 33] * g[1][1]); o.w = pk2(s[6 * 33] * g[1][2], s[7 * 33] * g[1][3]);
        *(GAS v4u*)(t.WT + (size_t)(t.n_dst + n) * t.K + t.k0 + 8 * c) = o; }
    LDS_WAIT(); asm volatile("" ::: "memory");
}
__device__ __forceinline__ void tr_pair(const Frame& F, int lane, LAS float* scr, int itA, int itB) {
    float wA[32], wB[32]; f32x4 gA[2], gB[2];
    const TItem tA = p0_decode(F, itA); p0_issue(tA, lane, wA, gA);
    const TItem tB = p0_decode(F, itB); p0_issue(tB, lane, wB, gB);
    tr_store(tA, lane, scr, wA, gA);
    tr_store(tB, lane, scr, wB, gB);
}
__device__ __forceinline__ void p0_prologue(Frame& F) {
    LAS float* scr = (LAS float*)(F.lds + RING_OFF + F.wave * 16384);
    constexpr int P0_ROWW = 4, P0_TRW = NWAVES - P0_ROWW;
    const bool row_role = F.wave < P0_ROWW;
    const int gw = row_role ? F.vcu * P0_ROWW + F.wave : F.vcu * P0_TRW + (F.wave - P0_ROWW), NGW = F.G * (row_role ? P0_ROWW : P0_TRW);
    bf16* Wga_t = (bf16*)(F.ws + WS_WGA);
    if (!row_role) tr_items(F, F.lane, scr, gw, NGW, TI_EARLY);
    if (!row_role) { const float* wi_ = IN_w_in; const float* gm_ = IN_g_mix;
      for (int i = gw * 64 + F.lane; i < 16 * D_; i += NGW * 64) { const int r = i >> 10, k = i & 1023; Wga_t[i] = (bf16)f2bf(wi_[(size_t)k * INW_ + 1536 + r] * gm_[k]); } }
    bf16* xb = (bf16*)(F.ws + WS_AB); bf16* pb = (bf16*)(F.ws + WS_PB); float* rstdx = (float*)(F.ws + WS_RSTDX);
    const float* x_ = IN_x; const float* p_ = IN_p;
    if (row_role) {
        f32x4 v[4][4], pv[4], vn[4][4], pvn[4];
        int m0 = gw * 4; bool have = m0 < S_;
        if (have) {
#pragma unroll
            for (int rr = 0; rr < 4; ++rr) { const GAS f32x4* xr = (const GAS f32x4*)(x_ + (size_t)(m0 + rr) * D_) + F.lane;
#pragma unroll
                for (int j = 0; j < 4; ++j) v[rr][j] = __builtin_nontemporal_load(xr + 64 * j);
                pv[rr] = __builtin_nontemporal_load((const GAS f32x4*)(p_ + (size_t)(m0 + rr) * PLE_) + F.lane); }
        }
        while (have) {
            const int m1 = m0 + NGW * 4; const bool nh = m1 < S_;
            if (nh) {
#pragma unroll
                for (int rr = 0; rr < 4; ++rr) { const GAS f32x4* xr = (const GAS f32x4*)(x_ + (size_t)(m1 + rr) * D_) + F.lane;
#pragma unroll
                    for (int j = 0; j < 4; ++j) vn[rr][j] = __builtin_nontemporal_load(xr + 64 * j);
                    pvn[rr] = __builtin_nontemporal_load((const GAS f32x4*)(p_ + (size_t)(m1 + rr) * PLE_) + F.lane); }
            }
#pragma unroll
            for (int rr = 0; rr < 4; ++rr) { const int m = m0 + rr; float s = 0.f;
#pragma unroll
                for (int j = 0; j < 4; ++j) s += (v[rr][j].x * v[rr][j].x + v[rr][j].y * v[rr][j].y) + (v[rr][j].z * v[rr][j].z + v[rr][j].w * v[rr][j].w);
                s = wave_sum(s);
                const float nrm = sqrtf(s * (1.0f / D_) + EPS_), rsd = 1.0f / nrm;
                GAS unsigned long long* o8 = (GAS unsigned long long*)(xb + (size_t)m * D_) + F.lane;
#pragma unroll
                for (int j = 0; j < 4; ++j) o8[64 * j] = (unsigned long long)pk2(v[rr][j].x * rsd, v[rr][j].y * rsd) | ((unsigned long long)pk2(v[rr][j].z * rsd, v[rr][j].w * rsd) << 32);
                if (F.lane == 0) rstdx[m] = nrm;
                *((GAS unsigned long long*)(pb + (size_t)m * PLE_) + F.lane) = (unsigned long long)pk2(pv[rr].x, pv[rr].y) | ((unsigned long long)pk2(pv[rr].z, pv[rr].w) << 32); }
#pragma unroll
            for (int rr = 0; rr < 4; ++rr) { pv[rr] = pvn[rr];
#pragma unroll
                for (int j = 0; j < 4; ++j) v[rr][j] = vn[rr][j]; }
            m0 = m1; have = nh;
        }
    }
}

__device__ __forceinline__ void p0_stage_p(Frame& F) {
    LAS float* scr = (LAS float*)(F.lds + RING_OFF + F.wave * 16384);
    constexpr int P0_ROWW = 4, P0_TRW = NWAVES - P0_ROWW;
    const bool row_role = F.wave < P0_ROWW;
    const int gw = row_role ? F.vcu * P0_ROWW + F.wave : F.vcu * P0_TRW + (F.wave - P0_ROWW), NGW = F.G * (row_role ? P0_ROWW : P0_TRW);
    if (!row_role) tr_items(F, F.lane, scr, TI_IN + gw, NGW, TI_EARLY);
    else {
        bf16* pb = (bf16*)(F.ws + WS_PB); const float* p_ = IN_p;
        f32x4 pv[4][4];
#pragma unroll
        for (int t = 0; t < 4; ++t)
#pragma unroll
            for (int rr = 0; rr < 4; ++rr) { const int m = gw * 4 + NGW * 4 * t + rr; if (m < S_) pv[t][rr] = __builtin_nontemporal_load((const GAS f32x4*)(p_ + (size_t)m * PLE_) + F.lane); }
#pragma unroll
        for (int t = 0; t < 4; ++t)
#pragma unroll
            for (int rr = 0; rr < 4; ++rr) { const int m = gw * 4 + NGW * 4 * t + rr;
                if (m < S_) *((GAS unsigned long long*)(pb + (size_t)m * PLE_) + F.lane) = (unsigned long long)pk2(pv[t][rr].x, pv[t][rr].y) | ((unsigned long long)pk2(pv[t][rr].z, pv[t][rr].w) << 32); }
    }
}
__device__ __forceinline__ void p0_stage_x(Frame& F) {
    LAS float* scr = (LAS float*)(F.lds + RING_OFF + F.wave * 16384);
    constexpr int P0_ROWW = 4, P0_TRW = NWAVES - P0_ROWW;
    const bool row_role = F.wave < P0_ROWW;
    const int gw = row_role ? F.vcu * P0_ROWW + F.wave : F.vcu * P0_TRW + (F.wave - P0_ROWW), NGW = F.G * (row_role ? P0_ROWW : P0_TRW);
    if (!row_role) {
        tr_items(F, F.lane, scr, gw, NGW, TI_IN);
        bf16* Wga_t = (bf16*)(F.ws + WS_WGA); const float* wi_ = IN_w_in; const float* gm_ = IN_g_mix;
        for (int i = gw * 64 + F.lane; i < 16 * D_; i += NGW * 64) { const int r = i >> 10, k = i & 1023; Wga_t[i] = (bf16)f2bf(wi_[(size_t)k * INW_ + 1536 + r] * gm_[k]); }
    } else {
        bf16* xb = (bf16*)(F.ws + WS_AB); float* rstdx = (float*)(F.ws + WS_RSTDX); const float* x_ = IN_x;
        f32x4 v[4][4], vn[4][4];
        int m0 = gw * 4; bool have = m0 < S_;
        if (have) {
#pragma unroll
            for (int rr = 0; rr < 4; ++rr) { const GAS f32x4* xr = (const GAS f32x4*)(x_ + (size_t)(m0 + rr) * D_) + F.lane;
#pragma unroll
                for (int j = 0; j < 4; ++j) v[rr][j] = __builtin_nontemporal_load(xr + 64 * j); }
        }
        while (have) {
            const int m1 = m0 + NGW * 4; const bool nh = m1 < S_;
            if (nh) {
#pragma unroll
                for (int rr = 0; rr < 4; ++rr) { const GAS f32x4* xr = (const GAS f32x4*)(x_ + (size_t)(m1 + rr) * D_) + F.lane;
#pragma unroll
                    for (int j = 0; j < 4; ++j) vn[rr][j] = __builtin_nontemporal_load(xr + 64 * j); }
            }
#pragma unroll
            for (int rr = 0; rr < 4; ++rr) { const int m = m0 + rr; float sq = 0.f;
#pragma unroll
                for (int j = 0; j < 4; ++j) sq += (v[rr][j].x * v[rr][j].x + v[rr][j].y * v[rr][j].y) + (v[rr][j].z * v[rr][j].z + v[rr][j].w * v[rr][j].w);
                sq = wave_sum(sq);
                const float nrm = sqrtf(sq * (1.0f / D_) + EPS_), rsd = 1.0f / nrm;
                GAS unsigned long long* o8 = (GAS unsigned long long*)(xb + (size_t)m * D_) + F.lane;
#pragma unroll
                for (int j = 0; j < 4; ++j) o8[64 * j] = (unsigned long long)pk2(v[rr][j].x * rsd, v[rr][j].y * rsd) | ((unsigned long long)pk2(v[rr][j].z * rsd, v[rr][j].w * rsd) << 32);
                if (F.lane == 0) rstdx[m] = nrm; }
#pragma unroll
            for (int rr = 0; rr < 4; ++rr)
#pragma unroll
                for (int j = 0; j < 4; ++j) v[rr][j] = vn[rr][j];
            m0 = m1; have = nh;
        }
    }
}

typedef float f32x16 __attribute__((ext_vector_type(16)));
typedef __bf16 bf2_t __attribute__((ext_vector_type(2)));
typedef float f2_t __attribute__((ext_vector_type(2)));
__device__ __forceinline__ unsigned pkbf(float lo, float hi) { f2_t v = {lo, hi}; bf2_t b = __builtin_convertvector(v, bf2_t); return __builtin_bit_cast(unsigned, b); }
#define MFMA32(a, b, c) __builtin_amdgcn_mfma_f32_32x32x16_bf16((a), (b), (c), 0, 0, 0)
#define WG_SYNC() do { asm volatile("s_waitcnt lgkmcnt(0)" ::: "memory"); __builtin_amdgcn_s_barrier(); asm volatile("" ::: "memory"); } while (0)
__device__ __forceinline__ bf16x8 pack8(const f32x16& x, int s) {
    v4u p; p.x = pkbf(x[8 * s], x[8 * s + 1]); p.y = pkbf(x[8 * s + 2], x[8 * s + 3]); p.z = pkbf(x[8 * s + 4], x[8 * s + 5]); p.w = pkbf(x[8 * s + 6], x[8 * s + 7]);
    return __builtin_bit_cast(bf16x8, p);
}
__device__ __forceinline__ float log_sigmoid(float s) { return fminf(s, 0.f) - __logf(1.0f + __expf(-fabsf(s))); }
constexpr int GROW = 72;
__device__ __forceinline__ int tperm(int tt) { return (tt & ~15) + 8 * ((tt >> 2) & 1) + 4 * ((tt >> 3) & 1) + (tt & 3); }
typedef short s16x4_t __attribute__((ext_vector_type(4)));
__device__ __forceinline__ unsigned voff_b(unsigned row, unsigned ch) { return 256u * row + 16u * (ch ^ (((row & 3u) << 2) | ((row >> 2) & 3u))); }
__device__ __forceinline__ bf16x8 v_tr_frag(const LAS unsigned char* VL, int kb0, int et, int lane) {
    const unsigned hh = lane >> 5, blk = (lane >> 4) & 1, q = (lane & 15) >> 2, p = lane & 3;
    const unsigned r0 = kb0 + 4 * hh + q, ch = 4 * et + 2 * blk + (p >> 1);
    const s16x4_t lo = __builtin_amdgcn_ds_read_tr16_b64_v4i16((LAS s16x4_t*)(VL + voff_b(r0, ch) + 8 * (p & 1)));
    const s16x4_t hi = __builtin_amdgcn_ds_read_tr16_b64_v4i16((LAS s16x4_t*)(VL + voff_b(r0 + 8, ch) + 8 * (p & 1)));
    return __builtin_shufflevector(lo, hi, 0, 1, 2, 3, 4, 5, 6, 7);
}
__device__ __forceinline__ void v_tr_offsets(int lane, unsigned (&o)[8]) {
    const unsigned hh = lane >> 5, blk = (lane >> 4) & 1, q = (lane & 15) >> 2, p = lane & 3;
#pragma unroll
    for (int et = 0; et < 4; ++et) { const unsigned ch = 4 * et + 2 * blk + (p >> 1); o[et] = voff_b(4 * hh + q, ch) + 8 * (p & 1); o[4 + et] = voff_b(8 + 4 * hh + q, ch) + 8 * (p & 1); }
}
__device__ __forceinline__ bf16x8 v_tr_frag_o(const LAS unsigned char* VL, int kb0, unsigned o_lo, unsigned o_hi) {
    const s16x4_t lo = __builtin_amdgcn_ds_read_tr16_b64_v4i16((LAS s16x4_t*)(VL + 256 * kb0 + o_lo));
    const s16x4_t hi = __builtin_amdgcn_ds_read_tr16_b64_v4i16((LAS s16x4_t*)(VL + 256 * kb0 + o_hi));
    return __builtin_shufflevector(lo, hi, 0, 1, 2, 3, 4, 5, 6, 7);
}

__device__ __forceinline__ void split_bf16x8(const float (&v)[8], bf16x8& hi, bf16x8& lo) {
    unsigned h[4], l[4];
#pragma unroll
    for (int k = 0; k < 4; ++k) { const unsigned p = pkbf(v[2 * k], v[2 * k + 1]); h[k] = p; l[k] = pkbf(v[2 * k] - bf2f(p & 0xffffu), v[2 * k + 1] - bf2f(p >> 16)); }
    hi = __builtin_bit_cast(bf16x8, (v4u){h[0], h[1], h[2], h[3]}); lo = __builtin_bit_cast(bf16x8, (v4u){l[0], l[1], l[2], l[3]});
}
__device__ __forceinline__ void gla_load_w2(Frame& F, bf16x8& whi, bf16x8& wlo, float& bias) {
    const int c = 32 * F.wave + (F.lane & 31), hh = F.lane >> 5;
    const float* wa2_ = IN_w_a2;
    float w[8];
#pragma unroll
    for (int j = 0; j < 8; ++j) w[j] = wa2_[(8 * hh + j) * 256 + c];
    split_bf16x8(w, whi, wlo);
    bias = IN_b_a[c];
}
__device__ __forceinline__ void gla_cumsum(Frame& F, const LAS float* GAS_, const bf16x8 whi, const bf16x8 wlo, float bias, float (&bv)[2][16], float& blast) {
    const int i = F.lane & 31, hh = F.lane >> 5;
    float gs[2][4];
#pragma unroll
    for (int tt = 0; tt < 2; ++tt) {
        const LAS f32x4* g4 = (const LAS f32x4*)(GAS_ + (32 * tt + i) * 16 + 8 * hh);
        const f32x4 g0 = g4[0], g1 = g4[1];
        const float gv[8] = {g0[0], g0[1], g0[2], g0[3], g1[0], g1[1], g1[2], g1[3]};
        bf16x8 ghi, glo; split_bf16x8(gv, ghi, glo);
        f32x16 acc;
#pragma unroll
        for (int r = 0; r < 16; ++r) acc[r] = 0.f;
        acc = MFMA32(ghi, whi, acc); acc = MFMA32(ghi, wlo, acc); acc = MFMA32(glo, whi, acc);
#pragma unroll
        for (int r = 0; r < 16; ++r) bv[tt][r] = log_sigmoid(acc[r] + bias) * (1.0f / 16.0f);
#pragma unroll
        for (int g = 0; g < 4; ++g) gs[tt][g] = (bv[tt][4 * g] + bv[tt][4 * g + 1]) + (bv[tt][4 * g + 2] + bv[tt][4 * g + 3]);
    }
    float run = 0.f;
#pragma unroll
    for (int tt = 0; tt < 2; ++tt)
#pragma unroll
        for (int g = 0; g < 4; ++g) {
            const float mine = gs[tt][g], other = __shfl_xor(mine, 32);
            float off = run + (hh ? other : 0.f);
#pragma unroll
            for (int j = 0; j < 4; ++j) { off += bv[tt][4 * g + j]; bv[tt][4 * g + j] = off; }
            run += mine + other;
        }
    blast = run;
}
__device__ __forceinline__ void gla_vt_load(Frame& F, const bf16* zb, int t0, v4u (&vw)[8]) {
#pragma unroll
    for (int i = 0; i < 8; ++i) { const int idx = F.tid + 512 * i, t = idx >> 6, c64 = idx & 63; vw[i] = *(const v4u*)(zb + (size_t)(t0 + t) * ZG + Z_GV + 8 * c64); }
}
__device__ __forceinline__ void gla_vt_write(Frame& F, LAS unsigned char* VL, const v4u (&vw)[8]) {
#pragma unroll
    for (int i = 0; i < 8; ++i) { const int idx = F.tid + 512 * i, t = idx >> 6, c64 = idx & 63; *(LAS v4u*)(VL + (c64 >> 4) * 16384 + voff_b(t, c64 & 15)) = vw[i]; }
}

__device__ __forceinline__ void gla_a_chunk(Frame& F, int ch) {
    LAS float* GA_S = (LAS float*)(F.lds);
    LAS float* TOT = (LAS float*)(F.lds + 8192);
    LAS bf16* KTE = (LAS bf16*)(F.lds + 10240);
    LAS unsigned char* VT = F.lds + 10240 + 4 * 64 * GROW * 2;
    const bf16* xb = (const bf16*)(F.ws + WS_AB); const bf16* zb = (const bf16*)(F.ws + WS_Z); const bf16* wga = (const bf16*)(F.ws + WS_WGA);
    const float* rstdx = (const float*)(F.ws + WS_RSTDX); float* ga_g = (float*)(F.ws + WS_GA); float* decay_g = (float*)(F.ws + WS_DECAY); bf16* dS_g = (bf16*)(F.ws + WS_DS);
    const int t0 = ch * 64;
    bf16x8 whi, wlo; float bias; gla_load_w2(F, whi, wlo, bias);
    v4u vw[8]; gla_vt_load(F, zb, t0, vw);
    LAS bf16* KRAW = (LAS bf16*)(VT + 65536);
    v4u kw[4];
#pragma unroll
    for (int i = 0; i < 4; ++i) { const int idx = F.tid + 512 * i, t = idx >> 5, c32 = idx & 31; kw[i] = *(const v4u*)(zb + (size_t)(t0 + t) * ZG + Z_GK + 8 * c32); }
    {
        const int rg = F.wave & 3, kh = F.wave >> 2, r = F.lane & 15, q = F.lane >> 4;
        const bf16* arow = xb + (size_t)(t0 + 16 * rg + r) * D_ + 8 * q; const bf16* brow = wga + (size_t)r * D_ + 8 * q;
        pg8::f32x4 acc = {0.f, 0.f, 0.f, 0.f};
#pragma unroll
        for (int s = 16 * kh; s < 16 * kh + 16; ++s) { const bf16x8 a = *(const bf16x8*)(arow + 32 * s), b = *(const bf16x8*)(brow + 32 * s); acc = __builtin_amdgcn_mfma_f32_16x16x32_bf16(a, b, acc, 0, 0, 0); }
#pragma unroll
        for (int g = 0; g < 4; ++g) GA_S[kh * 1024 + (16 * rg + 4 * q + g) * 16 + r] = acc[g];
    }
#pragma unroll
    for (int i = 0; i < 4; ++i) { const int idx = F.tid + 512 * i, t = idx >> 5, c32 = idx & 31; *(LAS v4u*)(KRAW + (size_t)((c32 >> 3) * 64 + t) * GROW + 8 * (c32 & 7)) = kw[i]; }
    gla_vt_write(F, VT, vw);
    WG_SYNC();
    for (int idx = F.tid; idx < 1024; idx += 512) { const float v = GA_S[idx] + GA_S[1024 + idx]; GA_S[idx] = v; ga_g[(size_t)t0 * 16 + idx] = v; }
    WG_SYNC();
    float bv[2][16], blast;
    gla_cumsum(F, GA_S, whi, wlo, bias, bv, blast);
    {
        const int i = F.lane & 31, hh = F.lane >> 5, c = 32 * F.wave + i, h = c >> 6, d = c & 63;
        if (hh == 0) decay_g[ch * 256 + c] = __expf(blast);
#pragma unroll
        for (int tt = 0; tt < 2; ++tt)
#pragma unroll
            for (int g = 0; g < 4; ++g) {
                float v[4];
#pragma unroll
                for (int j = 0; j < 4; ++j) { const int t = 32 * tt + 8 * g + 4 * hh + j; v[j] = bf2f(KRAW[(size_t)(h * 64 + t) * GROW + d]) * __expf(blast - bv[tt][4 * g + j]); }
                typedef unsigned u2 __attribute__((ext_vector_type(2)));
                u2 w; w.x = pkbf(v[0], v[1]); w.y = pkbf(v[2], v[3]);
                *(LAS u2*)(KTE + (size_t)(h * 64 + d) * GROW + 32 * tt + 16 * (g >> 1) + 8 * hh + 4 * (g & 1)) = w;
            }
    }
    WG_SYNC();
    {
        const int h = F.wave >> 1, dt = F.wave & 1, i = F.lane & 31, hh = F.lane >> 5;
        f32x16 acc[4];
#pragma unroll
        for (int et = 0; et < 4; ++et)
#pragma unroll
            for (int r = 0; r < 16; ++r) acc[et][r] = 0.f;
#pragma unroll
        for (int s = 0; s < 4; ++s) {
            const bf16x8 a = *(const LAS bf16x8*)(KTE + (size_t)(h * 64 + 32 * dt + i) * GROW + 16 * s + 8 * hh);
#pragma unroll
            for (int et = 0; et < 4; ++et) { const bf16x8 b = v_tr_frag(VT + h * 16384, 16 * s, et, F.lane); acc[et] = MFMA32(a, b, acc[et]); }
        }
        WG_SYNC();
        LAS bf16* DST = (LAS bf16*)VT;
#pragma unroll
        for (int et = 0; et < 4; ++et) {
            LAS bf16* dst = DST + (size_t)(h * 128 + 32 * et + i) * GROW + 32 * dt + 4 * hh;
            typedef unsigned u2 __attribute__((ext_vector_type(2)));
#pragma unroll
            for (int g = 0; g < 4; ++g) { u2 w; w.x = pkbf(acc[et][4 * g], acc[et][4 * g + 1]); w.y = pkbf(acc[et][4 * g + 2], acc[et][4 * g + 3]); *(LAS u2*)(dst + 8 * g) = w; }
        }
    }
    WG_SYNC();
    {
        const LAS bf16* DST = (const LAS bf16*)VT;
        bf16* dS_c = dS_g + (size_t)ch * 4 * 128 * 64;
#pragma unroll
        for (int k = 0; k < 8; ++k) { const int idx = F.tid + 512 * k, row = idx >> 3, p = idx & 7; *(v4u*)(dS_c + (size_t)idx * 8) = *(const LAS v4u*)(DST + (size_t)row * GROW + 8 * p); }
    }
    WG_SYNC();
}

__device__ __forceinline__ void gla_b_pair(Frame& F, int pair) {
    LAS float* DSL = (LAS float*)(F.lds);
    LAS float* DEC = (LAS float*)(F.lds + 65536);
    LAS float* SEGE = (LAS float*)(F.lds + 131072);
    LAS float* SEGP = (LAS float*)(F.lds + 131072 + 2048);
    const float* decay_g = (const float*)(F.ws + WS_DECAY); const bf16* dS_g = (const bf16*)(F.ws + WS_DS); bf16* sp_g = (bf16*)((unsigned char*)F.out + OUT_SPREV);
    const int h = pair >> 6, seg = F.tid >> 6, d = F.tid & 63;
#pragma unroll
    for (int i = 0; i < 8; ++i) { const int idx = F.tid + 512 * i, n = idx >> 4, d4 = idx & 15; *(LAS pg8::f32x4*)(DEC + n * 64 + 4 * d4) = *(const pg8::f32x4*)(decay_g + (size_t)n * 256 + h * 64 + 4 * d4); }
    for (int sub = 0; sub < 2; ++sub) {
        const int e = (pair & 63) * 2 + sub;
#pragma unroll
        for (int i = 0; i < 4; ++i) { const int idx = F.tid + 512 * i, n = idx >> 3, d8 = idx & 7;
            const v4u w = *(const v4u*)(dS_g + ((size_t)(n * 4 + h) * 128 + e) * 64 + 8 * d8);
            LAS pg8::f32x4* dp = (LAS pg8::f32x4*)(DSL + n * 64 + 8 * d8);
            dp[0] = (pg8::f32x4){bf2f(w.x & 0xffffu), bf2f(w.x >> 16), bf2f(w.y & 0xffffu), bf2f(w.y >> 16)}; dp[1] = (pg8::f32x4){bf2f(w.z & 0xffffu), bf2f(w.z >> 16), bf2f(w.w & 0xffffu), bf2f(w.w >> 16)}; }
        WG_SYNC();
        float Sv = 0.f, P = 1.f;
#pragma unroll 8
        for (int i = 0; i < 32; ++i) { const int n = seg * 32 + i; const float x = DSL[n * 64 + d], a = DEC[n * 64 + d]; DSL[n * 64 + d] = Sv; Sv = a * Sv + x; P *= a; }
        SEGE[seg * 64 + d] = Sv; SEGP[seg * 64 + d] = P;
        WG_SYNC();
        float st = 0.f;
        for (int k = 0; k < seg; ++k) st = SEGP[k * 64 + d] * st + SEGE[k * 64 + d];
        float Pq = 1.f;
#pragma unroll 8
        for (int i = 0; i < 32; ++i) { const int n = seg * 32 + i; const float v = DSL[n * 64 + d] + Pq * st; Pq *= DEC[n * 64 + d]; sp_g[((size_t)(n * 4 + h) * 128 + e) * 64 + d] = (bf16)f2bf(v); }
        WG_SYNC();
    }
}

__device__ __forceinline__ void gla_c_chunk(Frame& F, int ch) {
    LAS float* GA2 = (LAS float*)(F.lds);
    LAS float* TOT = (LAS float*)(F.lds + 4096);
    LAS bf16* QD = (LAS bf16*)(F.lds + 6144);
    LAS bf16* KI = (LAS bf16*)(F.lds + 6144 + 36864);
    LAS unsigned char* VT = F.lds + 6144 + 2 * 36864;
    const bf16* zb = (const bf16*)(F.ws + WS_Z); const float* ga_g = (const float*)(F.ws + WS_GA); const bf16* sp_g = (const bf16*)((const unsigned char*)F.out + OUT_SPREV); bf16* mixb = (bf16*)(F.ws + WS_MIX);
    const int t0 = ch * 64;
    bf16x8 whi, wlo; float bias; gla_load_w2(F, whi, wlo, bias);
    v4u vw[8]; gla_vt_load(F, zb, t0, vw);
    v4u qw[4], kw[4];
#pragma unroll
    for (int i = 0; i < 4; ++i) { const int idx = F.tid + 512 * i, t = idx >> 5, c32 = idx & 31; qw[i] = *(const v4u*)(zb + (size_t)(t0 + t) * ZG + Z_GQ + 8 * c32); kw[i] = *(const v4u*)(zb + (size_t)(t0 + t) * ZG + Z_GK + 8 * c32); }
    for (int idx = F.tid; idx < 1024; idx += 512) GA2[idx] = ga_g[(size_t)t0 * 16 + idx];
#pragma unroll
    for (int i = 0; i < 4; ++i) { const int idx = F.tid + 512 * i, t = idx >> 5, c32 = idx & 31; const size_t o = (size_t)((c32 >> 3) * 64 + t) * GROW + 8 * (c32 & 7); *(LAS v4u*)(QD + o) = qw[i]; *(LAS v4u*)(KI + o) = kw[i]; }
    gla_vt_write(F, VT, vw);
    WG_SYNC();
    float bv[2][16], blast;
    gla_cumsum(F, GA2, whi, wlo, bias, bv, blast);
    {
        const int i = F.lane & 31, hh = F.lane >> 5, c = 32 * F.wave + i, h = c >> 6, d = c & 63;
#pragma unroll
        for (int tt = 0; tt < 2; ++tt)
#pragma unroll
            for (int r = 0; r < 16; ++r) {
                const int t = 32 * tt + (r & 3) + 8 * (r >> 2) + 4 * hh; const float b = bv[tt][r];
                const size_t o = (size_t)(h * 64 + t) * GROW + d;
                const float qd = bf2f(QD[o]) * __expf(b) * 0.125f, ki = bf2f(KI[o]) * __expf(-b);
                QD[o] = (bf16)f2bf(qd); KI[o] = (bf16)f2bf(ki);
            }
    }
    bf16x8 sfr[4][4];
    { const int h_ = F.wave >> 1, i_ = F.lane & 31, hh_ = F.lane >> 5;
#pragma unroll
      for (int et = 0; et < 4; ++et) { const bf16* srow = sp_g + ((size_t)(ch * 4 + h_) * 128 + 32 * et + i_) * 64 + 8 * hh_;
#pragma unroll
          for (int s = 0; s < 4; ++s) sfr[et][s] = *(const bf16x8*)(srow + 16 * s); } }
    v4u ggw[8];
#pragma unroll
    for (int k = 0; k < 8; ++k) { const int idx = F.tid + 512 * k, t = idx >> 6, c64 = idx & 63; ggw[k] = *(const v4u*)(zb + (size_t)(t0 + t) * ZG + Z_GG + 8 * c64); }
    WG_SYNC();
    {
        const int h = F.wave >> 1, ct = (F.wave & 1) ^ ((F.wave >> 2) & 1), i = F.lane & 31, hh = F.lane >> 5;
        bf16x8 qf[4];
#pragma unroll
        for (int s = 0; s < 4; ++s) qf[s] = *(const LAS bf16x8*)(QD + (size_t)(h * 64 + 32 * ct + i) * GROW + 16 * s + 8 * hh);
        f32x16 acc[4];
#pragma unroll
        for (int et = 0; et < 4; ++et)
#pragma unroll
            for (int r = 0; r < 16; ++r) acc[et][r] = 0.f;
#pragma unroll
        for (int et = 0; et < 4; ++et) {
#pragma unroll
            for (int s = 0; s < 4; ++s) acc[et] = MFMA32(sfr[et][s], qf[s], acc[et]);
        }
        for (int jt = 0; jt <= ct; ++jt) {
            f32x16 X;
#pragma unroll
            for (int r = 0; r < 16; ++r) X[r] = 0.f;
#pragma unroll
            for (int s = 0; s < 4; ++s) { const bf16x8 kf = *(const LAS bf16x8*)(KI + (size_t)(h * 64 + 32 * jt + i) * GROW + 16 * s + 8 * hh); X = MFMA32(kf, qf[s], X); }
            if (jt == ct) {
#pragma unroll
                for (int r = 0; r < 16; ++r) { const int j = (r & 3) + 8 * (r >> 2) + 4 * hh; if (j > i) X[r] = 0.f; }
            }
#pragma unroll
            for (int s2 = 0; s2 < 2; ++s2) {
                const bf16x8 xs = pack8(X, s2);
#pragma unroll
                for (int et = 0; et < 4; ++et) { const bf16x8 vf = v_tr_frag(VT + h * 16384, 32 * jt + 16 * s2, et, F.lane); acc[et] = MFMA32(vf, xs, acc[et]); }
            }
        }
        float ss = 0.f;
#pragma unroll
        for (int et = 0; et < 4; ++et)
#pragma unroll
            for (int r = 0; r < 16; ++r) ss += acc[et][r] * acc[et][r];
        ss += __shfl_xor(ss, 32);
        const float rn = __builtin_amdgcn_rsqf(ss * (1.0f / 128.0f) + EPS_);
        const float* ggl_ = IN_g_gla;
        WG_SYNC();
        const int t = 32 * ct + i;
#pragma unroll
        for (int et = 0; et < 4; ++et)
#pragma unroll
            for (int g = 0; g < 4; ++g) {
                const int e0 = 32 * et + 8 * g + 4 * hh;
                const pg8::f32x4 gl = *(const pg8::f32x4*)(ggl_ + e0);
                typedef unsigned u2 __attribute__((ext_vector_type(2)));
                u2 w; w.x = pkbf(acc[et][4 * g] * rn * gl[0], acc[et][4 * g + 1] * rn * gl[1]); w.y = pkbf(acc[et][4 * g + 2] * rn * gl[2], acc[et][4 * g + 3] * rn * gl[3]);
                *(LAS u2*)(VT + h * 16384 + voff_b(t, e0 >> 3) + 8 * hh) = w;
            }
    }
    WG_SYNC();
#pragma unroll
    for (int k = 0; k < 8; ++k) { const int idx = F.tid + 512 * k, t = idx >> 6, c64 = idx & 63;
        const v4u on = *(const LAS v4u*)(VT + (c64 >> 4) * 16384 + voff_b(t, c64 & 15)), gw = ggw[k];
        float o[8] = {bf2f(on.x & 0xffffu), bf2f(on.x >> 16), bf2f(on.y & 0xffffu), bf2f(on.y >> 16), bf2f(on.z & 0xffffu), bf2f(on.z >> 16), bf2f(on.w & 0xffffu), bf2f(on.w >> 16)};
        float gv[8] = {bf2f(gw.x & 0xffffu), bf2f(gw.x >> 16), bf2f(gw.y & 0xffffu), bf2f(gw.y >> 16), bf2f(gw.z & 0xffffu), bf2f(gw.z >> 16), bf2f(gw.w & 0xffffu), bf2f(gw.w >> 16)};
#pragma unroll
        for (int j = 0; j < 8; ++j) o[j] *= gv[j] * __builtin_amdgcn_rcpf(1.0f + __expf(-gv[j]));
        v4u w; w.x = pkbf(o[0], o[1]); w.y = pkbf(o[2], o[3]); w.z = pkbf(o[4], o[5]); w.w = pkbf(o[6], o[7]);
        *(v4u*)(mixb + (size_t)(t0 + t) * D_ + 8 * c64) = w; }
    WG_SYNC();
}

constexpr int KROW = 136;
constexpr int LIST_PER_HEAD = 256 * 2016;
__device__ __forceinline__ int list_off(int h, int j) { return h * LIST_PER_HEAD + 256 * (63 * j - (j * (j - 1)) / 2); }
typedef unsigned u2_t __attribute__((ext_vector_type(2)));

__device__ __forceinline__ void sincos_acc(float a, float& s, float& c) {
    const float k = __builtin_rintf(a * 0.15915494309189535f);
    float r = __builtin_fmaf(-k, 6.28125f, a);
    r = __builtin_fmaf(-k, 0.0019353071693331003f, r);
    r = __builtin_fmaf(-k, 1.0253131677018246e-11f, r);
    const float rev = r * 0.15915494309189535f;
    s = __builtin_amdgcn_sinf(rev); c = __builtin_amdgcn_cosf(rev);
}

__device__ __forceinline__ void moba_a_item(Frame& F, int item) {
    const int blk = item >> 2, h = item & 3;
    LAS float* KM = (LAS float*)(F.lds);
    const bf16* zb = (const bf16*)(F.ws + WS_Z); float* kmean_g = (float*)(F.ws + WS_KMEAN);
    const int c16 = F.tid & 15, rg = F.tid >> 4;
    float acc8[8] = {0.f, 0.f, 0.f, 0.f, 0.f, 0.f, 0.f, 0.f};
    v4u w[8];
#pragma unroll
    for (int i = 0; i < 8; ++i) w[i] = *(const v4u*)(zb + zm_off(1, h) + (size_t)(blk * 256 + rg + 32 * i) * 128 + 8 * c16);
#pragma unroll
    for (int i = 0; i < 8; ++i) { acc8[0] += bf2f(w[i].x & 0xffffu); acc8[1] += bf2f(w[i].x >> 16); acc8[2] += bf2f(w[i].y & 0xffffu); acc8[3] += bf2f(w[i].y >> 16);
                                  acc8[4] += bf2f(w[i].z & 0xffffu); acc8[5] += bf2f(w[i].z >> 16); acc8[6] += bf2f(w[i].w & 0xffffu); acc8[7] += bf2f(w[i].w >> 16); }
#pragma unroll
    for (int j = 0; j < 8; ++j) KM[rg * 128 + 8 * c16 + j] = acc8[j];
    WG_SYNC();
    if (F.tid < 128) { float sm = 0.f;
#pragma unroll
        for (int r = 0; r < 32; ++r) sm += KM[r * 128 + F.tid];
        kmean_g[(size_t)(h * 64 + blk) * 128 + F.tid] = sm * (1.0f / 256.0f); }
    WG_SYNC();
}

__device__ __forceinline__ void top3_insert(float v, int j, float& v0, float& v1, float& v2, int& i0, int& i1, int& i2) {
    const bool b0 = (v > v0) || (v == v0 && j < i0), b1 = (v > v1) || (v == v1 && j < i1), b2 = (v > v2) || (v == v2 && j < i2);
    const float n2 = b1 ? v1 : (b2 ? v : v2); const int m2 = b1 ? i1 : (b2 ? j : i2);
    const float n1 = b0 ? v0 : (b1 ? v : v1); const int m1 = b0 ? i0 : (b1 ? j : i1);
    const float n0 = b0 ? v : v0; const int m0 = b0 ? j : i0;
    v0 = n0; v1 = n1; v2 = n2; i0 = m0; i1 = m1; i2 = m2;
}
__device__ __forceinline__ void moba_b_item(Frame& F, int item) {
    const int kb = item >> 2, h = item & 3;
    if (kb == 0) return;
    LAS bf16* KMH = (LAS bf16*)(F.lds);
    LAS bf16* KML = (LAS bf16*)(F.lds + 64 * KROW * 2);
    LAS unsigned* HIST = (LAS unsigned*)(F.lds + 2 * 64 * KROW * 2);
    LAS unsigned* BASE = HIST + 64;
    const bf16* zb = (const bf16*)(F.ws + WS_Z); const float* kmean_g = (const float*)(F.ws + WS_KMEAN); unsigned* list_g = (unsigned*)(F.ws + WS_LIST);
    const int i = F.lane & 31, kk = F.lane >> 5;
    const int t = kb * 256 + F.wave * 32 + i;
    bf16x8 qf[8];
    { const bf16* qrow = zb + zm_off(0, h) + (size_t)t * 128 + 8 * kk;
#pragma unroll
      for (int s = 0; s < 8; ++s) qf[s] = *(const bf16x8*)(qrow + 16 * s); }
    for (int idx = F.tid; idx < 64 * 128; idx += 512) { const int j = idx >> 7, d = idx & 127; const float v = (j < kb) ? kmean_g[(size_t)(h * 64 + j) * 128 + d] : 0.f;
        const unsigned hi = f2bf(v); const float rem = v - bf2f(hi); KMH[j * KROW + d] = (bf16)hi; KML[j * KROW + d] = (bf16)f2bf(rem); }
    if (F.tid < 64) HIST[F.tid] = 0u;
    WG_SYNC();
    float v0 = -INFINITY, v1 = -INFINITY, v2 = -INFINITY; int i0 = 1 << 20, i1 = 1 << 20, i2 = 1 << 20;
    const int njt = (kb + 31) >> 5;
    for (int jt = 0; jt < njt; ++jt) {
        f32x16 acc;
#pragma unroll
        for (int r = 0; r < 16; ++r) acc[r] = 0.f;
#pragma unroll
        for (int s = 0; s < 8; ++s) {
            const bf16x8 ah = *(const LAS bf16x8*)(KMH + (size_t)(32 * jt + i) * KROW + 16 * s + 8 * kk), al = *(const LAS bf16x8*)(KML + (size_t)(32 * jt + i) * KROW + 16 * s + 8 * kk);
            acc = MFMA32(ah, qf[s], acc); acc = MFMA32(al, qf[s], acc);
        }
#pragma unroll
        for (int r = 0; r < 16; ++r) { const int j = 32 * jt + (r & 3) + 8 * (r >> 2) + 4 * kk; if (j < kb) top3_insert(acc[r], j, v0, v1, v2, i0, i1, i2); }
    }
    {
        const float pv0 = __shfl_xor(v0, 32), pv1 = __shfl_xor(v1, 32), pv2 = __shfl_xor(v2, 32);
        const int pi0 = __shfl_xor(i0, 32), pi1 = __shfl_xor(i1, 32), pi2 = __shfl_xor(i2, 32);
        top3_insert(pv0, pi0, v0, v1, v2, i0, i1, i2); top3_insert(pv1, pi1, v0, v1, v2, i0, i1, i2); top3_insert(pv2, pi2, v0, v1, v2, i0, i1, i2);
    }
    const int nsel = kb < 3 ? kb : 3;
    unsigned lp0 = 0, lp1 = 0, lp2 = 0;
    if (kk == 0) {
        if (nsel > 0) lp0 = atomicAdd((unsigned*)&HIST[i0], 1u);
        if (nsel > 1) lp1 = atomicAdd((unsigned*)&HIST[i1], 1u);
        if (nsel > 2) lp2 = atomicAdd((unsigned*)&HIST[i2], 1u);
    }
    WG_SYNC();
    if (F.tid < 64) { const unsigned n = HIST[F.tid]; BASE[F.tid] = n ? atomicAdd((unsigned*)(F.ctl + CW_CNT + h * 64 + F.tid), n) : 0u; }
    WG_SYNC();
    if (kk == 0) {
        if (nsel > 0) list_g[list_off(h, i0) + BASE[i0] + lp0] = (unsigned)t | (0u << 16);
        if (nsel > 1) list_g[list_off(h, i1) + BASE[i1] + lp1] = (unsigned)t | (1u << 16);
        if (nsel > 2) list_g[list_off(h, i2) + BASE[i2] + lp2] = (unsigned)t | (2u << 16);
    }
    WG_SYNC();
}

__device__ __forceinline__ void moba_load_kv(Frame& F, int h, int j, LAS bf16* KL, LAS unsigned char* VL) {
    const bf16* zb = (const bf16*)(F.ws + WS_Z);
#pragma unroll
    for (int i = 0; i < 8; ++i) { const int idx = F.tid + 512 * i, r = idx >> 4, c16 = idx & 15;
        *(LAS v4u*)(KL + (size_t)r * KROW + 8 * c16) = *(const v4u*)(zb + zm_off(1, h) + (size_t)(j * 256 + r) * 128 + 8 * c16); }
#pragma unroll
    for (int i = 0; i < 8; ++i) { const int idx = F.tid + 512 * i, r = idx >> 4, c16 = idx & 15;
        *(LAS v4u*)(VL + voff_b(r, c16)) = *(const v4u*)(zb + zm_off(2, h) + (size_t)(j * 256 + r) * 128 + 8 * c16); }
}
__device__ __forceinline__ void moba_wave_attend(const bf16x8 (&qf)[8], const LAS bf16* KL, const LAS unsigned char* VL, int nkt, int diag_kt, int i, int hh, int lane, float c2, float mc2, f32x16 (&acc)[4], float& lsum) {
    unsigned vo[8]; v_tr_offsets(lane, vo);
    for (int kt = 0; kt < nkt; ++kt) {
        f32x16 St;
#pragma unroll
        for (int r = 0; r < 16; ++r) St[r] = 0.f;
#pragma unroll
        for (int s = 0; s < 8; ++s) { const bf16x8 kf = *(const LAS bf16x8*)(KL + (size_t)(32 * kt + i) * KROW + 16 * s + 8 * hh); St = MFMA32(kf, qf[s], St); }
#pragma unroll
        for (int r = 0; r < 16; ++r) St[r] = __builtin_amdgcn_exp2f(St[r] * c2 - mc2);
        if (kt == diag_kt) {
#pragma unroll
            for (int r = 0; r < 16; ++r) { const int kl = (r & 3) + 8 * (r >> 2) + 4 * hh; if (kl > i) St[r] = 0.f; }
        }
#pragma unroll
        for (int r = 0; r < 16; ++r) lsum += St[r];
#pragma unroll
        for (int s2 = 0; s2 < 2; ++s2) {
            const bf16x8 ps = pack8(St, s2);
#pragma unroll
            for (int et = 0; et < 4; ++et) { const bf16x8 vf = v_tr_frag_o(VL, 32 * kt + 16 * s2, vo[et], vo[4 + et]); acc[et] = MFMA32(vf, ps, acc[et]); }
        }
    }
}
__device__ __forceinline__ void moba_shift(Frame& F, float& c2, float& mc2) {
    const float* gmq_ = IN_g_mq; const float* gmk_ = IN_g_mk;
    float m1 = fmaxf(fabsf(gmq_[F.lane]), fabsf(gmq_[F.lane + 64])), m2 = fmaxf(fabsf(gmk_[F.lane]), fabsf(gmk_[F.lane + 64]));
#pragma unroll
    for (int o = 1; o < 64; o <<= 1) { m1 = fmaxf(m1, __shfl_xor(m1, o)); m2 = fmaxf(m2, __shfl_xor(m2, o)); }
    c2 = 0.08838834764831845f * 1.4426950408889634f;
    mc2 = 11.313708498984761f * m1 * m2 * 1.4426950408889634f;
}

__device__ __forceinline__ void mc_decode(const LAS int* PRE, int it, int& hj, int& chunk) {
    int lo = 0, hi = 255;
    while (lo < hi) { const int mid = (lo + hi + 1) >> 1; if (PRE[mid] <= it) lo = mid; else hi = mid - 1; }
    hj = lo; chunk = it - PRE[lo];
}
__device__ __forceinline__ void mc_fetch(const Frame& F, int hj, int chunk, int n, int i, int hh, bool& active, bool& valid, int& tq, int& slot, bf16x8 (&qf)[8]) {
    const bf16* zb = (const bf16*)(F.ws + WS_Z); const unsigned* list_g = (const unsigned*)(F.ws + WS_LIST);
    const int h = hj >> 6, j = hj & 63, base = chunk * 256 + F.wave * 32;
    active = base < n; valid = false; tq = 0; slot = 0;
    if (active) {
        const int eidx = base + i; valid = eidx < n;
        const unsigned ent = list_g[list_off(h, j) + (valid ? eidx : base)];
        tq = (int)(ent & 0xffffu); slot = (int)(ent >> 16);
        const bf16* qrow = zb + zm_off(0, h) + (size_t)tq * 128 + 8 * hh;
#pragma unroll
        for (int s = 0; s < 8; ++s) qf[s] = *(const bf16x8*)(qrow + 16 * s);
    }
}
__device__ __forceinline__ void moba_c_phase(Frame& F) {
    LAS bf16* KL = (LAS bf16*)(F.lds); LAS unsigned char* VL = F.lds + 256 * KROW * 2;
    LAS int* PRE = (LAS int*)(F.lds + 256 * KROW * 2 + 65536);
    LAS int* WT = PRE + 260;
    bf16* part_g = (bf16*)((unsigned char*)F.out + OUT_PART); float* lpart_g = (float*)(F.ws + WS_LPART);
    int mycnt = 0;
    if (F.tid < 256) {
        mycnt = (int)__hip_atomic_load(F.ctl + CW_CNT + F.tid, RLX_AGENT);
        int v = (mycnt + 255) >> 8, incl = v;
#pragma unroll
        for (int o = 1; o < 64; o <<= 1) { const int u = __shfl_up(incl, o); if (F.lane >= o) incl += u; }
        if (F.lane == 63) WT[F.wave] = incl;
        PRE[F.tid] = incl - v;
    }
    WG_SYNC();
    if (F.tid < 256) { int off = 0; for (int w = 0; w < F.wave; ++w) off += WT[w]; PRE[F.tid] += off; if (F.tid == 255) PRE[256] = PRE[255] + ((mycnt + 255) >> 8); }
    WG_SYNC();
    const int T = PRE[256];
    float c2, mc2; moba_shift(F, c2, mc2);
    const int i = F.lane & 31, hh = F.lane >> 5;
    const int it0 = (int)(((long long)F.vcu * T) / F.G), it1 = (int)(((long long)(F.vcu + 1) * T) / F.G);
    int cur_hj = -1;
    int hj = 0, chunk = 0, tq = 0, slot = 0; bool active = false, valid = false; bf16x8 qf[8];
#pragma unroll
    for (int s = 0; s < 8; ++s) qf[s] = (bf16x8){0, 0, 0, 0, 0, 0, 0, 0};
    if (it0 < it1) { mc_decode(PRE, it0, hj, chunk); const int n = (int)__hip_atomic_load(F.ctl + CW_CNT + hj, RLX_AGENT); mc_fetch(F, hj, chunk, n, i, hh, active, valid, tq, slot, qf); }
    for (int it = it0; it < it1; ++it) {
        const int h = hj >> 6, j = hj & 63;
        if (hj != cur_hj) { if (cur_hj >= 0) WG_SYNC(); moba_load_kv(F, h, j, KL, VL); WG_SYNC(); cur_hj = hj; }
        int hj2 = hj, chunk2 = 0, tq2 = 0, slot2 = 0; bool active2 = false, valid2 = false; bf16x8 qf2[8];
#pragma unroll
        for (int s = 0; s < 8; ++s) qf2[s] = qf[s];
        if (it + 1 < it1) { mc_decode(PRE, it + 1, hj2, chunk2); const int n2 = (int)__hip_atomic_load(F.ctl + CW_CNT + hj2, RLX_AGENT); mc_fetch(F, hj2, chunk2, n2, i, hh, active2, valid2, tq2, slot2, qf2); }
        if (active) {
            f32x16 acc[4]; float lsum = 0.f;
#pragma unroll
            for (int et = 0; et < 4; ++et)
#pragma unroll
                for (int r = 0; r < 16; ++r) acc[et][r] = 0.f;
            moba_wave_attend(qf, KL, VL, 8, -1, i, hh, F.lane, c2, mc2, acc, lsum);
            lsum += __shfl_xor(lsum, 32);
            if (valid) {
                bf16* prow = part_g + ((size_t)(slot * 4 + h) * S_ + tq) * 128;
#pragma unroll
                for (int et = 0; et < 4; ++et)
#pragma unroll
                    for (int g2 = 0; g2 < 2; ++g2) { v4u w; w.x = pkbf(acc[et][8 * g2], acc[et][8 * g2 + 1]); w.y = pkbf(acc[et][8 * g2 + 2], acc[et][8 * g2 + 3]); w.z = pkbf(acc[et][8 * g2 + 4], acc[et][8 * g2 + 5]); w.w = pkbf(acc[et][8 * g2 + 6], acc[et][8 * g2 + 7]);
                        *(v4u*)(prow + 64 * hh + 16 * et + 8 * g2) = w; }
                if (hh == 0) lpart_g[(size_t)(slot * 4 + h) * S_ + tq] = lsum;
            }
        }
        hj = hj2; chunk = chunk2; tq = tq2; slot = slot2; active = active2; valid = valid2;
#pragma unroll
        for (int s = 0; s < 8; ++s) qf[s] = qf2[s];
    }
    WG_SYNC();
}

__device__ __forceinline__ void moba_d_item(Frame& F, int item, float c2, float mc2, unsigned* bar_w, unsigned wait_target) {
    const int blk = item >> 2, h = item & 3;
    LAS bf16* KL = (LAS bf16*)(F.lds); LAS unsigned char* VL = F.lds + 256 * KROW * 2;
    const bf16* zb = (const bf16*)(F.ws + WS_Z); const bf16* part_g = (const bf16*)((const unsigned char*)F.out + OUT_PART); const float* lpart_g = (const float*)(F.ws + WS_LPART);
    bf16* mixb = (bf16*)(F.ws + WS_MIX);
    const int i = F.lane & 31, hh = F.lane >> 5;
    const int qt = F.wave < 4 ? F.wave : 11 - F.wave;
    const int tq = blk * 256 + qt * 32 + i;
    bf16x8 qf[8];
    { const bf16* qrow = zb + zm_off(0, h) + (size_t)tq * 128 + 8 * hh;
#pragma unroll
      for (int s = 0; s < 8; ++s) qf[s] = *(const bf16x8*)(qrow + 16 * s); }
    moba_load_kv(F, h, blk, KL, VL);
    WG_SYNC();
    f32x16 acc[4]; float lsum = 0.f;
#pragma unroll
    for (int et = 0; et < 4; ++et)
#pragma unroll
        for (int r = 0; r < 16; ++r) acc[et][r] = 0.f;
    moba_wave_attend(qf, KL, VL, qt + 1, qt, i, hh, F.lane, c2, mc2, acc, lsum);
    lsum += __shfl_xor(lsum, 32);
    if (wait_target != 0u) split_wait(bar_w, SPLU(5), wait_target - 1u, true);
    const int nsel = blk < 3 ? blk : 3;
    {
        v4u pw[3][8]; float lp[3];
#pragma unroll
        for (int s = 0; s < 3; ++s) { if (s < nsel) { const bf16* prow = part_g + ((size_t)(s * 4 + h) * S_ + tq) * 128 + 64 * hh; lp[s] = lpart_g[(size_t)(s * 4 + h) * S_ + tq];
#pragma unroll
                for (int k = 0; k < 8; ++k) pw[s][k] = *(const v4u*)(prow + 8 * k); } }
#pragma unroll
        for (int s = 0; s < 3; ++s) { if (s < nsel) { lsum += lp[s];
#pragma unroll
                for (int et = 0; et < 4; ++et)
#pragma unroll
                    for (int g2 = 0; g2 < 2; ++g2) { const v4u w = pw[s][2 * et + g2];
                        acc[et][8 * g2] += bf2f(w.x & 0xffffu); acc[et][8 * g2 + 1] += bf2f(w.x >> 16); acc[et][8 * g2 + 2] += bf2f(w.y & 0xffffu); acc[et][8 * g2 + 3] += bf2f(w.y >> 16);
                        acc[et][8 * g2 + 4] += bf2f(w.z & 0xffffu); acc[et][8 * g2 + 5] += bf2f(w.z >> 16); acc[et][8 * g2 + 6] += bf2f(w.w & 0xffffu); acc[et][8 * g2 + 7] += bf2f(w.w >> 16); } } }
    }
    const float inv = 1.0f / lsum;
    WG_SYNC();
    {
        LAS bf16* orow = KL + (size_t)(qt * 32 + i) * KROW;
#pragma unroll
        for (int et = 0; et < 4; ++et)
#pragma unroll
            for (int g = 0; g < 4; ++g) { u2_t w; w.x = pkbf(acc[et][4 * g] * inv, acc[et][4 * g + 1] * inv); w.y = pkbf(acc[et][4 * g + 2] * inv, acc[et][4 * g + 3] * inv); *(LAS u2_t*)(orow + 32 * et + 8 * g + 4 * hh) = w; }
        LDS_WAIT();
#pragma unroll
        for (int k = 0; k < 8; ++k) { const int r = qt * 32 + 4 * k + (F.lane >> 4), p = F.lane & 15;
            const v4u v = *(const LAS v4u*)(KL + (size_t)r * KROW + 8 * p);
            *(v4u*)(mixb + (size_t)(blk * 256 + r) * D_ + 512 + h * 128 + 8 * p) = v; }
    }
    WG_SYNC();
}

struct Args { const void* in[18]; float* out; unsigned char* ws; int ph_lo, ph_hi, li, pad; };
#ifndef SIB_FORCE_SLOW
#define SIB_FORCE_SLOW 0
#endif
constexpr int N_PHASES = 10;
__global__ void __launch_bounds__(NWAVES * 64, 2) mk_fwd(Args args) {
    extern __shared__ __attribute__((aligned(16))) unsigned char lds[];
    Frame F;
    F.lds = (LAS unsigned char*)lds;
    F.MISC = (volatile LAS unsigned*)(F.lds + MISC_OFF);
    F.tid = threadIdx.x; F.lane = F.tid & 63; F.wave = __builtin_amdgcn_readfirstlane(F.tid >> 6);
    F.G = gridDim.x; { const int bx = blockIdx.x; F.vcu = (F.G % 8 == 0) ? (bx % 8) * (F.G / 8) + bx / 8 : bx; }
    F.ws = args.ws; F.out = args.out; F.ctl = (gu32*)(args.ws + WS_CTL);
    if (F.tid < 32) F.MISC[F.tid] = 0u;
    if (F.tid == 0) {
#pragma unroll
        for (int k = 0; k < 18; ++k) { const unsigned long long pv = (unsigned long long)args.in[k]; F.MISC[32 + 2 * k] = (unsigned)pv; F.MISC[33 + 2 * k] = (unsigned)(pv >> 32); }
    }
    __syncthreads();
    XcdBarrier bar = xcd_barrier_post((unsigned*)(F.ctl + CW_BAR) + args.li * XCD_BAR_WORDS, F.MISC + 8);
    const int lo = args.ph_lo, hi = args.ph_hi;
#define IN(k) (lo <= (k) && (k) < hi)
#define SEAM(k) do { if (IN(k) && IN((k) + 1)) xcd_barrier(bar); STAMP((k) + 1); } while (0)
    bf16* xb = (bf16*)(F.ws + WS_AB); bf16* zb = (bf16*)(F.ws + WS_Z); bf16* mixb = (bf16*)(F.ws + WS_MIX); bf16* actb = (bf16*)(F.ws + WS_ACT); bf16* erawb = (bf16*)(F.ws + WS_ERAW);

    const bool sib_cfg = (F.G == 256) && lo == 0 && hi == N_PHASES;
    const int s_pm = __builtin_amdgcn_readfirstlane(8 * ((int)blockIdx.x % 8) + ((int)blockIdx.x / 8) % 8), s_pn = __builtin_amdgcn_readfirstlane((int)blockIdx.x / 64);
    unsigned* sib_cnt = (unsigned*)(F.ctl + CW_SIB) + 16 * s_pm;
#define SEAM_SIBA(k) do { if (sib_cfg && F.MISC[21] != 0u) sib_arrive(sib_cnt); else if (IN(k) && IN((k) + 1)) xcd_barrier(bar); STAMP((k) + 1); } while (0)
#define SEAM_SIB(k, target, acq) do { if (sib_cfg && F.MISC[21] != 0u) sib_barrier(bar.bar, sib_cnt, (target), (acq)); else if (IN(k) && IN((k) + 1)) xcd_barrier(bar); STAMP((k) + 1); } while (0)
    if (sib_cfg && F.tid == 0) __hip_atomic_store(F.ctl + CW_XCC + blockIdx.x, bar.x + 1u, RLX_AGENT);

    STAMP(0);
    if (sib_cfg) {
        if (F.tid == 0) { unsigned nloc_, nx_; xcd_barrier_complete(bar.bar, bar.x, nloc_, nx_); F.MISC[8] = nloc_; F.MISC[9] = nx_; }
        WG_SYNC();
        if (IN(0)) { p0_stage_p(F); split_arrive(SPLU(7), bar.x, F.MISC[8], F.MISC[9]); p0_stage_x(F); split_arrive(SPLU(8), bar.x, F.MISC[8], F.MISC[9]); }
        STAMP(1);
        split_wait(bar.bar, SPLU(7), bar.x, true);
    } else { if (IN(0)) { p0_prologue(F); } SEAM(0); }
    if (sib_cfg) {
        if (F.tid == 0) F.MISC[21] = SIB_FORCE_SLOW ? 0u : 1u;
        WG_SYNC();
        if (F.tid < 64) { const unsigned v0 = __hip_atomic_load(F.ctl + CW_XCC + F.tid, RLX_AGENT); bool same = v0 != 0u;
#pragma unroll
            for (int k = 1; k < 4; ++k) same = same && (__hip_atomic_load(F.ctl + CW_XCC + F.tid + 64 * k, RLX_AGENT) == v0);
            if (!same) F.MISC[21] = 0u; }
        WG_SYNC();
    }
    const bool sibf = sib_cfg && F.MISC[21] != 0u;
    if (IN(1)) {
        { pg8::Gemm g{(const bf16*)(F.ws + WS_PB), (const bf16*)(F.ws + WS_WPP), S_, D_, PLE_}; pg8::StaticOrder S; S.init(S_, D_, F.G, (int)blockIdx.x);
          pg8::EpiRes<0> E{nullptr, erawb, (float*)(F.ws + WS_SSQE), D_, nullptr, nullptr, EPS_};
          pg8::gemm_phase<pg8::EpiRes<0>, pg8::StaticOrder, false, PG8_SP2>(F.lds + RING_OFF, g, S, E); }
        if (sib_cfg) split_wait(bar.bar, SPLU(8), bar.x, true);
        { pg8::Gemm g{xb, (const bf16*)(F.ws + WS_WIN), S_, ZW, D_}; pg8::StaticOrder S; S.init(S_, ZW, F.G, (int)blockIdx.x);
          const int m8_ = 4 * (F.wave & 3) + (F.lane >> 4);
          pg8::EpiZ E{zb, ZG, zm_off(0, 0), (size_t)S_ * 128, (const float*)(F.ws + WS_RSTDX), IN_pos, IN_g_mq, IN_g_mk, (PG8_LAS unsigned char*)(F.lds + RING_OFF + RING_BYTES), EPS_,
                      1.0f / powf(10000.0f, (float)(4 * m8_ + 0) / 64.0f), 1.0f / powf(10000.0f, (float)(4 * m8_ + 1) / 64.0f), 1.0f / powf(10000.0f, (float)(4 * m8_ + 2) / 64.0f), 1.0f / powf(10000.0f, (float)(4 * m8_ + 3) / 64.0f)};
          static_assert(PG8_ALIGN, "EpiZ has workgroup barriers inside: it needs ALIGN_EPI");
          pg8::gemm_phase<pg8::EpiZ, pg8::StaticOrder, true, PG8_SP2>(F.lds + RING_OFF, g, S, E); }
        if (sibf) sib_arrive(sib_cnt);
    }
    { if (sibf) sib_wait(bar.bar, sib_cnt, 4u, false); else if (IN(1) && IN(2)) xcd_barrier(bar); STAMP(2); }
    const int pit0 = sib_cfg ? 4 * s_pm + s_pn : F.vcu, pstep = sib_cfg ? 256 : F.G;
    if (IN(2)) { for (int ch = pit0; ch < 256; ch += pstep) moba_a_item(F, ch);
                 if (sib_cfg) split_arrive(SPLU(1), bar.x, F.MISC[8], F.MISC[9]);
                 for (int ch = pit0; ch < 256; ch += pstep) gla_a_chunk(F, ch); }
    { if (sib_cfg) split_arrive(SPLU(2), bar.x, F.MISC[8], F.MISC[9]); else if (IN(2) && IN(3)) xcd_barrier(bar); STAMP(3); }
    if (IN(3)) { if (sib_cfg) split_wait(bar.bar, SPLU(1), bar.x, true);
                 for (int pr = F.vcu; pr < 256; pr += F.G) moba_b_item(F, pr);
                 if (sib_cfg) { split_arrive(SPLU(3), bar.x, F.MISC[8], F.MISC[9]); split_wait(bar.bar, SPLU(2), bar.x, true); }
                 for (int pr = F.vcu; pr < 256; pr += F.G) gla_b_pair(F, pr); }
    { if (sib_cfg) split_arrive(SPLU(4), bar.x, F.MISC[8], F.MISC[9]); else if (IN(3) && IN(4)) xcd_barrier(bar); STAMP(4); }
    if (IN(4)) {
        if (sib_cfg) split_wait(bar.bar, SPLU(3), bar.x, true);
        moba_c_phase(F);
        if (sib_cfg) split_wait(bar.bar, SPLU(4), bar.x, true);
        for (;;) {
            if (F.tid == 0) F.MISC[20] = __hip_atomic_fetch_add(F.ctl + CW_GLAQ, 1u, RLX_AGENT);
            WG_SYNC();
            const int ch = (int)F.MISC[20];
            WG_SYNC();
            if (ch >= 256) break;
            gla_c_chunk(F, ch);
        }
        for (;;) {
            if (F.tid == 0) F.MISC[20] = __hip_atomic_fetch_add(F.ctl + CW_TRQ, 1u, RLX_AGENT);
            WG_SYNC();
            const int tb = (int)F.MISC[20];
            WG_SYNC();
            if (tb >= TQ_N) break;
            const int b0 = TI_EARLY + tb * TQ_BATCH;
            int lane_o = F.lane; asm volatile("" : "+v"(lane_o));
            tr_pair(F, lane_o, (LAS float*)(F.lds + RING_OFF + F.wave * 16384), b0 + F.wave, b0 + NWAVES + F.wave);
        }
    }
    {
        if (sib_cfg) split_arrive(SPLU(5), bar.x, F.MISC[8], F.MISC[9]); else if (IN(4) && IN(5)) xcd_barrier(bar);
        STAMP(5);
    }
    if (IN(5)) { float c2, mc2; moba_shift(F, c2, mc2); const unsigned wt5 = sib_cfg ? bar.x + 1u : 0u; for (int it = pit0; it < 256; it += pstep) moba_d_item(F, it, c2, mc2, bar.bar, wt5); } SEAM_SIBA(5);
    if (IN(6)) {
        pg8::Gemm g{mixb, (const bf16*)(F.ws + WS_WOUT), S_, D_, D_}; SibOrder S; S.init(S_, D_, F.G, (int)blockIdx.x); S.tmo_bar = bar.bar; S.cnt = sib_cnt; S.target = sibf ? 8u : 0u; S.acq = false;
        pg8::EpiRes<2> E{nullptr, xb, (float*)(F.ws + WS_SSQH1), D_, (const float*)(F.ws + WS_RSTDX), nullptr, EPS_};
        pg8::gemm_phase<pg8::EpiRes<2>, SibOrder, false, PG8_SP2>(F.lds + RING_OFF, g, S, E);
    }
    {
        if (sib_cfg && F.MISC[21] != 0u) { split_arrive(SPLU(6), bar.x, F.MISC[8], F.MISC[9]); sib_arrive(sib_cnt); } else if (IN(6) && IN(7)) xcd_barrier(bar);
        STAMP(7);
    }
    if (IN(7)) {
        pg8::Gemm g{xb, (const bf16*)(F.ws + WS_WUP), S_, FF_, D_}; SibOrder S; S.init(S_, FF_, F.G, (int)blockIdx.x); S.tmo_bar = bar.bar; S.cnt = sib_cnt; S.target = sibf ? 12u : 0u; S.acq = true;
        pg8::EpiScale<1, 0> E{actb, FF_, nullptr, EPS_, (const unsigned*)(SPLU(6) + SPL_DONE + 16 * bar.x), (sib_cfg && F.MISC[21] != 0u) ? 1u : 0u};
        pg8::gemm_phase<pg8::EpiScale<1, 0>, SibOrder, PG8_ALIGN, PG8_SP2>(F.lds + RING_OFF, g, S, E);
    } SEAM_SIBA(7);
    if (IN(8)) {
        pg8::Gemm g{actb, (const bf16*)(F.ws + WS_WDOWN), S_, D_, FF_}; SibOrder S; S.init(S_, D_, F.G, (int)blockIdx.x); S.tmo_bar = bar.bar; S.cnt = sib_cnt; S.target = sibf ? 16u : 0u; S.acq = false;
        pg8::EpiRes<2> E{nullptr, xb, (float*)(F.ws + WS_SSQH2), D_, nullptr, (const float*)(F.ws + WS_SSQH1), EPS_};
        pg8::gemm_phase<pg8::EpiRes<2>, SibOrder, false, PG8_SP2>(F.lds + RING_OFF, g, S, E);
    } SEAM_SIBA(8);
    if (IN(9)) {
        pg8::Gemm g{xb, (const bf16*)(F.ws + WS_WPG), S_, D_, D_}; SibOrder S; S.init(S_, D_, F.G, (int)blockIdx.x); S.tmo_bar = bar.bar; S.cnt = sib_cnt; S.target = sibf ? 20u : 0u; S.acq = true;
        pg8::EpiGate E{F.out, xb, erawb, (const float*)(F.ws + WS_SSQH2), (const float*)(F.ws + WS_SSQE), IN_g_pe, D_, EPS_};
        pg8::gemm_phase<pg8::EpiGate, SibOrder, false, PG8_SP2>(F.lds + RING_OFF, g, S, E);
    }
#ifdef PROBE_LO
    STAMP(10);
    if (blockIdx.x == 0 && F.tid == 0) {
        const unsigned long long a_ = ((unsigned long long)F.MISC[81 + 2 * PROBE_LO] << 32) | F.MISC[80 + 2 * PROBE_LO], b_ = ((unsigned long long)F.MISC[81 + 2 * PROBE_HI] << 32) | F.MISC[80 + 2 * PROBE_HI];
        const unsigned long long d_ = (b_ - a_) * PROBE_K, t0_ = rt();
        while (rt() - t0_ < d_) __builtin_amdgcn_s_sleep(8);
    }
#endif
#undef IN
#undef SEAM
}

static void launch_range(const Args& a0, int lo, int hi, int li, int grid, hipStream_t stream) {
    Args a = a0; a.ph_lo = lo; a.ph_hi = hi; a.li = li;
    hipLaunchKernelGGL(mk_fwd, dim3(grid), dim3(NWAVES * 64), LDS_BYTES, stream, a);
    const hipError_t le = hipPeekAtLastError();
    if (le != hipSuccess) fprintf(stderr, "kernel_launch: launch [%d,%d) failed: %s\n", lo, hi, hipGetErrorName(le));
}
extern "C" void kernel_launch(void* const* d_in, const int* in_sizes, int n_in, void* d_out, int out_size, void* d_ws, size_t ws_size, hipStream_t stream) {
    static int grid = 0;
    if (grid == 0) {
        if (n_in != 18 || out_size != S_ * D_ || ws_size < WS_END) { fprintf(stderr, "kernel_launch: unexpected shapes (n_in %d out %d ws %zu)\n", n_in, out_size, ws_size); grid = -1; return; }
        int dev = 0, cus = 0, per_cu = 0;
        if (hipGetDevice(&dev) != hipSuccess || hipDeviceGetAttribute(&cus, hipDeviceAttributeMultiprocessorCount, dev) != hipSuccess) { grid = -1; return; }
        if (hipFuncSetAttribute((const void*)mk_fwd, hipFuncAttributeMaxDynamicSharedMemorySize, LDS_BYTES) != hipSuccess) { fprintf(stderr, "kernel_launch: hipFuncSetAttribute failed\n"); grid = -1; return; }
        if (hipOccupancyMaxActiveBlocksPerMultiprocessor(&per_cu, (const void*)mk_fwd, NWAVES * 64, LDS_BYTES) != hipSuccess || per_cu < 1) { fprintf(stderr, "kernel_launch: occupancy query says %d\n", per_cu); per_cu = 1; }
        (void)hipGetLastError();
        grid = cus;
        if (grid != 256) fprintf(stderr, "kernel_launch: note: %d CUs\n", grid);
    }
    if (grid < 0) return;
    (void)hipMemsetAsync((char*)d_ws + WS_CTL, 0, CTL_ZERO_BYTES, stream);
    Args a{};
    for (int i = 0; i < 18; ++i) a.in[i] = d_in[i];
    a.out = (float*)d_out; a.ws = (unsigned char*)d_ws;
    launch_range(a, 0, N_PHASES, 0, grid, stream);
}
```
